# Optimizing an MI355X kernel written in HIP

```python
import math
import jax, jax.numpy as jnp
from jax import lax
import numpy as np

D_MODEL = 1024
BATCH = 1
SEQ = 16384
DEPTH = 4

D_A = 512
HEAD_DIM_A = 128
N_HEADS_A = D_A // HEAD_DIM_A
CHUNK_A = 64
N_HEADS_B = 8
HEAD_DIM_B = 64
D_B = N_HEADS_B * HEAD_DIM_B
IDX_HEADS = 8
IDX_DIM = 64
TOPK_MAX = 256
Q_BLOCK = 128
N_BUCKETS = 32
MAX_DISTANCE = 128
ALPHA = (2 * DEPTH) ** 0.25
BETA = (8 * DEPTH) ** -0.25
LN_EPS = 1e-5
RMS_EPS = 1e-6

SPLITS = [D_A, D_A, D_A, D_A, D_B, D_B, D_B, D_B, IDX_HEADS * IDX_DIM, IDX_DIM, IDX_HEADS, D_MODEL, D_MODEL]
N_IN = sum(SPLITS)

kernel_name = "hgrn2_dsa_gated_hybrid_deepnorm"


def layer_norm(x, g, b):
    xf = x.astype(jnp.float32)
    mu = jnp.mean(xf, axis=-1, keepdims=True)
    var = jnp.mean(jnp.square(xf - mu), axis=-1, keepdims=True)
    return ((xf - mu) * lax.rsqrt(var + LN_EPS) * g.astype(jnp.float32) + b.astype(jnp.float32)).astype(x.dtype)


def t5_bucket(dist):
    max_exact = N_BUCKETS // 2
    d = jnp.maximum(dist, 0)
    df = jnp.maximum(d, 1).astype(jnp.float32)
    large = max_exact + (jnp.log(df / max_exact) / math.log(MAX_DISTANCE / max_exact)
                         * (N_BUCKETS - max_exact)).astype(jnp.int32)
    large = jnp.minimum(large, N_BUCKETS - 1)
    return jnp.where(d < max_exact, d, large)


def hgrn2_mix(q, f_logit, i, lb):
    B, L, _ = q.shape
    nc = L // CHUNK_A
    f32 = jnp.float32
    fl = f_logit.astype(f32)
    lbf = lb.astype(f32)
    log_f = jnp.logaddexp(jnp.log(lbf), jnp.log1p(-lbf) + jax.nn.log_sigmoid(fl))
    k = (1.0 - lbf) * jax.nn.sigmoid(-fl)

    def heads(t):
        return t.astype(f32).reshape(B, nc, CHUNK_A, N_HEADS_A, HEAD_DIM_A).transpose(1, 0, 3, 2, 4)

    qh, kh, vh, gh = heads(q), heads(k), heads(i), heads(log_f)
    bcum = jnp.cumsum(gh, axis=-2)
    causal = jnp.tril(jnp.ones((CHUNK_A, CHUNK_A), dtype=bool))[:, :, None]

    def step(S, inp):
        qc, kc, vc, bc = inp
        o_inter = jnp.einsum('bhtk,bhkv->bhtv', qc * jnp.exp(bc), S)
        diff = bc[:, :, :, None, :] - bc[:, :, None, :, :]
        decay = jnp.where(causal, jnp.exp(jnp.where(causal, diff, 0.0)), 0.0)
        scores = jnp.einsum('bhtk,bhtsk,bhsk->bhts', qc, decay, kc)
        o = o_inter + jnp.einsum('bhts,bhsv->bhtv', scores, vc)
        b_last = bc[:, :, -1:, :]
        S = jnp.exp(b_last[:, :, 0, :, None]) * S + jnp.einsum('bhsk,bhsv->bhkv', kc * jnp.exp(b_last - bc), vc)
        return S, o

    S0 = jnp.zeros((B, N_HEADS_A, HEAD_DIM_A, HEAD_DIM_A), f32)
    _, o = lax.scan(step, S0, (qh, kh, vh, bcum))
    return o.transpose(1, 0, 3, 2, 4).reshape(B, L, N_HEADS_A, HEAD_DIM_A)


def dsa_mix(q, k, v, q_idx, k_idx, w_idx, rel_bias):
    B, L, _ = q.shape
    f32 = jnp.float32
    topk = min(TOPK_MAX, L // 4)
    nb = L // Q_BLOCK
    kh = k.reshape(B, L, N_HEADS_B, HEAD_DIM_B)
    vh = v.reshape(B, L, N_HEADS_B, HEAD_DIM_B)
    kif = k_idx.astype(f32)
    key_pos = jnp.arange(L, dtype=jnp.int32)
    bidx = jnp.arange(B)[:, None, None]

    def to_blocks(t):
        return t.reshape(B, nb, Q_BLOCK, t.shape[-1]).transpose(1, 0, 2, 3)

    def block(args):
        qb, qib, wb, start = args
        qpos = start + jnp.arange(Q_BLOCK, dtype=jnp.int32)
        causal = key_pos[None, :] <= qpos[:, None]
        qi = qib.astype(f32).reshape(B, Q_BLOCK, IDX_HEADS, IDX_DIM)
        dots = jnp.einsum('bthd,bsd->bths', qi, kif) * (IDX_DIM ** -0.5)
        score = jnp.einsum('bth,bths->bts', wb.astype(f32) * (IDX_HEADS ** -0.5), jax.nn.relu(dots))
        score = jnp.where(causal[None], score, -jnp.inf)
        _, idx = lax.top_k(score, topk)
        valid = idx <= qpos[None, :, None]
        ks = kh[bidx, idx]
        vs = vh[bidx, idx]
        qh = qb.reshape(B, Q_BLOCK, N_HEADS_B, HEAD_DIM_B)
        logits = jnp.einsum('bthd,btkhd->bhtk', qh, ks).astype(f32) * (HEAD_DIM_B ** -0.5)
        bias = rel_bias[t5_bucket(qpos[None, :, None] - idx)].astype(f32)
        logits = logits + bias.transpose(0, 3, 1, 2)
        logits = jnp.where(valid[:, None], logits, -jnp.inf)
        p = jax.nn.softmax(logits, axis=-1)
        o = jnp.einsum('bhtk,btkhd->bthd', p.astype(vs.dtype), vs)
        return o.reshape(B, Q_BLOCK, D_B)

    starts = jnp.arange(nb, dtype=jnp.int32) * Q_BLOCK
    o = lax.map(block, (to_blocks(q), to_blocks(q_idx), to_blocks(w_idx), starts))
    return o.transpose(1, 0, 2, 3).reshape(B, L, D_B)


def hybrid_layer(x, w_in, b_in, w_up_a, w_up_b, w_out, lb, norm_a_g, rel_bias, ln_g, ln_b):
    B, L, _ = x.shape
    proj = jnp.einsum('bld,dn->bln', x, w_in) + b_in
    cuts = [int(c) for c in np.cumsum(SPLITS)[:-1]]
    qa, fa, ia, za, qb, kb, vb, zb, qi, ki, wi, ga, gb = jnp.split(proj, cuts, axis=-1)
    oa = hgrn2_mix(qa, fa, ia, lb)
    oa = oa * lax.rsqrt(jnp.mean(jnp.square(oa), axis=-1, keepdims=True) + RMS_EPS)
    oa = oa.reshape(B, L, D_A) * norm_a_g.astype(jnp.float32)
    ua = jnp.einsum('blc,cd->bld', (oa.astype(x.dtype) * jax.nn.silu(za)), w_up_a)
    ob = dsa_mix(qb, kb, vb, qi, ki, wi, rel_bias)
    ub = jnp.einsum('blc,cd->bld', ob * jax.nn.silu(zb), w_up_b)
    merged = jax.nn.sigmoid(ga) * ua + jax.nn.sigmoid(gb) * ub
    y = jnp.einsum('bld,de->ble', merged, w_out)
    return layer_norm(ALPHA * x + y, ln_g, ln_b)


def setup_inputs(seed: int = 0) -> dict:
    key = jax.random.key(seed)
    ks = jax.random.split(key, 12)
    f32 = jnp.float32
    x = jax.random.normal(ks[0], (BATCH, SEQ, D_MODEL), f32)
    w_in = jax.random.normal(ks[1], (DEPTH, D_MODEL, N_IN), f32) * D_MODEL ** -0.5
    b_in = jax.random.normal(ks[2], (DEPTH, N_IN), f32) * 0.02
    w_up_a = jax.random.normal(ks[3], (DEPTH, D_A, D_MODEL), f32) * (D_A ** -0.5) * BETA
    w_up_b = jax.random.normal(ks[4], (DEPTH, D_B, D_MODEL), f32) * (D_B ** -0.5) * BETA
    w_out = jax.random.normal(ks[5], (DEPTH, D_MODEL, D_MODEL), f32) * (D_MODEL ** -0.5) * BETA
    lb_logits = jax.random.normal(ks[6], (DEPTH, D_A), f32) * 0.5
    norm_a_g = 1.0 + 0.02 * jax.random.normal(ks[7], (DEPTH, D_A), f32)
    rel_bias = jax.random.normal(ks[8], (N_BUCKETS, N_HEADS_B), f32) * 0.5
    ln_g = 1.0 + 0.02 * jax.random.normal(ks[9], (DEPTH, D_MODEL), f32)
    ln_b = 0.02 * jax.random.normal(ks[10], (DEPTH, D_MODEL), f32)
    return {"x": x, "w_in": w_in, "b_in": b_in, "w_up_a": w_up_a, "w_up_b": w_up_b, "w_out": w_out,
            "lb_logits": lb_logits, "norm_a_g": norm_a_g, "rel_bias": rel_bias, "ln_g": ln_g, "ln_b": ln_b}


def reference(x, w_in, b_in, w_up_a, w_up_b, w_out, lb_logits, norm_a_g, rel_bias, ln_g, ln_b):
    lbs = jnp.cumsum(jax.nn.softmax(lb_logits.astype(jnp.float32), axis=0), axis=0)
    lbs = lbs - lbs[0:1]
    h = x
    for layer in range(DEPTH):
        h = hybrid_layer(h, w_in[layer], b_in[layer], w_up_a[layer], w_up_b[layer], w_out[layer],
                         lbs[layer], norm_a_g[layer], rel_bias, ln_g[layer], ln_b[layer])
    return h
```

```cpp
#include <hip/hip_runtime.h>
#include <hip/hip_cooperative_groups.h>
#include <cstdio>
#include <cstdint>
namespace cg = cooperative_groups;

#define DI __device__ __forceinline__
typedef __attribute__((ext_vector_type(8))) short bf16x8;
typedef __attribute__((ext_vector_type(16))) float f32x16;
typedef __attribute__((ext_vector_type(2))) float f32x2;
typedef __attribute__((ext_vector_type(2))) __bf16 bf16x2_t;
#define MFMA(a, b, c) __builtin_amdgcn_mfma_f32_32x32x16_bf16((a), (b), (c), 0, 0, 0)

constexpr int L_ = 16384, DM = 1024, NIN = 6728, NPAD = 6784, DEPTH_ = 4;
constexpr float ALPHA_ = 1.681792830507429f;
constexpr size_t MiB = 1048576;
constexpr size_t O_WTIN = 0 * MiB, O_WUA = 14 * MiB, O_WUB = 15 * MiB, O_WOUT = 16 * MiB, O_HB = 18 * MiB,
                 O_QA = 50 * MiB, O_G = 66 * MiB, O_KK = 98 * MiB, O_IA = 114 * MiB, O_ZA = 130 * MiB,
                 O_QB = 146 * MiB, O_KB = 162 * MiB, O_VB = 178 * MiB, O_ZB = 194 * MiB, O_QI = 210 * MiB,
                 O_KI = 226 * MiB, O_WI = 228 * MiB, O_D = 228 * MiB + 512 * 1024, O_SGA = 229 * MiB,
                 O_SGB = 261 * MiB, O_US = 293 * MiB, O_SEL = 325 * MiB, O_LBS = 333 * MiB,
                 O_BAR = 333 * MiB + 65536, O_AA = 334 * MiB, O_AB = 350 * MiB, O_MG = 366 * MiB, WS_NEED = 398 * MiB;

struct Params {
  const float *x, *w_in, *b_in, *w_up_a, *w_up_b, *w_out, *lb_logits, *norm_a_g, *rel_bias, *ln_g, *ln_b;
  float* out;
  char* ws;
};

extern __shared__ __attribute__((aligned(16))) char smem[];

DI unsigned cvtpk(float lo, float hi) {
  f32x2 v = {lo, hi};
  bf16x2_t b = __builtin_convertvector(v, bf16x2_t);
  return __builtin_bit_cast(unsigned, b);
}
DI unsigned short f2bf(float x) { return (unsigned short)(cvtpk(x, 0.f) & 0xffffu); }
DI float bflo(unsigned u) { return __uint_as_float(u << 16); }
DI float bfhi(unsigned u) { return __uint_as_float(u & 0xffff0000u); }
DI float bf2f(unsigned short s) { return __uint_as_float(((unsigned)s) << 16); }
DI float sigm(float x) { return 1.f / (1.f + __expf(-x)); }
DI float silu(float x) { return x / (1.f + __expf(-x)); }
DI int crow(int r, int hi) { return (r & 3) + 8 * (r >> 2) + 4 * hi; }
DI size_t tiled_unit(int r, int k, int KS) {
  return ((size_t)(r >> 5) * KS + (k >> 4)) * 64 + (r & 31) + 32 * ((k >> 3) & 1);
}
DI float dot2(unsigned a, unsigned b, float acc) {
  asm volatile("v_dot2c_f32_bf16 %0, %1, %2" : "+v"(acc) : "v"(a), "v"(b));
  return acc;
}
template <typename T> DI T* opq(T* x) { asm volatile("" : "+s"(x)); return x; }
#define LAUNDER(pin) Params p; p.x = opq((pin).x); p.w_in = (pin).w_in; p.b_in = (pin).b_in; p.w_up_a = (pin).w_up_a; p.w_up_b = (pin).w_up_b; \
  p.w_out = (pin).w_out; p.lb_logits = (pin).lb_logits; p.norm_a_g = (pin).norm_a_g; p.rel_bias = (pin).rel_bias; p.ln_g = (pin).ln_g; \
  p.ln_b = (pin).ln_b; p.out = opq((pin).out); p.ws = opq((pin).ws);
DI int vtid() { int t = threadIdx.x; asm volatile("" : "+v"(t)); return t; }
DI void cbar() { asm volatile("" ::: "memory"); }
DI void lds_fence() { asm volatile("s_waitcnt lgkmcnt(0)" ::: "memory"); }

DI int colmap(int np) {
  if (np < 4608) return np;
  if (np < 5632) return 4680 + (np - 4608);
  if (np < 6656) return 5704 + (np - 5632);
  if (np < 6720) return 4608 + (np - 6656);
  if (np < 6728) return 4672 + (np - 6720);
  return -1;
}

DI void conv_weight(const float* __restrict__ src, int K, int ldn, int Npad, bool useMap, uint4* __restrict__ dst,
                    int gtid, int gthreads) {
  const int KS = K >> 4;
  const int total = Npad * (K >> 3);
  for (int u = gtid; u < total; u += gthreads) {
    int kg = u / Npad, n = u - kg * Npad;
    int col = useMap ? colmap(n) : n;
    float v[8];
#pragma unroll
    for (int j = 0; j < 8; ++j) v[j] = (col >= 0) ? src[(size_t)(kg * 8 + j) * ldn + col] : 0.f;
    uint4 o;
    o.x = cvtpk(v[0], v[1]); o.y = cvtpk(v[2], v[3]); o.z = cvtpk(v[4], v[5]); o.w = cvtpk(v[6], v[7]);
    dst[tiled_unit(n, kg * 8, KS)] = o;
  }
}

DI void phase0(const Params& p) {
  const int gtid = blockIdx.x * 512 + vtid(), gthreads = gridDim.x * 512;
  conv_weight(p.w_in, 1024, NIN, NPAD, true, (uint4*)(p.ws + O_WTIN), gtid, gthreads);
  uint4* hb = (uint4*)(p.ws + O_HB);
  for (int u = gtid; u < L_ * 128; u += gthreads) {
    int lane = u & 63, ks = (u >> 6) & 63, mt = u >> 12;
    int t = mt * 32 + (lane & 31), k = ks * 16 + 8 * (lane >> 5);
    const float4* s = (const float4*)(p.x + (size_t)t * DM + k);
    float4 a = s[0], b = s[1];
    uint4 o;
    o.x = cvtpk(a.x, a.y); o.y = cvtpk(a.z, a.w); o.z = cvtpk(b.x, b.y); o.w = cvtpk(b.z, b.w);
    hb[u] = o;
  }
  float* lbs = (float*)(p.ws + O_LBS);
  for (int c = gtid; c < 512; c += gthreads) {
    float l0 = p.lb_logits[c], l1 = p.lb_logits[512 + c], l2 = p.lb_logits[1024 + c], l3 = p.lb_logits[1536 + c];
    float m = fmaxf(fmaxf(l0, l1), fmaxf(l2, l3));
    float e0 = expf(l0 - m), e1 = expf(l1 - m), e2 = expf(l2 - m), e3 = expf(l3 - m);
    float inv = 1.f / (e0 + e1 + e2 + e3);
    lbs[c] = 0.f; lbs[512 + c] = e1 * inv; lbs[1024 + c] = (e1 + e2) * inv; lbs[1536 + c] = (e1 + e2 + e3) * inv;
  }
}

DI void gemm_core(const uint4* __restrict__ A, int mt0, const uint4* __restrict__ B, int nt0, int KS,
                  f32x16 (&acc)[2][2], uint4* lds) {
  const int tid = vtid(), lane = tid & 63, w = tid >> 6, wm = w >> 1, wn = w & 1;
  const int nk = KS >> 2;
  const uint4* sp[6];
#pragma unroll
  for (int r = 0; r < 6; ++r) {
    int u = tid + 512 * r;
    if (u < 2048) sp[r] = A + ((size_t)(mt0 + (u >> 8)) * KS) * 64 + (u & 255);
    else { int u2 = u - 2048; sp[r] = B + ((size_t)(nt0 + (u2 >> 8)) * KS) * 64 + (u2 & 255); }
  }
#pragma unroll
  for (int r = 0; r < 6; ++r)
    __builtin_amdgcn_global_load_lds((const unsigned*)sp[r], (unsigned*)(lds + tid + 512 * r), 16, 0, 0);
  if (nk > 1) {
#pragma unroll
    for (int r = 0; r < 6; ++r)
      __builtin_amdgcn_global_load_lds((const unsigned*)(sp[r] + 256), (unsigned*)(lds + 3072 + tid + 512 * r), 16, 0, 0);
  }
  int cb = 0;
  for (int kt = 0; kt < nk; ++kt) {
    if (kt + 1 < nk) asm volatile("s_waitcnt vmcnt(6)" ::: "memory");
    else asm volatile("s_waitcnt vmcnt(0)" ::: "memory");
    __builtin_amdgcn_s_barrier();
    asm volatile("" ::: "memory");
    if (kt + 2 < nk) {
      int nb2 = cb + 2; if (nb2 >= 3) nb2 -= 3;
      uint4* nxt = lds + nb2 * 3072;
#pragma unroll
      for (int r = 0; r < 6; ++r)
        __builtin_amdgcn_global_load_lds((const unsigned*)(sp[r] + (size_t)(kt + 2) * 256), (unsigned*)(nxt + tid + 512 * r), 16, 0, 0);
    }
    const uint4* cur = lds + cb * 3072;
#pragma unroll
    for (int ks = 0; ks < 4; ++ks) {
      bf16x8 a0 = __builtin_bit_cast(bf16x8, cur[(2 * wm + 0) * 256 + ks * 64 + lane]);
      bf16x8 a1 = __builtin_bit_cast(bf16x8, cur[(2 * wm + 1) * 256 + ks * 64 + lane]);
      bf16x8 b0 = __builtin_bit_cast(bf16x8, cur[2048 + (2 * wn + 0) * 256 + ks * 64 + lane]);
      bf16x8 b1 = __builtin_bit_cast(bf16x8, cur[2048 + (2 * wn + 1) * 256 + ks * 64 + lane]);
      acc[0][0] = MFMA(a0, b0, acc[0][0]);
      acc[0][1] = MFMA(a0, b1, acc[0][1]);
      acc[1][0] = MFMA(a1, b0, acc[1][0]);
      acc[1][1] = MFMA(a1, b1, acc[1][1]);
    }
    cb = (cb == 2) ? 0 : cb + 1;
  }
  __syncthreads();
}

DI void zero_acc(f32x16 (&acc)[2][2]) {
#pragma unroll
  for (int i = 0; i < 2; ++i)
#pragma unroll
    for (int j = 0; j < 2; ++j)
#pragma unroll
      for (int r = 0; r < 16; ++r) acc[i][j][r] = 0.f;
}

DI void p1_tile(const Params& p, int layer, int mb, int nt) {
  const int tid = vtid(), lane = tid & 63, w = tid >> 6, wm = w >> 1, wn = w & 1, hi = lane >> 5, c31 = lane & 31;
  f32x16 acc[2][2];
  zero_acc(acc);
  gemm_core((const uint4*)(p.ws + O_HB), mb * 8, (const uint4*)(p.ws + O_WTIN), nt * 4, 64, acc, (uint4*)smem);
  unsigned short* tile = (unsigned short*)smem;
  const int row0 = mb * 256;
  const float* bin = p.b_in + (size_t)layer * NIN;
  const float* lbs = (const float*)(p.ws + O_LBS) + layer * 512;
#pragma unroll
  for (int j = 0; j < 2; ++j) {
    const int col = 64 * wn + 32 * j + c31;
    const int np = nt * 128 + col;
    const int oc = colmap(np);
    const float bias = oc >= 0 ? bin[oc] : 0.f;
    float lb = 0.f;
    if (nt >= 4 && nt < 8) lb = lbs[(nt - 4) * 128 + col];
#pragma unroll
    for (int i = 0; i < 2; ++i) {
#pragma unroll
      for (int r = 0; r < 16; ++r) {
        const int row = 64 * wm + 32 * i + crow(r, hi);
        float v = acc[i][j][r] + bias;
        float o;
        if (nt < 4) o = v;
        else if (nt < 8) {
          float sg = sigm(v);
          float f = lb + (1.f - lb) * sg;
          ((float*)(p.ws + O_G))[(size_t)(row0 + row) * 512 + (nt - 4) * 128 + col] = __logf(f);
          o = (1.f - lb) * (1.f - sg);
        } else if (nt < 12) o = v;
        else if (nt < 16) o = silu(v);
        else if (nt < 20) o = v * 0.125f;
        else if (nt < 28) o = v;
        else if (nt < 32) o = silu(v);
        else if (nt < 36) o = v;
        else if (nt < 52) o = sigm(v);
        else {
          o = v;
          if (col >= 64 && col < 72)
            ((float*)(p.ws + O_WI))[(size_t)(row0 + row) * 8 + (col - 64)] = v * 0.044194173824159216f;
        }
        tile[row * 128 + col] = f2bf(o);
      }
    }
  }
  __syncthreads();
#pragma unroll
  for (int q = 0; q < 8; ++q) {
    const int u = tid + 512 * q, r = u >> 4, c8 = u & 15;
    const uint4 val = *(const uint4*)&tile[r * 128 + c8 * 8];
    const int t = row0 + r;
    if (nt >= 20 && nt < 28) {
      int w0 = __builtin_amdgcn_cvt_pk_fp8_f32(bflo(val.x), bfhi(val.x), 0, false);
      w0 = __builtin_amdgcn_cvt_pk_fp8_f32(bflo(val.y), bfhi(val.y), w0, true);
      int w1 = __builtin_amdgcn_cvt_pk_fp8_f32(bflo(val.z), bfhi(val.z), 0, false);
      w1 = __builtin_amdgcn_cvt_pk_fp8_f32(bflo(val.w), bfhi(val.w), w1, true);
      const size_t base8 = (nt < 24) ? O_KB : O_VB;
      *(uint2*)(p.ws + base8 + (size_t)t * 512 + (nt & 3) * 128 + c8 * 8) = make_uint2((unsigned)w0, (unsigned)w1);
    } else if (nt < 32) {
      size_t base;
      switch (nt >> 2) {
        case 0: base = O_QA; break; case 1: base = O_KK; break; case 2: base = O_IA; break; case 3: base = O_ZA; break;
        case 4: base = O_QB; break; case 5: base = O_KB; break; case 6: base = O_VB; break; default: base = O_ZB; break;
      }
      *(uint4*)(p.ws + base + ((size_t)t * 512 + (nt & 3) * 128 + c8 * 8) * 2) = val;
    } else if (nt < 36) {
      const int head = 2 * (nt - 32) + (c8 >> 3), d0 = (c8 & 7) * 8;
      const int item = t >> 5, tq = t & 31, mtile = tq >> 2, q4 = tq & 3;
      const int rr = (head & 3) + 4 * (q4 >> 1) + 8 * (head >> 2) + 16 * (q4 & 1);
      const int laneA = rr + 32 * ((d0 >> 3) & 1), ks = d0 >> 4;
      ((uint4*)(p.ws + O_QI))[((size_t)(item * 8 + mtile) * 4 + ks) * 64 + laneA] = val;
    } else if (nt < 44) {
      *(uint4*)(p.ws + O_SGA + ((size_t)t * 1024 + (nt - 36) * 128 + c8 * 8) * 2) = val;
    } else if (nt < 52) {
      *(uint4*)(p.ws + O_SGB + ((size_t)t * 1024 + (nt - 44) * 128 + c8 * 8) * 2) = val;
    } else {
      if (c8 < 8) {
        const int d0 = c8 * 8;
        ((uint4*)(p.ws + O_KI))[((size_t)(t >> 5) * 4 + (d0 >> 4)) * 64 + (t & 31) + 32 * ((d0 >> 3) & 1)] = val;
      }
    }
  }
  __syncthreads();
}

constexpr int CAP = 1000, SEGCAP = 250, SEGTRIG = 154;
constexpr int IX_SC = 0, IX_IX = 64000, IX_RING = 96000, IX_CNT = 161536, IX_TAU = 161792, IX_FLAG = 161856, IX_WL = 161872;

DI float key2float(unsigned k) {
  unsigned b = (k & 0x80000000u) ? (k ^ 0x80000000u) : ~k;
  return __uint_as_float(b);
}
DI unsigned float2key(float f) {
  unsigned b = __float_as_uint(f);
  return (b & 0x80000000u) ? ~b : (b ^ 0x80000000u);
}
DI int wave_prefix_incl(int x) {
  int v = x;
  v += __builtin_amdgcn_update_dpp(0, v, 0x111, 0xf, 0xf, false);
  v += __builtin_amdgcn_update_dpp(0, v, 0x112, 0xf, 0xf, false);
  v += __builtin_amdgcn_update_dpp(0, v, 0x114, 0xf, 0xf, false);
  v += __builtin_amdgcn_update_dpp(0, v, 0x118, 0xf, 0xf, false);
  v += __builtin_amdgcn_update_dpp(0, v, 0x142, 0xa, 0xf, false);
  v += __builtin_amdgcn_update_dpp(0, v, 0x143, 0xc, 0xf, false);
  return v;
}

#define SEG_ADDR(j_) (((j_) >> 2) * SEGCAP + lane + 64 * ((j_) & 3))
DI int seg_count(const int4 c4, int s_) { return s_ == 0 ? c4.x : (s_ == 1 ? c4.y : (s_ == 2 ? c4.z : c4.w)); }

DI void wave_select(float* scq, unsigned short* ixq, int* cnt4q, float* tauq, unsigned* hist, int lane, unsigned short* final_sel) {
  lds_fence();
  const int4 c4 = *(const int4*)cnt4q;
  const int n = c4.x + c4.y + c4.z + c4.w;
  unsigned u[16], v16[16];
  unsigned mm = 0, am = 0;
#pragma unroll
  for (int j = 0; j < 16; ++j) {
    const bool valid = (lane + 64 * (j & 3)) < seg_count(c4, j >> 2);
    const float sv = valid ? scq[SEG_ADDR(j)] : 0.f;
    const unsigned id = valid ? (unsigned)ixq[SEG_ADDR(j)] : 0u;
    u[j] = float2key(sv);
    v16[j] = 0xFFFFu - id;
    mm |= valid ? (1u << j) : 0u;
  }
  unsigned prefix_u = 0;
  if (n > 256) {
    int need = 256;
    int r0 = 0;
    {
      unsigned ref = 0; bool have = false;
#pragma unroll
      for (int j = 15; j >= 0; --j) if ((mm >> j) & 1u) { ref = u[j] >> 24; have = true; }
      const unsigned long long hm = __ballot(have);
      const int fl = __ffsll((long long)hm) - 1;
      ref = (unsigned)__builtin_amdgcn_readlane((int)ref, fl);
      bool same = true;
#pragma unroll
      for (int j = 0; j < 16; ++j) same = same && (!((mm >> j) & 1u) || ((u[j] >> 24) == ref));
      if (__all(same)) { prefix_u = ref << 24; r0 = 1; }
    }
    for (int r = r0; r < 6; ++r) {
      const int sh = (r < 4) ? (24 - 8 * r) : (r == 4 ? 8 : 0);
      ((uint4*)hist)[lane] = make_uint4(0, 0, 0, 0);
      lds_fence();
#pragma unroll
      for (int j = 0; j < 16; ++j) {
        const unsigned src = (r < 4) ? u[j] : v16[j];
        const unsigned dgt = (src >> sh) & 255u;
        if ((mm >> j) & 1u) atomicAdd(&hist[dgt], 1u);
      }
      lds_fence();
      const uint4 hv = ((const uint4*)hist)[lane];
      const int c0 = hv.x, c1 = hv.y, c2 = hv.z, c3 = hv.w;
      const int Lsum = c0 + c1 + c2 + c3;
      const int Pfx = wave_prefix_incl(Lsum);
      const int total = __builtin_amdgcn_readlane(Pfx, 63);
      const int S = total - Pfx + Lsum;
      const unsigned long long mask = __ballot(S >= need);
      const int lstar = 63 - __clzll((long long)mask);
      int d_, ca_, cd_;
      {
        const int accu = S - Lsum;
        if (accu + c3 >= need) { d_ = 3; ca_ = accu; cd_ = c3; }
        else if (accu + c3 + c2 >= need) { d_ = 2; ca_ = accu + c3; cd_ = c2; }
        else if (accu + c3 + c2 + c1 >= need) { d_ = 1; ca_ = accu + c3 + c2; cd_ = c1; }
        else { d_ = 0; ca_ = accu + c3 + c2 + c1; cd_ = c0; }
      }
      const int D = __builtin_amdgcn_readlane(4 * lane + d_, lstar);
      const int cntAbove = __builtin_amdgcn_readlane(ca_, lstar);
      const int cntD = __builtin_amdgcn_readlane(cd_, lstar);
#pragma unroll
      for (int j = 0; j < 16; ++j) {
        const unsigned src = (r < 4) ? u[j] : v16[j];
        const int dgt = (int)((src >> sh) & 255u);
        if ((mm >> j) & 1u) {
          if (dgt > D) { am |= (1u << j); mm &= ~(1u << j); }
          else if (dgt < D) mm &= ~(1u << j);
        }
      }
      need -= cntAbove;
      if (r < 4) prefix_u |= ((unsigned)D) << sh;
      if (cntD == need) break;
    }
  }
  const unsigned km = am | mm;
  int base = 0;
#pragma unroll
  for (int j = 0; j < 16; ++j) {
    const bool keep = (km >> j) & 1u;
    const unsigned long long m = __ballot(keep);
    const int rk = base + __popcll(m & ((1ull << lane) - 1ull));
    if (keep) {
      if (final_sel) { if (rk < 256) final_sel[rk] = (unsigned short)(0xFFFFu - v16[j]); }
      else { const int ad = (rk & 3) * SEGCAP + (rk >> 2); scq[ad] = key2float(u[j]); ixq[ad] = (unsigned short)(0xFFFFu - v16[j]); }
    }
    base += __popcll(m);
  }
  if (!final_sel && lane == 0) {
    *(int4*)cnt4q = make_int4((base + 3) >> 2, (base + 2) >> 2, (base + 1) >> 2, base >> 2);
    if (n > 256) *tauq = key2float(prefix_u);
  }
  lds_fence();
}

typedef float f32x2v __attribute__((ext_vector_type(2)));
DI float relu_(float x) { int i = __float_as_int(x); i = i > 0 ? i : 0; return __int_as_float(i); }

DI void wave_compact(float* scq, unsigned short* ixq, int* cnt4q, float* tauq, unsigned* hist, int lane) {
  lds_fence();
  const int4 c4 = *(const int4*)cnt4q;
  const int n = c4.x + c4.y + c4.z + c4.w;
  if (n <= 320) return;
  unsigned u[16], idv[16];
  unsigned vm = 0;
  unsigned umin = 0xFFFFFFFFu, umax = 0u;
#pragma unroll
  for (int j = 0; j < 16; ++j) {
    const bool valid = (lane + 64 * (j & 3)) < seg_count(c4, j >> 2);
    u[j] = valid ? float2key(scq[SEG_ADDR(j)]) : 0u;
    idv[j] = valid ? (unsigned)ixq[SEG_ADDR(j)] : 0u;
    vm |= valid ? (1u << j) : 0u;
    umin = valid ? (u[j] < umin ? u[j] : umin) : umin;
    umax = valid ? (u[j] > umax ? u[j] : umax) : umax;
  }
#pragma unroll
  for (int off = 1; off < 64; off <<= 1) {
    const unsigned a = (unsigned)__shfl_xor((int)umin, off), b = (unsigned)__shfl_xor((int)umax, off);
    umin = a < umin ? a : umin; umax = b > umax ? b : umax;
  }
  const unsigned range = umax - umin;
  const int sh = range < 256u ? 0 : (24 - __clz((int)range));
  ((uint4*)hist)[lane] = make_uint4(0, 0, 0, 0);
  lds_fence();
#pragma unroll
  for (int j = 0; j < 16; ++j)
    if ((vm >> j) & 1u) atomicAdd(&hist[(u[j] - umin) >> sh], 1u);
  lds_fence();
  const uint4 hv = ((const uint4*)hist)[lane];
  const int c0 = hv.x, c1 = hv.y, c2 = hv.z, c3 = hv.w;
  const int Lsum = c0 + c1 + c2 + c3;
  const int Pfx = wave_prefix_incl(Lsum);
  const int total = __builtin_amdgcn_readlane(Pfx, 63);
  const int S = total - Pfx + Lsum;
  const unsigned long long mask = __ballot(S >= 256);
  const int lstar = 63 - __clzll((long long)mask);
  int d_, kept_;
  {
    const int accu = S - Lsum;
    if (accu + c3 >= 256) { d_ = 3; kept_ = accu + c3; }
    else if (accu + c3 + c2 >= 256) { d_ = 2; kept_ = accu + c3 + c2; }
    else if (accu + c3 + c2 + c1 >= 256) { d_ = 1; kept_ = accu + c3 + c2 + c1; }
    else { d_ = 0; kept_ = accu + Lsum; }
  }
  const int D = __builtin_amdgcn_readlane(4 * lane + d_, lstar);
  const int kept = __builtin_amdgcn_readlane(kept_, lstar);
  if (kept > 400) return;
  int base = 0;
#pragma unroll
  for (int j = 0; j < 16; ++j) {
    const bool keep = ((vm >> j) & 1u) && ((int)((u[j] - umin) >> sh) >= D);
    const unsigned long long m = __ballot(keep);
    const int rk = base + __popcll(m & ((1ull << lane) - 1ull));
    if (keep) { const int ad = (rk & 3) * SEGCAP + (rk >> 2); scq[ad] = key2float(u[j]); ixq[ad] = (unsigned short)idv[j]; }
    base += __popcll(m);
  }
  if (lane == 0) {
    *(int4*)cnt4q = make_int4((base + 3) >> 2, (base + 2) >> 2, (base + 1) >> 2, base >> 2);
    *tauq = key2float(umin + ((unsigned)D << sh));
  }
  lds_fence();
}

#define IDX_GLDS(step, bufi) do { _Pragma("unroll") for (int r_ = 0; r_ < 4; ++r_) \
    __builtin_amdgcn_global_load_lds((const unsigned*)(ki + (size_t)(step) * 2048 + tid + 512 * r_), \
                                     (unsigned*)(ring + (bufi) * 2048 + tid + 512 * r_), 16, 0, 0); } while (0)

DI void indexer_item(const Params& p, int item) {
  const int tid = vtid(), lane = tid & 63, w = tid >> 6, g = w & 1, kg = w >> 1, hi = lane >> 5, c31 = lane & 31;
  float* sc = (float*)(smem + IX_SC);
  unsigned short* ix = (unsigned short*)(smem + IX_IX);
  uint4* ring = (uint4*)(smem + IX_RING);
  int* cnt = (int*)(smem + IX_CNT);
  volatile int* flag = (volatile int*)(smem + IX_FLAG);
  float* tauv = (float*)(smem + IX_TAU);
  const uint4* qi = (const uint4*)(p.ws + O_QI);
  const uint4* ki = (const uint4*)(p.ws + O_KI);
  const float* wi = (const float*)(p.ws + O_WI);
  const int t0 = 16 * item;
  bf16x8 a[2][4];
#pragma unroll
  for (int mt = 0; mt < 2; ++mt)
#pragma unroll
    for (int ks = 0; ks < 4; ++ks)
      a[mt][ks] = __builtin_bit_cast(bf16x8, qi[((size_t)((item >> 1) * 8 + (item & 1) * 4 + 2 * g + mt) * 4 + ks) * 64 + lane]);
  float* wl = (float*)(smem + IX_WL);
  if (tid < 128) wl[tid] = wi[(size_t)t0 * 8 + tid];
  float tau[2][2];
#pragma unroll
  for (int mt = 0; mt < 2; ++mt) { tau[mt][0] = -INFINITY; tau[mt][1] = -INFINITY; }
  if (tid < 64) cnt[tid] = 0;
  if (tid < 16) tauv[tid] = -INFINITY;
  int cntv[2][2] = {{0, 0}, {0, 0}};
  if (tid < 2) flag[tid] = 0;
  const int nsteps = (t0 + 16 + 255) >> 8;
  asm volatile("s_waitcnt vmcnt(0)" ::: "memory");
  IDX_GLDS(0, 0);
  if (nsteps > 1) { IDX_GLDS(1, 1); asm volatile("s_waitcnt vmcnt(4)" ::: "memory"); }
  else asm volatile("s_waitcnt vmcnt(0)" ::: "memory");
  __syncthreads();
  const f32x16 z = {0.f, 0.f, 0.f, 0.f, 0.f, 0.f, 0.f, 0.f, 0.f, 0.f, 0.f, 0.f, 0.f, 0.f, 0.f, 0.f};
  f32x16 Ca0, Ca1, Cb0, Cb1;
  {
    const uint4* cur = ring;
    const uint4* bp = cur + ((2 * kg + 0) * 4) * 64 + lane;
    bf16x8 b0 = __builtin_bit_cast(bf16x8, bp[0]), b1 = __builtin_bit_cast(bf16x8, bp[64]);
    bf16x8 b2 = __builtin_bit_cast(bf16x8, bp[128]), b3 = __builtin_bit_cast(bf16x8, bp[192]);
    Ca0 = MFMA(a[0][0], b0, z); Ca1 = MFMA(a[1][0], b0, z);
    Ca0 = MFMA(a[0][1], b1, Ca0); Ca1 = MFMA(a[1][1], b1, Ca1);
    Ca0 = MFMA(a[0][2], b2, Ca0); Ca1 = MFMA(a[1][2], b2, Ca1);
    Ca0 = MFMA(a[0][3], b3, Ca0); Ca1 = MFMA(a[1][3], b3, Ca1);
  }
#define IDX_SCORE(Cx, mt_, aa_, sout) do { const float4 wa_ = *(const float4*)(wl + (8 * g + 4 * (mt_) + 2 * hi + (aa_)) * 8); \
    const float4 wb_ = *(const float4*)(wl + (8 * g + 4 * (mt_) + 2 * hi + (aa_)) * 8 + 4); \
    f32x2v r0_ = {relu_(Cx[8 * (aa_) + 0]), relu_(Cx[8 * (aa_) + 1])}, r1_ = {relu_(Cx[8 * (aa_) + 2]), relu_(Cx[8 * (aa_) + 3])}; \
    f32x2v r2_ = {relu_(Cx[8 * (aa_) + 4]), relu_(Cx[8 * (aa_) + 5])}, r3_ = {relu_(Cx[8 * (aa_) + 6]), relu_(Cx[8 * (aa_) + 7])}; \
    const f32x2v w0_ = {wa_.x, wa_.y}, w1_ = {wa_.z, wa_.w}, w2_ = {wb_.x, wb_.y}, w3_ = {wb_.z, wb_.w}; \
    f32x2v ac_ = r0_ * w0_; ac_ = r1_ * w1_ + ac_; ac_ = r2_ * w2_ + ac_; ac_ = r3_ * w3_ + ac_; \
    sout = ac_.x + ac_.y; } while (0)
  const unsigned ltm = (1u << c31) - 1u;
  const int tqb = t0 + 8 * g + 2 * hi;
  const int sb0 = ((8 * g + 2 * hi) * CAP + kg * SEGCAP) * 4;
#define IDX_APPEND(sval, mt_, aa_, keyv) do { \
    const bool pr_ = ((keyv) <= tqb + 4 * (mt_) + (aa_)) && ((sval) >= tau[mt_][aa_]); \
    const unsigned long long bm_ = __builtin_amdgcn_ballot_w64(pr_); \
    const unsigned half_ = hi ? (unsigned)(bm_ >> 32) : (unsigned)bm_; \
    const int pos_ = cntv[mt_][aa_] + __popc(half_ & ltm); \
    if (pr_) { const int bo_ = sb0 + (4 * (mt_) + (aa_)) * CAP * 4 + pos_ * 4; \
      *(float*)((char*)sc + bo_) = (sval); *(unsigned short*)((char*)ix + (bo_ >> 1)) = (unsigned short)(keyv); } \
    cntv[mt_][aa_] += __popc(half_); } while (0)
#define IDX_PUBLISH() do { if (c31 == 0) { _Pragma("unroll") for (int mt_ = 0; mt_ < 2; ++mt_) _Pragma("unroll") for (int aa_ = 0; aa_ < 2; ++aa_) \
    cnt[4 * (8 * g + 4 * mt_ + 2 * hi + aa_) + kg] = cntv[mt_][aa_]; } } while (0)
  for (int j = 0; j < nsteps; ++j) {
    const uint4* cur = ring + (j & 1) * 2048;
    {
      const uint4* bp = cur + ((2 * kg + 1) * 4) * 64 + lane;
      bf16x8 b0 = __builtin_bit_cast(bf16x8, bp[0]), b1 = __builtin_bit_cast(bf16x8, bp[64]);
      bf16x8 b2 = __builtin_bit_cast(bf16x8, bp[128]), b3 = __builtin_bit_cast(bf16x8, bp[192]);
      Cb0 = MFMA(a[0][0], b0, z); Cb1 = MFMA(a[1][0], b0, z);
      Cb0 = MFMA(a[0][1], b1, Cb0); Cb1 = MFMA(a[1][1], b1, Cb1);
      Cb0 = MFMA(a[0][2], b2, Cb0); Cb1 = MFMA(a[1][2], b2, Cb1);
      Cb0 = MFMA(a[0][3], b3, Cb0); Cb1 = MFMA(a[1][3], b3, Cb1);
    }
    {
      const int key = 256 * j + 64 * kg + c31;
      float s00, s01, s10, s11;
      IDX_SCORE(Ca0, 0, 0, s00); IDX_SCORE(Ca0, 0, 1, s01); IDX_SCORE(Ca1, 1, 0, s10); IDX_SCORE(Ca1, 1, 1, s11);
#pragma unroll
      for (int q_ = 0; q_ < 8; ++q_) { __builtin_amdgcn_sched_group_barrier(0x008, 1, 0); __builtin_amdgcn_sched_group_barrier(0x002, 9, 0); }
      IDX_APPEND(s00, 0, 0, key); IDX_APPEND(s01, 0, 1, key); IDX_APPEND(s10, 1, 0, key); IDX_APPEND(s11, 1, 1, key);
    }
    IDX_PUBLISH();
    __syncthreads();
    if (j > 0 && flag[(j - 1) & 1] == j) {
      unsigned* hist = (unsigned*)(ring + (j & 1) * 2048) + w * 256;
#pragma unroll 1
      for (int k = 0; k < 2; ++k) {
        const int q = 2 * w + k;
        wave_compact(sc + q * CAP, ix + q * CAP, cnt + 4 * q, tauv + q, hist, lane);
        lds_fence();
        { const int4 cc = *(const int4*)(cnt + 4 * q); if (cc.x + cc.y + cc.z + cc.w > 400) wave_select(sc + q * CAP, ix + q * CAP, cnt + 4 * q, tauv + q, hist, lane, nullptr); }
      }
      __syncthreads();
#pragma unroll
      for (int mt = 0; mt < 2; ++mt)
#pragma unroll
        for (int aa = 0; aa < 2; ++aa) { const int ql = 8 * g + 4 * mt + 2 * hi + aa; tau[mt][aa] = tauv[ql]; cntv[mt][aa] = cnt[4 * ql + kg]; }
    }
    if (j + 2 < nsteps) IDX_GLDS(j + 2, j & 1);
    if (j + 1 < nsteps) {
      const uint4* nxt = ring + ((j + 1) & 1) * 2048;
      const uint4* bp = nxt + ((2 * kg + 0) * 4) * 64 + lane;
      bf16x8 b0 = __builtin_bit_cast(bf16x8, bp[0]), b1 = __builtin_bit_cast(bf16x8, bp[64]);
      bf16x8 b2 = __builtin_bit_cast(bf16x8, bp[128]), b3 = __builtin_bit_cast(bf16x8, bp[192]);
      Ca0 = MFMA(a[0][0], b0, z); Ca1 = MFMA(a[1][0], b0, z);
      Ca0 = MFMA(a[0][1], b1, Ca0); Ca1 = MFMA(a[1][1], b1, Ca1);
      Ca0 = MFMA(a[0][2], b2, Ca0); Ca1 = MFMA(a[1][2], b2, Ca1);
      Ca0 = MFMA(a[0][3], b3, Ca0); Ca1 = MFMA(a[1][3], b3, Ca1);
    }
    {
      const int key = 256 * j + 64 * kg + 32 + c31;
      float s00, s01, s10, s11;
      IDX_SCORE(Cb0, 0, 0, s00); IDX_SCORE(Cb0, 0, 1, s01); IDX_SCORE(Cb1, 1, 0, s10); IDX_SCORE(Cb1, 1, 1, s11);
#pragma unroll
      for (int q_ = 0; q_ < 8; ++q_) { __builtin_amdgcn_sched_group_barrier(0x008, 1, 0); __builtin_amdgcn_sched_group_barrier(0x002, 9, 0); }
      IDX_APPEND(s00, 0, 0, key); IDX_APPEND(s01, 0, 1, key); IDX_APPEND(s10, 1, 0, key); IDX_APPEND(s11, 1, 1, key);
    }
    {
      const int mxc = max(max(cntv[0][0], cntv[0][1]), max(cntv[1][0], cntv[1][1]));
      if (__ballot(mxc > SEGTRIG) != 0ull) { if (lane == 0) flag[j & 1] = j + 1; }
    }
  }
  IDX_PUBLISH();
  __syncthreads();
  unsigned short* sel = (unsigned short*)(p.ws + O_SEL);
  unsigned* hist = (unsigned*)ring + w * 512;
#pragma unroll 1
  for (int k = 0; k < 2; ++k) {
    const int q = 2 * w + k;
    wave_select(sc + q * CAP, ix + q * CAP, cnt + 4 * q, tauv + q, hist, lane, sel + (size_t)(t0 + q) * 256);
  }
  __syncthreads();
}

DI void hgrn_a_item(const Params& p, int c, int h) {
  const int tid = vtid(), lane = tid & 63, w = tid >> 6, hi = lane >> 5, c31 = lane & 31;
  float* tot = (float*)smem;
  unsigned short* kT = (unsigned short*)(smem + 2048);
  unsigned short* vT = (unsigned short*)(smem + 2048 + 18432);
  const int seg = tid >> 7, k = tid & 127;
  const float* G = (const float*)(p.ws + O_G);
  const unsigned short* KK = (const unsigned short*)(p.ws + O_KK);
  const unsigned short* IA = (const unsigned short*)(p.ws + O_IA);
  const size_t rowbase = (size_t)(64 * c + 16 * seg);
  float b[16];
  {
    float run = 0.f;
#pragma unroll
    for (int i = 0; i < 16; ++i) { run += G[(rowbase + i) * 512 + 128 * h + k]; b[i] = run; }
    tot[seg * 128 + k] = run;
  }
  __syncthreads();
  float off = 0.f, blast = 0.f;
#pragma unroll
  for (int s2 = 0; s2 < 4; ++s2) { float tv = tot[s2 * 128 + k]; if (s2 < seg) off += tv; blast += tv; }
  {
    unsigned pk[8], pv[8];
#pragma unroll
    for (int i = 0; i < 16; i += 2) {
      float k0 = bf2f(KK[(rowbase + i) * 512 + 128 * h + k]) * __expf(blast - (b[i] + off));
      float k1 = bf2f(KK[(rowbase + i + 1) * 512 + 128 * h + k]) * __expf(blast - (b[i + 1] + off));
      pk[i >> 1] = cvtpk(k0, k1);
      unsigned v0 = IA[(rowbase + i) * 512 + 128 * h + k], v1 = IA[(rowbase + i + 1) * 512 + 128 * h + k];
      pv[i >> 1] = v0 | (v1 << 16);
    }
    uint4* dk = (uint4*)(kT + k * 72 + 16 * seg);
    dk[0] = make_uint4(pk[0], pk[1], pk[2], pk[3]); dk[1] = make_uint4(pk[4], pk[5], pk[6], pk[7]);
    uint4* dv = (uint4*)(vT + k * 72 + 16 * seg);
    dv[0] = make_uint4(pv[0], pv[1], pv[2], pv[3]); dv[1] = make_uint4(pv[4], pv[5], pv[6], pv[7]);
    if (seg == 0) ((float*)(p.ws + O_D))[(size_t)(c * 4 + h) * 128 + k] = __expf(blast);
  }
  __syncthreads();
  const int mt = w >> 1;
  f32x16 acc[2];
#pragma unroll
  for (int r = 0; r < 16; ++r) { acc[0][r] = 0.f; acc[1][r] = 0.f; }
#pragma unroll
  for (int ks = 0; ks < 4; ++ks) {
    bf16x8 af = __builtin_bit_cast(bf16x8, *(const uint4*)(kT + (32 * mt + c31) * 72 + 16 * ks + 8 * hi));
#pragma unroll
    for (int jn = 0; jn < 2; ++jn) {
      const int nt = 2 * (w & 1) + jn;
      bf16x8 bfv = __builtin_bit_cast(bf16x8, *(const uint4*)(vT + (32 * nt + c31) * 72 + 16 * ks + 8 * hi));
      acc[jn] = MFMA(af, bfv, acc[jn]);
    }
  }
  char* us = p.ws + O_US + (size_t)(c * 4 + h) * 32768;
#pragma unroll
  for (int jn = 0; jn < 2; ++jn) {
    const int nt = 2 * (w & 1) + jn;
    const int v = 32 * nt + c31;
#pragma unroll
    for (int gq = 0; gq < 4; ++gq) {
      const int k0 = 32 * mt + 8 * gq;
      const size_t unit = ((size_t)(v >> 5) * 8 + (k0 >> 4)) * 64 + (v & 31) + 32 * ((k0 >> 3) & 1);
      uint2 val;
      val.x = cvtpk(acc[jn][4 * gq + 0], acc[jn][4 * gq + 1]);
      val.y = cvtpk(acc[jn][4 * gq + 2], acc[jn][4 * gq + 3]);
      *(uint2*)(us + unit * 16 + 8 * hi) = val;
    }
  }
  __syncthreads();
}

DI void hgrn_scan(const Params& p) {
  const int tid = vtid();
  if (tid >= 128) return;
  for (int pid = blockIdx.x * 128 + tid; pid < 32768; pid += gridDim.x * 128) {
    const int q4 = pid & 3, unit = (pid >> 2) & 2047, h = pid >> 13;
    const int lanep = unit & 63, ks = (unit >> 6) & 7;
    const int k = ks * 16 + 8 * (lanep >> 5) + 2 * q4;
    unsigned* us = (unsigned*)(p.ws + O_US) + (size_t)h * 8192 + unit * 4 + q4;
    const float* dd = (const float*)(p.ws + O_D) + h * 128 + k;
    float s0 = 0.f, s1 = 0.f;
    for (int c0 = 0; c0 < 256; c0 += 16) {
      unsigned uv[16];
      float2 dv[16];
#pragma unroll
      for (int i = 0; i < 16; ++i) {
        uv[i] = us[(size_t)(c0 + i) * 32768];
        dv[i] = *(const float2*)(dd + (size_t)(c0 + i) * 512);
      }
#pragma unroll
      for (int i = 0; i < 16; ++i) {
        us[(size_t)(c0 + i) * 32768] = cvtpk(s0, s1);
        s0 = fmaf(dv[i].x, s0, bflo(uv[i]));
        s1 = fmaf(dv[i].y, s1, bfhi(uv[i]));
      }
    }
  }
}

constexpr int AT_LUT = 0, AT_RB = 512, AT_WAVE = 2048, AT_WSZ = 8192 + 1024 + 16 * 528;
DI void attn_setup() {
  const int tid = vtid();
  int* lut = (int*)(smem + AT_LUT);
  if (tid < 128) {
    int d = tid;
    int bk;
    if (d < 16) bk = d;
    else {
      float df = (float)d;
      int lg = 16 + (int)(logf(df / 16.f) / 2.0794415416798357f * 16.f);
      bk = lg < 31 ? lg : 31;
    }
    lut[tid] = bk;
  }
}
DI float dppf(float v, int ctrl_sel) {
  const int iv = __builtin_bit_cast(int, v);
  int r;
  if (ctrl_sel == 0) r = __builtin_amdgcn_update_dpp(0, iv, 0xB1, 0xf, 0xf, false);
  else if (ctrl_sel == 1) r = __builtin_amdgcn_update_dpp(0, iv, 0x4E, 0xf, 0xf, false);
  else r = __builtin_amdgcn_update_dpp(0, iv, 0x141, 0xf, 0xf, false);
  return __builtin_bit_cast(float, r);
}
DI float sum8(float v) { v += dppf(v, 0); v += dppf(v, 1); v += dppf(v, 2); return v; }
DI float max8(float v) { v = fmaxf(v, dppf(v, 0)); v = fmaxf(v, dppf(v, 1)); v = fmaxf(v, dppf(v, 2)); return v; }

DI size_t prob_off(int t) {
  return t < 8192 ? O_MG + (size_t)t * 4096 : (t < 12288 ? O_AA + (size_t)(t - 8192) * 4096 : O_QI + (size_t)(t - 12288) * 4096);
}
#define MFMA8S(a, b, c) __builtin_amdgcn_mfma_f32_16x16x32_fp8_fp8((a), (b), (c), 0, 0, 0)
typedef __attribute__((ext_vector_type(4))) float f32x4v;
constexpr int AT_KROW = 528;
DI void attn_query(const Params& p, int t, int w, int lane) {
  const int h = lane >> 3, dg = lane & 7, n15 = lane & 15, quad = lane >> 4, hi = lane >> 5, c31 = lane & 31;
  const int* lut = (const int*)(smem + AT_LUT);
  const float* rb = (const float*)(smem + AT_RB);
  float* lgw = (float*)(smem + AT_WAVE + w * AT_WSZ);
  int* ixw = (int*)(smem + AT_WAVE + w * AT_WSZ + 8192);
  char* kst = smem + AT_WAVE + w * AT_WSZ + 9216;
  const int nsel = t + 1 < 256 ? t + 1 : 256;
  const unsigned short* sel = (const unsigned short*)(p.ws + O_SEL) + (size_t)t * 256;
#pragma unroll
  for (int j = 0; j < 4; ++j) {
    const int pos = lane + 64 * j;
    ixw[pos] = pos < nsel ? (int)sel[pos] : 0;
  }
  long qreg[2];
  {
    const int hq = n15 & 7;
#pragma unroll
    for (int c = 0; c < 2; ++c) {
      const uint4 qv = *(const uint4*)((const unsigned short*)(p.ws + O_QB) + (size_t)t * 512 + hq * 64 + 32 * c + 8 * quad);
      int w0 = __builtin_amdgcn_cvt_pk_fp8_f32(bflo(qv.x) * 8.f, bfhi(qv.x) * 8.f, 0, false);
      w0 = __builtin_amdgcn_cvt_pk_fp8_f32(bflo(qv.y) * 8.f, bfhi(qv.y) * 8.f, w0, true);
      int w1 = __builtin_amdgcn_cvt_pk_fp8_f32(bflo(qv.z) * 8.f, bfhi(qv.z) * 8.f, 0, false);
      w1 = __builtin_amdgcn_cvt_pk_fp8_f32(bflo(qv.w) * 8.f, bfhi(qv.w) * 8.f, w1, true);
      const long v = (long)(((unsigned long long)(unsigned)w1 << 32) | (unsigned long long)(unsigned)w0);
      qreg[c] = (n15 < 8) ? v : 0L;
    }
  }
  long bsel[16];
#pragma unroll
  for (int ks = 0; ks < 16; ++ks) bsel[ks] = (n15 == (ks >> 1)) ? qreg[ks & 1] : 0L;
  lds_fence();
  const uint4* KB16 = (const uint4*)(p.ws + O_KB);
  const uint2* VB = (const uint2*)(p.ws + O_VB);
  const int ntile = (nsel + 15) >> 4;
#define AT_KMMA(kt_) do { f32x4v acc0 = {0.f, 0.f, 0.f, 0.f}, acc1 = acc0, acc2 = acc0, acc3 = acc0; \
    const char* ar = kst + n15 * AT_KROW + 8 * quad; \
    _Pragma("unroll") for (int ks = 0; ks < 16; ks += 4) { \
      acc0 = MFMA8S(*(const long*)(ar + 32 * ks), bsel[ks], acc0); \
      acc1 = MFMA8S(*(const long*)(ar + 32 * ks + 32), bsel[ks + 1], acc1); \
      acc2 = MFMA8S(*(const long*)(ar + 32 * ks + 64), bsel[ks + 2], acc2); \
      acc3 = MFMA8S(*(const long*)(ar + 32 * ks + 96), bsel[ks + 3], acc3); } \
    const f32x4v acc = (acc0 + acc1) + (acc2 + acc3); \
    if (n15 < 8) { _Pragma("unroll") for (int i = 0; i < 4; ++i) lgw[(16 * (kt_) + 4 * quad + i) * 8 + n15] = acc[i] * 0.125f; } \
    cbar(); } while (0)
  uint4 kgA0, kgA1, kgA2, kgA3, kgA4, kgA5, kgA6, kgA7, kgB0, kgB1, kgB2, kgB3, kgB4, kgB5, kgB6, kgB7, kgC0, kgC1, kgC2, kgC3, kgC4, kgC5, kgC6, kgC7;
    { const int tl_ = (0) < ntile ? (0) : ntile - 1;
      const int4 ia_ = *(const int4*)(ixw + 16 * tl_ + 8 * hi), ib_ = *(const int4*)(ixw + 16 * tl_ + 8 * hi + 4);
      kgA0 = KB16[(size_t)ia_.x * 32 + c31]; kgA1 = KB16[(size_t)ia_.y * 32 + c31]; kgA2 = KB16[(size_t)ia_.z * 32 + c31]; kgA3 = KB16[(size_t)ia_.w * 32 + c31];
      kgA4 = KB16[(size_t)ib_.x * 32 + c31]; kgA5 = KB16[(size_t)ib_.y * 32 + c31]; kgA6 = KB16[(size_t)ib_.z * 32 + c31]; kgA7 = KB16[(size_t)ib_.w * 32 + c31]; }
    { const int tl_ = (1) < ntile ? (1) : ntile - 1;
      const int4 ia_ = *(const int4*)(ixw + 16 * tl_ + 8 * hi), ib_ = *(const int4*)(ixw + 16 * tl_ + 8 * hi + 4);
      kgB0 = KB16[(size_t)ia_.x * 32 + c31]; kgB1 = KB16[(size_t)ia_.y * 32 + c31]; kgB2 = KB16[(size_t)ia_.z * 32 + c31]; kgB3 = KB16[(size_t)ia_.w * 32 + c31];
      kgB4 = KB16[(size_t)ib_.x * 32 + c31]; kgB5 = KB16[(size_t)ib_.y * 32 + c31]; kgB6 = KB16[(size_t)ib_.z * 32 + c31]; kgB7 = KB16[(size_t)ib_.w * 32 + c31]; }
    { const int tl_ = (2) < ntile ? (2) : ntile - 1;
      const int4 ia_ = *(const int4*)(ixw + 16 * tl_ + 8 * hi), ib_ = *(const int4*)(ixw + 16 * tl_ + 8 * hi + 4);
      kgC0 = KB16[(size_t)ia_.x * 32 + c31]; kgC1 = KB16[(size_t)ia_.y * 32 + c31]; kgC2 = KB16[(size_t)ia_.z * 32 + c31]; kgC3 = KB16[(size_t)ia_.w * 32 + c31];
      kgC4 = KB16[(size_t)ib_.x * 32 + c31]; kgC5 = KB16[(size_t)ib_.y * 32 + c31]; kgC6 = KB16[(size_t)ib_.z * 32 + c31]; kgC7 = KB16[(size_t)ib_.w * 32 + c31]; }
  for (int kt = 0; kt < ntile; kt += 3) {
    { char* wr = kst + (8 * hi) * AT_KROW + c31 * 16; *(uint4*)(wr + 0 * AT_KROW) = kgA0; *(uint4*)(wr + 1 * AT_KROW) = kgA1; *(uint4*)(wr + 2 * AT_KROW) = kgA2; *(uint4*)(wr + 3 * AT_KROW) = kgA3; *(uint4*)(wr + 4 * AT_KROW) = kgA4; *(uint4*)(wr + 5 * AT_KROW) = kgA5; *(uint4*)(wr + 6 * AT_KROW) = kgA6; *(uint4*)(wr + 7 * AT_KROW) = kgA7; }
    { const int tl_ = ((kt) + 3) < ntile ? ((kt) + 3) : ntile - 1;
      const int4 ia_ = *(const int4*)(ixw + 16 * tl_ + 8 * hi), ib_ = *(const int4*)(ixw + 16 * tl_ + 8 * hi + 4);
      kgA0 = KB16[(size_t)ia_.x * 32 + c31]; kgA1 = KB16[(size_t)ia_.y * 32 + c31]; kgA2 = KB16[(size_t)ia_.z * 32 + c31]; kgA3 = KB16[(size_t)ia_.w * 32 + c31];
      kgA4 = KB16[(size_t)ib_.x * 32 + c31]; kgA5 = KB16[(size_t)ib_.y * 32 + c31]; kgA6 = KB16[(size_t)ib_.z * 32 + c31]; kgA7 = KB16[(size_t)ib_.w * 32 + c31]; }
    cbar();
    AT_KMMA(kt);
    if (kt + 1 < ntile) {
    { char* wr = kst + (8 * hi) * AT_KROW + c31 * 16; *(uint4*)(wr + 0 * AT_KROW) = kgB0; *(uint4*)(wr + 1 * AT_KROW) = kgB1; *(uint4*)(wr + 2 * AT_KROW) = kgB2; *(uint4*)(wr + 3 * AT_KROW) = kgB3; *(uint4*)(wr + 4 * AT_KROW) = kgB4; *(uint4*)(wr + 5 * AT_KROW) = kgB5; *(uint4*)(wr + 6 * AT_KROW) = kgB6; *(uint4*)(wr + 7 * AT_KROW) = kgB7; }
    { const int tl_ = ((kt + 1) + 3) < ntile ? ((kt + 1) + 3) : ntile - 1;
      const int4 ia_ = *(const int4*)(ixw + 16 * tl_ + 8 * hi), ib_ = *(const int4*)(ixw + 16 * tl_ + 8 * hi + 4);
      kgB0 = KB16[(size_t)ia_.x * 32 + c31]; kgB1 = KB16[(size_t)ia_.y * 32 + c31]; kgB2 = KB16[(size_t)ia_.z * 32 + c31]; kgB3 = KB16[(size_t)ia_.w * 32 + c31];
      kgB4 = KB16[(size_t)ib_.x * 32 + c31]; kgB5 = KB16[(size_t)ib_.y * 32 + c31]; kgB6 = KB16[(size_t)ib_.z * 32 + c31]; kgB7 = KB16[(size_t)ib_.w * 32 + c31]; }
    cbar();
    AT_KMMA(kt + 1);
    }
    if (kt + 2 < ntile) {
    { char* wr = kst + (8 * hi) * AT_KROW + c31 * 16; *(uint4*)(wr + 0 * AT_KROW) = kgC0; *(uint4*)(wr + 1 * AT_KROW) = kgC1; *(uint4*)(wr + 2 * AT_KROW) = kgC2; *(uint4*)(wr + 3 * AT_KROW) = kgC3; *(uint4*)(wr + 4 * AT_KROW) = kgC4; *(uint4*)(wr + 5 * AT_KROW) = kgC5; *(uint4*)(wr + 6 * AT_KROW) = kgC6; *(uint4*)(wr + 7 * AT_KROW) = kgC7; }
    { const int tl_ = ((kt + 2) + 3) < ntile ? ((kt + 2) + 3) : ntile - 1;
      const int4 ia_ = *(const int4*)(ixw + 16 * tl_ + 8 * hi), ib_ = *(const int4*)(ixw + 16 * tl_ + 8 * hi + 4);
      kgC0 = KB16[(size_t)ia_.x * 32 + c31]; kgC1 = KB16[(size_t)ia_.y * 32 + c31]; kgC2 = KB16[(size_t)ia_.z * 32 + c31]; kgC3 = KB16[(size_t)ia_.w * 32 + c31];
      kgC4 = KB16[(size_t)ib_.x * 32 + c31]; kgC5 = KB16[(size_t)ib_.y * 32 + c31]; kgC6 = KB16[(size_t)ib_.z * 32 + c31]; kgC7 = KB16[(size_t)ib_.w * 32 + c31]; }
    cbar();
    AT_KMMA(kt + 2);
    }
  }
  lds_fence();
  const int ngroups = (nsel + 7) >> 3;
  float mx = -INFINITY;
#pragma unroll 8
  for (int i = 0; i < 32; ++i) {
    const int kk = 8 * i + dg;
    const int myidx = ixw[kk];
    const int dist = t - myidx;
    const int bk = dist < 128 ? lut[dist < 0 ? 0 : dist] : 31;
    const float raw = lgw[kk * 8 + h];
    const float lgt = (kk < nsel) ? raw + rb[bk * 8 + h] : -INFINITY;
    lgw[kk * 8 + h] = lgt;
    mx = fmaxf(mx, lgt);
  }
  mx = max8(mx);
  float sum = 0.f;
#pragma unroll 8
  for (int i = 0; i < 32; ++i) {
    const float pv = __expf(lgw[(8 * i + dg) * 8 + h] - mx);
    sum += pv;
    lgw[(8 * i + dg) * 8 + h] = pv;
  }
  sum = sum8(sum);
  {
    const float inv = 1.f / sum;
#pragma unroll 8
    for (int i = 0; i < 32; ++i) lgw[(8 * i + dg) * 8 + h] *= inv;
  }
  lds_fence();
  {
    uint4 pk[4];
#pragma unroll
    for (int k = 0; k < 4; ++k) {
      const float4 a_ = *(const float4*)(lgw + (4 * lane + k) * 8), b_ = *(const float4*)(lgw + (4 * lane + k) * 8 + 4);
      pk[k] = make_uint4(cvtpk(a_.x, a_.y), cvtpk(a_.z, a_.w), cvtpk(b_.x, b_.y), cvtpk(b_.z, b_.w));
    }
    uint4* pdst = (uint4*)(p.ws + prob_off(t)) + lane * 4;
    pdst[0] = pk[0]; pdst[1] = pk[1]; pdst[2] = pk[2]; pdst[3] = pk[3];
  }
  lds_fence();
}

DI void attn_pv_query(const Params& p, int t, int w, int lane) {
  const int h = lane >> 3, dg = lane & 7;
  unsigned short* pl = (unsigned short*)(smem + AT_WAVE + w * AT_WSZ);
  int* ixw = (int*)(smem + AT_WAVE + w * AT_WSZ + 8192);
  const int nsel = t + 1 < 256 ? t + 1 : 256;
  const unsigned short* sel = (const unsigned short*)(p.ws + O_SEL) + (size_t)t * 256;
#pragma unroll
  for (int j = 0; j < 4; ++j) {
    const int pos = lane + 64 * j;
    ixw[pos] = pos < nsel ? (int)sel[pos] : 0;
  }
  {
    const uint4* psrc = (const uint4*)(p.ws + prob_off(t)) + lane * 4;
    uint4* pd = (uint4*)pl + lane * 4;
    const uint4 a0 = psrc[0], a1 = psrc[1], a2 = psrc[2], a3 = psrc[3];
    pd[0] = a0; pd[1] = a1; pd[2] = a2; pd[3] = a3;
  }
  lds_fence();
  const uint2* VB = (const uint2*)(p.ws + O_VB);
  const int ngroups = (nsel + 7) >> 3;
  f32x2v o01 = {0.f, 0.f}, o23 = {0.f, 0.f}, o45 = {0.f, 0.f}, o67 = {0.f, 0.f};
  uint2 kc[16], kn[16];
#define AT_VLOAD16(dst, ib) do { _Pragma("unroll") for (int q_ = 0; q_ < 4; ++q_) { const int4 i_ = *(const int4*)(ixw + (ib) + 4 * q_); \
    dst[4 * q_ + 0] = VB[(size_t)i_.x * 64 + lane]; dst[4 * q_ + 1] = VB[(size_t)i_.y * 64 + lane]; \
    dst[4 * q_ + 2] = VB[(size_t)i_.z * 64 + lane]; dst[4 * q_ + 3] = VB[(size_t)i_.w * 64 + lane]; } } while (0)
  const int ng16 = (nsel + 15) >> 4;
  AT_VLOAD16(kc, 0);
  for (int i = 0; i < ng16; ++i) {
    { const int nx = (i + 1 < ng16) ? i + 1 : i; AT_VLOAD16(kn, 16 * nx); }
    const float pa = bf2f(pl[(16 * i + dg) * 8 + h]);
    const float pbv = bf2f(pl[(16 * i + 8 + dg) * 8 + h]);
#pragma unroll
    for (int d = 0; d < 16; ++d) {
      const float pb = __shfl(d < 8 ? pa : pbv, (lane & ~7) | (d & 7));
      const f32x2v pb2 = {pb, pb};
      o01 = __builtin_amdgcn_cvt_pk_f32_fp8(kc[d].x, false) * pb2 + o01;
      o23 = __builtin_amdgcn_cvt_pk_f32_fp8(kc[d].x, true) * pb2 + o23;
      o45 = __builtin_amdgcn_cvt_pk_f32_fp8(kc[d].y, false) * pb2 + o45;
      o67 = __builtin_amdgcn_cvt_pk_f32_fp8(kc[d].y, true) * pb2 + o67;
    }
#pragma unroll
    for (int d = 0; d < 16; ++d) kc[d] = kn[d];
  }
  const uint4 zv = ((const uint4*)(p.ws + O_ZB))[(size_t)t * 64 + lane];
  uint4 ov;
  ov.x = cvtpk(o01.x * bflo(zv.x), o01.y * bfhi(zv.x));
  ov.y = cvtpk(o23.x * bflo(zv.y), o23.y * bfhi(zv.y));
  ov.z = cvtpk(o45.x * bflo(zv.z), o45.y * bfhi(zv.z));
  ov.w = cvtpk(o67.x * bflo(zv.w), o67.y * bfhi(zv.w));
  ((uint4*)(p.ws + O_AB))[tiled_unit(t, lane * 8, 32)] = ov;
  lds_fence();
}

constexpr int HC_B = 0;
constexpr int HC_QT = 33792;
constexpr int HC_QH = HC_QT + 17408;
constexpr int HC_KH = HC_QH + 17408;
constexpr int HC_VT = HC_KH + 17408;
constexpr int HC_P = HC_VT + 18432;
constexpr int HC_TOT = HC_P + 9216;
DI void hgrn_c_item(const Params& p, int layer, int c, int h) {
  const int tid = vtid(), lane = tid & 63, w = tid >> 6, hi = lane >> 5, c31 = lane & 31;
  float* bL = (float*)(smem + HC_B);
  unsigned short* qT = (unsigned short*)(smem + HC_QT);
  unsigned short* qH = (unsigned short*)(smem + HC_QH);
  unsigned short* kH = (unsigned short*)(smem + HC_KH);
  unsigned short* vT = (unsigned short*)(smem + HC_VT);
  unsigned short* P = (unsigned short*)(smem + HC_P);
  float* tot = (float*)(smem + HC_TOT);
  const float* G = (const float*)(p.ws + O_G);
  const unsigned short* KK = (const unsigned short*)(p.ws + O_KK);
  const unsigned short* IA = (const unsigned short*)(p.ws + O_IA);
  const unsigned short* QA = (const unsigned short*)(p.ws + O_QA);
  const int mt = w >> 2, nv = w & 3;
  const uint4* us = (const uint4*)(p.ws + O_US + (size_t)(c * 4 + h) * 32768);
  uint4 sfr[8];
#pragma unroll
  for (int ks = 0; ks < 8; ++ks) sfr[ks] = us[(nv * 8 + ks) * 64 + lane];
  uint4 qv_pre[2], kv_pre[2];
#pragma unroll
  for (int rep = 0; rep < 2; ++rep) {
    const int pr = tid + 512 * rep, t = pr >> 4, oc = pr & 15;
    qv_pre[rep] = *(const uint4*)(QA + (size_t)(64 * c + t) * 512 + 128 * h + oc * 8);
    kv_pre[rep] = *(const uint4*)(KK + (size_t)(64 * c + t) * 512 + 128 * h + oc * 8);
  }
  const uint4 z0_pre = *(const uint4*)((const unsigned short*)(p.ws + O_ZA) + (size_t)(64 * c + (tid >> 3)) * 512 + 128 * h + 16 * (tid & 7));
  const uint4 z1_pre = *(const uint4*)((const unsigned short*)(p.ws + O_ZA) + (size_t)(64 * c + (tid >> 3)) * 512 + 128 * h + 16 * (tid & 7) + 8);
  {
    const int seg = tid >> 7, k = tid & 127;
    const size_t rowbase = (size_t)(64 * c + 16 * seg);
    float b[16];
    float run = 0.f;
#pragma unroll
    for (int i = 0; i < 16; ++i) { run += G[(rowbase + i) * 512 + 128 * h + k]; b[i] = run; }
    tot[seg * 128 + k] = run;
    unsigned pv[8];
#pragma unroll
    for (int i = 0; i < 16; i += 2) {
      unsigned v0 = IA[(rowbase + i) * 512 + 128 * h + k], v1 = IA[(rowbase + i + 1) * 512 + 128 * h + k];
      pv[i >> 1] = v0 | (v1 << 16);
    }
    uint4* dv = (uint4*)(vT + k * 72 + 16 * seg);
    dv[0] = make_uint4(pv[0], pv[1], pv[2], pv[3]); dv[1] = make_uint4(pv[4], pv[5], pv[6], pv[7]);
    __syncthreads();
    float off = 0.f;
#pragma unroll
    for (int s2 = 0; s2 < 4; ++s2) { float tv = tot[s2 * 128 + k]; if (s2 < seg) off += tv; }
#pragma unroll
    for (int i = 0; i < 16; ++i) bL[(16 * seg + i) * 132 + k] = b[i] + off;
  }
  __syncthreads();
#pragma unroll
  for (int rep = 0; rep < 2; ++rep) {
    const int pr = tid + 512 * rep, t = pr >> 4, oc = pr & 15;
    const float4 b0 = *(const float4*)(bL + t * 132 + oc * 8), b1 = *(const float4*)(bL + t * 132 + oc * 8 + 4);
    const float4 r0 = *(const float4*)(bL + 31 * 132 + oc * 8), r1 = *(const float4*)(bL + 31 * 132 + oc * 8 + 4);
    const uint4 qv = qv_pre[rep];
    const uint4 kv = kv_pre[rep];
    const float bb[8] = {b0.x, b0.y, b0.z, b0.w, b1.x, b1.y, b1.z, b1.w};
    const float rr[8] = {r0.x, r0.y, r0.z, r0.w, r1.x, r1.y, r1.z, r1.w};
    const float qq[8] = {bflo(qv.x), bfhi(qv.x), bflo(qv.y), bfhi(qv.y), bflo(qv.z), bfhi(qv.z), bflo(qv.w), bfhi(qv.w)};
    const float kq[8] = {bflo(kv.x), bfhi(kv.x), bflo(kv.y), bfhi(kv.y), bflo(kv.z), bfhi(kv.z), bflo(kv.w), bfhi(kv.w)};
    float a1[8], a2[8], a3[8];
#pragma unroll
    for (int e = 0; e < 8; ++e) {
      a1[e] = qq[e] * __expf(bb[e]);
      a2[e] = qq[e] * __expf(bb[e] - rr[e]);
      a3[e] = kq[e] * __expf(rr[e] - bb[e]);
    }
    *(uint4*)(qT + t * 136 + oc * 8) = make_uint4(cvtpk(a1[0], a1[1]), cvtpk(a1[2], a1[3]), cvtpk(a1[4], a1[5]), cvtpk(a1[6], a1[7]));
    *(uint4*)(qH + t * 136 + oc * 8) = make_uint4(cvtpk(a2[0], a2[1]), cvtpk(a2[2], a2[3]), cvtpk(a2[4], a2[5]), cvtpk(a2[6], a2[7]));
    *(uint4*)(kH + t * 136 + oc * 8) = make_uint4(cvtpk(a3[0], a3[1]), cvtpk(a3[2], a3[3]), cvtpk(a3[4], a3[5]), cvtpk(a3[6], a3[7]));
  }
  __syncthreads();
  if (w < 4) {
    const int ms = w >> 1, ntq = w & 1;
    f32x16 sacc;
#pragma unroll
    for (int r = 0; r < 16; ++r) sacc[r] = 0.f;
#pragma unroll
    for (int ks = 0; ks < 8; ++ks) {
      bf16x8 af = __builtin_bit_cast(bf16x8, *(const uint4*)(kH + (32 * ms + c31) * 136 + 16 * ks + 8 * hi));
      bf16x8 bfv = __builtin_bit_cast(bf16x8, *(const uint4*)(qH + (32 * ntq + c31) * 136 + 16 * ks + 8 * hi));
      sacc = MFMA(af, bfv, sacc);
    }
    const int t = 32 * ntq + c31;
#pragma unroll
    for (int gq = 0; gq < 4; ++gq) {
      const int s0 = 32 * ms + 8 * gq + 4 * hi;
      float v0 = (s0 + 0 <= t) ? sacc[4 * gq + 0] : 0.f;
      float v1 = (s0 + 1 <= t) ? sacc[4 * gq + 1] : 0.f;
      float v2 = (s0 + 2 <= t) ? sacc[4 * gq + 2] : 0.f;
      float v3 = (s0 + 3 <= t) ? sacc[4 * gq + 3] : 0.f;
      uint2 val; val.x = cvtpk(v0, v1); val.y = cvtpk(v2, v3);
      *(uint2*)(P + t * 72 + s0) = val;
    }
  }
  f32x16 oacc;
#pragma unroll
  for (int r = 0; r < 16; ++r) oacc[r] = 0.f;
#pragma unroll
  for (int ks = 0; ks < 8; ++ks) {
    bf16x8 af = __builtin_bit_cast(bf16x8, *(const uint4*)(qT + (32 * mt + c31) * 136 + 16 * ks + 8 * hi));
    oacc = MFMA(af, __builtin_bit_cast(bf16x8, sfr[ks]), oacc);
  }
  __syncthreads();
#pragma unroll
  for (int ks = 0; ks < 4; ++ks) {
    bf16x8 af = __builtin_bit_cast(bf16x8, *(const uint4*)(P + (32 * mt + c31) * 72 + 16 * ks + 8 * hi));
    bf16x8 bfv = __builtin_bit_cast(bf16x8, *(const uint4*)(vT + (32 * nv + c31) * 72 + 16 * ks + 8 * hi));
    oacc = MFMA(af, bfv, oacc);
  }
  float* oL = bL;
#pragma unroll
  for (int r = 0; r < 16; ++r) oL[(32 * mt + crow(r, hi)) * 132 + 32 * nv + c31] = oacc[r];
  __syncthreads();
  {
    const int t = tid >> 3, sg = tid & 7;
    float ov[16];
#pragma unroll
    for (int e = 0; e < 16; e += 4) {
      const float4 f = *(const float4*)(oL + t * 132 + 16 * sg + e);
      ov[e] = f.x; ov[e + 1] = f.y; ov[e + 2] = f.z; ov[e + 3] = f.w;
    }
    float ss = 0.f;
#pragma unroll
    for (int e = 0; e < 16; ++e) ss = fmaf(ov[e], ov[e], ss);
    ss += __shfl_xor(ss, 1);
    ss += __shfl_xor(ss, 2);
    ss += __shfl_xor(ss, 4);
    const float rs = rsqrtf(ss * (1.f / 128.f) + 1e-6f);
    const int tg = 64 * c + t, k0 = 128 * h + 16 * sg;
    const float* ng = p.norm_a_g + (size_t)layer * 512 + k0;
    const uint4 z0 = z0_pre, z1 = z1_pre;
    const float zz[16] = {bflo(z0.x), bfhi(z0.x), bflo(z0.y), bfhi(z0.y), bflo(z0.z), bfhi(z0.z), bflo(z0.w), bfhi(z0.w),
                          bflo(z1.x), bfhi(z1.x), bflo(z1.y), bfhi(z1.y), bflo(z1.z), bfhi(z1.z), bflo(z1.w), bfhi(z1.w)};
    float rr[16];
#pragma unroll
    for (int e = 0; e < 16; ++e) rr[e] = ov[e] * rs * ng[e] * zz[e];
    uint4* aa = (uint4*)(p.ws + O_AA);
    aa[tiled_unit(tg, k0, 32)] = make_uint4(cvtpk(rr[0], rr[1]), cvtpk(rr[2], rr[3]), cvtpk(rr[4], rr[5]), cvtpk(rr[6], rr[7]));
    aa[tiled_unit(tg, k0 + 8, 32)] = make_uint4(cvtpk(rr[8], rr[9]), cvtpk(rr[10], rr[11]), cvtpk(rr[12], rr[13]), cvtpk(rr[14], rr[15]));
  }
  __syncthreads();
}

DI void acc_to_lds_bf16(f32x16 (&acc)[2][2], unsigned short* tile) {
  const int tid = vtid(), lane = tid & 63, w = tid >> 6, wm = w >> 1, wn = w & 1, hi = lane >> 5, c31 = lane & 31;
#pragma unroll
  for (int i = 0; i < 2; ++i)
#pragma unroll
    for (int j = 0; j < 2; ++j)
#pragma unroll
      for (int r = 0; r < 16; ++r)
        tile[(64 * wm + 32 * i + crow(r, hi)) * 128 + 64 * wn + 32 * j + c31] = f2bf(acc[i][j][r]);
}
DI void p5_tile(const Params& p, int mb, int nt) {
  const int tid = vtid(), lane = tid & 63, w = tid >> 6, wm = w >> 1, wn = w & 1, hi = lane >> 5, c31 = lane & 31;
  f32x16 acc[2][2];
  zero_acc(acc);
  gemm_core((const uint4*)(p.ws + O_AA), mb * 8, (const uint4*)(p.ws + O_WUA), nt * 4, 32, acc, (uint4*)smem);
  unsigned uap[2][2][8];
#pragma unroll
  for (int i = 0; i < 2; ++i)
#pragma unroll
    for (int j = 0; j < 2; ++j)
#pragma unroll
      for (int r = 0; r < 16; r += 2) uap[i][j][r >> 1] = cvtpk(acc[i][j][r], acc[i][j][r + 1]);
  zero_acc(acc);
  gemm_core((const uint4*)(p.ws + O_AB), mb * 8, (const uint4*)(p.ws + O_WUB), nt * 4, 32, acc, (uint4*)smem);
  unsigned short* tA = (unsigned short*)smem;
  unsigned short* tB = (unsigned short*)(smem + 65536);
#pragma unroll
  for (int i = 0; i < 2; ++i)
#pragma unroll
    for (int j = 0; j < 2; ++j)
#pragma unroll
      for (int r = 0; r < 16; r += 2) {
        const int o0 = (64 * wm + 32 * i + crow(r, hi)) * 128 + 64 * wn + 32 * j + c31;
        tA[o0] = (unsigned short)(uap[i][j][r >> 1] & 0xffffu);
        tA[o0 + 128] = (unsigned short)(uap[i][j][r >> 1] >> 16);
        tB[o0] = f2bf(acc[i][j][r]);
        tB[o0 + 128] = f2bf(acc[i][j][r + 1]);
      }
  __syncthreads();
  const int row0 = mb * 256;
#pragma unroll 2
  for (int q = 0; q < 8; ++q) {
    const int u = tid + 512 * q, r = u >> 4, c8 = u & 15;
    const uint4 ua = *(const uint4*)&tA[r * 128 + c8 * 8];
    const uint4 ub = *(const uint4*)&tB[r * 128 + c8 * 8];
    const int t = row0 + r, n0 = nt * 128 + c8 * 8;
    const uint4 ga = *(const uint4*)(p.ws + O_SGA + ((size_t)t * 1024 + n0) * 2);
    const uint4 gb = *(const uint4*)(p.ws + O_SGB + ((size_t)t * 1024 + n0) * 2);
    uint4 o;
    o.x = cvtpk(bflo(ga.x) * bflo(ua.x) + bflo(gb.x) * bflo(ub.x), bfhi(ga.x) * bfhi(ua.x) + bfhi(gb.x) * bfhi(ub.x));
    o.y = cvtpk(bflo(ga.y) * bflo(ua.y) + bflo(gb.y) * bflo(ub.y), bfhi(ga.y) * bfhi(ua.y) + bfhi(gb.y) * bfhi(ub.y));
    o.z = cvtpk(bflo(ga.z) * bflo(ua.z) + bflo(gb.z) * bflo(ub.z), bfhi(ga.z) * bfhi(ua.z) + bfhi(gb.z) * bfhi(ub.z));
    o.w = cvtpk(bflo(ga.w) * bflo(ua.w) + bflo(gb.w) * bflo(ub.w), bfhi(ga.w) * bfhi(ua.w) + bfhi(gb.w) * bfhi(ub.w));
    ((uint4*)(p.ws + O_MG))[tiled_unit(t, n0, 64)] = o;
  }
  __syncthreads();
}

DI void p6_tile(const Params& p, int layer, int mb, int nt) {
  const int tid = vtid(), lane = tid & 63, w = tid >> 6, wm = w >> 1, wn = w & 1, hi = lane >> 5, c31 = lane & 31;
  f32x16 acc[2][2];
  zero_acc(acc);
  gemm_core((const uint4*)(p.ws + O_MG), mb * 8, (const uint4*)(p.ws + O_WOUT), nt * 4, 64, acc, (uint4*)smem);
  const float* hin = (layer == 0) ? p.x : p.out;
#pragma unroll
  for (int i = 0; i < 2; ++i)
#pragma unroll
    for (int j = 0; j < 2; ++j)
#pragma unroll
      for (int r = 0; r < 16; ++r) {
        const size_t idx = (size_t)(mb * 256 + 64 * wm + 32 * i + crow(r, hi)) * DM + nt * 128 + 64 * wn + 32 * j + c31;
        p.out[idx] = fmaf(ALPHA_, hin[idx], acc[i][j][r]);
      }
}

DI float dpp_add_f(float v, int which) {
  const int iv = __builtin_bit_cast(int, v);
  int r;
  switch (which) {
    case 0: r = __builtin_amdgcn_update_dpp(0, iv, 0x111, 0xf, 0xf, true); break;
    case 1: r = __builtin_amdgcn_update_dpp(0, iv, 0x112, 0xf, 0xf, true); break;
    case 2: r = __builtin_amdgcn_update_dpp(0, iv, 0x114, 0xf, 0xf, true); break;
    case 3: r = __builtin_amdgcn_update_dpp(0, iv, 0x118, 0xf, 0xf, true); break;
    default: r = __builtin_amdgcn_update_dpp(0, iv, 0x142, 0xa, 0xf, false); break;
  }
  return v + __builtin_bit_cast(float, r);
}
DI float half_sum_to_last(float v) {
  v = dpp_add_f(v, 0); v = dpp_add_f(v, 1); v = dpp_add_f(v, 2); v = dpp_add_f(v, 3); v = dpp_add_f(v, 4);
  return v;
}
DI void fused_out_ln(const Params& p, int layer, int mb64) {
  const int tid = vtid(), lane = tid & 63, w = tid >> 6, hi = lane >> 5, c31 = lane & 31;
  uint4* lds = (uint4*)smem;
  const uint4* A = (const uint4*)(p.ws + O_MG) + (size_t)(2 * mb64) * 64 * 64;
#pragma unroll
  for (int r = 0; r < 16; ++r)
    __builtin_amdgcn_global_load_lds((const unsigned*)(A + tid + 512 * r), (unsigned*)(lds + tid + 512 * r), 16, 0, 0);
  const uint4* Bw = (const uint4*)(p.ws + O_WOUT) + (size_t)(4 * w) * 64 * 64 + lane;
  uint4 bq[4][4];
#pragma unroll
  for (int s_ = 0; s_ < 4; ++s_)
#pragma unroll
    for (int j = 0; j < 4; ++j) bq[s_][j] = Bw[(size_t)(j * 64 + s_) * 64];
  f32x16 acc[2][4];
#pragma unroll
  for (int i = 0; i < 2; ++i)
#pragma unroll
    for (int j = 0; j < 4; ++j)
#pragma unroll
      for (int r = 0; r < 16; ++r) acc[i][j][r] = 0.f;
  __syncthreads();
#pragma unroll 1
  for (int k4 = 0; k4 < 16; ++k4) {
#pragma unroll
    for (int s_ = 0; s_ < 4; ++s_) {
      const int ks = 4 * k4 + s_;
      const bf16x8 a0 = __builtin_bit_cast(bf16x8, lds[ks * 64 + lane]);
      const bf16x8 a1 = __builtin_bit_cast(bf16x8, lds[4096 + ks * 64 + lane]);
#pragma unroll
      for (int j = 0; j < 4; ++j) {
        const bf16x8 b = __builtin_bit_cast(bf16x8, bq[s_][j]);
        acc[0][j] = MFMA(a0, b, acc[0][j]);
        acc[1][j] = MFMA(a1, b, acc[1][j]);
      }
      if (k4 < 15) {
#pragma unroll
        for (int j = 0; j < 4; ++j) bq[s_][j] = Bw[(size_t)(j * 64 + ks + 4) * 64];
      }
    }
  }
  const float* hin = (layer == 0) ? p.x : p.out;
  float* ft = (float*)smem;
  uint2* hb2 = (uint2*)(p.ws + O_HB);
  const int rr = tid >> 4, seg = tid & 15;
#pragma unroll
  for (int i = 0; i < 2; ++i) {
    __syncthreads();
    {
      float* b0 = ft + (4 * hi) * 1024 + 128 * w + c31;
      float* b1 = b0 + 16 * 1024;
#pragma unroll
      for (int j = 0; j < 4; ++j)
#pragma unroll
        for (int r = 0; r < 16; ++r) {
          float* bp = (r < 8) ? b0 : b1;
          bp[((r & 3) + 8 * ((r >> 2) & 1)) * 1024 + 32 * j] = acc[i][j][r];
        }
    }
    __syncthreads();
    const int trow = 64 * mb64 + 32 * i + rr;
    const float* hrow = hin + (size_t)trow * DM;
    float s1 = 0.f, s2 = 0.f;
    float* frow = ft + rr * 1024 + 4 * seg;
#pragma unroll 4
    for (int e = 0; e < 16; ++e) {
      const float4 y = *(const float4*)(frow + 64 * e);
      const float4 hv = *(const float4*)(hrow + 64 * e + 4 * seg);
      float4 pre;
      pre.x = fmaf(ALPHA_, hv.x, y.x); pre.y = fmaf(ALPHA_, hv.y, y.y); pre.z = fmaf(ALPHA_, hv.z, y.z); pre.w = fmaf(ALPHA_, hv.w, y.w);
      s1 += (pre.x + pre.y) + (pre.z + pre.w);
      s2 = fmaf(pre.x, pre.x, s2); s2 = fmaf(pre.y, pre.y, s2); s2 = fmaf(pre.z, pre.z, s2); s2 = fmaf(pre.w, pre.w, s2);
      *(float4*)(frow + 64 * e) = pre;
    }
    s1 += __shfl_xor(s1, 1); s1 += __shfl_xor(s1, 2); s1 += __shfl_xor(s1, 4); s1 += __shfl_xor(s1, 8);
    s2 += __shfl_xor(s2, 1); s2 += __shfl_xor(s2, 2); s2 += __shfl_xor(s2, 4); s2 += __shfl_xor(s2, 8);
    const float mu = s1 * (1.f / 1024.f);
    const float rs = rsqrtf(fmaxf(s2 * (1.f / 1024.f) - mu * mu, 0.f) + 1e-5f);
    const float* gp = p.ln_g + (size_t)layer * DM;
    const float* bp2 = p.ln_b + (size_t)layer * DM;
    float* orow = p.out + (size_t)trow * DM;
#pragma unroll 4
    for (int e = 0; e < 16; ++e) {
      const int c0 = 64 * e + 4 * seg;
      const float4 pre = *(const float4*)(frow + 64 * e);
      const float4 g4 = *(const float4*)(gp + c0), b4 = *(const float4*)(bp2 + c0);
      float4 o;
      o.x = (pre.x - mu) * rs * g4.x + b4.x; o.y = (pre.y - mu) * rs * g4.y + b4.y;
      o.z = (pre.z - mu) * rs * g4.z + b4.z; o.w = (pre.w - mu) * rs * g4.w + b4.w;
      *(float4*)(orow + c0) = o;
      hb2[tiled_unit(trow, c0 & ~7, 64) * 2 + ((c0 >> 2) & 1)] = make_uint2(cvtpk(o.x, o.y), cvtpk(o.z, o.w));
    }
  }
  __syncthreads();
}

DI void p7_rows(const Params& p, int layer) {
  const int tid = vtid();
  const int lane = tid & 63, gw = blockIdx.x * 8 + (tid >> 6), nw = gridDim.x * 8;
  const float* g = p.ln_g + (size_t)layer * DM;
  const float* bb = p.ln_b + (size_t)layer * DM;
  uint4* hb = (uint4*)(p.ws + O_HB);
  for (int t = gw; t < L_; t += nw) {
    float* row = p.out + (size_t)t * DM;
    float v[16];
#pragma unroll
    for (int q = 0; q < 2; ++q) {
      const float4 a = *(const float4*)(row + q * 512 + lane * 8), b = *(const float4*)(row + q * 512 + lane * 8 + 4);
      v[8 * q + 0] = a.x; v[8 * q + 1] = a.y; v[8 * q + 2] = a.z; v[8 * q + 3] = a.w;
      v[8 * q + 4] = b.x; v[8 * q + 5] = b.y; v[8 * q + 6] = b.z; v[8 * q + 7] = b.w;
    }
    float s = 0.f;
#pragma unroll
    for (int e = 0; e < 16; ++e) s += v[e];
#pragma unroll
    for (int off = 1; off < 64; off <<= 1) s += __shfl_xor(s, off);
    const float mu = s * (1.f / 1024.f);
    float ss = 0.f;
#pragma unroll
    for (int e = 0; e < 16; ++e) { const float d = v[e] - mu; ss = fmaf(d, d, ss); }
#pragma unroll
    for (int off = 1; off < 64; off <<= 1) ss += __shfl_xor(ss, off);
    const float rs = rsqrtf(ss * (1.f / 1024.f) + 1e-5f);
#pragma unroll
    for (int q = 0; q < 2; ++q) {
      const int k0 = q * 512 + lane * 8;
      float o[8];
#pragma unroll
      for (int e = 0; e < 8; ++e) o[e] = (v[8 * q + e] - mu) * rs * g[k0 + e] + bb[k0 + e];
      *(float4*)(row + k0) = make_float4(o[0], o[1], o[2], o[3]);
      *(float4*)(row + k0 + 4) = make_float4(o[4], o[5], o[6], o[7]);
      hb[tiled_unit(t, k0, 64)] = make_uint4(cvtpk(o[0], o[1]), cvtpk(o[2], o[3]), cvtpk(o[4], o[5]), cvtpk(o[6], o[7]));
    }
  }
}


#define XB_TMO      128
#define XB_XCNT(j)  (256  + 64 * (j))
#define XB_XSUB(j)  (1280 + 64 * (j))
#define XB_XGEN(j)  (2304 + 64 * (j))
#define XB_TOP      3328
#define XB_TOPGEN   3392
#define XCD_BAR_WORDS 3456
#define XB_SPIN_CAP (1u << 22)
#define LAS __attribute__((address_space(3)))
DI unsigned xb_ld(unsigned* p)              { return __hip_atomic_load(p, __ATOMIC_RELAXED, __HIP_MEMORY_SCOPE_AGENT); }
DI unsigned xb_add(unsigned* p, unsigned v) { return __hip_atomic_fetch_add(p, v, __ATOMIC_RELAXED, __HIP_MEMORY_SCOPE_AGENT); }
DI unsigned xb_xcc_id() { return (unsigned)__builtin_amdgcn_s_getreg((3 << 11) | 20) & 0xFu; }
#define XB_SPIN(cond, bar) do { unsigned _sp = 0; while (cond) { __builtin_amdgcn_s_sleep(1); \
    if ((++_sp & 255u) == 0u) { if (xb_ld(&(bar)[XB_TMO])) break; if (_sp > XB_SPIN_CAP) { atomicAdd(&(bar)[XB_TMO], 1u); break; } } } } while (0)
struct XcdBarrier { unsigned* bar; unsigned x; volatile LAS unsigned* st; };
DI XcdBarrier xcd_barrier_post(unsigned* bar, volatile LAS unsigned* st) {
  XcdBarrier b; b.bar = bar; b.x = xb_xcc_id(); b.st = st;
  if (threadIdx.x == 0) (void)xb_add(&bar[XB_XCNT(b.x)], 1u);
  return b;
}
DI void xcd_barrier_complete(unsigned* bar, unsigned x, unsigned& nloc, unsigned& nx) {
  const unsigned G = gridDim.x * gridDim.y * gridDim.z;
  unsigned sum, cnt, mine, sp = 0u;
  for (;;) {
    sum = 0u; cnt = 0u; mine = 0u;
#pragma unroll
    for (unsigned j = 0; j < 16; ++j) { const unsigned c = xb_ld(&bar[XB_XCNT(j)]); sum += c; cnt += (c > 0u) ? 1u : 0u; mine = (j == x) ? c : mine; }
    if (sum == G) break;
    __builtin_amdgcn_s_sleep(1);
    if ((++sp & 255u) == 0u) { if (xb_ld(&bar[XB_TMO])) break; if (sp > XB_SPIN_CAP) { atomicAdd(&bar[XB_TMO], 1u); break; } }
  }
  nloc = mine > 0u ? mine : 1u; nx = cnt > 0u ? cnt : 1u;
}
DI void xcd_barrier(const XcdBarrier& b) {
  asm volatile("s_waitcnt vmcnt(0)" ::: "memory");
  __syncthreads();
  if (threadIdx.x == 0) {
    unsigned* bar = b.bar;
    __builtin_amdgcn_s_waitcnt(0);
    unsigned nloc = b.st[0], nx = b.st[1];
    if (nloc == 0u) { xcd_barrier_complete(bar, b.x, nloc, nx); b.st[0] = nloc; b.st[1] = nx; }
    const unsigned old = xb_add(&bar[XB_XSUB(b.x)], 1u);
    const unsigned gen = old / nloc;
    if (old + 1u == (gen + 1u) * nloc) {
      __builtin_amdgcn_fence(__ATOMIC_RELEASE, "agent");
      asm volatile("s_waitcnt vmcnt(0)" ::: "memory");
      const unsigned og = xb_add(&bar[XB_TOP], 1u);
      const unsigned tg = og / nx;
      if (og + 1u == (tg + 1u) * nx) xb_add(&bar[XB_TOPGEN], 1u);
      else XB_SPIN(xb_ld(&bar[XB_TOPGEN]) == tg, bar);
      __builtin_amdgcn_fence(__ATOMIC_ACQUIRE, "agent");
      xb_add(&bar[XB_XGEN(b.x)], 1u);
      asm volatile("s_waitcnt vmcnt(0)" ::: "memory");
    } else {
      XB_SPIN(xb_ld(&bar[XB_XGEN(b.x)]) == gen, bar);
      __builtin_amdgcn_fence(__ATOMIC_ACQUIRE, "agent");
      asm volatile("s_waitcnt vmcnt(0)" ::: "memory");
    }
  }
  __syncthreads();
}
constexpr int LDS_BARST = 163840 - 16;

__global__ void __launch_bounds__(512) mk(Params p) {
  cg::grid_group grid = cg::this_grid();
  const int nb = gridDim.x, bid = blockIdx.x;
  volatile LAS unsigned* bst_ = (volatile LAS unsigned*)(smem + LDS_BARST);
  if (threadIdx.x < 4) bst_[threadIdx.x] = 0u;
  __syncthreads();
  (void)xcd_barrier_post((unsigned*)(p.ws + O_BAR), bst_);
#define XB_NOW() XcdBarrier{(unsigned*)(p.ws + O_BAR), xb_xcc_id(), (volatile LAS unsigned*)(smem + LDS_BARST)}
  phase0(p);
  grid.sync();
  for (int layer = 0; layer < DEPTH_; ++layer) {
    {
      const int gtid = bid * 512 + vtid(), gthreads = nb * 512;
      conv_weight(p.w_up_a + (size_t)layer * 512 * 1024, 512, 1024, 1024, false, (uint4*)(p.ws + O_WUA), gtid, gthreads);
      conv_weight(p.w_up_b + (size_t)layer * 512 * 1024, 512, 1024, 1024, false, (uint4*)(p.ws + O_WUB), gtid, gthreads);
      conv_weight(p.w_out + (size_t)layer * 1024 * 1024, 1024, 1024, 1024, false, (uint4*)(p.ws + O_WOUT), gtid, gthreads);
#ifndef NO_P1
      for (int id = bid; id < 64 * 53; id += nb) p1_tile(p, layer, id & 63, id >> 6);
#endif
    }
    xcd_barrier(XB_NOW());
    {
      if (layer + 1 < DEPTH_) {
        const int gtid = bid * 512 + vtid(), gthreads = nb * 512;
        conv_weight(p.w_in + (size_t)(layer + 1) * 1024 * NIN, 1024, NIN, NPAD, true, (uint4*)(p.ws + O_WTIN), gtid, gthreads);
      }
#ifndef NO_HA
      for (int id = bid; id < 1024; id += nb) hgrn_a_item(p, id >> 2, id & 3);
#endif
      for (int s = bid; s < 1024; s += nb) {
        const int rnd = s / nb, pos = s - rnd * nb;
        const int rem = 1024 - rnd * nb, count = rem < nb ? rem : nb;
        const int sp = (rnd & 1) ? (rnd * nb + count - 1 - pos) : s;
        indexer_item(p, 1023 - sp);
      }
    }
    xcd_barrier(XB_NOW());
    {
      attn_setup();
      const int tid = vtid();
      if (tid < 256) ((float*)(smem + AT_RB))[tid] = p.rel_bias[tid];
      __syncthreads();
#ifndef NO_SCAN
      hgrn_scan(p);
#endif
      const int w = tid >> 6, lane = tid & 63;
#ifndef NO_ATT
      for (int t = bid * 8 + w; t < L_; t += nb * 8) attn_query(p, t, w, lane);
#endif
      __syncthreads();
    }
    xcd_barrier(XB_NOW());
    {
      const int tid = vtid();
      const int w = tid >> 6, lane = tid & 63;
      for (int t = bid * 8 + w; t < L_; t += nb * 8) attn_pv_query(p, t, w, lane);
      __syncthreads();
    }
    xcd_barrier(XB_NOW());
#ifndef NO_HC
    for (int id = bid; id < 1024; id += nb) hgrn_c_item(p, layer, id >> 2, id & 3);
#endif
    xcd_barrier(XB_NOW());
#ifndef NO_P5
    for (int id = bid; id < 64 * 8; id += nb) p5_tile(p, id & 63, id >> 6);
#endif
    xcd_barrier(XB_NOW());
    for (int id = bid; id < 256; id += nb) fused_out_ln(p, layer, id);
    xcd_barrier(XB_NOW());
  }}

extern "C" void kernel_launch(void* const* d_in, const int* in_sizes, int n_in, void* d_out, int out_size, void* d_ws,
                              size_t ws_size, hipStream_t stream) {
  constexpr size_t kLds = 160 * 1024;
  static int grid_blocks = 0;
  if (!grid_blocks) {
    int dev = 0, cus = 0, per_cu = 0;
    (void)hipGetDevice(&dev);
    (void)hipDeviceGetAttribute(&cus, hipDeviceAttributeMultiprocessorCount, dev);
    (void)hipFuncSetAttribute((const void*)mk, hipFuncAttributeMaxDynamicSharedMemorySize, (int)kLds);
    (void)hipOccupancyMaxActiveBlocksPerMultiprocessor(&per_cu, mk, 512, kLds);
    if (per_cu > 1) per_cu = 1;
    grid_blocks = cus * per_cu;
  }
  if (ws_size < WS_NEED || grid_blocks <= 0) { fprintf(stderr, "ws too small or no occupancy\n"); return; }
  Params p{};
  p.x = (const float*)d_in[0]; p.w_in = (const float*)d_in[1]; p.b_in = (const float*)d_in[2];
  p.w_up_a = (const float*)d_in[3]; p.w_up_b = (const float*)d_in[4]; p.w_out = (const float*)d_in[5];
  p.lb_logits = (const float*)d_in[6]; p.norm_a_g = (const float*)d_in[7]; p.rel_bias = (const float*)d_in[8];
  p.ln_g = (const float*)d_in[9]; p.ln_b = (const float*)d_in[10];
  p.out = (float*)d_out; p.ws = (char*)d_ws;
  (void)hipMemsetAsync((char*)d_ws + O_BAR, 0, XCD_BAR_WORDS * 4, stream);
  void* args[] = {&p};
  hipError_t e = hipLaunchCooperativeKernel((void*)mk, dim3(grid_blocks), dim3(512), args, kLds, stream);
  if (e != hipSuccess) fprintf(stderr, "cooperative launch failed: %s (grid %d)\n", hipGetErrorString(e), grid_blocks);
}
```

```cpp
#include <hip/hip_runtime.h>
#include <hip/hip_cooperative_groups.h>
#include <cstdio>
#include <cstdint>
namespace cg = cooperative_groups;

#define DI __device__ __forceinline__
typedef __attribute__((ext_vector_type(8))) short bf16x8;
typedef __attribute__((ext_vector_type(16))) float f32x16;
typedef __attribute__((ext_vector_type(2))) float f32x2;
typedef __attribute__((ext_vector_type(2))) __bf16 bf16x2_t;
#define MFMA(a, b, c) __builtin_amdgcn_mfma_f32_32x32x16_bf16((a), (b), (c), 0, 0, 0)

constexpr int L_ = 16384, DM = 1024, NIN = 6728, NPAD = 6784, DEPTH_ = 4;
constexpr float ALPHA_ = 1.681792830507429f;
constexpr size_t MiB = 1048576;
constexpr size_t O_WTIN = 0 * MiB, O_WUA = 14 * MiB, O_WUB = 15 * MiB, O_WOUT = 16 * MiB, O_HB = 18 * MiB,
                 O_QA = 50 * MiB, O_G = 66 * MiB, O_KK = 98 * MiB, O_IA = 114 * MiB, O_ZA = 130 * MiB,
                 O_QB = 146 * MiB, O_KB = 162 * MiB, O_VB = 178 * MiB, O_ZB = 194 * MiB, O_QI = 210 * MiB,
                 O_KI = 226 * MiB, O_WI = 228 * MiB, O_D = 228 * MiB + 512 * 1024, O_SGA = 229 * MiB,
                 O_SGB = 261 * MiB, O_US = 293 * MiB, O_SEL = 325 * MiB, O_LBS = 333 * MiB,
                 O_BAR = 333 * MiB + 65536, O_AA = 334 * MiB, O_AB = 350 * MiB, O_MG = 366 * MiB, WS_NEED = 398 * MiB;

struct Params {
  const float *x, *w_in, *b_in, *w_up_a, *w_up_b, *w_out, *lb_logits, *norm_a_g, *rel_bias, *ln_g, *ln_b;
  float* out;
  char* ws;
};

extern __shared__ __attribute__((aligned(16))) char smem[];

DI unsigned cvtpk(float lo, float hi) {
  f32x2 v = {lo, hi};
  bf16x2_t b = __builtin_convertvector(v, bf16x2_t);
  return __builtin_bit_cast(unsigned, b);
}
DI unsigned short f2bf(float x) { return (unsigned short)(cvtpk(x, 0.f) & 0xffffu); }
DI float bflo(unsigned u) { return __uint_as_float(u << 16); }
DI float bfhi(unsigned u) { return __uint_as_float(u & 0xffff0000u); }
DI float bf2f(unsigned short s) { return __uint_as_float(((unsigned)s) << 16); }
DI float sigm(float x) { return 1.f / (1.f + __expf(-x)); }
DI float silu(float x) { return x / (1.f + __expf(-x)); }
DI int crow(int r, int hi) { return (r & 3) + 8 * (r >> 2) + 4 * hi; }
DI size_t tiled_unit(int r, int k, int KS) {
  return ((size_t)(r >> 5) * KS + (k >> 4)) * 64 + (r & 31) + 32 * ((k >> 3) & 1);
}
DI float dot2(unsigned a, unsigned b, float acc) {
  asm volatile("v_dot2c_f32_bf16 %0, %1, %2" : "+v"(acc) : "v"(a), "v"(b));
  return acc;
}
template <typename T> DI T* opq(T* x) { asm volatile("" : "+s"(x)); return x; }
#define LAUNDER(pin) Params p; p.x = opq((pin).x); p.w_in = (pin).w_in; p.b_in = (pin).b_in; p.w_up_a = (pin).w_up_a; p.w_up_b = (pin).w_up_b; \
  p.w_out = (pin).w_out; p.lb_logits = (pin).lb_logits; p.norm_a_g = (pin).norm_a_g; p.rel_bias = (pin).rel_bias; p.ln_g = (pin).ln_g; \
  p.ln_b = (pin).ln_b; p.out = opq((pin).out); p.ws = opq((pin).ws);
DI int vtid() { int t = threadIdx.x; asm volatile("" : "+v"(t)); return t; }
DI void cbar() { asm volatile("" ::: "memory"); }
DI void lds_fence() { asm volatile("s_waitcnt lgkmcnt(0)" ::: "memory"); }

DI int colmap(int np) {
  if (np < 4608) return np;
  if (np < 5632) return 4680 + (np - 4608);
  if (np < 6656) return 5704 + (np - 5632);
  if (np < 6720) return 4608 + (np - 6656);
  if (np < 6728) return 4672 + (np - 6720);
  return -1;
}

DI void conv_weight(const float* __restrict__ src, int K, int ldn, int Npad, bool useMap, uint4* __restrict__ dst,
                    int gtid, int gthreads) {
  const int KS = K >> 4;
  const int total = Npad * (K >> 3);
  for (int u = gtid; u < total; u += gthreads) {
    int kg = u / Npad, n = u - kg * Npad;
    int col = useMap ? colmap(n) : n;
    float v[8];
#pragma unroll
    for (int j = 0; j < 8; ++j) v[j] = (col >= 0) ? src[(size_t)(kg * 8 + j) * ldn + col] : 0.f;
    uint4 o;
    o.x = cvtpk(v[0], v[1]); o.y = cvtpk(v[2], v[3]); o.z = cvtpk(v[4], v[5]); o.w = cvtpk(v[6], v[7]);
    dst[tiled_unit(n, kg * 8, KS)] = o;
  }
}

DI void phase0(const Params& p) {
  const int gtid = blockIdx.x * 512 + vtid(), gthreads = gridDim.x * 512;
  conv_weight(p.w_in, 1024, NIN, NPAD, true, (uint4*)(p.ws + O_WTIN), gtid, gthreads);
  uint4* hb = (uint4*)(p.ws + O_HB);
  for (int u = gtid; u < L_ * 128; u += gthreads) {
    int lane = u & 63, ks = (u >> 6) & 63, mt = u >> 12;
    int t = mt * 32 + (lane & 31), k = ks * 16 + 8 * (lane >> 5);
    const float4* s = (const float4*)(p.x + (size_t)t * DM + k);
    float4 a = s[0], b = s[1];
    uint4 o;
    o.x = cvtpk(a.x, a.y); o.y = cvtpk(a.z, a.w); o.z = cvtpk(b.x, b.y); o.w = cvtpk(b.z, b.w);
    hb[u] = o;
  }
  float* lbs = (float*)(p.ws + O_LBS);
  for (int c = gtid; c < 512; c += gthreads) {
    float l0 = p.lb_logits[c], l1 = p.lb_logits[512 + c], l2 = p.lb_logits[1024 + c], l3 = p.lb_logits[1536 + c];
    float m = fmaxf(fmaxf(l0, l1), fmaxf(l2, l3));
    float e0 = expf(l0 - m), e1 = expf(l1 - m), e2 = expf(l2 - m), e3 = expf(l3 - m);
    float inv = 1.f / (e0 + e1 + e2 + e3);
    lbs[c] = 0.f; lbs[512 + c] = e1 * inv; lbs[1024 + c] = (e1 + e2) * inv; lbs[1536 + c] = (e1 + e2 + e3) * inv;
  }
}

DI void gemm_core(const uint4* __restrict__ A, int mt0, const uint4* __restrict__ B, int nt0, int KS,
                  f32x16 (&acc)[2][2], uint4* lds) {
  const int tid = vtid(), lane = tid & 63, w = tid >> 6, wm = w >> 1, wn = w & 1;
  const int nk = KS >> 2;
  const uint4* sp[6];
#pragma unroll
  for (int r = 0; r < 6; ++r) {
    int u = tid + 512 * r;
    if (u < 2048) sp[r] = A + ((size_t)(mt0 + (u >> 8)) * KS) * 64 + (u & 255);
    else { int u2 = u - 2048; sp[r] = B + ((size_t)(nt0 + (u2 >> 8)) * KS) * 64 + (u2 & 255); }
  }
#pragma unroll
  for (int r = 0; r < 6; ++r)
    __builtin_amdgcn_global_load_lds((const unsigned*)sp[r], (unsigned*)(lds + tid + 512 * r), 16, 0, 0);
  if (nk > 1) {
#pragma unroll
    for (int r = 0; r < 6; ++r)
      __builtin_amdgcn_global_load_lds((const unsigned*)(sp[r] + 256), (unsigned*)(lds + 3072 + tid + 512 * r), 16, 0, 0);
  }
  int cb = 0;
  for (int kt = 0; kt < nk; ++kt) {
    if (kt + 1 < nk) asm volatile("s_waitcnt vmcnt(6)" ::: "memory");
    else asm volatile("s_waitcnt vmcnt(0)" ::: "memory");
    __builtin_amdgcn_s_barrier();
    asm volatile("" ::: "memory");
    if (kt + 2 < nk) {
      int nb2 = cb + 2; if (nb2 >= 3) nb2 -= 3;
      uint4* nxt = lds + nb2 * 3072;
#pragma unroll
      for (int r = 0; r < 6; ++r)
        __builtin_amdgcn_global_load_lds((const unsigned*)(sp[r] + (size_t)(kt + 2) * 256), (unsigned*)(nxt + tid + 512 * r), 16, 0, 0);
    }
    const uint4* cur = lds + cb * 3072;
#pragma unroll
    for (int ks = 0; ks < 4; ++ks) {
      bf16x8 a0 = __builtin_bit_cast(bf16x8, cur[(2 * wm + 0) * 256 + ks * 64 + lane]);
      bf16x8 a1 = __builtin_bit_cast(bf16x8, cur[(2 * wm + 1) * 256 + ks * 64 + lane]);
      bf16x8 b0 = __builtin_bit_cast(bf16x8, cur[2048 + (2 * wn + 0) * 256 + ks * 64 + lane]);
      bf16x8 b1 = __builtin_bit_cast(bf16x8, cur[2048 + (2 * wn + 1) * 256 + ks * 64 + lane]);
      acc[0][0] = MFMA(a0, b0, acc[0][0]);
      acc[0][1] = MFMA(a0, b1, acc[0][1]);
      acc[1][0] = MFMA(a1, b0, acc[1][0]);
      acc[1][1] = MFMA(a1, b1, acc[1][1]);
    }
    cb = (cb == 2) ? 0 : cb + 1;
  }
  __syncthreads();
}

DI void zero_acc(f32x16 (&acc)[2][2]) {
#pragma unroll
  for (int i = 0; i < 2; ++i)
#pragma unroll
    for (int j = 0; j < 2; ++j)
#pragma unroll
      for (int r = 0; r < 16; ++r) acc[i][j][r] = 0.f;
}

DI void p1_tile(const Params& p, int layer, int mb, int nt) {
  const int tid = vtid(), lane = tid & 63, w = tid >> 6, wm = w >> 1, wn = w & 1, hi = lane >> 5, c31 = lane & 31;
  f32x16 acc[2][2];
  zero_acc(acc);
  gemm_core((const uint4*)(p.ws + O_HB), mb * 8, (const uint4*)(p.ws + O_WTIN), nt * 4, 64, acc, (uint4*)smem);
  unsigned short* tile = (unsigned short*)smem;
  const int row0 = mb * 256;
  const float* bin = p.b_in + (size_t)layer * NIN;
  const float* lbs = (const float*)(p.ws + O_LBS) + layer * 512;
#pragma unroll
  for (int j = 0; j < 2; ++j) {
    const int col = 64 * wn + 32 * j + c31;
    const int np = nt * 128 + col;
    const int oc = colmap(np);
    const float bias = oc >= 0 ? bin[oc] : 0.f;
    float lb = 0.f;
    if (nt >= 4 && nt < 8) lb = lbs[(nt - 4) * 128 + col];
#pragma unroll
    for (int i = 0; i < 2; ++i) {
#pragma unroll
      for (int r = 0; r < 16; ++r) {
        const int row = 64 * wm + 32 * i + crow(r, hi);
        float v = acc[i][j][r] + bias;
        float o;
        if (nt < 4) o = v;
        else if (nt < 8) {
          float sg = sigm(v);
          float f = lb + (1.f - lb) * sg;
          ((float*)(p.ws + O_G))[(size_t)(row0 + row) * 512 + (nt - 4) * 128 + col] = __logf(f);
          o = (1.f - lb) * (1.f - sg);
        } else if (nt < 12) o = v;
        else if (nt < 16) o = silu(v);
        else if (nt < 20) o = v * 0.125f;
        else if (nt < 28) o = v;
        else if (nt < 32) o = silu(v);
        else if (nt < 36) o = v;
        else if (nt < 52) o = sigm(v);
        else {
          o = v;
          if (col >= 64 && col < 72)
            ((float*)(p.ws + O_WI))[(size_t)(row0 + row) * 8 + (col - 64)] = v * 0.044194173824159216f;
        }
        tile[row * 128 + col] = f2bf(o);
      }
    }
  }
  __syncthreads();
#pragma unroll
  for (int q = 0; q < 8; ++q) {
    const int u = tid + 512 * q, r = u >> 4, c8 = u & 15;
    const uint4 val = *(const uint4*)&tile[r * 128 + c8 * 8];
    const int t = row0 + r;
    if (nt >= 20 && nt < 28) {
      int w0 = __builtin_amdgcn_cvt_pk_fp8_f32(bflo(val.x), bfhi(val.x), 0, false);
      w0 = __builtin_amdgcn_cvt_pk_fp8_f32(bflo(val.y), bfhi(val.y), w0, true);
      int w1 = __builtin_amdgcn_cvt_pk_fp8_f32(bflo(val.z), bfhi(val.z), 0, false);
      w1 = __builtin_amdgcn_cvt_pk_fp8_f32(bflo(val.w), bfhi(val.w), w1, true);
      const size_t base8 = (nt < 24) ? O_KB : O_VB;
      *(uint2*)(p.ws + base8 + (size_t)t * 512 + (nt & 3) * 128 + c8 * 8) = make_uint2((unsigned)w0, (unsigned)w1);
    } else if (nt < 32) {
      size_t base;
      switch (nt >> 2) {
        case 0: base = O_QA; break; case 1: base = O_KK; break; case 2: base = O_IA; break; case 3: base = O_ZA; break;
        case 4: base = O_QB; break; case 5: base = O_KB; break; case 6: base = O_VB; break; default: base = O_ZB; break;
      }
      *(uint4*)(p.ws + base + ((size_t)t * 512 + (nt & 3) * 128 + c8 * 8) * 2) = val;
    } else if (nt < 36) {
      const int head = 2 * (nt - 32) + (c8 >> 3), d0 = (c8 & 7) * 8;
      const int item = t >> 5, tq = t & 31, mtile = tq >> 2, q4 = tq & 3;
      const int rr = (head & 3) + 4 * (q4 >> 1) + 8 * (head >> 2) + 16 * (q4 & 1);
      const int laneA = rr + 32 * ((d0 >> 3) & 1), ks = d0 >> 4;
      ((uint4*)(p.ws + O_QI))[((size_t)(item * 8 + mtile) * 4 + ks) * 64 + laneA] = val;
    } else if (nt < 44) {
      *(uint4*)(p.ws + O_SGA + ((size_t)t * 1024 + (nt - 36) * 128 + c8 * 8) * 2) = val;
    } else if (nt < 52) {
      *(uint4*)(p.ws + O_SGB + ((size_t)t * 1024 + (nt - 44) * 128 + c8 * 8) * 2) = val;
    } else {
      if (c8 < 8) {
        const int d0 = c8 * 8;
        ((uint4*)(p.ws + O_KI))[((size_t)(t >> 5) * 4 + (d0 >> 4)) * 64 + (t & 31) + 32 * ((d0 >> 3) & 1)] = val;
      }
    }
  }
  __syncthreads();
}

constexpr int CAP = 1000, SEGCAP = 250, SEGTRIG = 154;
constexpr int IX_SC = 0, IX_IX = 64000, IX_RING = 96000, IX_CNT = 161536, IX_TAU = 161792, IX_FLAG = 161856, IX_WL = 161872;

DI float key2float(unsigned k) {
  unsigned b = (k & 0x80000000u) ? (k ^ 0x80000000u) : ~k;
  return __uint_as_float(b);
}
DI unsigned float2key(float f) {
  unsigned b = __float_as_uint(f);
  return (b & 0x80000000u) ? ~b : (b ^ 0x80000000u);
}
DI int wave_prefix_incl(int x) {
  int v = x;
  v += __builtin_amdgcn_update_dpp(0, v, 0x111, 0xf, 0xf, false);
  v += __builtin_amdgcn_update_dpp(0, v, 0x112, 0xf, 0xf, false);
  v += __builtin_amdgcn_update_dpp(0, v, 0x114, 0xf, 0xf, false);
  v += __builtin_amdgcn_update_dpp(0, v, 0x118, 0xf, 0xf, false);
  v += __builtin_amdgcn_update_dpp(0, v, 0x142, 0xa, 0xf, false);
  v += __builtin_amdgcn_update_dpp(0, v, 0x143, 0xc, 0xf, false);
  return v;
}

#define SEG_ADDR(j_) (((j_) >> 2) * SEGCAP + lane + 64 * ((j_) & 3))
DI int seg_count(const int4 c4, int s_) { return s_ == 0 ? c4.x : (s_ == 1 ? c4.y : (s_ == 2 ? c4.z : c4.w)); }

DI void wave_select(float* scq, unsigned short* ixq, int* cnt4q, float* tauq, unsigned* hist, int lane, unsigned short* final_sel) {
  lds_fence();
  const int4 c4 = *(const int4*)cnt4q;
  const int n = c4.x + c4.y + c4.z + c4.w;
  unsigned u[16], v16[16];
  unsigned mm = 0, am = 0;
#pragma unroll
  for (int j = 0; j < 16; ++j) {
    const bool valid = (lane + 64 * (j & 3)) < seg_count(c4, j >> 2);
    const float sv = valid ? scq[SEG_ADDR(j)] : 0.f;
    const unsigned id = valid ? (unsigned)ixq[SEG_ADDR(j)] : 0u;
    u[j] = float2key(sv);
    v16[j] = 0xFFFFu - id;
    mm |= valid ? (1u << j) : 0u;
  }
  unsigned prefix_u = 0;
  if (n > 256) {
    int need = 256;
    int r0 = 0;
    {
      unsigned ref = 0; bool have = false;
#pragma unroll
      for (int j = 15; j >= 0; --j) if ((mm >> j) & 1u) { ref = u[j] >> 24; have = true; }
      const unsigned long long hm = __ballot(have);
      const int fl = __ffsll((long long)hm) - 1;
      ref = (unsigned)__builtin_amdgcn_readlane((int)ref, fl);
      bool same = true;
#pragma unroll
      for (int j = 0; j < 16; ++j) same = same && (!((mm >> j) & 1u) || ((u[j] >> 24) == ref));
      if (__all(same)) { prefix_u = ref << 24; r0 = 1; }
    }
    for (int r = r0; r < 6; ++r) {
      const int sh = (r < 4) ? (24 - 8 * r) : (r == 4 ? 8 : 0);
      ((uint4*)hist)[lane] = make_uint4(0, 0, 0, 0);
      lds_fence();
#pragma unroll
      for (int j = 0; j < 16; ++j) {
        const unsigned src = (r < 4) ? u[j] : v16[j];
        const unsigned dgt = (src >> sh) & 255u;
        if ((mm >> j) & 1u) atomicAdd(&hist[dgt], 1u);
      }
      lds_fence();
      const uint4 hv = ((const uint4*)hist)[lane];
      const int c0 = hv.x, c1 = hv.y, c2 = hv.z, c3 = hv.w;
      const int Lsum = c0 + c1 + c2 + c3;
      const int Pfx = wave_prefix_incl(Lsum);
      const int total = __builtin_amdgcn_readlane(Pfx, 63);
      const int S = total - Pfx + Lsum;
      const unsigned long long mask = __ballot(S >= need);
      const int lstar = 63 - __clzll((long long)mask);
      int d_, ca_, cd_;
      {
        const int accu = S - Lsum;
        if (accu + c3 >= need) { d_ = 3; ca_ = accu; cd_ = c3; }
        else if (accu + c3 + c2 >= need) { d_ = 2; ca_ = accu + c3; cd_ = c2; }
        else if (accu + c3 + c2 + c1 >= need) { d_ = 1; ca_ = accu + c3 + c2; cd_ = c1; }
        else { d_ = 0; ca_ = accu + c3 + c2 + c1; cd_ = c0; }
      }
      const int D = __builtin_amdgcn_readlane(4 * lane + d_, lstar);
      const int cntAbove = __builtin_amdgcn_readlane(ca_, lstar);
      const int cntD = __builtin_amdgcn_readlane(cd_, lstar);
#pragma unroll
      for (int j = 0; j < 16; ++j) {
        const unsigned src = (r < 4) ? u[j] : v16[j];
        const int dgt = (int)((src >> sh) & 255u);
        if ((mm >> j) & 1u) {
          if (dgt > D) { am |= (1u << j); mm &= ~(1u << j); }
          else if (dgt < D) mm &= ~(1u << j);
        }
      }
      need -= cntAbove;
      if (r < 4) prefix_u |= ((unsigned)D) << sh;
      if (cntD == need) break;
    }
  }
  const unsigned km = am | mm;
  int base = 0;
#pragma unroll
  for (int j = 0; j < 16; ++j) {
    const bool keep = (km >> j) & 1u;
    const unsigned long long m = __ballot(keep);
    const int rk = base + __popcll(m & ((1ull << lane) - 1ull));
    if (keep) {
      if (final_sel) { if (rk < 256) final_sel[rk] = (unsigned short)(0xFFFFu - v16[j]); }
      else { const int ad = (rk & 3) * SEGCAP + (rk >> 2); scq[ad] = key2float(u[j]); ixq[ad] = (unsigned short)(0xFFFFu - v16[j]); }
    }
    base += __popcll(m);
  }
  if (!final_sel && lane == 0) {
    *(int4*)cnt4q = make_int4((base + 3) >> 2, (base + 2) >> 2, (base + 1) >> 2, base >> 2);
    if (n > 256) *tauq = key2float(prefix_u);
  }
  lds_fence();
}

typedef float f32x2v __attribute__((ext_vector_type(2)));
DI float relu_(float x) { int i = __float_as_int(x); i = i > 0 ? i : 0; return __int_as_float(i); }

DI unsigned wave_umin(unsigned v) {
#define UMIN_STEP(ctrl, rm) { const unsigned o_ = (unsigned)__builtin_amdgcn_update_dpp((int)0xFFFFFFFFu, (int)v, ctrl, rm, 0xf, false); v = o_ < v ? o_ : v; }
  UMIN_STEP(0x111, 0xf) UMIN_STEP(0x112, 0xf) UMIN_STEP(0x114, 0xf) UMIN_STEP(0x118, 0xf) UMIN_STEP(0x142, 0xa) UMIN_STEP(0x143, 0xc)
#undef UMIN_STEP
  return (unsigned)__builtin_amdgcn_readlane((int)v, 63);
}
DI unsigned wave_umax(unsigned v) {
#define UMAX_STEP(ctrl, rm) { const unsigned o_ = (unsigned)__builtin_amdgcn_update_dpp(0, (int)v, ctrl, rm, 0xf, false); v = o_ > v ? o_ : v; }
  UMAX_STEP(0x111, 0xf) UMAX_STEP(0x112, 0xf) UMAX_STEP(0x114, 0xf) UMAX_STEP(0x118, 0xf) UMAX_STEP(0x142, 0xa) UMAX_STEP(0x143, 0xc)
#undef UMAX_STEP
  return (unsigned)__builtin_amdgcn_readlane((int)v, 63);
}
DI void wave_compact(float* scq, unsigned short* ixq, int* cnt4q, float* tauq, unsigned* hist, int lane) {
  lds_fence();
  const int4 c4 = *(const int4*)cnt4q;
  const int n = c4.x + c4.y + c4.z + c4.w;
  if (n <= 320) return;
  unsigned u[16], idv[16];
  unsigned vm = 0;
  unsigned umin = 0xFFFFFFFFu, umax = 0u;
  ((uint4*)hist)[lane] = make_uint4(0, 0, 0, 0);

#pragma unroll
  for (int j = 0; j < 16; ++j) {
    const bool valid = (lane + 64 * (j & 3)) < seg_count(c4, j >> 2);
    u[j] = valid ? float2key(scq[SEG_ADDR(j)]) : 0u;
    idv[j] = valid ? (unsigned)ixq[SEG_ADDR(j)] : 0u;
    vm |= valid ? (1u << j) : 0u;
    umin = valid ? (u[j] < umin ? u[j] : umin) : umin;
    umax = valid ? (u[j] > umax ? u[j] : umax) : umax;
  }
  umin = wave_umin(umin);
  umax = wave_umax(umax);
  const unsigned range = umax - umin;
  const int sh = range < 256u ? 0 : (24 - __clz((int)range));
#pragma unroll
  for (int j = 0; j < 16; ++j) {
    const unsigned bin = ((vm >> j) & 1u) ? ((u[j] - umin) >> sh) : 256u + lane;
    atomicAdd(&hist[bin], 1u);
  }
  lds_fence();
  const uint4 hv = ((const uint4*)hist)[lane];
  const int c0 = hv.x, c1 = hv.y, c2 = hv.z, c3 = hv.w;
  const int Lsum = c0 + c1 + c2 + c3;
  const int Pfx = wave_prefix_incl(Lsum);
  const int total = __builtin_amdgcn_readlane(Pfx, 63);
  const int S = total - Pfx + Lsum;
  const unsigned long long mask = __ballot(S >= 256);
  const int lstar = 63 - __clzll((long long)mask);
  int d_, kept_;
  {
    const int accu = S - Lsum;
    if (accu + c3 >= 256) { d_ = 3; kept_ = accu + c3; }
    else if (accu + c3 + c2 >= 256) { d_ = 2; kept_ = accu + c3 + c2; }
    else if (accu + c3 + c2 + c1 >= 256) { d_ = 1; kept_ = accu + c3 + c2 + c1; }
    else { d_ = 0; kept_ = accu + Lsum; }
  }
  const int D = __builtin_amdgcn_readlane(4 * lane + d_, lstar);
  const int kept = __builtin_amdgcn_readlane(kept_, lstar);
  if (kept > 400) return;
  int base = 0;
#pragma unroll
  for (int j = 0; j < 16; ++j) {
    const bool keep = ((vm >> j) & 1u) && ((int)((u[j] - umin) >> sh) >= D);
    const unsigned long long m = __ballot(keep);
    const int rk = base + __popcll(m & ((1ull << lane) - 1ull));
    if (keep) { const int ad = (rk & 3) * SEGCAP + (rk >> 2); scq[ad] = key2float(u[j]); ixq[ad] = (unsigned short)idv[j]; }
    base += __popcll(m);
  }
  if (lane == 0) {
    *(int4*)cnt4q = make_int4((base + 3) >> 2, (base + 2) >> 2, (base + 1) >> 2, base >> 2);
    *tauq = key2float(umin + ((unsigned)D << sh));
  }
  lds_fence();
}

#define IDX_GLDS(step, bufi) do { _Pragma("unroll") for (int r_ = 0; r_ < 4; ++r_) \
    __builtin_amdgcn_global_load_lds((const unsigned*)(ki + (size_t)(step) * 2048 + tid + 512 * r_), \
                                     (unsigned*)(ring + (bufi) * 2048 + tid + 512 * r_), 16, 0, 0); } while (0)

DI void indexer_item(const Params& p, int item) {
  const int tid = vtid(), lane = tid & 63, w = tid >> 6, g = w & 1, kg = w >> 1, hi = lane >> 5, c31 = lane & 31;
  float* sc = (float*)(smem + IX_SC);
  unsigned short* ix = (unsigned short*)(smem + IX_IX);
  uint4* ring = (uint4*)(smem + IX_RING);
  int* cnt = (int*)(smem + IX_CNT);
  volatile int* flag = (volatile int*)(smem + IX_FLAG);
  float* tauv = (float*)(smem + IX_TAU);
  const uint4* qi = (const uint4*)(p.ws + O_QI);
  const uint4* ki = (const uint4*)(p.ws + O_KI);
  const float* wi = (const float*)(p.ws + O_WI);
  const int t0 = 16 * item;
  bf16x8 a[2][4];
#pragma unroll
  for (int mt = 0; mt < 2; ++mt)
#pragma unroll
    for (int ks = 0; ks < 4; ++ks)
      a[mt][ks] = __builtin_bit_cast(bf16x8, qi[((size_t)((item >> 1) * 8 + (item & 1) * 4 + 2 * g + mt) * 4 + ks) * 64 + lane]);
  float* wl = (float*)(smem + IX_WL);
  if (tid < 128) wl[tid] = wi[(size_t)t0 * 8 + tid];
  float tau[2][2];
#pragma unroll
  for (int mt = 0; mt < 2; ++mt) { tau[mt][0] = -INFINITY; tau[mt][1] = -INFINITY; }
  if (tid < 64) cnt[tid] = 0;
  if (tid < 16) tauv[tid] = -INFINITY;
  int cntv[2][2] = {{0, 0}, {0, 0}};
  if (tid < 2) flag[tid] = 0;
  const int nsteps = (t0 + 16 + 255) >> 8;
  asm volatile("s_waitcnt vmcnt(0)" ::: "memory");
  IDX_GLDS(0, 0);
  if (nsteps > 1) { IDX_GLDS(1, 1); asm volatile("s_waitcnt vmcnt(4)" ::: "memory"); }
  else asm volatile("s_waitcnt vmcnt(0)" ::: "memory");
  __syncthreads();
  const f32x16 z = {0.f, 0.f, 0.f, 0.f, 0.f, 0.f, 0.f, 0.f, 0.f, 0.f, 0.f, 0.f, 0.f, 0.f, 0.f, 0.f};
  f32x16 Ca0, Ca1, Cb0, Cb1;
  {
    const uint4* cur = ring;
    const uint4* bp = cur + ((2 * kg + 0) * 4) * 64 + lane;
    bf16x8 b0 = __builtin_bit_cast(bf16x8, bp[0]), b1 = __builtin_bit_cast(bf16x8, bp[64]);
    bf16x8 b2 = __builtin_bit_cast(bf16x8, bp[128]), b3 = __builtin_bit_cast(bf16x8, bp[192]);
    Ca0 = MFMA(a[0][0], b0, z); Ca1 = MFMA(a[1][0], b0, z);
    Ca0 = MFMA(a[0][1], b1, Ca0); Ca1 = MFMA(a[1][1], b1, Ca1);
    Ca0 = MFMA(a[0][2], b2, Ca0); Ca1 = MFMA(a[1][2], b2, Ca1);
    Ca0 = MFMA(a[0][3], b3, Ca0); Ca1 = MFMA(a[1][3], b3, Ca1);
  }
#define IDX_SCORE(Cx, mt_, aa_, sout) do { const float4 wa_ = *(const float4*)(wl + (8 * g + 4 * (mt_) + 2 * hi + (aa_)) * 8); \
    const float4 wb_ = *(const float4*)(wl + (8 * g + 4 * (mt_) + 2 * hi + (aa_)) * 8 + 4); \
    f32x2v r0_ = {relu_(Cx[8 * (aa_) + 0]), relu_(Cx[8 * (aa_) + 1])}, r1_ = {relu_(Cx[8 * (aa_) + 2]), relu_(Cx[8 * (aa_) + 3])}; \
    f32x2v r2_ = {relu_(Cx[8 * (aa_) + 4]), relu_(Cx[8 * (aa_) + 5])}, r3_ = {relu_(Cx[8 * (aa_) + 6]), relu_(Cx[8 * (aa_) + 7])}; \
    const f32x2v w0_ = {wa_.x, wa_.y}, w1_ = {wa_.z, wa_.w}, w2_ = {wb_.x, wb_.y}, w3_ = {wb_.z, wb_.w}; \
    f32x2v ac_ = r0_ * w0_; ac_ = r1_ * w1_ + ac_; ac_ = r2_ * w2_ + ac_; ac_ = r3_ * w3_ + ac_; \
    sout = ac_.x + ac_.y; } while (0)
  const unsigned ltm = (1u << c31) - 1u;
  const int tqb = t0 + 8 * g + 2 * hi;
  const int sb0 = ((8 * g + 2 * hi) * CAP + kg * SEGCAP) * 4;
#define IDX_APPEND(sval, mt_, aa_, keyv) do { \
    const bool pr_ = ((keyv) <= tqb + 4 * (mt_) + (aa_)) && ((sval) >= tau[mt_][aa_]); \
    const unsigned long long bm_ = __builtin_amdgcn_ballot_w64(pr_); \
    const unsigned half_ = hi ? (unsigned)(bm_ >> 32) : (unsigned)bm_; \
    const int pos_ = cntv[mt_][aa_] + __popc(half_ & ltm); \
    if (pr_) { const int bo_ = sb0 + (4 * (mt_) + (aa_)) * CAP * 4 + pos_ * 4; \
      *(float*)((char*)sc + bo_) = (sval); *(unsigned short*)((char*)ix + (bo_ >> 1)) = (unsigned short)(keyv); } \
    cntv[mt_][aa_] += __popc(half_); } while (0)
#define IDX_PUBLISH() do { if (c31 == 0) { _Pragma("unroll") for (int mt_ = 0; mt_ < 2; ++mt_) _Pragma("unroll") for (int aa_ = 0; aa_ < 2; ++aa_) \
    cnt[4 * (8 * g + 4 * mt_ + 2 * hi + aa_) + kg] = cntv[mt_][aa_]; } } while (0)
  for (int j = 0; j < nsteps; ++j) {
    const uint4* cur = ring + (j & 1) * 2048;
    {
      const uint4* bp = cur + ((2 * kg + 1) * 4) * 64 + lane;
      bf16x8 b0 = __builtin_bit_cast(bf16x8, bp[0]), b1 = __builtin_bit_cast(bf16x8, bp[64]);
      bf16x8 b2 = __builtin_bit_cast(bf16x8, bp[128]), b3 = __builtin_bit_cast(bf16x8, bp[192]);
      Cb0 = MFMA(a[0][0], b0, z); Cb1 = MFMA(a[1][0], b0, z);
      Cb0 = MFMA(a[0][1], b1, Cb0); Cb1 = MFMA(a[1][1], b1, Cb1);
      Cb0 = MFMA(a[0][2], b2, Cb0); Cb1 = MFMA(a[1][2], b2, Cb1);
      Cb0 = MFMA(a[0][3], b3, Cb0); Cb1 = MFMA(a[1][3], b3, Cb1);
    }
    {
      const int key = 256 * j + 64 * kg + c31;
      float s00, s01, s10, s11;
      IDX_SCORE(Ca0, 0, 0, s00); IDX_SCORE(Ca0, 0, 1, s01); IDX_SCORE(Ca1, 1, 0, s10); IDX_SCORE(Ca1, 1, 1, s11);
#pragma unroll
      for (int q_ = 0; q_ < 8; ++q_) { __builtin_amdgcn_sched_group_barrier(0x008, 1, 0); __builtin_amdgcn_sched_group_barrier(0x002, 9, 0); }
      IDX_APPEND(s00, 0, 0, key); IDX_APPEND(s01, 0, 1, key); IDX_APPEND(s10, 1, 0, key); IDX_APPEND(s11, 1, 1, key);
    }
    IDX_PUBLISH();
    __syncthreads();
    if (j > 0 && flag[(j - 1) & 1] == j) {
      unsigned* hist = (unsigned*)(ring + (j & 1) * 2048) + w * 512;
#pragma unroll 1
      for (int k = 0; k < 2; ++k) {
        const int q = 2 * w + k;
        wave_compact(sc + q * CAP, ix + q * CAP, cnt + 4 * q, tauv + q, hist, lane);
        lds_fence();
        { const int4 cc = *(const int4*)(cnt + 4 * q); if (cc.x + cc.y + cc.z + cc.w > 400) wave_select(sc + q * CAP, ix + q * CAP, cnt + 4 * q, tauv + q, hist, lane, nullptr); }
      }
      __syncthreads();
#pragma unroll
      for (int mt = 0; mt < 2; ++mt)
#pragma unroll
        for (int aa = 0; aa < 2; ++aa) { const int ql = 8 * g + 4 * mt + 2 * hi + aa; tau[mt][aa] = tauv[ql]; cntv[mt][aa] = cnt[4 * ql + kg]; }
    }
    if (j + 2 < nsteps) IDX_GLDS(j + 2, j & 1);
    if (j + 1 < nsteps) {
      const uint4* nxt = ring + ((j + 1) & 1) * 2048;
      const uint4* bp = nxt + ((2 * kg + 0) * 4) * 64 + lane;
      bf16x8 b0 = __builtin_bit_cast(bf16x8, bp[0]), b1 = __builtin_bit_cast(bf16x8, bp[64]);
      bf16x8 b2 = __builtin_bit_cast(bf16x8, bp[128]), b3 = __builtin_bit_cast(bf16x8, bp[192]);
      Ca0 = MFMA(a[0][0], b0, z); Ca1 = MFMA(a[1][0], b0, z);
      Ca0 = MFMA(a[0][1], b1, Ca0); Ca1 = MFMA(a[1][1], b1, Ca1);
      Ca0 = MFMA(a[0][2], b2, Ca0); Ca1 = MFMA(a[1][2], b2, Ca1);
      Ca0 = MFMA(a[0][3], b3, Ca0); Ca1 = MFMA(a[1][3], b3, Ca1);
    }
    {
      const int key = 256 * j + 64 * kg + 32 + c31;
      float s00, s01, s10, s11;
      IDX_SCORE(Cb0, 0, 0, s00); IDX_SCORE(Cb0, 0, 1, s01); IDX_SCORE(Cb1, 1, 0, s10); IDX_SCORE(Cb1, 1, 1, s11);
#pragma unroll
      for (int q_ = 0; q_ < 8; ++q_) { __builtin_amdgcn_sched_group_barrier(0x008, 1, 0); __builtin_amdgcn_sched_group_barrier(0x002, 9, 0); }
      IDX_APPEND(s00, 0, 0, key); IDX_APPEND(s01, 0, 1, key); IDX_APPEND(s10, 1, 0, key); IDX_APPEND(s11, 1, 1, key);
    }
    {
      const int mxc = max(max(cntv[0][0], cntv[0][1]), max(cntv[1][0], cntv[1][1]));
      if (__ballot(mxc > SEGTRIG) != 0ull) { if (lane == 0) flag[j & 1] = j + 1; }
    }
  }
  IDX_PUBLISH();
  __syncthreads();
  unsigned short* sel = (unsigned short*)(p.ws + O_SEL);
  unsigned* hist = (unsigned*)ring + w * 512;
#pragma unroll 1
  for (int k = 0; k < 2; ++k) {
    const int q = 2 * w + k;
    wave_select(sc + q * CAP, ix + q * CAP, cnt + 4 * q, tauv + q, hist, lane, sel + (size_t)(t0 + q) * 256);
  }
  __syncthreads();
}

DI void hgrn_a_item(const Params& p, int c, int h) {
  const int tid = vtid(), lane = tid & 63, w = tid >> 6, hi = lane >> 5, c31 = lane & 31;
  float* tot = (float*)smem;
  unsigned short* kT = (unsigned short*)(smem + 2048);
  unsigned short* vT = (unsigned short*)(smem + 2048 + 18432);
  const int seg = tid >> 7, k = tid & 127;
  const float* G = (const float*)(p.ws + O_G);
  const unsigned short* KK = (const unsigned short*)(p.ws + O_KK);
  const unsigned short* IA = (const unsigned short*)(p.ws + O_IA);
  const size_t rowbase = (size_t)(64 * c + 16 * seg);
  float b[16];
  {
    float run = 0.f;
#pragma unroll
    for (int i = 0; i < 16; ++i) { run += G[(rowbase + i) * 512 + 128 * h + k]; b[i] = run; }
    tot[seg * 128 + k] = run;
  }
  __syncthreads();
  float off = 0.f, blast = 0.f;
#pragma unroll
  for (int s2 = 0; s2 < 4; ++s2) { float tv = tot[s2 * 128 + k]; if (s2 < seg) off += tv; blast += tv; }
  {
    unsigned pk[8], pv[8];
#pragma unroll
    for (int i = 0; i < 16; i += 2) {
      float k0 = bf2f(KK[(rowbase + i) * 512 + 128 * h + k]) * __expf(blast - (b[i] + off));
      float k1 = bf2f(KK[(rowbase + i + 1) * 512 + 128 * h + k]) * __expf(blast - (b[i + 1] + off));
      pk[i >> 1] = cvtpk(k0, k1);
      unsigned v0 = IA[(rowbase + i) * 512 + 128 * h + k], v1 = IA[(rowbase + i + 1) * 512 + 128 * h + k];
      pv[i >> 1] = v0 | (v1 << 16);
    }
    uint4* dk = (uint4*)(kT + k * 72 + 16 * seg);
    dk[0] = make_uint4(pk[0], pk[1], pk[2], pk[3]); dk[1] = make_uint4(pk[4], pk[5], pk[6], pk[7]);
    uint4* dv = (uint4*)(vT + k * 72 + 16 * seg);
    dv[0] = make_uint4(pv[0], pv[1], pv[2], pv[3]); dv[1] = make_uint4(pv[4], pv[5], pv[6], pv[7]);
    if (seg == 0) ((float*)(p.ws + O_D))[(size_t)(c * 4 + h) * 128 + k] = __expf(blast);
  }
  __syncthreads();
  const int mt = w >> 1;
  f32x16 acc[2];
#pragma unroll
  for (int r = 0; r < 16; ++r) { acc[0][r] = 0.f; acc[1][r] = 0.f; }
#pragma unroll
  for (int ks = 0; ks < 4; ++ks) {
    bf16x8 af = __builtin_bit_cast(bf16x8, *(const uint4*)(kT + (32 * mt + c31) * 72 + 16 * ks + 8 * hi));
#pragma unroll
    for (int jn = 0; jn < 2; ++jn) {
      const int nt = 2 * (w & 1) + jn;
      bf16x8 bfv = __builtin_bit_cast(bf16x8, *(const uint4*)(vT + (32 * nt + c31) * 72 + 16 * ks + 8 * hi));
      acc[jn] = MFMA(af, bfv, acc[jn]);
    }
  }
  char* us = p.ws + O_US + (size_t)(c * 4 + h) * 32768;
#pragma unroll
  for (int jn = 0; jn < 2; ++jn) {
    const int nt = 2 * (w & 1) + jn;
    const int v = 32 * nt + c31;
#pragma unroll
    for (int gq = 0; gq < 4; ++gq) {
      const int k0 = 32 * mt + 8 * gq;
      const size_t unit = ((size_t)(v >> 5) * 8 + (k0 >> 4)) * 64 + (v & 31) + 32 * ((k0 >> 3) & 1);
      uint2 val;
      val.x = cvtpk(acc[jn][4 * gq + 0], acc[jn][4 * gq + 1]);
      val.y = cvtpk(acc[jn][4 * gq + 2], acc[jn][4 * gq + 3]);
      *(uint2*)(us + unit * 16 + 8 * hi) = val;
    }
  }
  __syncthreads();
}

DI void hgrn_scan(const Params& p) {
  const int tid = vtid();
  if (tid >= 128) return;
  for (int pid = blockIdx.x * 128 + tid; pid < 32768; pid += gridDim.x * 128) {
    const int q4 = pid & 3, unit = (pid >> 2) & 2047, h = pid >> 13;
    const int lanep = unit & 63, ks = (unit >> 6) & 7;
    const int k = ks * 16 + 8 * (lanep >> 5) + 2 * q4;
    unsigned* us = (unsigned*)(p.ws + O_US) + (size_t)h * 8192 + unit * 4 + q4;
    const float* dd = (const float*)(p.ws + O_D) + h * 128 + k;
    float s0 = 0.f, s1 = 0.f;
    for (int c0 = 0; c0 < 256; c0 += 16) {
      unsigned uv[16];
      float2 dv[16];
#pragma unroll
      for (int i = 0; i < 16; ++i) {
        uv[i] = us[(size_t)(c0 + i) * 32768];
        dv[i] = *(const float2*)(dd + (size_t)(c0 + i) * 512);
      }
#pragma unroll
      for (int i = 0; i < 16; ++i) {
        us[(size_t)(c0 + i) * 32768] = cvtpk(s0, s1);
        s0 = fmaf(dv[i].x, s0, bflo(uv[i]));
        s1 = fmaf(dv[i].y, s1, bfhi(uv[i]));
      }
    }
  }
}

constexpr int AT_LUT = 0, AT_RB = 512, AT_WAVE = 2048, AT_WSZ = 8192 + 1024 + 16 * 528;
DI void attn_setup() {
  const int tid = vtid();
  int* lut = (int*)(smem + AT_LUT);
  if (tid < 128) {
    int d = tid;
    int bk;
    if (d < 16) bk = d;
    else {
      float df = (float)d;
      int lg = 16 + (int)(logf(df / 16.f) / 2.0794415416798357f * 16.f);
      bk = lg < 31 ? lg : 31;
    }
    lut[tid] = bk;
  }
}
DI float dppf(float v, int ctrl_sel) {
  const int iv = __builtin_bit_cast(int, v);
  int r;
  if (ctrl_sel == 0) r = __builtin_amdgcn_update_dpp(0, iv, 0xB1, 0xf, 0xf, false);
  else if (ctrl_sel == 1) r = __builtin_amdgcn_update_dpp(0, iv, 0x4E, 0xf, 0xf, false);
  else r = __builtin_amdgcn_update_dpp(0, iv, 0x141, 0xf, 0xf, false);
  return __builtin_bit_cast(float, r);
}
DI float sum8(float v) { v += dppf(v, 0); v += dppf(v, 1); v += dppf(v, 2); return v; }
DI float max8(float v) { v = fmaxf(v, dppf(v, 0)); v = fmaxf(v, dppf(v, 1)); v = fmaxf(v, dppf(v, 2)); return v; }

DI size_t prob_off(int t) {
  return t < 8192 ? O_MG + (size_t)t * 4096 : (t < 12288 ? O_AA + (size_t)(t - 8192) * 4096 : O_QI + (size_t)(t - 12288) * 4096);
}
#define MFMA8S(a, b, c) __builtin_amdgcn_mfma_f32_16x16x32_fp8_fp8((a), (b), (c), 0, 0, 0)
typedef __attribute__((ext_vector_type(4))) float f32x4v;
constexpr int AT_KROW = 528;
DI void attn_query(const Params& p, int t, int w, int lane) {
  const int h = lane >> 3, dg = lane & 7, n15 = lane & 15, quad = lane >> 4, hi = lane >> 5, c31 = lane & 31;
  const int* lut = (const int*)(smem + AT_LUT);
  const float* rb = (const float*)(smem + AT_RB);
  float* lgw = (float*)(smem + AT_WAVE + w * AT_WSZ);
  int* ixw = (int*)(smem + AT_WAVE + w * AT_WSZ + 8192);
  char* kst = smem + AT_WAVE + w * AT_WSZ + 9216;
  const int nsel = t + 1 < 256 ? t + 1 : 256;
  const unsigned short* sel = (const unsigned short*)(p.ws + O_SEL) + (size_t)t * 256;
#pragma unroll
  for (int j = 0; j < 4; ++j) {
    const int pos = lane + 64 * j;
    ixw[pos] = pos < nsel ? (int)sel[pos] : 0;
  }
  long qreg[2];
  {
    const int hq = n15 & 7;
#pragma unroll
    for (int c = 0; c < 2; ++c) {
      const uint4 qv = *(const uint4*)((const unsigned short*)(p.ws + O_QB) + (size_t)t * 512 + hq * 64 + 32 * c + 8 * quad);
      int w0 = __builtin_amdgcn_cvt_pk_fp8_f32(bflo(qv.x) * 8.f, bfhi(qv.x) * 8.f, 0, false);
      w0 = __builtin_amdgcn_cvt_pk_fp8_f32(bflo(qv.y) * 8.f, bfhi(qv.y) * 8.f, w0, true);
      int w1 = __builtin_amdgcn_cvt_pk_fp8_f32(bflo(qv.z) * 8.f, bfhi(qv.z) * 8.f, 0, false);
      w1 = __builtin_amdgcn_cvt_pk_fp8_f32(bflo(qv.w) * 8.f, bfhi(qv.w) * 8.f, w1, true);
      const long v = (long)(((unsigned long long)(unsigned)w1 << 32) | (unsigned long long)(unsigned)w0);
      qreg[c] = (n15 < 8) ? v : 0L;
    }
  }
  long bsel[16];
#pragma unroll
  for (int ks = 0; ks < 16; ++ks) bsel[ks] = (n15 == (ks >> 1)) ? qreg[ks & 1] : 0L;
  lds_fence();
  const uint4* KB16 = (const uint4*)(p.ws + O_KB);
  const uint2* VB = (const uint2*)(p.ws + O_VB);
  const int ntile = (nsel + 15) >> 4;
#define AT_KMMA(kt_) do { f32x4v acc0 = {0.f, 0.f, 0.f, 0.f}, acc1 = acc0, acc2 = acc0, acc3 = acc0; \
    const char* ar = kst + n15 * AT_KROW + 8 * quad; \
    _Pragma("unroll") for (int ks = 0; ks < 16; ks += 4) { \
      acc0 = MFMA8S(*(const long*)(ar + 32 * ks), bsel[ks], acc0); \
      acc1 = MFMA8S(*(const long*)(ar + 32 * ks + 32), bsel[ks + 1], acc1); \
      acc2 = MFMA8S(*(const long*)(ar + 32 * ks + 64), bsel[ks + 2], acc2); \
      acc3 = MFMA8S(*(const long*)(ar + 32 * ks + 96), bsel[ks + 3], acc3); } \
    const f32x4v acc = (acc0 + acc1) + (acc2 + acc3); \
    if (n15 < 8) { _Pragma("unroll") for (int i = 0; i < 4; ++i) lgw[(16 * (kt_) + 4 * quad + i) * 8 + n15] = acc[i] * 0.125f; } \
    cbar(); } while (0)
  uint4 kgA0, kgA1, kgA2, kgA3, kgA4, kgA5, kgA6, kgA7, kgB0, kgB1, kgB2, kgB3, kgB4, kgB5, kgB6, kgB7, kgC0, kgC1, kgC2, kgC3, kgC4, kgC5, kgC6, kgC7;
    { const int tl_ = (0) < ntile ? (0) : ntile - 1;
      const int4 ia_ = *(const int4*)(ixw + 16 * tl_ + 8 * hi), ib_ = *(const int4*)(ixw + 16 * tl_ + 8 * hi + 4);
      kgA0 = KB16[(size_t)ia_.x * 32 + c31]; kgA1 = KB16[(size_t)ia_.y * 32 + c31]; kgA2 = KB16[(size_t)ia_.z * 32 + c31]; kgA3 = KB16[(size_t)ia_.w * 32 + c31];
      kgA4 = KB16[(size_t)ib_.x * 32 + c31]; kgA5 = KB16[(size_t)ib_.y * 32 + c31]; kgA6 = KB16[(size_t)ib_.z * 32 + c31]; kgA7 = KB16[(size_t)ib_.w * 32 + c31]; }
    { const int tl_ = (1) < ntile ? (1) : ntile - 1;
      const int4 ia_ = *(const int4*)(ixw + 16 * tl_ + 8 * hi), ib_ = *(const int4*)(ixw + 16 * tl_ + 8 * hi + 4);
      kgB0 = KB16[(size_t)ia_.x * 32 + c31]; kgB1 = KB16[(size_t)ia_.y * 32 + c31]; kgB2 = KB16[(size_t)ia_.z * 32 + c31]; kgB3 = KB16[(size_t)ia_.w * 32 + c31];
      kgB4 = KB16[(size_t)ib_.x * 32 + c31]; kgB5 = KB16[(size_t)ib_.y * 32 + c31]; kgB6 = KB16[(size_t)ib_.z * 32 + c31]; kgB7 = KB16[(size_t)ib_.w * 32 + c31]; }
    { const int tl_ = (2) < ntile ? (2) : ntile - 1;
      const int4 ia_ = *(const int4*)(ixw + 16 * tl_ + 8 * hi), ib_ = *(const int4*)(ixw + 16 * tl_ + 8 * hi + 4);
      kgC0 = KB16[(size_t)ia_.x * 32 + c31]; kgC1 = KB16[(size_t)ia_.y * 32 + c31]; kgC2 = KB16[(size_t)ia_.z * 32 + c31]; kgC3 = KB16[(size_t)ia_.w * 32 + c31];
      kgC4 = KB16[(size_t)ib_.x * 32 + c31]; kgC5 = KB16[(size_t)ib_.y * 32 + c31]; kgC6 = KB16[(size_t)ib_.z * 32 + c31]; kgC7 = KB16[(size_t)ib_.w * 32 + c31]; }
  for (int kt = 0; kt < ntile; kt += 3) {
    { char* wr = kst + (8 * hi) * AT_KROW + c31 * 16; *(uint4*)(wr + 0 * AT_KROW) = kgA0; *(uint4*)(wr + 1 * AT_KROW) = kgA1; *(uint4*)(wr + 2 * AT_KROW) = kgA2; *(uint4*)(wr + 3 * AT_KROW) = kgA3; *(uint4*)(wr + 4 * AT_KROW) = kgA4; *(uint4*)(wr + 5 * AT_KROW) = kgA5; *(uint4*)(wr + 6 * AT_KROW) = kgA6; *(uint4*)(wr + 7 * AT_KROW) = kgA7; }
    { const int tl_ = ((kt) + 3) < ntile ? ((kt) + 3) : ntile - 1;
      const int4 ia_ = *(const int4*)(ixw + 16 * tl_ + 8 * hi), ib_ = *(const int4*)(ixw + 16 * tl_ + 8 * hi + 4);
      kgA0 = KB16[(size_t)ia_.x * 32 + c31]; kgA1 = KB16[(size_t)ia_.y * 32 + c31]; kgA2 = KB16[(size_t)ia_.z * 32 + c31]; kgA3 = KB16[(size_t)ia_.w * 32 + c31];
      kgA4 = KB16[(size_t)ib_.x * 32 + c31]; kgA5 = KB16[(size_t)ib_.y * 32 + c31]; kgA6 = KB16[(size_t)ib_.z * 32 + c31]; kgA7 = KB16[(size_t)ib_.w * 32 + c31]; }
    cbar();
    AT_KMMA(kt);
    if (kt + 1 < ntile) {
    { char* wr = kst + (8 * hi) * AT_KROW + c31 * 16; *(uint4*)(wr + 0 * AT_KROW) = kgB0; *(uint4*)(wr + 1 * AT_KROW) = kgB1; *(uint4*)(wr + 2 * AT_KROW) = kgB2; *(uint4*)(wr + 3 * AT_KROW) = kgB3; *(uint4*)(wr + 4 * AT_KROW) = kgB4; *(uint4*)(wr + 5 * AT_KROW) = kgB5; *(uint4*)(wr + 6 * AT_KROW) = kgB6; *(uint4*)(wr + 7 * AT_KROW) = kgB7; }
    { const int tl_ = ((kt + 1) + 3) < ntile ? ((kt + 1) + 3) : ntile - 1;
      const int4 ia_ = *(const int4*)(ixw + 16 * tl_ + 8 * hi), ib_ = *(const int4*)(ixw + 16 * tl_ + 8 * hi + 4);
      kgB0 = KB16[(size_t)ia_.x * 32 + c31]; kgB1 = KB16[(size_t)ia_.y * 32 + c31]; kgB2 = KB16[(size_t)ia_.z * 32 + c31]; kgB3 = KB16[(size_t)ia_.w * 32 + c31];
      kgB4 = KB16[(size_t)ib_.x * 32 + c31]; kgB5 = KB16[(size_t)ib_.y * 32 + c31]; kgB6 = KB16[(size_t)ib_.z * 32 + c31]; kgB7 = KB16[(size_t)ib_.w * 32 + c31]; }
    cbar();
    AT_KMMA(kt + 1);
    }
    if (kt + 2 < ntile) {
    { char* wr = kst + (8 * hi) * AT_KROW + c31 * 16; *(uint4*)(wr + 0 * AT_KROW) = kgC0; *(uint4*)(wr + 1 * AT_KROW) = kgC1; *(uint4*)(wr + 2 * AT_KROW) = kgC2; *(uint4*)(wr + 3 * AT_KROW) = kgC3; *(uint4*)(wr + 4 * AT_KROW) = kgC4; *(uint4*)(wr + 5 * AT_KROW) = kgC5; *(uint4*)(wr + 6 * AT_KROW) = kgC6; *(uint4*)(wr + 7 * AT_KROW) = kgC7; }
    { const int tl_ = ((kt + 2) + 3) < ntile ? ((kt + 2) + 3) : ntile - 1;
      const int4 ia_ = *(const int4*)(ixw + 16 * tl_ + 8 * hi), ib_ = *(const int4*)(ixw + 16 * tl_ + 8 * hi + 4);
      kgC0 = KB16[(size_t)ia_.x * 32 + c31]; kgC1 = KB16[(size_t)ia_.y * 32 + c31]; kgC2 = KB16[(size_t)ia_.z * 32 + c31]; kgC3 = KB16[(size_t)ia_.w * 32 + c31];
      kgC4 = KB16[(size_t)ib_.x * 32 + c31]; kgC5 = KB16[(size_t)ib_.y * 32 + c31]; kgC6 = KB16[(size_t)ib_.z * 32 + c31]; kgC7 = KB16[(size_t)ib_.w * 32 + c31]; }
    cbar();
    AT_KMMA(kt + 2);
    }
  }
  lds_fence();
  const int ngroups = (nsel + 7) >> 3;
  float mx = -INFINITY;
#pragma unroll 8
  for (int i = 0; i < 32; ++i) {
    const int kk = 8 * i + dg;
    const int myidx = ixw[kk];
    const int dist = t - myidx;
    const int bk = dist < 128 ? lut[dist < 0 ? 0 : dist] : 31;
    const float raw = lgw[kk * 8 + h];
    const float lgt = (kk < nsel) ? raw + rb[bk * 8 + h] : -INFINITY;
    lgw[kk * 8 + h] = lgt;
    mx = fmaxf(mx, lgt);
  }
  mx = max8(mx);
  float sum = 0.f;
#pragma unroll 8
  for (int i = 0; i < 32; ++i) {
    const float pv = __expf(lgw[(8 * i + dg) * 8 + h] - mx);
    sum += pv;
    lgw[(8 * i + dg) * 8 + h] = pv;
  }
  sum = sum8(sum);
  {
    const float inv = 1.f / sum;
#pragma unroll 8
    for (int i = 0; i < 32; ++i) lgw[(8 * i + dg) * 8 + h] *= inv;
  }
  lds_fence();
  {
    uint4 pk[4];
#pragma unroll
    for (int k = 0; k < 4; ++k) {
      const float4 a_ = *(const float4*)(lgw + (4 * lane + k) * 8), b_ = *(const float4*)(lgw + (4 * lane + k) * 8 + 4);
      pk[k] = make_uint4(cvtpk(a_.x, a_.y), cvtpk(a_.z, a_.w), cvtpk(b_.x, b_.y), cvtpk(b_.z, b_.w));
    }
    uint4* pdst = (uint4*)(p.ws + prob_off(t)) + lane * 4;
    pdst[0] = pk[0]; pdst[1] = pk[1]; pdst[2] = pk[2]; pdst[3] = pk[3];
  }
  lds_fence();
}

DI void attn_pv_query(const Params& p, int t, int w, int lane) {
  const int h = lane >> 3, dg = lane & 7;
  unsigned short* pl = (unsigned short*)(smem + AT_WAVE + w * AT_WSZ);
  int* ixw = (int*)(smem + AT_WAVE + w * AT_WSZ + 8192);
  const int nsel = t + 1 < 256 ? t + 1 : 256;
  const unsigned short* sel = (const unsigned short*)(p.ws + O_SEL) + (size_t)t * 256;
#pragma unroll
  for (int j = 0; j < 4; ++j) {
    const int pos = lane + 64 * j;
    ixw[pos] = pos < nsel ? (int)sel[pos] : 0;
  }
  {
    const uint4* psrc = (const uint4*)(p.ws + prob_off(t)) + lane * 4;
    uint4* pd = (uint4*)pl + lane * 4;
    const uint4 a0 = psrc[0], a1 = psrc[1], a2 = psrc[2], a3 = psrc[3];
    pd[0] = a0; pd[1] = a1; pd[2] = a2; pd[3] = a3;
  }
  lds_fence();
  const uint2* VB = (const uint2*)(p.ws + O_VB);
  const int ngroups = (nsel + 7) >> 3;
  f32x2v o01 = {0.f, 0.f}, o23 = {0.f, 0.f}, o45 = {0.f, 0.f}, o67 = {0.f, 0.f};
  uint2 kc[16], kn[16];
#define AT_VLOAD16(dst, ib) do { _Pragma("unroll") for (int q_ = 0; q_ < 4; ++q_) { const int4 i_ = *(const int4*)(ixw + (ib) + 4 * q_); \
    dst[4 * q_ + 0] = VB[(size_t)i_.x * 64 + lane]; dst[4 * q_ + 1] = VB[(size_t)i_.y * 64 + lane]; \
    dst[4 * q_ + 2] = VB[(size_t)i_.z * 64 + lane]; dst[4 * q_ + 3] = VB[(size_t)i_.w * 64 + lane]; } } while (0)
  const int ng16 = (nsel + 15) >> 4;
  AT_VLOAD16(kc, 0);
  for (int i = 0; i < ng16; ++i) {
    { const int nx = (i + 1 < ng16) ? i + 1 : i; AT_VLOAD16(kn, 16 * nx); }
    const float pa = bf2f(pl[(16 * i + dg) * 8 + h]);
    const float pbv = bf2f(pl[(16 * i + 8 + dg) * 8 + h]);
#pragma unroll
    for (int d = 0; d < 16; ++d) {
      const float pb = __shfl(d < 8 ? pa : pbv, (lane & ~7) | (d & 7));
      const f32x2v pb2 = {pb, pb};
      o01 = __builtin_amdgcn_cvt_pk_f32_fp8(kc[d].x, false) * pb2 + o01;
      o23 = __builtin_amdgcn_cvt_pk_f32_fp8(kc[d].x, true) * pb2 + o23;
      o45 = __builtin_amdgcn_cvt_pk_f32_fp8(kc[d].y, false) * pb2 + o45;
      o67 = __builtin_amdgcn_cvt_pk_f32_fp8(kc[d].y, true) * pb2 + o67;
    }
#pragma unroll
    for (int d = 0; d < 16; ++d) kc[d] = kn[d];
  }
  const uint4 zv = ((const uint4*)(p.ws + O_ZB))[(size_t)t * 64 + lane];
  uint4 ov;
  ov.x = cvtpk(o01.x * bflo(zv.x), o01.y * bfhi(zv.x));
  ov.y = cvtpk(o23.x * bflo(zv.y), o23.y * bfhi(zv.y));
  ov.z = cvtpk(o45.x * bflo(zv.z), o45.y * bfhi(zv.z));
  ov.w = cvtpk(o67.x * bflo(zv.w), o67.y * bfhi(zv.w));
  ((uint4*)(p.ws + O_AB))[tiled_unit(t, lane * 8, 32)] = ov;
  lds_fence();
}

constexpr int HC_B = 0;
constexpr int HC_QT = 33792;
constexpr int HC_QH = HC_QT + 17408;
constexpr int HC_KH = HC_QH + 17408;
constexpr int HC_VT = HC_KH + 17408;
constexpr int HC_P = HC_VT + 18432;
constexpr int HC_TOT = HC_P + 9216;
DI void hgrn_c_item(const Params& p, int layer, int c, int h) {
  const int tid = vtid(), lane = tid & 63, w = tid >> 6, hi = lane >> 5, c31 = lane & 31;
  float* bL = (float*)(smem + HC_B);
  unsigned short* qT = (unsigned short*)(smem + HC_QT);
  unsigned short* qH = (unsigned short*)(smem + HC_QH);
  unsigned short* kH = (unsigned short*)(smem + HC_KH);
  unsigned short* vT = (unsigned short*)(smem + HC_VT);
  unsigned short* P = (unsigned short*)(smem + HC_P);
  float* tot = (float*)(smem + HC_TOT);
  const float* G = (const float*)(p.ws + O_G);
  const unsigned short* KK = (const unsigned short*)(p.ws + O_KK);
  const unsigned short* IA = (const unsigned short*)(p.ws + O_IA);
  const unsigned short* QA = (const unsigned short*)(p.ws + O_QA);
  const int mt = w >> 2, nv = w & 3;
  const uint4* us = (const uint4*)(p.ws + O_US + (size_t)(c * 4 + h) * 32768);
  uint4 sfr[8];
#pragma unroll
  for (int ks = 0; ks < 8; ++ks) sfr[ks] = us[(nv * 8 + ks) * 64 + lane];
  uint4 qv_pre[2], kv_pre[2];
#pragma unroll
  for (int rep = 0; rep < 2; ++rep) {
    const int pr = tid + 512 * rep, t = pr >> 4, oc = pr & 15;
    qv_pre[rep] = *(const uint4*)(QA + (size_t)(64 * c + t) * 512 + 128 * h + oc * 8);
    kv_pre[rep] = *(const uint4*)(KK + (size_t)(64 * c + t) * 512 + 128 * h + oc * 8);
  }
  const uint4 z0_pre = *(const uint4*)((const unsigned short*)(p.ws + O_ZA) + (size_t)(64 * c + (tid >> 3)) * 512 + 128 * h + 16 * (tid & 7));
  const uint4 z1_pre = *(const uint4*)((const unsigned short*)(p.ws + O_ZA) + (size_t)(64 * c + (tid >> 3)) * 512 + 128 * h + 16 * (tid & 7) + 8);
  {
    const int seg = tid >> 7, k = tid & 127;
    const size_t rowbase = (size_t)(64 * c + 16 * seg);
    float b[16];
    float run = 0.f;
#pragma unroll
    for (int i = 0; i < 16; ++i) { run += G[(rowbase + i) * 512 + 128 * h + k]; b[i] = run; }
    tot[seg * 128 + k] = run;
    unsigned pv[8];
#pragma unroll
    for (int i = 0; i < 16; i += 2) {
      unsigned v0 = IA[(rowbase + i) * 512 + 128 * h + k], v1 = IA[(rowbase + i + 1) * 512 + 128 * h + k];
      pv[i >> 1] = v0 | (v1 << 16);
    }
    uint4* dv = (uint4*)(vT + k * 72 + 16 * seg);
    dv[0] = make_uint4(pv[0], pv[1], pv[2], pv[3]); dv[1] = make_uint4(pv[4], pv[5], pv[6], pv[7]);
    __syncthreads();
    float off = 0.f;
#pragma unroll
    for (int s2 = 0; s2 < 4; ++s2) { float tv = tot[s2 * 128 + k]; if (s2 < seg) off += tv; }
#pragma unroll
    for (int i = 0; i < 16; ++i) bL[(16 * seg + i) * 132 + k] = b[i] + off;
  }
  __syncthreads();
#pragma unroll
  for (int rep = 0; rep < 2; ++rep) {
    const int pr = tid + 512 * rep, t = pr >> 4, oc = pr & 15;
    const float4 b0 = *(const float4*)(bL + t * 132 + oc * 8), b1 = *(const float4*)(bL + t * 132 + oc * 8 + 4);
    const float4 r0 = *(const float4*)(bL + 31 * 132 + oc * 8), r1 = *(const float4*)(bL + 31 * 132 + oc * 8 + 4);
    const uint4 qv = qv_pre[rep];
    const uint4 kv = kv_pre[rep];
    const float bb[8] = {b0.x, b0.y, b0.z, b0.w, b1.x, b1.y, b1.z, b1.w};
    const float rr[8] = {r0.x, r0.y, r0.z, r0.w, r1.x, r1.y, r1.z, r1.w};
    const float qq[8] = {bflo(qv.x), bfhi(qv.x), bflo(qv.y), bfhi(qv.y), bflo(qv.z), bfhi(qv.z), bflo(qv.w), bfhi(qv.w)};
    const float kq[8] = {bflo(kv.x), bfhi(kv.x), bflo(kv.y), bfhi(kv.y), bflo(kv.z), bfhi(kv.z), bflo(kv.w), bfhi(kv.w)};
    float a1[8], a2[8], a3[8];
#pragma unroll
    for (int e = 0; e < 8; ++e) {
      a1[e] = qq[e] * __expf(bb[e]);
      a2[e] = qq[e] * __expf(bb[e] - rr[e]);
      a3[e] = kq[e] * __expf(rr[e] - bb[e]);
    }
    *(uint4*)(qT + t * 136 + oc * 8) = make_uint4(cvtpk(a1[0], a1[1]), cvtpk(a1[2], a1[3]), cvtpk(a1[4], a1[5]), cvtpk(a1[6], a1[7]));
    *(uint4*)(qH + t * 136 + oc * 8) = make_uint4(cvtpk(a2[0], a2[1]), cvtpk(a2[2], a2[3]), cvtpk(a2[4], a2[5]), cvtpk(a2[6], a2[7]));
    *(uint4*)(kH + t * 136 + oc * 8) = make_uint4(cvtpk(a3[0], a3[1]), cvtpk(a3[2], a3[3]), cvtpk(a3[4], a3[5]), cvtpk(a3[6], a3[7]));
  }
  __syncthreads();
  if (w < 4) {
    const int ms = w >> 1, ntq = w & 1;
    f32x16 sacc;
#pragma unroll
    for (int r = 0; r < 16; ++r) sacc[r] = 0.f;
#pragma unroll
    for (int ks = 0; ks < 8; ++ks) {
      bf16x8 af = __builtin_bit_cast(bf16x8, *(const uint4*)(kH + (32 * ms + c31) * 136 + 16 * ks + 8 * hi));
      bf16x8 bfv = __builtin_bit_cast(bf16x8, *(const uint4*)(qH + (32 * ntq + c31) * 136 + 16 * ks + 8 * hi));
      sacc = MFMA(af, bfv, sacc);
    }
    const int t = 32 * ntq + c31;
#pragma unroll
    for (int gq = 0; gq < 4; ++gq) {
      const int s0 = 32 * ms + 8 * gq + 4 * hi;
      float v0 = (s0 + 0 <= t) ? sacc[4 * gq + 0] : 0.f;
      float v1 = (s0 + 1 <= t) ? sacc[4 * gq + 1] : 0.f;
      float v2 = (s0 + 2 <= t) ? sacc[4 * gq + 2] : 0.f;
      float v3 = (s0 + 3 <= t) ? sacc[4 * gq + 3] : 0.f;
      uint2 val; val.x = cvtpk(v0, v1); val.y = cvtpk(v2, v3);
      *(uint2*)(P + t * 72 + s0) = val;
    }
  }
  f32x16 oacc;
#pragma unroll
  for (int r = 0; r < 16; ++r) oacc[r] = 0.f;
#pragma unroll
  for (int ks = 0; ks < 8; ++ks) {
    bf16x8 af = __builtin_bit_cast(bf16x8, *(const uint4*)(qT + (32 * mt + c31) * 136 + 16 * ks + 8 * hi));
    oacc = MFMA(af, __builtin_bit_cast(bf16x8, sfr[ks]), oacc);
  }
  __syncthreads();
#pragma unroll
  for (int ks = 0; ks < 4; ++ks) {
    bf16x8 af = __builtin_bit_cast(bf16x8, *(const uint4*)(P + (32 * mt + c31) * 72 + 16 * ks + 8 * hi));
    bf16x8 bfv = __builtin_bit_cast(bf16x8, *(const uint4*)(vT + (32 * nv + c31) * 72 + 16 * ks + 8 * hi));
    oacc = MFMA(af, bfv, oacc);
  }
  float* oL = bL;
#pragma unroll
  for (int r = 0; r < 16; ++r) oL[(32 * mt + crow(r, hi)) * 132 + 32 * nv + c31] = oacc[r];
  __syncthreads();
  {
    const int t = tid >> 3, sg = tid & 7;
    float ov[16];
#pragma unroll
    for (int e = 0; e < 16; e += 4) {
      const float4 f = *(const float4*)(oL + t * 132 + 16 * sg + e);
      ov[e] = f.x; ov[e + 1] = f.y; ov[e + 2] = f.z; ov[e + 3] = f.w;
    }
    float ss = 0.f;
#pragma unroll
    for (int e = 0; e < 16; ++e) ss = fmaf(ov[e], ov[e], ss);
    ss += __shfl_xor(ss, 1);
    ss += __shfl_xor(ss, 2);
    ss += __shfl_xor(ss, 4);
    const float rs = rsqrtf(ss * (1.f / 128.f) + 1e-6f);
    const int tg = 64 * c + t, k0 = 128 * h + 16 * sg;
    const float* ng = p.norm_a_g + (size_t)layer * 512 + k0;
    const uint4 z0 = z0_pre, z1 = z1_pre;
    const float zz[16] = {bflo(z0.x), bfhi(z0.x), bflo(z0.y), bfhi(z0.y), bflo(z0.z), bfhi(z0.z), bflo(z0.w), bfhi(z0.w),
                          bflo(z1.x), bfhi(z1.x), bflo(z1.y), bfhi(z1.y), bflo(z1.z), bfhi(z1.z), bflo(z1.w), bfhi(z1.w)};
    float rr[16];
#pragma unroll
    for (int e = 0; e < 16; ++e) rr[e] = ov[e] * rs * ng[e] * zz[e];
    uint4* aa = (uint4*)(p.ws + O_AA);
    aa[tiled_unit(tg, k0, 32)] = make_uint4(cvtpk(rr[0], rr[1]), cvtpk(rr[2], rr[3]), cvtpk(rr[4], rr[5]), cvtpk(rr[6], rr[7]));
    aa[tiled_unit(tg, k0 + 8, 32)] = make_uint4(cvtpk(rr[8], rr[9]), cvtpk(rr[10], rr[11]), cvtpk(rr[12], rr[13]), cvtpk(rr[14], rr[15]));
  }
  __syncthreads();
}

DI void acc_to_lds_bf16(f32x16 (&acc)[2][2], unsigned short* tile) {
  const int tid = vtid(), lane = tid & 63, w = tid >> 6, wm = w >> 1, wn = w & 1, hi = lane >> 5, c31 = lane & 31;
#pragma unroll
  for (int i = 0; i < 2; ++i)
#pragma unroll
    for (int j = 0; j < 2; ++j)
#pragma unroll
      for (int r = 0; r < 16; ++r)
        tile[(64 * wm + 32 * i + crow(r, hi)) * 128 + 64 * wn + 32 * j + c31] = f2bf(acc[i][j][r]);
}
DI void p5_tile(const Params& p, int mb, int nt) {
  const int tid = vtid(), lane = tid & 63, w = tid >> 6, wm = w >> 1, wn = w & 1, hi = lane >> 5, c31 = lane & 31;
  f32x16 acc[2][2];
  zero_acc(acc);
  gemm_core((const uint4*)(p.ws + O_AA), mb * 8, (const uint4*)(p.ws + O_WUA), nt * 4, 32, acc, (uint4*)smem);
  unsigned uap[2][2][8];
#pragma unroll
  for (int i = 0; i < 2; ++i)
#pragma unroll
    for (int j = 0; j < 2; ++j)
#pragma unroll
      for (int r = 0; r < 16; r += 2) uap[i][j][r >> 1] = cvtpk(acc[i][j][r], acc[i][j][r + 1]);
  zero_acc(acc);
  gemm_core((const uint4*)(p.ws + O_AB), mb * 8, (const uint4*)(p.ws + O_WUB), nt * 4, 32, acc, (uint4*)smem);
  unsigned short* tA = (unsigned short*)smem;
  unsigned short* tB = (unsigned short*)(smem + 65536);
#pragma unroll
  for (int i = 0; i < 2; ++i)
#pragma unroll
    for (int j = 0; j < 2; ++j)
#pragma unroll
      for (int r = 0; r < 16; r += 2) {
        const int o0 = (64 * wm + 32 * i + crow(r, hi)) * 128 + 64 * wn + 32 * j + c31;
        tA[o0] = (unsigned short)(uap[i][j][r >> 1] & 0xffffu);
        tA[o0 + 128] = (unsigned short)(uap[i][j][r >> 1] >> 16);
        tB[o0] = f2bf(acc[i][j][r]);
        tB[o0 + 128] = f2bf(acc[i][j][r + 1]);
      }
  __syncthreads();
  const int row0 = mb * 256;
#pragma unroll 2
  for (int q = 0; q < 8; ++q) {
    const int u = tid + 512 * q, r = u >> 4, c8 = u & 15;
    const uint4 ua = *(const uint4*)&tA[r * 128 + c8 * 8];
    const uint4 ub = *(const uint4*)&tB[r * 128 + c8 * 8];
    const int t = row0 + r, n0 = nt * 128 + c8 * 8;
    const uint4 ga = *(const uint4*)(p.ws + O_SGA + ((size_t)t * 1024 + n0) * 2);
    const uint4 gb = *(const uint4*)(p.ws + O_SGB + ((size_t)t * 1024 + n0) * 2);
    uint4 o;
    o.x = cvtpk(bflo(ga.x) * bflo(ua.x) + bflo(gb.x) * bflo(ub.x), bfhi(ga.x) * bfhi(ua.x) + bfhi(gb.x) * bfhi(ub.x));
    o.y = cvtpk(bflo(ga.y) * bflo(ua.y) + bflo(gb.y) * bflo(ub.y), bfhi(ga.y) * bfhi(ua.y) + bfhi(gb.y) * bfhi(ub.y));
    o.z = cvtpk(bflo(ga.z) * bflo(ua.z) + bflo(gb.z) * bflo(ub.z), bfhi(ga.z) * bfhi(ua.z) + bfhi(gb.z) * bfhi(ub.z));
    o.w = cvtpk(bflo(ga.w) * bflo(ua.w) + bflo(gb.w) * bflo(ub.w), bfhi(ga.w) * bfhi(ua.w) + bfhi(gb.w) * bfhi(ub.w));
    ((uint4*)(p.ws + O_MG))[tiled_unit(t, n0, 64)] = o;
  }
  __syncthreads();
}

DI void p6_tile(const Params& p, int layer, int mb, int nt) {
  const int tid = vtid(), lane = tid & 63, w = tid >> 6, wm = w >> 1, wn = w & 1, hi = lane >> 5, c31 = lane & 31;
  f32x16 acc[2][2];
  zero_acc(acc);
  gemm_core((const uint4*)(p.ws + O_MG), mb * 8, (const uint4*)(p.ws + O_WOUT), nt * 4, 64, acc, (uint4*)smem);
  const float* hin = (layer == 0) ? p.x : p.out;
#pragma unroll
  for (int i = 0; i < 2; ++i)
#pragma unroll
    for (int j = 0; j < 2; ++j)
#pragma unroll
      for (int r = 0; r < 16; ++r) {
        const size_t idx = (size_t)(mb * 256 + 64 * wm + 32 * i + crow(r, hi)) * DM + nt * 128 + 64 * wn + 32 * j + c31;
        p.out[idx] = fmaf(ALPHA_, hin[idx], acc[i][j][r]);
      }
}

DI float dpp_add_f(float v, int which) {
  const int iv = __builtin_bit_cast(int, v);
  int r;
  switch (which) {
    case 0: r = __builtin_amdgcn_update_dpp(0, iv, 0x111, 0xf, 0xf, true); break;
    case 1: r = __builtin_amdgcn_update_dpp(0, iv, 0x112, 0xf, 0xf, true); break;
    case 2: r = __builtin_amdgcn_update_dpp(0, iv, 0x114, 0xf, 0xf, true); break;
    case 3: r = __builtin_amdgcn_update_dpp(0, iv, 0x118, 0xf, 0xf, true); break;
    default: r = __builtin_amdgcn_update_dpp(0, iv, 0x142, 0xa, 0xf, false); break;
  }
  return v + __builtin_bit_cast(float, r);
}
DI float half_sum_to_last(float v) {
  v = dpp_add_f(v, 0); v = dpp_add_f(v, 1); v = dpp_add_f(v, 2); v = dpp_add_f(v, 3); v = dpp_add_f(v, 4);
  return v;
}
DI void fused_out_ln(const Params& p, int layer, int mb64) {
  const int tid = vtid(), lane = tid & 63, w = tid >> 6, hi = lane >> 5, c31 = lane & 31;
  uint4* lds = (uint4*)smem;
  const uint4* A = (const uint4*)(p.ws + O_MG) + (size_t)(2 * mb64) * 64 * 64;
#pragma unroll
  for (int r = 0; r < 16; ++r)
    __builtin_amdgcn_global_load_lds((const unsigned*)(A + tid + 512 * r), (unsigned*)(lds + tid + 512 * r), 16, 0, 0);
  const uint4* Bw = (const uint4*)(p.ws + O_WOUT) + (size_t)(4 * w) * 64 * 64 + lane;
  uint4 bq[4][4];
#pragma unroll
  for (int s_ = 0; s_ < 4; ++s_)
#pragma unroll
    for (int j = 0; j < 4; ++j) bq[s_][j] = Bw[(size_t)(j * 64 + s_) * 64];
  f32x16 acc[2][4];
#pragma unroll
  for (int i = 0; i < 2; ++i)
#pragma unroll
    for (int j = 0; j < 4; ++j)
#pragma unroll
      for (int r = 0; r < 16; ++r) acc[i][j][r] = 0.f;
  __syncthreads();
#pragma unroll 1
  for (int k4 = 0; k4 < 16; ++k4) {
#pragma unroll
    for (int s_ = 0; s_ < 4; ++s_) {
      const int ks = 4 * k4 + s_;
      const bf16x8 a0 = __builtin_bit_cast(bf16x8, lds[ks * 64 + lane]);
      const bf16x8 a1 = __builtin_bit_cast(bf16x8, lds[4096 + ks * 64 + lane]);
#pragma unroll
      for (int j = 0; j < 4; ++j) {
        const bf16x8 b = __builtin_bit_cast(bf16x8, bq[s_][j]);
        acc[0][j] = MFMA(a0, b, acc[0][j]);
        acc[1][j] = MFMA(a1, b, acc[1][j]);
      }
      if (k4 < 15) {
#pragma unroll
        for (int j = 0; j < 4; ++j) bq[s_][j] = Bw[(size_t)(j * 64 + ks + 4) * 64];
      }
    }
  }
  const float* hin = (layer == 0) ? p.x : p.out;
  float* ft = (float*)smem;
  uint2* hb2 = (uint2*)(p.ws + O_HB);
  const int rr = tid >> 4, seg = tid & 15;
#pragma unroll
  for (int i = 0; i < 2; ++i) {
    __syncthreads();
    {
      float* b0 = ft + (4 * hi) * 1024 + 128 * w + c31;
      float* b1 = b0 + 16 * 1024;
#pragma unroll
      for (int j = 0; j < 4; ++j)
#pragma unroll
        for (int r = 0; r < 16; ++r) {
          float* bp = (r < 8) ? b0 : b1;
          bp[((r & 3) + 8 * ((r >> 2) & 1)) * 1024 + 32 * j] = acc[i][j][r];
        }
    }
    __syncthreads();
    const int trow = 64 * mb64 + 32 * i + rr;
    const float* hrow = hin + (size_t)trow * DM;
    float s1 = 0.f, s2 = 0.f;
    float* frow = ft + rr * 1024 + 4 * seg;
#pragma unroll 4
    for (int e = 0; e < 16; ++e) {
      const float4 y = *(const float4*)(frow + 64 * e);
      const float4 hv = *(const float4*)(hrow + 64 * e + 4 * seg);
      float4 pre;
      pre.x = fmaf(ALPHA_, hv.x, y.x); pre.y = fmaf(ALPHA_, hv.y, y.y); pre.z = fmaf(ALPHA_, hv.z, y.z); pre.w = fmaf(ALPHA_, hv.w, y.w);
      s1 += (pre.x + pre.y) + (pre.z + pre.w);
      s2 = fmaf(pre.x, pre.x, s2); s2 = fmaf(pre.y, pre.y, s2); s2 = fmaf(pre.z, pre.z, s2); s2 = fmaf(pre.w, pre.w, s2);
      *(float4*)(frow + 64 * e) = pre;
    }
    s1 += __shfl_xor(s1, 1); s1 += __shfl_xor(s1, 2); s1 += __shfl_xor(s1, 4); s1 += __shfl_xor(s1, 8);
    s2 += __shfl_xor(s2, 1); s2 += __shfl_xor(s2, 2); s2 += __shfl_xor(s2, 4); s2 += __shfl_xor(s2, 8);
    const float mu = s1 * (1.f / 1024.f);
    const float rs = rsqrtf(fmaxf(s2 * (1.f / 1024.f) - mu * mu, 0.f) + 1e-5f);
    const float* gp = p.ln_g + (size_t)layer * DM;
    const float* bp2 = p.ln_b + (size_t)layer * DM;
    float* orow = p.out + (size_t)trow * DM;
#pragma unroll 4
    for (int e = 0; e < 16; ++e) {
      const int c0 = 64 * e + 4 * seg;
      const float4 pre = *(const float4*)(frow + 64 * e);
      const float4 g4 = *(const float4*)(gp + c0), b4 = *(const float4*)(bp2 + c0);
      float4 o;
      o.x = (pre.x - mu) * rs * g4.x + b4.x; o.y = (pre.y - mu) * rs * g4.y + b4.y;
      o.z = (pre.z - mu) * rs * g4.z + b4.z; o.w = (pre.w - mu) * rs * g4.w + b4.w;
      *(float4*)(orow + c0) = o;
      hb2[tiled_unit(trow, c0 & ~7, 64) * 2 + ((c0 >> 2) & 1)] = make_uint2(cvtpk(o.x, o.y), cvtpk(o.z, o.w));
    }
  }
  __syncthreads();
}

DI void p7_rows(const Params& p, int layer) {
  const int tid = vtid();
  const int lane = tid & 63, gw = blockIdx.x * 8 + (tid >> 6), nw = gridDim.x * 8;
  const float* g = p.ln_g + (size_t)layer * DM;
  const float* bb = p.ln_b + (size_t)layer * DM;
  uint4* hb = (uint4*)(p.ws + O_HB);
  for (int t = gw; t < L_; t += nw) {
    float* row = p.out + (size_t)t * DM;
    float v[16];
#pragma unroll
    for (int q = 0; q < 2; ++q) {
      const float4 a = *(const float4*)(row + q * 512 + lane * 8), b = *(const float4*)(row + q * 512 + lane * 8 + 4);
      v[8 * q + 0] = a.x; v[8 * q + 1] = a.y; v[8 * q + 2] = a.z; v[8 * q + 3] = a.w;
      v[8 * q + 4] = b.x; v[8 * q + 5] = b.y; v[8 * q + 6] = b.z; v[8 * q + 7] = b.w;
    }
    float s = 0.f;
#pragma unroll
    for (int e = 0; e < 16; ++e) s += v[e];
#pragma unroll
    for (int off = 1; off < 64; off <<= 1) s += __shfl_xor(s, off);
    const float mu = s * (1.f / 1024.f);
    float ss = 0.f;
#pragma unroll
    for (int e = 0; e < 16; ++e) { const float d = v[e] - mu; ss = fmaf(d, d, ss); }
#pragma unroll
    for (int off = 1; off < 64; off <<= 1) ss += __shfl_xor(ss, off);
    const float rs = rsqrtf(ss * (1.f / 1024.f) + 1e-5f);
#pragma unroll
    for (int q = 0; q < 2; ++q) {
      const int k0 = q * 512 + lane * 8;
      float o[8];
#pragma unroll
      for (int e = 0; e < 8; ++e) o[e] = (v[8 * q + e] - mu) * rs * g[k0 + e] + bb[k0 + e];
      *(float4*)(row + k0) = make_float4(o[0], o[1], o[2], o[3]);
      *(float4*)(row + k0 + 4) = make_float4(o[4], o[5], o[6], o[7]);
      hb[tiled_unit(t, k0, 64)] = make_uint4(cvtpk(o[0], o[1]), cvtpk(o[2], o[3]), cvtpk(o[4], o[5]), cvtpk(o[6], o[7]));
    }
  }
}


#define XB_TMO      128
#define XB_XCNT(j)  (256  + 64 * (j))
#define XB_XSUB(j)  (1280 + 64 * (j))
#define XB_XGEN(j)  (2304 + 64 * (j))
#define XB_TOP      3328
#define XB_TOPGEN   3392
#define XCD_BAR_WORDS 3456
#define XB_SPIN_CAP (1u << 22)
#define LAS __attribute__((address_space(3)))
DI unsigned xb_ld(unsigned* p)              { return __hip_atomic_load(p, __ATOMIC_RELAXED, __HIP_MEMORY_SCOPE_AGENT); }
DI unsigned xb_add(unsigned* p, unsigned v) { return __hip_atomic_fetch_add(p, v, __ATOMIC_RELAXED, __HIP_MEMORY_SCOPE_AGENT); }
DI unsigned xb_xcc_id() { return (unsigned)__builtin_amdgcn_s_getreg((3 << 11) | 20) & 0xFu; }
#define XB_SPIN(cond, bar) do { unsigned _sp = 0; while (cond) { __builtin_amdgcn_s_sleep(1); \
    if ((++_sp & 255u) == 0u) { if (xb_ld(&(bar)[XB_TMO])) break; if (_sp > XB_SPIN_CAP) { atomicAdd(&(bar)[XB_TMO], 1u); break; } } } } while (0)
struct XcdBarrier { unsigned* bar; unsigned x; volatile LAS unsigned* st; };
DI XcdBarrier xcd_barrier_post(unsigned* bar, volatile LAS unsigned* st) {
  XcdBarrier b; b.bar = bar; b.x = xb_xcc_id(); b.st = st;
  if (threadIdx.x == 0) (void)xb_add(&bar[XB_XCNT(b.x)], 1u);
  return b;
}
DI void xcd_barrier_complete(unsigned* bar, unsigned x, unsigned& nloc, unsigned& nx) {
  const unsigned G = gridDim.x * gridDim.y * gridDim.z;
  unsigned sum, cnt, mine, sp = 0u;
  for (;;) {
    sum = 0u; cnt = 0u; mine = 0u;
#pragma unroll
    for (unsigned j = 0; j < 16; ++j) { const unsigned c = xb_ld(&bar[XB_XCNT(j)]); sum += c; cnt += (c > 0u) ? 1u : 0u; mine = (j == x) ? c : mine; }
    if (sum == G) break;
    __builtin_amdgcn_s_sleep(1);
    if ((++sp & 255u) == 0u) { if (xb_ld(&bar[XB_TMO])) break; if (sp > XB_SPIN_CAP) { atomicAdd(&bar[XB_TMO], 1u); break; } }
  }
  nloc = mine > 0u ? mine : 1u; nx = cnt > 0u ? cnt : 1u;
}
DI void xcd_barrier(const XcdBarrier& b) {
  asm volatile("s_waitcnt vmcnt(0)" ::: "memory");
  __syncthreads();
  if (threadIdx.x == 0) {
    unsigned* bar = b.bar;
    __builtin_amdgcn_s_waitcnt(0);
    unsigned nloc = b.st[0], nx = b.st[1];
    if (nloc == 0u) { xcd_barrier_complete(bar, b.x, nloc, nx); b.st[0] = nloc; b.st[1] = nx; }
    const unsigned old = xb_add(&bar[XB_XSUB(b.x)], 1u);
    const unsigned gen = old / nloc;
    if (old + 1u == (gen + 1u) * nloc) {
      __builtin_amdgcn_fence(__ATOMIC_RELEASE, "agent");
      asm volatile("s_waitcnt vmcnt(0)" ::: "memory");
      const unsigned og = xb_add(&bar[XB_TOP], 1u);
      const unsigned tg = og / nx;
      if (og + 1u == (tg + 1u) * nx) xb_add(&bar[XB_TOPGEN], 1u);
      else XB_SPIN(xb_ld(&bar[XB_TOPGEN]) == tg, bar);
      __builtin_amdgcn_fence(__ATOMIC_ACQUIRE, "agent");
      xb_add(&bar[XB_XGEN(b.x)], 1u);
      asm volatile("s_waitcnt vmcnt(0)" ::: "memory");
    } else {
      XB_SPIN(xb_ld(&bar[XB_XGEN(b.x)]) == gen, bar);
      __builtin_amdgcn_fence(__ATOMIC_ACQUIRE, "agent");
      asm volatile("s_waitcnt vmcnt(0)" ::: "memory");
    }
  }
  __syncthreads();
}
constexpr int LDS_BARST = 163840 - 16;

__global__ void __launch_bounds__(512) mk(Params p) {
  cg::grid_group grid = cg::this_grid();
  const int nb = gridDim.x, bid = blockIdx.x;
  volatile LAS unsigned* bst_ = (volatile LAS unsigned*)(smem + LDS_BARST);
  if (threadIdx.x < 4) bst_[threadIdx.x] = 0u;
  __syncthreads();
  (void)xcd_barrier_post((unsigned*)(p.ws + O_BAR), bst_);
#define XB_NOW() XcdBarrier{(unsigned*)(p.ws + O_BAR), xb_xcc_id(), (volatile LAS unsigned*)(smem + LDS_BARST)}
  phase0(p);
  grid.sync();
  for (int layer = 0; layer < DEPTH_; ++layer) {
    {
      const int gtid = bid * 512 + vtid(), gthreads = nb * 512;
      conv_weight(p.w_up_a + (size_t)layer * 512 * 1024, 512, 1024, 1024, false, (uint4*)(p.ws + O_WUA), gtid, gthreads);
      conv_weight(p.w_up_b + (size_t)layer * 512 * 1024, 512, 1024, 1024, false, (uint4*)(p.ws + O_WUB), gtid, gthreads);
      conv_weight(p.w_out + (size_t)layer * 1024 * 1024, 1024, 1024, 1024, false, (uint4*)(p.ws + O_WOUT), gtid, gthreads);
#ifndef NO_P1
      for (int id = bid; id < 64 * 53; id += nb) p1_tile(p, layer, id & 63, id >> 6);
#endif
    }
    xcd_barrier(XB_NOW());
    {
      if (layer + 1 < DEPTH_) {
        const int gtid = bid * 512 + vtid(), gthreads = nb * 512;
        conv_weight(p.w_in + (size_t)(layer + 1) * 1024 * NIN, 1024, NIN, NPAD, true, (uint4*)(p.ws + O_WTIN), gtid, gthreads);
      }
#ifndef NO_HA
      for (int id = bid; id < 1024; id += nb) hgrn_a_item(p, id >> 2, id & 3);
#endif
      for (int s = bid; s < 1024; s += nb) {
        const int rnd = s / nb, pos = s - rnd * nb;
        const int rem = 1024 - rnd * nb, count = rem < nb ? rem : nb;
        const int sp = (rnd & 1) ? (rnd * nb + count - 1 - pos) : s;
        indexer_item(p, 1023 - sp);
      }
    }
    xcd_barrier(XB_NOW());
    {
      attn_setup();
      const int tid = vtid();
      if (tid < 256) ((float*)(smem + AT_RB))[tid] = p.rel_bias[tid];
      __syncthreads();
#ifndef NO_SCAN
      hgrn_scan(p);
#endif
      const int w = tid >> 6, lane = tid & 63;
#ifndef NO_ATT
      for (int t = bid * 8 + w; t < L_; t += nb * 8) attn_query(p, t, w, lane);
#endif
      __syncthreads();
    }
    xcd_barrier(XB_NOW());
    {
      const int tid = vtid();
      const int w = tid >> 6, lane = tid & 63;
      for (int t = bid * 8 + w; t < L_; t += nb * 8) attn_pv_query(p, t, w, lane);
      __syncthreads();
    }
    xcd_barrier(XB_NOW());
#ifndef NO_HC
    for (int id = bid; id < 1024; id += nb) hgrn_c_item(p, layer, id >> 2, id & 3);
#endif
    xcd_barrier(XB_NOW());
#ifndef NO_P5
    for (int id = bid; id < 64 * 8; id += nb) p5_tile(p, id & 63, id >> 6);
#endif
    xcd_barrier(XB_NOW());
    for (int id = bid; id < 256; id += nb) fused_out_ln(p, layer, id);
    xcd_barrier(XB_NOW());
  }}

extern "C" void kernel_launch(void* const* d_in, const int* in_sizes, int n_in, void* d_out, int out_size, void* d_ws,
                              size_t ws_size, hipStream_t stream) {
  constexpr size_t kLds = 160 * 1024;
  static int grid_blocks = 0;
  if (!grid_blocks) {
    int dev = 0, cus = 0, per_cu = 0;
    (void)hipGetDevice(&dev);
    (void)hipDeviceGetAttribute(&cus, hipDeviceAttributeMultiprocessorCount, dev);
    (void)hipFuncSetAttribute((const void*)mk, hipFuncAttributeMaxDynamicSharedMemorySize, (int)kLds);
    (void)hipOccupancyMaxActiveBlocksPerMultiprocessor(&per_cu, mk, 512, kLds);
    if (per_cu > 1) per_cu = 1;
    grid_blocks = cus * per_cu;
  }
  if (ws_size < WS_NEED || grid_blocks <= 0) { fprintf(stderr, "ws too small or no occupancy\n"); return; }
  Params p{};
  p.x = (const float*)d_in[0]; p.w_in = (const float*)d_in[1]; p.b_in = (const float*)d_in[2];
  p.w_up_a = (const float*)d_in[3]; p.w_up_b = (const float*)d_in[4]; p.w_out = (const float*)d_in[5];
  p.lb_logits = (const float*)d_in[6]; p.norm_a_g = (const float*)d_in[7]; p.rel_bias = (const float*)d_in[8];
  p.ln_g = (const float*)d_in[9]; p.ln_b = (const float*)d_in[10];
  p.out = (float*)d_out; p.ws = (char*)d_ws;
  (void)hipMemsetAsync((char*)d_ws + O_BAR, 0, XCD_BAR_WORDS * 4, stream);
  void* args[] = {&p};
  hipError_t e = hipLaunchCooperativeKernel((void*)mk, dim3(grid_blocks), dim3(512), args, kLds, stream);
  if (e != hipSuccess) fprintf(stderr, "cooperative launch failed: %s (grid %d)\n", hipGetErrorString(e), grid_blocks);
}
```

```cpp
#include <hip/hip_runtime.h>
#include <hip/hip_cooperative_groups.h>
#include <cstdio>
#include <cstdint>
namespace cg = cooperative_groups;

#define DI __device__ __forceinline__
typedef __attribute__((ext_vector_type(8))) short bf16x8;
typedef __attribute__((ext_vector_type(16))) float f32x16;
typedef __attribute__((ext_vector_type(2))) float f32x2;
typedef __attribute__((ext_vector_type(2))) __bf16 bf16x2_t;
#define MFMA(a, b, c) __builtin_amdgcn_mfma_f32_32x32x16_bf16((a), (b), (c), 0, 0, 0)

constexpr int L_ = 16384, DM = 1024, NIN = 6728, NPAD = 6784, DEPTH_ = 4;
constexpr float ALPHA_ = 1.681792830507429f;
constexpr size_t MiB = 1048576;
constexpr size_t O_WTIN = 0 * MiB, O_WUA = 14 * MiB, O_WUB = 15 * MiB, O_WOUT = 16 * MiB, O_HB = 18 * MiB,
                 O_QA = 50 * MiB, O_G = 66 * MiB, O_KK = 98 * MiB, O_IA = 114 * MiB, O_ZA = 130 * MiB,
                 O_QB = 146 * MiB, O_KB = 162 * MiB, O_VB = 178 * MiB, O_ZB = 194 * MiB, O_QI = 210 * MiB,
                 O_KI = 226 * MiB, O_WI = 228 * MiB, O_D = 228 * MiB + 512 * 1024, O_SGA = 229 * MiB,
                 O_SGB = 261 * MiB, O_US = 293 * MiB, O_SEL = 325 * MiB, O_LBS = 333 * MiB,
                 O_BAR = 333 * MiB + 65536, O_AA = 334 * MiB, O_AB = 350 * MiB, O_MG = 366 * MiB, WS_NEED = 398 * MiB;

struct Params {
  const float *x, *w_in, *b_in, *w_up_a, *w_up_b, *w_out, *lb_logits, *norm_a_g, *rel_bias, *ln_g, *ln_b;
  float* out;
  char* ws;
};

extern __shared__ __attribute__((aligned(16))) char smem[];

DI unsigned cvtpk(float lo, float hi) {
  f32x2 v = {lo, hi};
  bf16x2_t b = __builtin_convertvector(v, bf16x2_t);
  return __builtin_bit_cast(unsigned, b);
}
DI unsigned short f2bf(float x) { return (unsigned short)(cvtpk(x, 0.f) & 0xffffu); }
DI float bflo(unsigned u) { return __uint_as_float(u << 16); }
DI float bfhi(unsigned u) { return __uint_as_float(u & 0xffff0000u); }
DI float bf2f(unsigned short s) { return __uint_as_float(((unsigned)s) << 16); }
DI float sigm(float x) { return 1.f / (1.f + __expf(-x)); }
DI float silu(float x) { return x / (1.f + __expf(-x)); }
DI int crow(int r, int hi) { return (r & 3) + 8 * (r >> 2) + 4 * hi; }
DI size_t tiled_unit(int r, int k, int KS) {
  return ((size_t)(r >> 5) * KS + (k >> 4)) * 64 + (r & 31) + 32 * ((k >> 3) & 1);
}
DI float dot2(unsigned a, unsigned b, float acc) {
  asm volatile("v_dot2c_f32_bf16 %0, %1, %2" : "+v"(acc) : "v"(a), "v"(b));
  return acc;
}
template <typename T> DI T* opq(T* x) { asm volatile("" : "+s"(x)); return x; }
#define LAUNDER(pin) Params p; p.x = opq((pin).x); p.w_in = (pin).w_in; p.b_in = (pin).b_in; p.w_up_a = (pin).w_up_a; p.w_up_b = (pin).w_up_b; \
  p.w_out = (pin).w_out; p.lb_logits = (pin).lb_logits; p.norm_a_g = (pin).norm_a_g; p.rel_bias = (pin).rel_bias; p.ln_g = (pin).ln_g; \
  p.ln_b = (pin).ln_b; p.out = opq((pin).out); p.ws = opq((pin).ws);
DI int vtid() { int t = threadIdx.x; asm volatile("" : "+v"(t)); return t; }
DI void cbar() { asm volatile("" ::: "memory"); }
DI void lds_fence() { asm volatile("s_waitcnt lgkmcnt(0)" ::: "memory"); }

DI int colmap(int np) {
  if (np < 4608) return np;
  if (np < 5632) return 4680 + (np - 4608);
  if (np < 6656) return 5704 + (np - 5632);
  if (np < 6720) return 4608 + (np - 6656);
  if (np < 6728) return 4672 + (np - 6720);
  return -1;
}

DI void conv_weight(const float* __restrict__ src, int K, int ldn, int Npad, bool useMap, uint4* __restrict__ dst,
                    int gtid, int gthreads) {
  const int KS = K >> 4;
  const int total = Npad * (K >> 3);
  for (int u = gtid; u < total; u += gthreads) {
    int kg = u / Npad, n = u - kg * Npad;
    int col = useMap ? colmap(n) : n;
    float v[8];
#pragma unroll
    for (int j = 0; j < 8; ++j) v[j] = (col >= 0) ? src[(size_t)(kg * 8 + j) * ldn + col] : 0.f;
    uint4 o;
    o.x = cvtpk(v[0], v[1]); o.y = cvtpk(v[2], v[3]); o.z = cvtpk(v[4], v[5]); o.w = cvtpk(v[6], v[7]);
    dst[tiled_unit(n, kg * 8, KS)] = o;
  }
}

DI void phase0(const Params& p) {
  const int gtid = blockIdx.x * 512 + vtid(), gthreads = gridDim.x * 512;
  conv_weight(p.w_in, 1024, NIN, NPAD, true, (uint4*)(p.ws + O_WTIN), gtid, gthreads);
  uint4* hb = (uint4*)(p.ws + O_HB);
  for (int u = gtid; u < L_ * 128; u += gthreads) {
    int lane = u & 63, ks = (u >> 6) & 63, mt = u >> 12;
    int t = mt * 32 + (lane & 31), k = ks * 16 + 8 * (lane >> 5);
    const float4* s = (const float4*)(p.x + (size_t)t * DM + k);
    float4 a = s[0], b = s[1];
    uint4 o;
    o.x = cvtpk(a.x, a.y); o.y = cvtpk(a.z, a.w); o.z = cvtpk(b.x, b.y); o.w = cvtpk(b.z, b.w);
    hb[u] = o;
  }
  float* lbs = (float*)(p.ws + O_LBS);
  for (int c = gtid; c < 512; c += gthreads) {
    float l0 = p.lb_logits[c], l1 = p.lb_logits[512 + c], l2 = p.lb_logits[1024 + c], l3 = p.lb_logits[1536 + c];
    float m = fmaxf(fmaxf(l0, l1), fmaxf(l2, l3));
    float e0 = expf(l0 - m), e1 = expf(l1 - m), e2 = expf(l2 - m), e3 = expf(l3 - m);
    float inv = 1.f / (e0 + e1 + e2 + e3);
    lbs[c] = 0.f; lbs[512 + c] = e1 * inv; lbs[1024 + c] = (e1 + e2) * inv; lbs[1536 + c] = (e1 + e2 + e3) * inv;
  }
}

DI void gemm_core(const uint4* __restrict__ A, int mt0, const uint4* __restrict__ B, int nt0, int KS,
                  f32x16 (&acc)[2][2], uint4* lds) {
  const int tid = vtid(), lane = tid & 63, w = tid >> 6, wm = w >> 1, wn = w & 1;
  const int nk = KS >> 2;
  const uint4* sp[6];
#pragma unroll
  for (int r = 0; r < 6; ++r) {
    int u = tid + 512 * r;
    if (u < 2048) sp[r] = A + ((size_t)(mt0 + (u >> 8)) * KS) * 64 + (u & 255);
    else { int u2 = u - 2048; sp[r] = B + ((size_t)(nt0 + (u2 >> 8)) * KS) * 64 + (u2 & 255); }
  }
#pragma unroll
  for (int r = 0; r < 6; ++r)
    __builtin_amdgcn_global_load_lds((const unsigned*)sp[r], (unsigned*)(lds + tid + 512 * r), 16, 0, 0);
  if (nk > 1) {
#pragma unroll
    for (int r = 0; r < 6; ++r)
      __builtin_amdgcn_global_load_lds((const unsigned*)(sp[r] + 256), (unsigned*)(lds + 3072 + tid + 512 * r), 16, 0, 0);
  }
  int cb = 0;
  for (int kt = 0; kt < nk; ++kt) {
    if (kt + 1 < nk) asm volatile("s_waitcnt vmcnt(6)" ::: "memory");
    else asm volatile("s_waitcnt vmcnt(0)" ::: "memory");
    __builtin_amdgcn_s_barrier();
    asm volatile("" ::: "memory");
    if (kt + 2 < nk) {
      int nb2 = cb + 2; if (nb2 >= 3) nb2 -= 3;
      uint4* nxt = lds + nb2 * 3072;
#pragma unroll
      for (int r = 0; r < 6; ++r)
        __builtin_amdgcn_global_load_lds((const unsigned*)(sp[r] + (size_t)(kt + 2) * 256), (unsigned*)(nxt + tid + 512 * r), 16, 0, 0);
    }
    const uint4* cur = lds + cb * 3072;
#pragma unroll
    for (int ks = 0; ks < 4; ++ks) {
      bf16x8 a0 = __builtin_bit_cast(bf16x8, cur[(2 * wm + 0) * 256 + ks * 64 + lane]);
      bf16x8 a1 = __builtin_bit_cast(bf16x8, cur[(2 * wm + 1) * 256 + ks * 64 + lane]);
      bf16x8 b0 = __builtin_bit_cast(bf16x8, cur[2048 + (2 * wn + 0) * 256 + ks * 64 + lane]);
      bf16x8 b1 = __builtin_bit_cast(bf16x8, cur[2048 + (2 * wn + 1) * 256 + ks * 64 + lane]);
      acc[0][0] = MFMA(a0, b0, acc[0][0]);
      acc[0][1] = MFMA(a0, b1, acc[0][1]);
      acc[1][0] = MFMA(a1, b0, acc[1][0]);
      acc[1][1] = MFMA(a1, b1, acc[1][1]);
    }
    cb = (cb == 2) ? 0 : cb + 1;
  }
  __syncthreads();
}

DI void zero_acc(f32x16 (&acc)[2][2]) {
#pragma unroll
  for (int i = 0; i < 2; ++i)
#pragma unroll
    for (int j = 0; j < 2; ++j)
#pragma unroll
      for (int r = 0; r < 16; ++r) acc[i][j][r] = 0.f;
}

DI void p1_tile(const Params& p, int layer, int mb, int nt) {
  const int tid = vtid(), lane = tid & 63, w = tid >> 6, wm = w >> 1, wn = w & 1, hi = lane >> 5, c31 = lane & 31;
  f32x16 acc[2][2];
  zero_acc(acc);
  gemm_core((const uint4*)(p.ws + O_HB), mb * 8, (const uint4*)(p.ws + O_WTIN), nt * 4, 64, acc, (uint4*)smem);
  unsigned short* tile = (unsigned short*)smem;
  const int row0 = mb * 256;
  const float* bin = p.b_in + (size_t)layer * NIN;
  const float* lbs = (const float*)(p.ws + O_LBS) + layer * 512;
#pragma unroll
  for (int j = 0; j < 2; ++j) {
    const int col = 64 * wn + 32 * j + c31;
    const int np = nt * 128 + col;
    const int oc = colmap(np);
    const float bias = oc >= 0 ? bin[oc] : 0.f;
    float lb = 0.f;
    if (nt >= 4 && nt < 8) lb = lbs[(nt - 4) * 128 + col];
#pragma unroll
    for (int i = 0; i < 2; ++i) {
#pragma unroll
      for (int r = 0; r < 16; ++r) {
        const int row = 64 * wm + 32 * i + crow(r, hi);
        float v = acc[i][j][r] + bias;
        float o;
        if (nt < 4) o = v;
        else if (nt < 8) {
          float sg = sigm(v);
          float f = lb + (1.f - lb) * sg;
          ((float*)(p.ws + O_G))[(size_t)(row0 + row) * 512 + (nt - 4) * 128 + col] = __logf(f);
          o = (1.f - lb) * (1.f - sg);
        } else if (nt < 12) o = v;
        else if (nt < 16) o = silu(v);
        else if (nt < 20) o = v * 0.125f;
        else if (nt < 28) o = v;
        else if (nt < 32) o = silu(v);
        else if (nt < 36) o = v;
        else if (nt < 52) o = sigm(v);
        else {
          o = v;
          if (col >= 64 && col < 72)
            ((float*)(p.ws + O_WI))[(size_t)(row0 + row) * 8 + (col - 64)] = v * 0.044194173824159216f;
        }
        tile[row * 128 + col] = f2bf(o);
      }
    }
  }
  __syncthreads();
#pragma unroll
  for (int q = 0; q < 8; ++q) {
    const int u = tid + 512 * q, r = u >> 4, c8 = u & 15;
    const uint4 val = *(const uint4*)&tile[r * 128 + c8 * 8];
    const int t = row0 + r;
    if (nt >= 20 && nt < 28) {
      int w0 = __builtin_amdgcn_cvt_pk_fp8_f32(bflo(val.x), bfhi(val.x), 0, false);
      w0 = __builtin_amdgcn_cvt_pk_fp8_f32(bflo(val.y), bfhi(val.y), w0, true);
      int w1 = __builtin_amdgcn_cvt_pk_fp8_f32(bflo(val.z), bfhi(val.z), 0, false);
      w1 = __builtin_amdgcn_cvt_pk_fp8_f32(bflo(val.w), bfhi(val.w), w1, true);
      const size_t base8 = (nt < 24) ? O_KB : O_VB;
      *(uint2*)(p.ws + base8 + (size_t)t * 512 + (nt & 3) * 128 + c8 * 8) = make_uint2((unsigned)w0, (unsigned)w1);
    } else if (nt < 32) {
      size_t base;
      switch (nt >> 2) {
        case 0: base = O_QA; break; case 1: base = O_KK; break; case 2: base = O_IA; break; case 3: base = O_ZA; break;
        case 4: base = O_QB; break; case 5: base = O_KB; break; case 6: base = O_VB; break; default: base = O_ZB; break;
      }
      *(uint4*)(p.ws + base + ((size_t)t * 512 + (nt & 3) * 128 + c8 * 8) * 2) = val;
    } else if (nt < 36) {
      const int head = 2 * (nt - 32) + (c8 >> 3), d0 = (c8 & 7) * 8;
      const int item = t >> 5, tq = t & 31, mtile = tq >> 2, q4 = tq & 3;
      const int rr = (head & 3) + 4 * (q4 >> 1) + 8 * (head >> 2) + 16 * (q4 & 1);
      const int laneA = rr + 32 * ((d0 >> 3) & 1), ks = d0 >> 4;
      ((uint4*)(p.ws + O_QI))[((size_t)(item * 8 + mtile) * 4 + ks) * 64 + laneA] = val;
    } else if (nt < 44) {
      *(uint4*)(p.ws + O_SGA + ((size_t)t * 1024 + (nt - 36) * 128 + c8 * 8) * 2) = val;
    } else if (nt < 52) {
      *(uint4*)(p.ws + O_SGB + ((size_t)t * 1024 + (nt - 44) * 128 + c8 * 8) * 2) = val;
    } else {
      if (c8 < 8) {
        const int d0 = c8 * 8;
        ((uint4*)(p.ws + O_KI))[((size_t)(t >> 5) * 4 + (d0 >> 4)) * 64 + (t & 31) + 32 * ((d0 >> 3) & 1)] = val;
      }
    }
  }
  __syncthreads();
}

constexpr int CAP = 1000, SEGCAP = 250, SEGTRIG = 186;
constexpr int IX_SC = 0, IX_IX = 64000, IX_RING = 96000, IX_CNT = 161536, IX_TAU = 161792, IX_FLAG = 161856, IX_WL = 161872;

DI float key2float(unsigned k) {
  unsigned b = (k & 0x80000000u) ? (k ^ 0x80000000u) : ~k;
  return __uint_as_float(b);
}
DI unsigned float2key(float f) {
  unsigned b = __float_as_uint(f);
  return (b & 0x80000000u) ? ~b : (b ^ 0x80000000u);
}
DI int wave_prefix_incl(int x) {
  int v = x;
  v += __builtin_amdgcn_update_dpp(0, v, 0x111, 0xf, 0xf, false);
  v += __builtin_amdgcn_update_dpp(0, v, 0x112, 0xf, 0xf, false);
  v += __builtin_amdgcn_update_dpp(0, v, 0x114, 0xf, 0xf, false);
  v += __builtin_amdgcn_update_dpp(0, v, 0x118, 0xf, 0xf, false);
  v += __builtin_amdgcn_update_dpp(0, v, 0x142, 0xa, 0xf, false);
  v += __builtin_amdgcn_update_dpp(0, v, 0x143, 0xc, 0xf, false);
  return v;
}

#define SEG_ADDR(j_) (((j_) >> 2) * SEGCAP + lane + 64 * ((j_) & 3))
DI int seg_count(const int4 c4, int s_) { return s_ == 0 ? c4.x : (s_ == 1 ? c4.y : (s_ == 2 ? c4.z : c4.w)); }

DI void wave_select(float* scq, unsigned short* ixq, int* cnt4q, float* tauq, unsigned* hist, int lane, unsigned short* final_sel) {
  lds_fence();
  const int4 c4 = *(const int4*)cnt4q;
  const int n = c4.x + c4.y + c4.z + c4.w;
  unsigned u[16], v16[16];
  unsigned mm = 0, am = 0;
#pragma unroll
  for (int j = 0; j < 16; ++j) {
    const bool valid = (lane + 64 * (j & 3)) < seg_count(c4, j >> 2);
    const float sv = valid ? scq[SEG_ADDR(j)] : 0.f;
    const unsigned id = valid ? (unsigned)ixq[SEG_ADDR(j)] : 0u;
    u[j] = float2key(sv);
    v16[j] = 0xFFFFu - id;
    mm |= valid ? (1u << j) : 0u;
  }
  unsigned prefix_u = 0;
  if (n > 256) {
    int need = 256;
    int r0 = 0;
    {
      unsigned ref = 0; bool have = false;
#pragma unroll
      for (int j = 15; j >= 0; --j) if ((mm >> j) & 1u) { ref = u[j] >> 24; have = true; }
      const unsigned long long hm = __ballot(have);
      const int fl = __ffsll((long long)hm) - 1;
      ref = (unsigned)__builtin_amdgcn_readlane((int)ref, fl);
      bool same = true;
#pragma unroll
      for (int j = 0; j < 16; ++j) same = same && (!((mm >> j) & 1u) || ((u[j] >> 24) == ref));
      if (__all(same)) { prefix_u = ref << 24; r0 = 1; }
    }
    for (int r = r0; r < 6; ++r) {
      const int sh = (r < 4) ? (24 - 8 * r) : (r == 4 ? 8 : 0);
      ((uint4*)hist)[lane] = make_uint4(0, 0, 0, 0);
      lds_fence();
#pragma unroll
      for (int j = 0; j < 16; ++j) {
        const unsigned src = (r < 4) ? u[j] : v16[j];
        const unsigned dgt = ((mm >> j) & 1u) ? ((src >> sh) & 255u) : 256u + lane;
        atomicAdd(&hist[dgt], 1u);
      }
      lds_fence();
      const uint4 hv = ((const uint4*)hist)[lane];
      const int c0 = hv.x, c1 = hv.y, c2 = hv.z, c3 = hv.w;
      const int Lsum = c0 + c1 + c2 + c3;
      const int Pfx = wave_prefix_incl(Lsum);
      const int total = __builtin_amdgcn_readlane(Pfx, 63);
      const int S = total - Pfx + Lsum;
      const unsigned long long mask = __ballot(S >= need);
      const int lstar = 63 - __clzll((long long)mask);
      int d_, ca_, cd_;
      {
        const int accu = S - Lsum;
        if (accu + c3 >= need) { d_ = 3; ca_ = accu; cd_ = c3; }
        else if (accu + c3 + c2 >= need) { d_ = 2; ca_ = accu + c3; cd_ = c2; }
        else if (accu + c3 + c2 + c1 >= need) { d_ = 1; ca_ = accu + c3 + c2; cd_ = c1; }
        else { d_ = 0; ca_ = accu + c3 + c2 + c1; cd_ = c0; }
      }
      const int D = __builtin_amdgcn_readlane(4 * lane + d_, lstar);
      const int cntAbove = __builtin_amdgcn_readlane(ca_, lstar);
      const int cntD = __builtin_amdgcn_readlane(cd_, lstar);
#pragma unroll
      for (int j = 0; j < 16; ++j) {
        const unsigned src = (r < 4) ? u[j] : v16[j];
        const int dgt = (int)((src >> sh) & 255u);
        if ((mm >> j) & 1u) {
          if (dgt > D) { am |= (1u << j); mm &= ~(1u << j); }
          else if (dgt < D) mm &= ~(1u << j);
        }
      }
      need -= cntAbove;
      if (r < 4) prefix_u |= ((unsigned)D) << sh;
      if (cntD == need) break;
    }
  }
  const unsigned km = am | mm;
  int base = 0;
#pragma unroll
  for (int j = 0; j < 16; ++j) {
    const bool keep = (km >> j) & 1u;
    const unsigned long long m = __ballot(keep);
    const int rk = base + __popcll(m & ((1ull << lane) - 1ull));
    if (keep) {
      if (final_sel) { if (rk < 256) final_sel[rk] = (unsigned short)(0xFFFFu - v16[j]); }
      else { const int ad = (rk & 3) * SEGCAP + (rk >> 2); scq[ad] = key2float(u[j]); ixq[ad] = (unsigned short)(0xFFFFu - v16[j]); }
    }
    base += __popcll(m);
  }
  if (!final_sel && lane == 0) {
    *(int4*)cnt4q = make_int4((base + 3) >> 2, (base + 2) >> 2, (base + 1) >> 2, base >> 2);
    if (n > 256) *tauq = key2float(prefix_u);
  }
  lds_fence();
}

typedef float f32x2v __attribute__((ext_vector_type(2)));
DI float relu_(float x) { int i = __float_as_int(x); i = i > 0 ? i : 0; return __int_as_float(i); }

DI unsigned wave_umin(unsigned v) {
#define UMIN_STEP(ctrl, rm) { const unsigned o_ = (unsigned)__builtin_amdgcn_update_dpp((int)0xFFFFFFFFu, (int)v, ctrl, rm, 0xf, false); v = o_ < v ? o_ : v; }
  UMIN_STEP(0x111, 0xf) UMIN_STEP(0x112, 0xf) UMIN_STEP(0x114, 0xf) UMIN_STEP(0x118, 0xf) UMIN_STEP(0x142, 0xa) UMIN_STEP(0x143, 0xc)
#undef UMIN_STEP
  return (unsigned)__builtin_amdgcn_readlane((int)v, 63);
}
DI unsigned wave_umax(unsigned v) {
#define UMAX_STEP(ctrl, rm) { const unsigned o_ = (unsigned)__builtin_amdgcn_update_dpp(0, (int)v, ctrl, rm, 0xf, false); v = o_ > v ? o_ : v; }
  UMAX_STEP(0x111, 0xf) UMAX_STEP(0x112, 0xf) UMAX_STEP(0x114, 0xf) UMAX_STEP(0x118, 0xf) UMAX_STEP(0x142, 0xa) UMAX_STEP(0x143, 0xc)
#undef UMAX_STEP
  return (unsigned)__builtin_amdgcn_readlane((int)v, 63);
}
DI void wave_compact(float* scq, unsigned short* ixq, int* cnt4q, float* tauq, unsigned* hist, int lane) {
  lds_fence();
  const int4 c4 = *(const int4*)cnt4q;
  const int n = c4.x + c4.y + c4.z + c4.w;
  if (n <= 320) return;
  unsigned u[16], idv[16];
  unsigned vm = 0;
  unsigned umin = 0xFFFFFFFFu, umax = 0u;
  ((uint4*)hist)[lane] = make_uint4(0, 0, 0, 0);

#pragma unroll
  for (int j = 0; j < 16; ++j) {
    const bool valid = (lane + 64 * (j & 3)) < seg_count(c4, j >> 2);
    u[j] = valid ? float2key(scq[SEG_ADDR(j)]) : 0u;
    idv[j] = valid ? (unsigned)ixq[SEG_ADDR(j)] : 0u;
    vm |= valid ? (1u << j) : 0u;
    umin = valid ? (u[j] < umin ? u[j] : umin) : umin;
    umax = valid ? (u[j] > umax ? u[j] : umax) : umax;
  }
  umin = wave_umin(umin);
  umax = wave_umax(umax);
  const unsigned range = umax - umin;
  const int sh = range < 256u ? 0 : (24 - __clz((int)range));
#pragma unroll
  for (int j = 0; j < 16; ++j) {
    const unsigned bin = ((vm >> j) & 1u) ? ((u[j] - umin) >> sh) : 256u + lane;
    atomicAdd(&hist[bin], 1u);
  }
  lds_fence();
  const uint4 hv = ((const uint4*)hist)[lane];
  const int c0 = hv.x, c1 = hv.y, c2 = hv.z, c3 = hv.w;
  const int Lsum = c0 + c1 + c2 + c3;
  const int Pfx = wave_prefix_incl(Lsum);
  const int total = __builtin_amdgcn_readlane(Pfx, 63);
  const int S = total - Pfx + Lsum;
  const unsigned long long mask = __ballot(S >= 256);
  const int lstar = 63 - __clzll((long long)mask);
  int d_, kept_;
  {
    const int accu = S - Lsum;
    if (accu + c3 >= 256) { d_ = 3; kept_ = accu + c3; }
    else if (accu + c3 + c2 >= 256) { d_ = 2; kept_ = accu + c3 + c2; }
    else if (accu + c3 + c2 + c1 >= 256) { d_ = 1; kept_ = accu + c3 + c2 + c1; }
    else { d_ = 0; kept_ = accu + Lsum; }
  }
  const int D = __builtin_amdgcn_readlane(4 * lane + d_, lstar);
  const int kept = __builtin_amdgcn_readlane(kept_, lstar);
  if (kept > 400) return;
  int base = 0;
#pragma unroll
  for (int j = 0; j < 16; ++j) {
    const bool keep = ((vm >> j) & 1u) && ((int)((u[j] - umin) >> sh) >= D);
    const unsigned long long m = __ballot(keep);
    const int rk = base + __popcll(m & ((1ull << lane) - 1ull));
    if (keep) { const int ad = (rk & 3) * SEGCAP + (rk >> 2); scq[ad] = key2float(u[j]); ixq[ad] = (unsigned short)idv[j]; }
    base += __popcll(m);
  }
  if (lane == 0) {
    *(int4*)cnt4q = make_int4((base + 3) >> 2, (base + 2) >> 2, (base + 1) >> 2, base >> 2);
    *tauq = key2float(umin + ((unsigned)D << sh));
  }
  lds_fence();
}

#define IDX_GLDS(step, bufi) do { _Pragma("unroll") for (int r_ = 0; r_ < 4; ++r_) \
    __builtin_amdgcn_global_load_lds((const unsigned*)(ki + (size_t)(step) * 2048 + tid + 512 * r_), \
                                     (unsigned*)(ring + (bufi) * 2048 + tid + 512 * r_), 16, 0, 0); } while (0)

DI void indexer_item(const Params& p, int item) {
  const int tid = vtid(), lane = tid & 63, w = tid >> 6, g = w & 1, kg = w >> 1, hi = lane >> 5, c31 = lane & 31;
  float* sc = (float*)(smem + IX_SC);
  unsigned short* ix = (unsigned short*)(smem + IX_IX);
  uint4* ring = (uint4*)(smem + IX_RING);
  int* cnt = (int*)(smem + IX_CNT);
  volatile int* flag = (volatile int*)(smem + IX_FLAG);
  float* tauv = (float*)(smem + IX_TAU);
  const uint4* qi = (const uint4*)(p.ws + O_QI);
  const uint4* ki = (const uint4*)(p.ws + O_KI);
  const float* wi = (const float*)(p.ws + O_WI);
  const int t0 = 16 * item;
  bf16x8 a[2][4];
#pragma unroll
  for (int mt = 0; mt < 2; ++mt)
#pragma unroll
    for (int ks = 0; ks < 4; ++ks)
      a[mt][ks] = __builtin_bit_cast(bf16x8, qi[((size_t)((item >> 1) * 8 + (item & 1) * 4 + 2 * g + mt) * 4 + ks) * 64 + lane]);
  float* wl = (float*)(smem + IX_WL);
  if (tid < 128) wl[tid] = wi[(size_t)t0 * 8 + tid];
  float tau[2][2];
#pragma unroll
  for (int mt = 0; mt < 2; ++mt) { tau[mt][0] = -INFINITY; tau[mt][1] = -INFINITY; }
  if (tid < 64) cnt[tid] = 0;
  if (tid < 16) tauv[tid] = -INFINITY;
  int cntv[2][2] = {{0, 0}, {0, 0}};
  if (tid < 2) flag[tid] = 0;
  const int nsteps = (t0 + 16 + 255) >> 8;
  asm volatile("s_waitcnt vmcnt(0)" ::: "memory");
  IDX_GLDS(0, 0);
  if (nsteps > 1) { IDX_GLDS(1, 1); asm volatile("s_waitcnt vmcnt(4)" ::: "memory"); }
  else asm volatile("s_waitcnt vmcnt(0)" ::: "memory");
  __syncthreads();
  const f32x16 z = {0.f, 0.f, 0.f, 0.f, 0.f, 0.f, 0.f, 0.f, 0.f, 0.f, 0.f, 0.f, 0.f, 0.f, 0.f, 0.f};
  f32x16 Ca0, Ca1, Cb0, Cb1;
  {
    const uint4* cur = ring;
    const uint4* bp = cur + ((2 * kg + 0) * 4) * 64 + lane;
    bf16x8 b0 = __builtin_bit_cast(bf16x8, bp[0]), b1 = __builtin_bit_cast(bf16x8, bp[64]);
    bf16x8 b2 = __builtin_bit_cast(bf16x8, bp[128]), b3 = __builtin_bit_cast(bf16x8, bp[192]);
    Ca0 = MFMA(a[0][0], b0, z); Ca1 = MFMA(a[1][0], b0, z);
    Ca0 = MFMA(a[0][1], b1, Ca0); Ca1 = MFMA(a[1][1], b1, Ca1);
    Ca0 = MFMA(a[0][2], b2, Ca0); Ca1 = MFMA(a[1][2], b2, Ca1);
    Ca0 = MFMA(a[0][3], b3, Ca0); Ca1 = MFMA(a[1][3], b3, Ca1);
  }
#define IDX_SCORE(Cx, mt_, aa_, sout) do { const float4 wa_ = *(const float4*)(wl + (8 * g + 4 * (mt_) + 2 * hi + (aa_)) * 8); \
    const float4 wb_ = *(const float4*)(wl + (8 * g + 4 * (mt_) + 2 * hi + (aa_)) * 8 + 4); \
    f32x2v r0_ = {relu_(Cx[8 * (aa_) + 0]), relu_(Cx[8 * (aa_) + 1])}, r1_ = {relu_(Cx[8 * (aa_) + 2]), relu_(Cx[8 * (aa_) + 3])}; \
    f32x2v r2_ = {relu_(Cx[8 * (aa_) + 4]), relu_(Cx[8 * (aa_) + 5])}, r3_ = {relu_(Cx[8 * (aa_) + 6]), relu_(Cx[8 * (aa_) + 7])}; \
    const f32x2v w0_ = {wa_.x, wa_.y}, w1_ = {wa_.z, wa_.w}, w2_ = {wb_.x, wb_.y}, w3_ = {wb_.z, wb_.w}; \
    f32x2v ac_ = r0_ * w0_; ac_ = r1_ * w1_ + ac_; ac_ = r2_ * w2_ + ac_; ac_ = r3_ * w3_ + ac_; \
    sout = ac_.x + ac_.y; } while (0)
  const unsigned ltm = (1u << c31) - 1u;
  const int tqb = t0 + 8 * g + 2 * hi;
  const int sb0 = ((8 * g + 2 * hi) * CAP + kg * SEGCAP) * 4;
#define IDX_APPEND(sval, mt_, aa_, keyv) do { \
    const bool pr_ = ((keyv) <= tqb + 4 * (mt_) + (aa_)) && ((sval) >= tau[mt_][aa_]); \
    const unsigned long long bm_ = __builtin_amdgcn_ballot_w64(pr_); \
    const unsigned half_ = hi ? (unsigned)(bm_ >> 32) : (unsigned)bm_; \
    const int pos_ = cntv[mt_][aa_] + __popc(half_ & ltm); \
    if (pr_) { const int bo_ = sb0 + (4 * (mt_) + (aa_)) * CAP * 4 + pos_ * 4; \
      *(float*)((char*)sc + bo_) = (sval); *(unsigned short*)((char*)ix + (bo_ >> 1)) = (unsigned short)(keyv); } \
    cntv[mt_][aa_] += __popc(half_); } while (0)
#define IDX_PUBLISH() do { if (c31 == 0) { _Pragma("unroll") for (int mt_ = 0; mt_ < 2; ++mt_) _Pragma("unroll") for (int aa_ = 0; aa_ < 2; ++aa_) \
    cnt[4 * (8 * g + 4 * mt_ + 2 * hi + aa_) + kg] = cntv[mt_][aa_]; } } while (0)
  for (int j = 0; j < nsteps; ++j) {
    const uint4* cur = ring + (j & 1) * 2048;
    {
      const uint4* bp = cur + ((2 * kg + 1) * 4) * 64 + lane;
      bf16x8 b0 = __builtin_bit_cast(bf16x8, bp[0]), b1 = __builtin_bit_cast(bf16x8, bp[64]);
      bf16x8 b2 = __builtin_bit_cast(bf16x8, bp[128]), b3 = __builtin_bit_cast(bf16x8, bp[192]);
      Cb0 = MFMA(a[0][0], b0, z); Cb1 = MFMA(a[1][0], b0, z);
      Cb0 = MFMA(a[0][1], b1, Cb0); Cb1 = MFMA(a[1][1], b1, Cb1);
      Cb0 = MFMA(a[0][2], b2, Cb0); Cb1 = MFMA(a[1][2], b2, Cb1);
      Cb0 = MFMA(a[0][3], b3, Cb0); Cb1 = MFMA(a[1][3], b3, Cb1);
    }
    {
      const int key = 256 * j + 64 * kg + c31;
      float s00, s01, s10, s11;
      IDX_SCORE(Ca0, 0, 0, s00); IDX_SCORE(Ca0, 0, 1, s01); IDX_SCORE(Ca1, 1, 0, s10); IDX_SCORE(Ca1, 1, 1, s11);
#pragma unroll
      for (int q_ = 0; q_ < 8; ++q_) { __builtin_amdgcn_sched_group_barrier(0x008, 1, 0); __builtin_amdgcn_sched_group_barrier(0x002, 9, 0); }
      IDX_APPEND(s00, 0, 0, key); IDX_APPEND(s01, 0, 1, key); IDX_APPEND(s10, 1, 0, key); IDX_APPEND(s11, 1, 1, key);
    }
    IDX_PUBLISH();
    {
      const int mxc = max(max(cntv[0][0], cntv[0][1]), max(cntv[1][0], cntv[1][1]));
      if (__ballot(mxc > SEGTRIG) != 0ull) { if (lane == 0) flag[j & 1] = j + 1; }
    }
    __syncthreads();
    if (flag[j & 1] == j + 1) {
      unsigned* hist = (unsigned*)(ring + (j & 1) * 2048) + w * 512;
#pragma unroll 1
      for (int k = 0; k < 2; ++k) {
        const int q = 2 * w + k;
        wave_compact(sc + q * CAP, ix + q * CAP, cnt + 4 * q, tauv + q, hist, lane);
        lds_fence();
        { const int4 cc = *(const int4*)(cnt + 4 * q); if (cc.x + cc.y + cc.z + cc.w > 400) wave_select(sc + q * CAP, ix + q * CAP, cnt + 4 * q, tauv + q, hist, lane, nullptr); }
      }
      __syncthreads();
#pragma unroll
      for (int mt = 0; mt < 2; ++mt)
#pragma unroll
        for (int aa = 0; aa < 2; ++aa) { const int ql = 8 * g + 4 * mt + 2 * hi + aa; tau[mt][aa] = tauv[ql]; cntv[mt][aa] = cnt[4 * ql + kg]; }
    }
    if (j + 2 < nsteps) IDX_GLDS(j + 2, j & 1);
    if (j + 1 < nsteps) {
      const uint4* nxt = ring + ((j + 1) & 1) * 2048;
      const uint4* bp = nxt + ((2 * kg + 0) * 4) * 64 + lane;
      bf16x8 b0 = __builtin_bit_cast(bf16x8, bp[0]), b1 = __builtin_bit_cast(bf16x8, bp[64]);
      bf16x8 b2 = __builtin_bit_cast(bf16x8, bp[128]), b3 = __builtin_bit_cast(bf16x8, bp[192]);
      Ca0 = MFMA(a[0][0], b0, z); Ca1 = MFMA(a[1][0], b0, z);
      Ca0 = MFMA(a[0][1], b1, Ca0); Ca1 = MFMA(a[1][1], b1, Ca1);
      Ca0 = MFMA(a[0][2], b2, Ca0); Ca1 = MFMA(a[1][2], b2, Ca1);
      Ca0 = MFMA(a[0][3], b3, Ca0); Ca1 = MFMA(a[1][3], b3, Ca1);
    }
    {
      const int key = 256 * j + 64 * kg + 32 + c31;
      float s00, s01, s10, s11;
      IDX_SCORE(Cb0, 0, 0, s00); IDX_SCORE(Cb0, 0, 1, s01); IDX_SCORE(Cb1, 1, 0, s10); IDX_SCORE(Cb1, 1, 1, s11);
#pragma unroll
      for (int q_ = 0; q_ < 8; ++q_) { __builtin_amdgcn_sched_group_barrier(0x008, 1, 0); __builtin_amdgcn_sched_group_barrier(0x002, 9, 0); }
      IDX_APPEND(s00, 0, 0, key); IDX_APPEND(s01, 0, 1, key); IDX_APPEND(s10, 1, 0, key); IDX_APPEND(s11, 1, 1, key);
    }
  }
  IDX_PUBLISH();
  __syncthreads();
  unsigned short* sel = (unsigned short*)(p.ws + O_SEL);
  unsigned* hist = (unsigned*)ring + w * 512;
#pragma unroll 1
  for (int k = 0; k < 2; ++k) {
    const int q = 2 * w + k;
    wave_select(sc + q * CAP, ix + q * CAP, cnt + 4 * q, tauv + q, hist, lane, sel + (size_t)(t0 + q) * 256);
  }
  __syncthreads();
}

DI void hgrn_a_item(const Params& p, int c, int h) {
  const int tid = vtid(), lane = tid & 63, w = tid >> 6, hi = lane >> 5, c31 = lane & 31;
  float* tot = (float*)smem;
  unsigned short* kT = (unsigned short*)(smem + 2048);
  unsigned short* vT = (unsigned short*)(smem + 2048 + 18432);
  const int seg = tid >> 7, k = tid & 127;
  const float* G = (const float*)(p.ws + O_G);
  const unsigned short* KK = (const unsigned short*)(p.ws + O_KK);
  const unsigned short* IA = (const unsigned short*)(p.ws + O_IA);
  const size_t rowbase = (size_t)(64 * c + 16 * seg);
  float b[16];
  {
    float run = 0.f;
#pragma unroll
    for (int i = 0; i < 16; ++i) { run += G[(rowbase + i) * 512 + 128 * h + k]; b[i] = run; }
    tot[seg * 128 + k] = run;
  }
  __syncthreads();
  float off = 0.f, blast = 0.f;
#pragma unroll
  for (int s2 = 0; s2 < 4; ++s2) { float tv = tot[s2 * 128 + k]; if (s2 < seg) off += tv; blast += tv; }
  {
    unsigned pk[8], pv[8];
#pragma unroll
    for (int i = 0; i < 16; i += 2) {
      float k0 = bf2f(KK[(rowbase + i) * 512 + 128 * h + k]) * __expf(blast - (b[i] + off));
      float k1 = bf2f(KK[(rowbase + i + 1) * 512 + 128 * h + k]) * __expf(blast - (b[i + 1] + off));
      pk[i >> 1] = cvtpk(k0, k1);
      unsigned v0 = IA[(rowbase + i) * 512 + 128 * h + k], v1 = IA[(rowbase + i + 1) * 512 + 128 * h + k];
      pv[i >> 1] = v0 | (v1 << 16);
    }
    uint4* dk = (uint4*)(kT + k * 72 + 16 * seg);
    dk[0] = make_uint4(pk[0], pk[1], pk[2], pk[3]); dk[1] = make_uint4(pk[4], pk[5], pk[6], pk[7]);
    uint4* dv = (uint4*)(vT + k * 72 + 16 * seg);
    dv[0] = make_uint4(pv[0], pv[1], pv[2], pv[3]); dv[1] = make_uint4(pv[4], pv[5], pv[6], pv[7]);
    if (seg == 0) ((float*)(p.ws + O_D))[(size_t)(c * 4 + h) * 128 + k] = __expf(blast);
  }
  __syncthreads();
  const int mt = w >> 1;
  f32x16 acc[2];
#pragma unroll
  for (int r = 0; r < 16; ++r) { acc[0][r] = 0.f; acc[1][r] = 0.f; }
#pragma unroll
  for (int ks = 0; ks < 4; ++ks) {
    bf16x8 af = __builtin_bit_cast(bf16x8, *(const uint4*)(kT + (32 * mt + c31) * 72 + 16 * ks + 8 * hi));
#pragma unroll
    for (int jn = 0; jn < 2; ++jn) {
      const int nt = 2 * (w & 1) + jn;
      bf16x8 bfv = __builtin_bit_cast(bf16x8, *(const uint4*)(vT + (32 * nt + c31) * 72 + 16 * ks + 8 * hi));
      acc[jn] = MFMA(af, bfv, acc[jn]);
    }
  }
  char* us = p.ws + O_US + (size_t)(c * 4 + h) * 32768;
#pragma unroll
  for (int jn = 0; jn < 2; ++jn) {
    const int nt = 2 * (w & 1) + jn;
    const int v = 32 * nt + c31;
#pragma unroll
    for (int gq = 0; gq < 4; ++gq) {
      const int k0 = 32 * mt + 8 * gq;
      const size_t unit = ((size_t)(v >> 5) * 8 + (k0 >> 4)) * 64 + (v & 31) + 32 * ((k0 >> 3) & 1);
      uint2 val;
      val.x = cvtpk(acc[jn][4 * gq + 0], acc[jn][4 * gq + 1]);
      val.y = cvtpk(acc[jn][4 * gq + 2], acc[jn][4 * gq + 3]);
      *(uint2*)(us + unit * 16 + 8 * hi) = val;
    }
  }
  __syncthreads();
}

DI void hgrn_scan(const Params& p) {
  const int tid = vtid();
  if (tid >= 128) return;
  for (int pid = blockIdx.x * 128 + tid; pid < 32768; pid += gridDim.x * 128) {
    const int q4 = pid & 3, unit = (pid >> 2) & 2047, h = pid >> 13;
    const int lanep = unit & 63, ks = (unit >> 6) & 7;
    const int k = ks * 16 + 8 * (lanep >> 5) + 2 * q4;
    unsigned* us = (unsigned*)(p.ws + O_US) + (size_t)h * 8192 + unit * 4 + q4;
    const float* dd = (const float*)(p.ws + O_D) + h * 128 + k;
    float s0 = 0.f, s1 = 0.f;
    for (int c0 = 0; c0 < 256; c0 += 16) {
      unsigned uv[16];
      float2 dv[16];
#pragma unroll
      for (int i = 0; i < 16; ++i) {
        uv[i] = us[(size_t)(c0 + i) * 32768];
        dv[i] = *(const float2*)(dd + (size_t)(c0 + i) * 512);
      }
#pragma unroll
      for (int i = 0; i < 16; ++i) {
        us[(size_t)(c0 + i) * 32768] = cvtpk(s0, s1);
        s0 = fmaf(dv[i].x, s0, bflo(uv[i]));
        s1 = fmaf(dv[i].y, s1, bfhi(uv[i]));
      }
    }
  }
}

constexpr int AT_LUT = 0, AT_RB = 512, AT_WAVE = 2048, AT_WSZ = 8192 + 1024 + 16 * 528;
DI void attn_setup() {
  const int tid = vtid();
  int* lut = (int*)(smem + AT_LUT);
  if (tid < 128) {
    int d = tid;
    int bk;
    if (d < 16) bk = d;
    else {
      float df = (float)d;
      int lg = 16 + (int)(logf(df / 16.f) / 2.0794415416798357f * 16.f);
      bk = lg < 31 ? lg : 31;
    }
    lut[tid] = bk;
  }
}
DI float dppf(float v, int ctrl_sel) {
  const int iv = __builtin_bit_cast(int, v);
  int r;
  if (ctrl_sel == 0) r = __builtin_amdgcn_update_dpp(0, iv, 0xB1, 0xf, 0xf, false);
  else if (ctrl_sel == 1) r = __builtin_amdgcn_update_dpp(0, iv, 0x4E, 0xf, 0xf, false);
  else r = __builtin_amdgcn_update_dpp(0, iv, 0x141, 0xf, 0xf, false);
  return __builtin_bit_cast(float, r);
}
DI float sum8(float v) { v += dppf(v, 0); v += dppf(v, 1); v += dppf(v, 2); return v; }
DI float max8(float v) { v = fmaxf(v, dppf(v, 0)); v = fmaxf(v, dppf(v, 1)); v = fmaxf(v, dppf(v, 2)); return v; }

DI size_t prob_off(int t) {
  return t < 8192 ? O_MG + (size_t)t * 4096 : (t < 12288 ? O_AA + (size_t)(t - 8192) * 4096 : O_QI + (size_t)(t - 12288) * 4096);
}
#define MFMA8S(a, b, c) __builtin_amdgcn_mfma_f32_16x16x32_fp8_fp8((a), (b), (c), 0, 0, 0)
typedef __attribute__((ext_vector_type(4))) float f32x4v;
constexpr int AT_KROW = 528;
struct QKPF { int s0, s1, s2, s3; uint4 q0, q1; };
DI void qk_fetch(const Params& p, int t, int lane, QKPF& f) {
  const int nsel = t + 1 < 256 ? t + 1 : 256;
  const unsigned short* sel = (const unsigned short*)(p.ws + O_SEL) + (size_t)t * 256;
  f.s0 = lane < nsel ? (int)sel[lane] : 0; f.s1 = lane + 64 < nsel ? (int)sel[lane + 64] : 0;
  f.s2 = lane + 128 < nsel ? (int)sel[lane + 128] : 0; f.s3 = lane + 192 < nsel ? (int)sel[lane + 192] : 0;
  const unsigned short* qp = (const unsigned short*)(p.ws + O_QB) + (size_t)t * 512 + (lane & 7) * 64 + 8 * (lane >> 4);
  f.q0 = *(const uint4*)qp; f.q1 = *(const uint4*)(qp + 32);
}
DI void attn_query(const Params& p, int t, int tnext, int w, int lane, QKPF& pf) {
  const int h = lane >> 3, dg = lane & 7, n15 = lane & 15, quad = lane >> 4, hi = lane >> 5, c31 = lane & 31;
  const int* lut = (const int*)(smem + AT_LUT);
  const float* rb = (const float*)(smem + AT_RB);
  float* lgw = (float*)(smem + AT_WAVE + w * AT_WSZ);
  int* ixw = (int*)(smem + AT_WAVE + w * AT_WSZ + 8192);
  char* kst = smem + AT_WAVE + w * AT_WSZ + 9216;
  const int nsel = t + 1 < 256 ? t + 1 : 256;
  ixw[lane] = pf.s0; ixw[lane + 64] = pf.s1; ixw[lane + 128] = pf.s2; ixw[lane + 192] = pf.s3;
  const uint4 qcur0 = pf.q0, qcur1 = pf.q1;
  qk_fetch(p, tnext < L_ ? tnext : t, lane, pf);
  long qreg[2];
  {
#pragma unroll
    for (int c = 0; c < 2; ++c) {
      const uint4 qv = c == 0 ? qcur0 : qcur1;
      int w0 = __builtin_amdgcn_cvt_pk_fp8_f32(bflo(qv.x) * 8.f, bfhi(qv.x) * 8.f, 0, false);
      w0 = __builtin_amdgcn_cvt_pk_fp8_f32(bflo(qv.y) * 8.f, bfhi(qv.y) * 8.f, w0, true);
      int w1 = __builtin_amdgcn_cvt_pk_fp8_f32(bflo(qv.z) * 8.f, bfhi(qv.z) * 8.f, 0, false);
      w1 = __builtin_amdgcn_cvt_pk_fp8_f32(bflo(qv.w) * 8.f, bfhi(qv.w) * 8.f, w1, true);
      const long v = (long)(((unsigned long long)(unsigned)w1 << 32) | (unsigned long long)(unsigned)w0);
      qreg[c] = (n15 < 8) ? v : 0L;
    }
  }
  long bsel[16];
#pragma unroll
  for (int ks = 0; ks < 16; ++ks) bsel[ks] = (n15 == (ks >> 1)) ? qreg[ks & 1] : 0L;
  lds_fence();
  const uint4* KB16 = (const uint4*)(p.ws + O_KB);
  const uint2* VB = (const uint2*)(p.ws + O_VB);
  const int ntile = (nsel + 15) >> 4;
#define AT_KMMA(kt_) do { f32x4v acc0 = {0.f, 0.f, 0.f, 0.f}, acc1 = acc0, acc2 = acc0, acc3 = acc0; \
    const char* ar = kst + n15 * AT_KROW + 8 * quad; \
    _Pragma("unroll") for (int ks = 0; ks < 16; ks += 4) { \
      acc0 = MFMA8S(*(const long*)(ar + 32 * ks), bsel[ks], acc0); \
      acc1 = MFMA8S(*(const long*)(ar + 32 * ks + 32), bsel[ks + 1], acc1); \
      acc2 = MFMA8S(*(const long*)(ar + 32 * ks + 64), bsel[ks + 2], acc2); \
      acc3 = MFMA8S(*(const long*)(ar + 32 * ks + 96), bsel[ks + 3], acc3); } \
    const f32x4v acc = (acc0 + acc1) + (acc2 + acc3); \
    if (n15 < 8) { _Pragma("unroll") for (int i = 0; i < 4; ++i) lgw[(16 * (kt_) + 4 * quad + i) * 8 + n15] = acc[i] * 0.125f; } \
    cbar(); } while (0)
  uint4 kgA0, kgA1, kgA2, kgA3, kgA4, kgA5, kgA6, kgA7, kgB0, kgB1, kgB2, kgB3, kgB4, kgB5, kgB6, kgB7, kgC0, kgC1, kgC2, kgC3, kgC4, kgC5, kgC6, kgC7;
    { const int tl_ = (0) < ntile ? (0) : ntile - 1;
      const int4 ia_ = *(const int4*)(ixw + 16 * tl_ + 8 * hi), ib_ = *(const int4*)(ixw + 16 * tl_ + 8 * hi + 4);
      kgA0 = KB16[(size_t)ia_.x * 32 + c31]; kgA1 = KB16[(size_t)ia_.y * 32 + c31]; kgA2 = KB16[(size_t)ia_.z * 32 + c31]; kgA3 = KB16[(size_t)ia_.w * 32 + c31];
      kgA4 = KB16[(size_t)ib_.x * 32 + c31]; kgA5 = KB16[(size_t)ib_.y * 32 + c31]; kgA6 = KB16[(size_t)ib_.z * 32 + c31]; kgA7 = KB16[(size_t)ib_.w * 32 + c31]; }
    { const int tl_ = (1) < ntile ? (1) : ntile - 1;
      const int4 ia_ = *(const int4*)(ixw + 16 * tl_ + 8 * hi), ib_ = *(const int4*)(ixw + 16 * tl_ + 8 * hi + 4);
      kgB0 = KB16[(size_t)ia_.x * 32 + c31]; kgB1 = KB16[(size_t)ia_.y * 32 + c31]; kgB2 = KB16[(size_t)ia_.z * 32 + c31]; kgB3 = KB16[(size_t)ia_.w * 32 + c31];
      kgB4 = KB16[(size_t)ib_.x * 32 + c31]; kgB5 = KB16[(size_t)ib_.y * 32 + c31]; kgB6 = KB16[(size_t)ib_.z * 32 + c31]; kgB7 = KB16[(size_t)ib_.w * 32 + c31]; }
    { const int tl_ = (2) < ntile ? (2) : ntile - 1;
      const int4 ia_ = *(const int4*)(ixw + 16 * tl_ + 8 * hi), ib_ = *(const int4*)(ixw + 16 * tl_ + 8 * hi + 4);
      kgC0 = KB16[(size_t)ia_.x * 32 + c31]; kgC1 = KB16[(size_t)ia_.y * 32 + c31]; kgC2 = KB16[(size_t)ia_.z * 32 + c31]; kgC3 = KB16[(size_t)ia_.w * 32 + c31];
      kgC4 = KB16[(size_t)ib_.x * 32 + c31]; kgC5 = KB16[(size_t)ib_.y * 32 + c31]; kgC6 = KB16[(size_t)ib_.z * 32 + c31]; kgC7 = KB16[(size_t)ib_.w * 32 + c31]; }
  for (int kt = 0; kt < ntile; kt += 3) {
    { char* wr = kst + (8 * hi) * AT_KROW + c31 * 16; *(uint4*)(wr + 0 * AT_KROW) = kgA0; *(uint4*)(wr + 1 * AT_KROW) = kgA1; *(uint4*)(wr + 2 * AT_KROW) = kgA2; *(uint4*)(wr + 3 * AT_KROW) = kgA3; *(uint4*)(wr + 4 * AT_KROW) = kgA4; *(uint4*)(wr + 5 * AT_KROW) = kgA5; *(uint4*)(wr + 6 * AT_KROW) = kgA6; *(uint4*)(wr + 7 * AT_KROW) = kgA7; }
    { const int tl_ = ((kt) + 3) < ntile ? ((kt) + 3) : ntile - 1;
      const int4 ia_ = *(const int4*)(ixw + 16 * tl_ + 8 * hi), ib_ = *(const int4*)(ixw + 16 * tl_ + 8 * hi + 4);
      kgA0 = KB16[(size_t)ia_.x * 32 + c31]; kgA1 = KB16[(size_t)ia_.y * 32 + c31]; kgA2 = KB16[(size_t)ia_.z * 32 + c31]; kgA3 = KB16[(size_t)ia_.w * 32 + c31];
      kgA4 = KB16[(size_t)ib_.x * 32 + c31]; kgA5 = KB16[(size_t)ib_.y * 32 + c31]; kgA6 = KB16[(size_t)ib_.z * 32 + c31]; kgA7 = KB16[(size_t)ib_.w * 32 + c31]; }
    cbar();
    AT_KMMA(kt);
    if (kt + 1 < ntile) {
    { char* wr = kst + (8 * hi) * AT_KROW + c31 * 16; *(uint4*)(wr + 0 * AT_KROW) = kgB0; *(uint4*)(wr + 1 * AT_KROW) = kgB1; *(uint4*)(wr + 2 * AT_KROW) = kgB2; *(uint4*)(wr + 3 * AT_KROW) = kgB3; *(uint4*)(wr + 4 * AT_KROW) = kgB4; *(uint4*)(wr + 5 * AT_KROW) = kgB5; *(uint4*)(wr + 6 * AT_KROW) = kgB6; *(uint4*)(wr + 7 * AT_KROW) = kgB7; }
    { const int tl_ = ((kt + 1) + 3) < ntile ? ((kt + 1) + 3) : ntile - 1;
      const int4 ia_ = *(const int4*)(ixw + 16 * tl_ + 8 * hi), ib_ = *(const int4*)(ixw + 16 * tl_ + 8 * hi + 4);
      kgB0 = KB16[(size_t)ia_.x * 32 + c31]; kgB1 = KB16[(size_t)ia_.y * 32 + c31]; kgB2 = KB16[(size_t)ia_.z * 32 + c31]; kgB3 = KB16[(size_t)ia_.w * 32 + c31];
      kgB4 = KB16[(size_t)ib_.x * 32 + c31]; kgB5 = KB16[(size_t)ib_.y * 32 + c31]; kgB6 = KB16[(size_t)ib_.z * 32 + c31]; kgB7 = KB16[(size_t)ib_.w * 32 + c31]; }
    cbar();
    AT_KMMA(kt + 1);
    }
    if (kt + 2 < ntile) {
    { char* wr = kst + (8 * hi) * AT_KROW + c31 * 16; *(uint4*)(wr + 0 * AT_KROW) = kgC0; *(uint4*)(wr + 1 * AT_KROW) = kgC1; *(uint4*)(wr + 2 * AT_KROW) = kgC2; *(uint4*)(wr + 3 * AT_KROW) = kgC3; *(uint4*)(wr + 4 * AT_KROW) = kgC4; *(uint4*)(wr + 5 * AT_KROW) = kgC5; *(uint4*)(wr + 6 * AT_KROW) = kgC6; *(uint4*)(wr + 7 * AT_KROW) = kgC7; }
    { const int tl_ = ((kt + 2) + 3) < ntile ? ((kt + 2) + 3) : ntile - 1;
      const int4 ia_ = *(const int4*)(ixw + 16 * tl_ + 8 * hi), ib_ = *(const int4*)(ixw + 16 * tl_ + 8 * hi + 4);
      kgC0 = KB16[(size_t)ia_.x * 32 + c31]; kgC1 = KB16[(size_t)ia_.y * 32 + c31]; kgC2 = KB16[(size_t)ia_.z * 32 + c31]; kgC3 = KB16[(size_t)ia_.w * 32 + c31];
      kgC4 = KB16[(size_t)ib_.x * 32 + c31]; kgC5 = KB16[(size_t)ib_.y * 32 + c31]; kgC6 = KB16[(size_t)ib_.z * 32 + c31]; kgC7 = KB16[(size_t)ib_.w * 32 + c31]; }
    cbar();
    AT_KMMA(kt + 2);
    }
  }
  lds_fence();
  const int ngroups = (nsel + 7) >> 3;
  float mx = -INFINITY;
#pragma unroll 8
  for (int i = 0; i < 32; ++i) {
    const int kk = 8 * i + dg;
    const int myidx = ixw[kk];
    const int dist = t - myidx;
    const int bk = dist < 128 ? lut[dist < 0 ? 0 : dist] : 31;
    const float raw = lgw[kk * 8 + h];
    const float lgt = (kk < nsel) ? raw + rb[bk * 8 + h] : -INFINITY;
    lgw[kk * 8 + h] = lgt;
    mx = fmaxf(mx, lgt);
  }
  mx = max8(mx);
  float sum = 0.f;
#pragma unroll 8
  for (int i = 0; i < 32; ++i) {
    const float pv = __expf(lgw[(8 * i + dg) * 8 + h] - mx);
    sum += pv;
    lgw[(8 * i + dg) * 8 + h] = pv;
  }
  sum = sum8(sum);
  {
    const float inv = 1.f / sum;
#pragma unroll 8
    for (int i = 0; i < 32; ++i) lgw[(8 * i + dg) * 8 + h] *= inv;
  }
  lds_fence();
  {
    uint4 pk[4];
#pragma unroll
    for (int k = 0; k < 4; ++k) {
      const float4 a_ = *(const float4*)(lgw + (4 * lane + k) * 8), b_ = *(const float4*)(lgw + (4 * lane + k) * 8 + 4);
      pk[k] = make_uint4(cvtpk(a_.x, a_.y), cvtpk(a_.z, a_.w), cvtpk(b_.x, b_.y), cvtpk(b_.z, b_.w));
    }
    uint4* pdst = (uint4*)(p.ws + prob_off(t)) + lane * 4;
    pdst[0] = pk[0]; pdst[1] = pk[1]; pdst[2] = pk[2]; pdst[3] = pk[3];
  }
  lds_fence();
}

DI void attn_pv_query(const Params& p, int t, int w, int lane) {
  const int h = lane >> 3, dg = lane & 7;
  unsigned short* pl = (unsigned short*)(smem + AT_WAVE + w * AT_WSZ);
  int* ixw = (int*)(smem + AT_WAVE + w * AT_WSZ + 8192);
  const int nsel = t + 1 < 256 ? t + 1 : 256;
  const unsigned short* sel = (const unsigned short*)(p.ws + O_SEL) + (size_t)t * 256;
#pragma unroll
  for (int j = 0; j < 4; ++j) {
    const int pos = lane + 64 * j;
    ixw[pos] = pos < nsel ? (int)sel[pos] : 0;
  }
  {
    const uint4* psrc = (const uint4*)(p.ws + prob_off(t)) + lane * 4;
    uint4* pd = (uint4*)pl + lane * 4;
    const uint4 a0 = psrc[0], a1 = psrc[1], a2 = psrc[2], a3 = psrc[3];
    pd[0] = a0; pd[1] = a1; pd[2] = a2; pd[3] = a3;
  }
  lds_fence();
  const uint2* VB = (const uint2*)(p.ws + O_VB);
  const int ngroups = (nsel + 7) >> 3;
  f32x2v o01 = {0.f, 0.f}, o23 = {0.f, 0.f}, o45 = {0.f, 0.f}, o67 = {0.f, 0.f};
  uint2 kc[16], kn[16];
#define AT_VLOAD16(dst, ib) do { _Pragma("unroll") for (int q_ = 0; q_ < 4; ++q_) { const int4 i_ = *(const int4*)(ixw + (ib) + 4 * q_); \
    dst[4 * q_ + 0] = VB[(size_t)i_.x * 64 + lane]; dst[4 * q_ + 1] = VB[(size_t)i_.y * 64 + lane]; \
    dst[4 * q_ + 2] = VB[(size_t)i_.z * 64 + lane]; dst[4 * q_ + 3] = VB[(size_t)i_.w * 64 + lane]; } } while (0)
  const int ng16 = (nsel + 15) >> 4;
  AT_VLOAD16(kc, 0);
  for (int i = 0; i < ng16; ++i) {
    { const int nx = (i + 1 < ng16) ? i + 1 : i; AT_VLOAD16(kn, 16 * nx); }
    const float pa = bf2f(pl[(16 * i + dg) * 8 + h]);
    const float pbv = bf2f(pl[(16 * i + 8 + dg) * 8 + h]);
#pragma unroll
    for (int d = 0; d < 16; ++d) {
      const float pb = __shfl(d < 8 ? pa : pbv, (lane & ~7) | (d & 7));
      const f32x2v pb2 = {pb, pb};
      o01 = __builtin_amdgcn_cvt_pk_f32_fp8(kc[d].x, false) * pb2 + o01;
      o23 = __builtin_amdgcn_cvt_pk_f32_fp8(kc[d].x, true) * pb2 + o23;
      o45 = __builtin_amdgcn_cvt_pk_f32_fp8(kc[d].y, false) * pb2 + o45;
      o67 = __builtin_amdgcn_cvt_pk_f32_fp8(kc[d].y, true) * pb2 + o67;
    }
#pragma unroll
    for (int d = 0; d < 16; ++d) kc[d] = kn[d];
  }
  const uint4 zv = ((const uint4*)(p.ws + O_ZB))[(size_t)t * 64 + lane];
  uint4 ov;
  ov.x = cvtpk(o01.x * bflo(zv.x), o01.y * bfhi(zv.x));
  ov.y = cvtpk(o23.x * bflo(zv.y), o23.y * bfhi(zv.y));
  ov.z = cvtpk(o45.x * bflo(zv.z), o45.y * bfhi(zv.z));
  ov.w = cvtpk(o67.x * bflo(zv.w), o67.y * bfhi(zv.w));
  ((uint4*)(p.ws + O_AB))[tiled_unit(t, lane * 8, 32)] = ov;
  lds_fence();
}

constexpr int HC_B = 0;
constexpr int HC_QT = 33792;
constexpr int HC_QH = HC_QT + 17408;
constexpr int HC_KH = HC_QH + 17408;
constexpr int HC_VT = HC_KH + 17408;
constexpr int HC_P = HC_VT + 18432;
constexpr int HC_TOT = HC_P + 9216;
DI void hgrn_c_item(const Params& p, int layer, int c, int h) {
  const int tid = vtid(), lane = tid & 63, w = tid >> 6, hi = lane >> 5, c31 = lane & 31;
  float* bL = (float*)(smem + HC_B);
  unsigned short* qT = (unsigned short*)(smem + HC_QT);
  unsigned short* qH = (unsigned short*)(smem + HC_QH);
  unsigned short* kH = (unsigned short*)(smem + HC_KH);
  unsigned short* vT = (unsigned short*)(smem + HC_VT);
  unsigned short* P = (unsigned short*)(smem + HC_P);
  float* tot = (float*)(smem + HC_TOT);
  const float* G = (const float*)(p.ws + O_G);
  const unsigned short* KK = (const unsigned short*)(p.ws + O_KK);
  const unsigned short* IA = (const unsigned short*)(p.ws + O_IA);
  const unsigned short* QA = (const unsigned short*)(p.ws + O_QA);
  const int mt = w >> 2, nv = w & 3;
  const uint4* us = (const uint4*)(p.ws + O_US + (size_t)(c * 4 + h) * 32768);
  uint4 sfr[8];
#pragma unroll
  for (int ks = 0; ks < 8; ++ks) sfr[ks] = us[(nv * 8 + ks) * 64 + lane];
  uint4 qv_pre[2], kv_pre[2];
#pragma unroll
  for (int rep = 0; rep < 2; ++rep) {
    const int pr = tid + 512 * rep, t = pr >> 4, oc = pr & 15;
    qv_pre[rep] = *(const uint4*)(QA + (size_t)(64 * c + t) * 512 + 128 * h + oc * 8);
    kv_pre[rep] = *(const uint4*)(KK + (size_t)(64 * c + t) * 512 + 128 * h + oc * 8);
  }
  const uint4 z0_pre = *(const uint4*)((const unsigned short*)(p.ws + O_ZA) + (size_t)(64 * c + (tid >> 3)) * 512 + 128 * h + 16 * (tid & 7));
  const uint4 z1_pre = *(const uint4*)((const unsigned short*)(p.ws + O_ZA) + (size_t)(64 * c + (tid >> 3)) * 512 + 128 * h + 16 * (tid & 7) + 8);
  {
    const int seg = tid >> 7, k = tid & 127;
    const size_t rowbase = (size_t)(64 * c + 16 * seg);
    float b[16];
    float run = 0.f;
#pragma unroll
    for (int i = 0; i < 16; ++i) { run += G[(rowbase + i) * 512 + 128 * h + k]; b[i] = run; }
    tot[seg * 128 + k] = run;
    unsigned pv[8];
#pragma unroll
    for (int i = 0; i < 16; i += 2) {
      unsigned v0 = IA[(rowbase + i) * 512 + 128 * h + k], v1 = IA[(rowbase + i + 1) * 512 + 128 * h + k];
      pv[i >> 1] = v0 | (v1 << 16);
    }
    uint4* dv = (uint4*)(vT + k * 72 + 16 * seg);
    dv[0] = make_uint4(pv[0], pv[1], pv[2], pv[3]); dv[1] = make_uint4(pv[4], pv[5], pv[6], pv[7]);
    __syncthreads();
    float off = 0.f;
#pragma unroll
    for (int s2 = 0; s2 < 4; ++s2) { float tv = tot[s2 * 128 + k]; if (s2 < seg) off += tv; }
#pragma unroll
    for (int i = 0; i < 16; ++i) bL[(16 * seg + i) * 132 + k] = b[i] + off;
  }
  __syncthreads();
#pragma unroll
  for (int rep = 0; rep < 2; ++rep) {
    const int pr = tid + 512 * rep, t = pr >> 4, oc = pr & 15;
    const float4 b0 = *(const float4*)(bL + t * 132 + oc * 8), b1 = *(const float4*)(bL + t * 132 + oc * 8 + 4);
    const float4 r0 = *(const float4*)(bL + 31 * 132 + oc * 8), r1 = *(const float4*)(bL + 31 * 132 + oc * 8 + 4);
    const uint4 qv = qv_pre[rep];
    const uint4 kv = kv_pre[rep];
    const float bb[8] = {b0.x, b0.y, b0.z, b0.w, b1.x, b1.y, b1.z, b1.w};
    const float rr[8] = {r0.x, r0.y, r0.z, r0.w, r1.x, r1.y, r1.z, r1.w};
    const float qq[8] = {bflo(qv.x), bfhi(qv.x), bflo(qv.y), bfhi(qv.y), bflo(qv.z), bfhi(qv.z), bflo(qv.w), bfhi(qv.w)};
    const float kq[8] = {bflo(kv.x), bfhi(kv.x), bflo(kv.y), bfhi(kv.y), bflo(kv.z), bfhi(kv.z), bflo(kv.w), bfhi(kv.w)};
    float a1[8], a2[8], a3[8];
#pragma unroll
    for (int e = 0; e < 8; ++e) {
      a1[e] = qq[e] * __expf(bb[e]);
      a2[e] = qq[e] * __expf(bb[e] - rr[e]);
      a3[e] = kq[e] * __expf(rr[e] - bb[e]);
    }
    *(uint4*)(qT + t * 136 + oc * 8) = make_uint4(cvtpk(a1[0], a1[1]), cvtpk(a1[2], a1[3]), cvtpk(a1[4], a1[5]), cvtpk(a1[6], a1[7]));
    *(uint4*)(qH + t * 136 + oc * 8) = make_uint4(cvtpk(a2[0], a2[1]), cvtpk(a2[2], a2[3]), cvtpk(a2[4], a2[5]), cvtpk(a2[6], a2[7]));
    *(uint4*)(kH + t * 136 + oc * 8) = make_uint4(cvtpk(a3[0], a3[1]), cvtpk(a3[2], a3[3]), cvtpk(a3[4], a3[5]), cvtpk(a3[6], a3[7]));
  }
  __syncthreads();
  if (w < 4) {
    const int ms = w >> 1, ntq = w & 1;
    f32x16 sacc;
#pragma unroll
    for (int r = 0; r < 16; ++r) sacc[r] = 0.f;
#pragma unroll
    for (int ks = 0; ks < 8; ++ks) {
      bf16x8 af = __builtin_bit_cast(bf16x8, *(const uint4*)(kH + (32 * ms + c31) * 136 + 16 * ks + 8 * hi));
      bf16x8 bfv = __builtin_bit_cast(bf16x8, *(const uint4*)(qH + (32 * ntq + c31) * 136 + 16 * ks + 8 * hi));
      sacc = MFMA(af, bfv, sacc);
    }
    const int t = 32 * ntq + c31;
#pragma unroll
    for (int gq = 0; gq < 4; ++gq) {
      const int s0 = 32 * ms + 8 * gq + 4 * hi;
      float v0 = (s0 + 0 <= t) ? sacc[4 * gq + 0] : 0.f;
      float v1 = (s0 + 1 <= t) ? sacc[4 * gq + 1] : 0.f;
      float v2 = (s0 + 2 <= t) ? sacc[4 * gq + 2] : 0.f;
      float v3 = (s0 + 3 <= t) ? sacc[4 * gq + 3] : 0.f;
      uint2 val; val.x = cvtpk(v0, v1); val.y = cvtpk(v2, v3);
      *(uint2*)(P + t * 72 + s0) = val;
    }
  }
  f32x16 oacc;
#pragma unroll
  for (int r = 0; r < 16; ++r) oacc[r] = 0.f;
#pragma unroll
  for (int ks = 0; ks < 8; ++ks) {
    bf16x8 af = __builtin_bit_cast(bf16x8, *(const uint4*)(qT + (32 * mt + c31) * 136 + 16 * ks + 8 * hi));
    oacc = MFMA(af, __builtin_bit_cast(bf16x8, sfr[ks]), oacc);
  }
  __syncthreads();
#pragma unroll
  for (int ks = 0; ks < 4; ++ks) {
    bf16x8 af = __builtin_bit_cast(bf16x8, *(const uint4*)(P + (32 * mt + c31) * 72 + 16 * ks + 8 * hi));
    bf16x8 bfv = __builtin_bit_cast(bf16x8, *(const uint4*)(vT + (32 * nv + c31) * 72 + 16 * ks + 8 * hi));
    oacc = MFMA(af, bfv, oacc);
  }
  float* oL = bL;
#pragma unroll
  for (int r = 0; r < 16; ++r) oL[(32 * mt + crow(r, hi)) * 132 + 32 * nv + c31] = oacc[r];
  __syncthreads();
  {
    const int t = tid >> 3, sg = tid & 7;
    float ov[16];
#pragma unroll
    for (int e = 0; e < 16; e += 4) {
      const float4 f = *(const float4*)(oL + t * 132 + 16 * sg + e);
      ov[e] = f.x; ov[e + 1] = f.y; ov[e + 2] = f.z; ov[e + 3] = f.w;
    }
    float ss = 0.f;
#pragma unroll
    for (int e = 0; e < 16; ++e) ss = fmaf(ov[e], ov[e], ss);
    ss += __shfl_xor(ss, 1);
    ss += __shfl_xor(ss, 2);
    ss += __shfl_xor(ss, 4);
    const float rs = rsqrtf(ss * (1.f / 128.f) + 1e-6f);
    const int tg = 64 * c + t, k0 = 128 * h + 16 * sg;
    const float* ng = p.norm_a_g + (size_t)layer * 512 + k0;
    const uint4 z0 = z0_pre, z1 = z1_pre;
    const float zz[16] = {bflo(z0.x), bfhi(z0.x), bflo(z0.y), bfhi(z0.y), bflo(z0.z), bfhi(z0.z), bflo(z0.w), bfhi(z0.w),
                          bflo(z1.x), bfhi(z1.x), bflo(z1.y), bfhi(z1.y), bflo(z1.z), bfhi(z1.z), bflo(z1.w), bfhi(z1.w)};
    float rr[16];
#pragma unroll
    for (int e = 0; e < 16; ++e) rr[e] = ov[e] * rs * ng[e] * zz[e];
    uint4* aa = (uint4*)(p.ws + O_AA);
    aa[tiled_unit(tg, k0, 32)] = make_uint4(cvtpk(rr[0], rr[1]), cvtpk(rr[2], rr[3]), cvtpk(rr[4], rr[5]), cvtpk(rr[6], rr[7]));
    aa[tiled_unit(tg, k0 + 8, 32)] = make_uint4(cvtpk(rr[8], rr[9]), cvtpk(rr[10], rr[11]), cvtpk(rr[12], rr[13]), cvtpk(rr[14], rr[15]));
  }
  __syncthreads();
}

DI void acc_to_lds_bf16(f32x16 (&acc)[2][2], unsigned short* tile) {
  const int tid = vtid(), lane = tid & 63, w = tid >> 6, wm = w >> 1, wn = w & 1, hi = lane >> 5, c31 = lane & 31;
#pragma unroll
  for (int i = 0; i < 2; ++i)
#pragma unroll
    for (int j = 0; j < 2; ++j)
#pragma unroll
      for (int r = 0; r < 16; ++r)
        tile[(64 * wm + 32 * i + crow(r, hi)) * 128 + 64 * wn + 32 * j + c31] = f2bf(acc[i][j][r]);
}
DI void p5_tile(const Params& p, int mb, int nt) {
  const int tid = vtid(), lane = tid & 63, w = tid >> 6, wm = w >> 1, wn = w & 1, hi = lane >> 5, c31 = lane & 31;
  f32x16 acc[2][2];
  zero_acc(acc);
  gemm_core((const uint4*)(p.ws + O_AA), mb * 8, (const uint4*)(p.ws + O_WUA), nt * 4, 32, acc, (uint4*)smem);
  unsigned uap[2][2][8];
#pragma unroll
  for (int i = 0; i < 2; ++i)
#pragma unroll
    for (int j = 0; j < 2; ++j)
#pragma unroll
      for (int r = 0; r < 16; r += 2) uap[i][j][r >> 1] = cvtpk(acc[i][j][r], acc[i][j][r + 1]);
  zero_acc(acc);
  gemm_core((const uint4*)(p.ws + O_AB), mb * 8, (const uint4*)(p.ws + O_WUB), nt * 4, 32, acc, (uint4*)smem);
  unsigned short* tA = (unsigned short*)smem;
  unsigned short* tB = (unsigned short*)(smem + 65536);
#pragma unroll
  for (int i = 0; i < 2; ++i)
#pragma unroll
    for (int j = 0; j < 2; ++j)
#pragma unroll
      for (int r = 0; r < 16; r += 2) {
        const int o0 = (64 * wm + 32 * i + crow(r, hi)) * 128 + 64 * wn + 32 * j + c31;
        tA[o0] = (unsigned short)(uap[i][j][r >> 1] & 0xffffu);
        tA[o0 + 128] = (unsigned short)(uap[i][j][r >> 1] >> 16);
        tB[o0] = f2bf(acc[i][j][r]);
        tB[o0 + 128] = f2bf(acc[i][j][r + 1]);
      }
  __syncthreads();
  const int row0 = mb * 256;
#pragma unroll 2
  for (int q = 0; q < 8; ++q) {
    const int u = tid + 512 * q, r = u >> 4, c8 = u & 15;
    const uint4 ua = *(const uint4*)&tA[r * 128 + c8 * 8];
    const uint4 ub = *(const uint4*)&tB[r * 128 + c8 * 8];
    const int t = row0 + r, n0 = nt * 128 + c8 * 8;
    const uint4 ga = *(const uint4*)(p.ws + O_SGA + ((size_t)t * 1024 + n0) * 2);
    const uint4 gb = *(const uint4*)(p.ws + O_SGB + ((size_t)t * 1024 + n0) * 2);
    uint4 o;
    o.x = cvtpk(bflo(ga.x) * bflo(ua.x) + bflo(gb.x) * bflo(ub.x), bfhi(ga.x) * bfhi(ua.x) + bfhi(gb.x) * bfhi(ub.x));
    o.y = cvtpk(bflo(ga.y) * bflo(ua.y) + bflo(gb.y) * bflo(ub.y), bfhi(ga.y) * bfhi(ua.y) + bfhi(gb.y) * bfhi(ub.y));
    o.z = cvtpk(bflo(ga.z) * bflo(ua.z) + bflo(gb.z) * bflo(ub.z), bfhi(ga.z) * bfhi(ua.z) + bfhi(gb.z) * bfhi(ub.z));
    o.w = cvtpk(bflo(ga.w) * bflo(ua.w) + bflo(gb.w) * bflo(ub.w), bfhi(ga.w) * bfhi(ua.w) + bfhi(gb.w) * bfhi(ub.w));
    ((uint4*)(p.ws + O_MG))[tiled_unit(t, n0, 64)] = o;
  }
  __syncthreads();
}

DI void p6_tile(const Params& p, int layer, int mb, int nt) {
  const int tid = vtid(), lane = tid & 63, w = tid >> 6, wm = w >> 1, wn = w & 1, hi = lane >> 5, c31 = lane & 31;
  f32x16 acc[2][2];
  zero_acc(acc);
  gemm_core((const uint4*)(p.ws + O_MG), mb * 8, (const uint4*)(p.ws + O_WOUT), nt * 4, 64, acc, (uint4*)smem);
  const float* hin = (layer == 0) ? p.x : p.out;
#pragma unroll
  for (int i = 0; i < 2; ++i)
#pragma unroll
    for (int j = 0; j < 2; ++j)
#pragma unroll
      for (int r = 0; r < 16; ++r) {
        const size_t idx = (size_t)(mb * 256 + 64 * wm + 32 * i + crow(r, hi)) * DM + nt * 128 + 64 * wn + 32 * j + c31;
        p.out[idx] = fmaf(ALPHA_, hin[idx], acc[i][j][r]);
      }
}

DI float dpp_add_f(float v, int which) {
  const int iv = __builtin_bit_cast(int, v);
  int r;
  switch (which) {
    case 0: r = __builtin_amdgcn_update_dpp(0, iv, 0x111, 0xf, 0xf, true); break;
    case 1: r = __builtin_amdgcn_update_dpp(0, iv, 0x112, 0xf, 0xf, true); break;
    case 2: r = __builtin_amdgcn_update_dpp(0, iv, 0x114, 0xf, 0xf, true); break;
    case 3: r = __builtin_amdgcn_update_dpp(0, iv, 0x118, 0xf, 0xf, true); break;
    default: r = __builtin_amdgcn_update_dpp(0, iv, 0x142, 0xa, 0xf, false); break;
  }
  return v + __builtin_bit_cast(float, r);
}
DI float half_sum_to_last(float v) {
  v = dpp_add_f(v, 0); v = dpp_add_f(v, 1); v = dpp_add_f(v, 2); v = dpp_add_f(v, 3); v = dpp_add_f(v, 4);
  return v;
}
DI void fused_out_ln(const Params& p, int layer, int mb64) {
  const int tid = vtid(), lane = tid & 63, w = tid >> 6, hi = lane >> 5, c31 = lane & 31;
  uint4* lds = (uint4*)smem;
  const uint4* A = (const uint4*)(p.ws + O_MG) + (size_t)(2 * mb64) * 64 * 64;
#pragma unroll
  for (int r = 0; r < 16; ++r)
    __builtin_amdgcn_global_load_lds((const unsigned*)(A + tid + 512 * r), (unsigned*)(lds + tid + 512 * r), 16, 0, 0);
  const uint4* Bw = (const uint4*)(p.ws + O_WOUT) + (size_t)(4 * w) * 64 * 64 + lane;
  uint4 bq[4][4];
#pragma unroll
  for (int s_ = 0; s_ < 4; ++s_)
#pragma unroll
    for (int j = 0; j < 4; ++j) bq[s_][j] = Bw[(size_t)(j * 64 + s_) * 64];
  f32x16 acc[2][4];
#pragma unroll
  for (int i = 0; i < 2; ++i)
#pragma unroll
    for (int j = 0; j < 4; ++j)
#pragma unroll
      for (int r = 0; r < 16; ++r) acc[i][j][r] = 0.f;
  __syncthreads();
#pragma unroll 1
  for (int k4 = 0; k4 < 16; ++k4) {
#pragma unroll
    for (int s_ = 0; s_ < 4; ++s_) {
      const int ks = 4 * k4 + s_;
      const bf16x8 a0 = __builtin_bit_cast(bf16x8, lds[ks * 64 + lane]);
      const bf16x8 a1 = __builtin_bit_cast(bf16x8, lds[4096 + ks * 64 + lane]);
#pragma unroll
      for (int j = 0; j < 4; ++j) {
        const bf16x8 b = __builtin_bit_cast(bf16x8, bq[s_][j]);
        acc[0][j] = MFMA(a0, b, acc[0][j]);
        acc[1][j] = MFMA(a1, b, acc[1][j]);
      }
      if (k4 < 15) {
#pragma unroll
        for (int j = 0; j < 4; ++j) bq[s_][j] = Bw[(size_t)(j * 64 + ks + 4) * 64];
      }
    }
  }
  const float* hin = (layer == 0) ? p.x : p.out;
  float* ft = (float*)smem;
  uint2* hb2 = (uint2*)(p.ws + O_HB);
  const int rr = tid >> 4, seg = tid & 15;
#pragma unroll
  for (int i = 0; i < 2; ++i) {
    __syncthreads();
    {
      float* b0 = ft + (4 * hi) * 1024 + 128 * w + c31;
      float* b1 = b0 + 16 * 1024;
#pragma unroll
      for (int j = 0; j < 4; ++j)
#pragma unroll
        for (int r = 0; r < 16; ++r) {
          float* bp = (r < 8) ? b0 : b1;
          bp[((r & 3) + 8 * ((r >> 2) & 1)) * 1024 + 32 * j] = acc[i][j][r];
        }
    }
    __syncthreads();
    const int trow = 64 * mb64 + 32 * i + rr;
    const float* hrow = hin + (size_t)trow * DM;
    float s1 = 0.f, s2 = 0.f;
    float* frow = ft + rr * 1024 + 4 * seg;
#pragma unroll 4
    for (int e = 0; e < 16; ++e) {
      const float4 y = *(const float4*)(frow + 64 * e);
      const float4 hv = *(const float4*)(hrow + 64 * e + 4 * seg);
      float4 pre;
      pre.x = fmaf(ALPHA_, hv.x, y.x); pre.y = fmaf(ALPHA_, hv.y, y.y); pre.z = fmaf(ALPHA_, hv.z, y.z); pre.w = fmaf(ALPHA_, hv.w, y.w);
      s1 += (pre.x + pre.y) + (pre.z + pre.w);
      s2 = fmaf(pre.x, pre.x, s2); s2 = fmaf(pre.y, pre.y, s2); s2 = fmaf(pre.z, pre.z, s2); s2 = fmaf(pre.w, pre.w, s2);
      *(float4*)(frow + 64 * e) = pre;
    }
    s1 += __shfl_xor(s1, 1); s1 += __shfl_xor(s1, 2); s1 += __shfl_xor(s1, 4); s1 += __shfl_xor(s1, 8);
    s2 += __shfl_xor(s2, 1); s2 += __shfl_xor(s2, 2); s2 += __shfl_xor(s2, 4); s2 += __shfl_xor(s2, 8);
    const float mu = s1 * (1.f / 1024.f);
    const float rs = rsqrtf(fmaxf(s2 * (1.f / 1024.f) - mu * mu, 0.f) + 1e-5f);
    const float* gp = p.ln_g + (size_t)layer * DM;
    const float* bp2 = p.ln_b + (size_t)layer * DM;
    float* orow = p.out + (size_t)trow * DM;
#pragma unroll 4
    for (int e = 0; e < 16; ++e) {
      const int c0 = 64 * e + 4 * seg;
      const float4 pre = *(const float4*)(frow + 64 * e);
      const float4 g4 = *(const float4*)(gp + c0), b4 = *(const float4*)(bp2 + c0);
      float4 o;
      o.x = (pre.x - mu) * rs * g4.x + b4.x; o.y = (pre.y - mu) * rs * g4.y + b4.y;
      o.z = (pre.z - mu) * rs * g4.z + b4.z; o.w = (pre.w - mu) * rs * g4.w + b4.w;
      *(float4*)(orow + c0) = o;
      hb2[tiled_unit(trow, c0 & ~7, 64) * 2 + ((c0 >> 2) & 1)] = make_uint2(cvtpk(o.x, o.y), cvtpk(o.z, o.w));
    }
  }
  __syncthreads();
}

DI void p7_rows(const Params& p, int layer) {
  const int tid = vtid();
  const int lane = tid & 63, gw = blockIdx.x * 8 + (tid >> 6), nw = gridDim.x * 8;
  const float* g = p.ln_g + (size_t)layer * DM;
  const float* bb = p.ln_b + (size_t)layer * DM;
  uint4* hb = (uint4*)(p.ws + O_HB);
  for (int t = gw; t < L_; t += nw) {
    float* row = p.out + (size_t)t * DM;
    float v[16];
#pragma unroll
    for (int q = 0; q < 2; ++q) {
      const float4 a = *(const float4*)(row + q * 512 + lane * 8), b = *(const float4*)(row + q * 512 + lane * 8 + 4);
      v[8 * q + 0] = a.x; v[8 * q + 1] = a.y; v[8 * q + 2] = a.z; v[8 * q + 3] = a.w;
      v[8 * q + 4] = b.x; v[8 * q + 5] = b.y; v[8 * q + 6] = b.z; v[8 * q + 7] = b.w;
    }
    float s = 0.f;
#pragma unroll
    for (int e = 0; e < 16; ++e) s += v[e];
#pragma unroll
    for (int off = 1; off < 64; off <<= 1) s += __shfl_xor(s, off);
    const float mu = s * (1.f / 1024.f);
    float ss = 0.f;
#pragma unroll
    for (int e = 0; e < 16; ++e) { const float d = v[e] - mu; ss = fmaf(d, d, ss); }
#pragma unroll
    for (int off = 1; off < 64; off <<= 1) ss += __shfl_xor(ss, off);
    const float rs = rsqrtf(ss * (1.f / 1024.f) + 1e-5f);
#pragma unroll
    for (int q = 0; q < 2; ++q) {
      const int k0 = q * 512 + lane * 8;
      float o[8];
#pragma unroll
      for (int e = 0; e < 8; ++e) o[e] = (v[8 * q + e] - mu) * rs * g[k0 + e] + bb[k0 + e];
      *(float4*)(row + k0) = make_float4(o[0], o[1], o[2], o[3]);
      *(float4*)(row + k0 + 4) = make_float4(o[4], o[5], o[6], o[7]);
      hb[tiled_unit(t, k0, 64)] = make_uint4(cvtpk(o[0], o[1]), cvtpk(o[2], o[3]), cvtpk(o[4], o[5]), cvtpk(o[6], o[7]));
    }
  }
}


#define XB_TMO      128
#define XB_XCNT(j)  (256  + 64 * (j))
#define XB_XSUB(j)  (1280 + 64 * (j))
#define XB_XGEN(j)  (2304 + 64 * (j))
#define XB_TOP      3328
#define XB_TOPGEN   3392
#define XCD_BAR_WORDS 3456
#define XB_SPIN_CAP (1u << 22)
#define LAS __attribute__((address_space(3)))
DI unsigned xb_ld(unsigned* p)              { return __hip_atomic_load(p, __ATOMIC_RELAXED, __HIP_MEMORY_SCOPE_AGENT); }
DI unsigned xb_add(unsigned* p, unsigned v) { return __hip_atomic_fetch_add(p, v, __ATOMIC_RELAXED, __HIP_MEMORY_SCOPE_AGENT); }
DI unsigned xb_xcc_id() { return (unsigned)__builtin_amdgcn_s_getreg((3 << 11) | 20) & 0xFu; }
#define XB_SPIN(cond, bar) do { unsigned _sp = 0; while (cond) { __builtin_amdgcn_s_sleep(1); \
    if ((++_sp & 255u) == 0u) { if (xb_ld(&(bar)[XB_TMO])) break; if (_sp > XB_SPIN_CAP) { atomicAdd(&(bar)[XB_TMO], 1u); break; } } } } while (0)
struct XcdBarrier { unsigned* bar; unsigned x; volatile LAS unsigned* st; };
DI XcdBarrier xcd_barrier_post(unsigned* bar, volatile LAS unsigned* st) {
  XcdBarrier b; b.bar = bar; b.x = xb_xcc_id(); b.st = st;
  if (threadIdx.x == 0) (void)xb_add(&bar[XB_XCNT(b.x)], 1u);
  return b;
}
DI void xcd_barrier_complete(unsigned* bar, unsigned x, unsigned& nloc, unsigned& nx) {
  const unsigned G = gridDim.x * gridDim.y * gridDim.z;
  unsigned sum, cnt, mine, sp = 0u;
  for (;;) {
    sum = 0u; cnt = 0u; mine = 0u;
#pragma unroll
    for (unsigned j = 0; j < 16; ++j) { const unsigned c = xb_ld(&bar[XB_XCNT(j)]); sum += c; cnt += (c > 0u) ? 1u : 0u; mine = (j == x) ? c : mine; }
    if (sum == G) break;
    __builtin_amdgcn_s_sleep(1);
    if ((++sp & 255u) == 0u) { if (xb_ld(&bar[XB_TMO])) break; if (sp > XB_SPIN_CAP) { atomicAdd(&bar[XB_TMO], 1u); break; } }
  }
  nloc = mine > 0u ? mine : 1u; nx = cnt > 0u ? cnt : 1u;
}
DI void xcd_barrier(const XcdBarrier& b) {
  asm volatile("s_waitcnt vmcnt(0)" ::: "memory");
  __syncthreads();
  if (threadIdx.x == 0) {
    unsigned* bar = b.bar;
    __builtin_amdgcn_s_waitcnt(0);
    unsigned nloc = b.st[0], nx = b.st[1];
    if (nloc == 0u) { xcd_barrier_complete(bar, b.x, nloc, nx); b.st[0] = nloc; b.st[1] = nx; }
    const unsigned old = xb_add(&bar[XB_XSUB(b.x)], 1u);
    const unsigned gen = old / nloc;
    if (old + 1u == (gen + 1u) * nloc) {
      __builtin_amdgcn_fence(__ATOMIC_RELEASE, "agent");
      asm volatile("s_waitcnt vmcnt(0)" ::: "memory");
      const unsigned og = xb_add(&bar[XB_TOP], 1u);
      const unsigned tg = og / nx;
      if (og + 1u == (tg + 1u) * nx) xb_add(&bar[XB_TOPGEN], 1u);
      else XB_SPIN(xb_ld(&bar[XB_TOPGEN]) == tg, bar);
      __builtin_amdgcn_fence(__ATOMIC_ACQUIRE, "agent");
      xb_add(&bar[XB_XGEN(b.x)], 1u);
      asm volatile("s_waitcnt vmcnt(0)" ::: "memory");
    } else {
      XB_SPIN(xb_ld(&bar[XB_XGEN(b.x)]) == gen, bar);
      __builtin_amdgcn_fence(__ATOMIC_ACQUIRE, "agent");
      asm volatile("s_waitcnt vmcnt(0)" ::: "memory");
    }
  }
  __syncthreads();
}
constexpr int LDS_BARST = 163840 - 16;

__global__ void __launch_bounds__(512) mk(Params p) {
  cg::grid_group grid = cg::this_grid();
  const int nb = gridDim.x, bid = blockIdx.x;
  volatile LAS unsigned* bst_ = (volatile LAS unsigned*)(smem + LDS_BARST);
  if (threadIdx.x < 4) bst_[threadIdx.x] = 0u;
  __syncthreads();
  (void)xcd_barrier_post((unsigned*)(p.ws + O_BAR), bst_);
#define XB_NOW() XcdBarrier{(unsigned*)(p.ws + O_BAR), xb_xcc_id(), (volatile LAS unsigned*)(smem + LDS_BARST)}
  phase0(p);
  grid.sync();
  for (int layer = 0; layer < DEPTH_; ++layer) {
    {
      const int gtid = bid * 512 + vtid(), gthreads = nb * 512;
      conv_weight(p.w_up_a + (size_t)layer * 512 * 1024, 512, 1024, 1024, false, (uint4*)(p.ws + O_WUA), gtid, gthreads);
      conv_weight(p.w_up_b + (size_t)layer * 512 * 1024, 512, 1024, 1024, false, (uint4*)(p.ws + O_WUB), gtid, gthreads);
      conv_weight(p.w_out + (size_t)layer * 1024 * 1024, 1024, 1024, 1024, false, (uint4*)(p.ws + O_WOUT), gtid, gthreads);
#ifndef NO_P1
      for (int id = bid; id < 64 * 53; id += nb) p1_tile(p, layer, id & 63, id >> 6);
#endif
    }
    xcd_barrier(XB_NOW());
    {
      if (layer + 1 < DEPTH_) {
        const int gtid = bid * 512 + vtid(), gthreads = nb * 512;
        conv_weight(p.w_in + (size_t)(layer + 1) * 1024 * NIN, 1024, NIN, NPAD, true, (uint4*)(p.ws + O_WTIN), gtid, gthreads);
      }
#ifndef NO_HA
      for (int id = bid; id < 1024; id += nb) hgrn_a_item(p, id >> 2, id & 3);
#endif
      for (int s = bid; s < 1024; s += nb) {
        const int rnd = s / nb, pos = s - rnd * nb;
        const int rem = 1024 - rnd * nb, count = rem < nb ? rem : nb;
        const int sp = (rnd & 1) ? (rnd * nb + count - 1 - pos) : s;
        indexer_item(p, 1023 - sp);
      }
    }
    xcd_barrier(XB_NOW());
    {
      attn_setup();
      const int tid = vtid();
      if (tid < 256) ((float*)(smem + AT_RB))[tid] = p.rel_bias[tid];
      __syncthreads();
#ifndef NO_SCAN
      hgrn_scan(p);
#endif
      const int w = tid >> 6, lane = tid & 63;
#ifndef NO_ATT
      { QKPF pf; qk_fetch(p, bid * 8 + w, lane, pf);
        for (int t = bid * 8 + w; t < L_; t += nb * 8) attn_query(p, t, t + nb * 8, w, lane, pf); }
#endif
      __syncthreads();
    }
    xcd_barrier(XB_NOW());
    {
      const int tid = vtid();
      const int w = tid >> 6, lane = tid & 63;
      for (int t = bid * 8 + w; t < L_; t += nb * 8) attn_pv_query(p, t, w, lane);
      __syncthreads();
    }
    xcd_barrier(XB_NOW());
#ifndef NO_HC
    for (int id = bid; id < 1024; id += nb) hgrn_c_item(p, layer, id >> 2, id & 3);
#endif
    xcd_barrier(XB_NOW());
#ifndef NO_P5
    for (int id = bid; id < 64 * 8; id += nb) p5_tile(p, id & 63, id >> 6);
#endif
    xcd_barrier(XB_NOW());
    for (int id = bid; id < 256; id += nb) fused_out_ln(p, layer, id);
    xcd_barrier(XB_NOW());
  }}

extern "C" void kernel_launch(void* const* d_in, const int* in_sizes, int n_in, void* d_out, int out_size, void* d_ws,
                              size_t ws_size, hipStream_t stream) {
  constexpr size_t kLds = 160 * 1024;
  static int grid_blocks = 0;
  if (!grid_blocks) {
    int dev = 0, cus = 0, per_cu = 0;
    (void)hipGetDevice(&dev);
    (void)hipDeviceGetAttribute(&cus, hipDeviceAttributeMultiprocessorCount, dev);
    (void)hipFuncSetAttribute((const void*)mk, hipFuncAttributeMaxDynamicSharedMemorySize, (int)kLds);
    (void)hipOccupancyMaxActiveBlocksPerMultiprocessor(&per_cu, mk, 512, kLds);
    if (per_cu > 1) per_cu = 1;
    grid_blocks = cus * per_cu;
  }
  if (ws_size < WS_NEED || grid_blocks <= 0) { fprintf(stderr, "ws too small or no occupancy\n"); return; }
  Params p{};
  p.x = (const float*)d_in[0]; p.w_in = (const float*)d_in[1]; p.b_in = (const float*)d_in[2];
  p.w_up_a = (const float*)d_in[3]; p.w_up_b = (const float*)d_in[4]; p.w_out = (const float*)d_in[5];
  p.lb_logits = (const float*)d_in[6]; p.norm_a_g = (const float*)d_in[7]; p.rel_bias = (const float*)d_in[8];
  p.ln_g = (const float*)d_in[9]; p.ln_b = (const float*)d_in[10];
  p.out = (float*)d_out; p.ws = (char*)d_ws;
  (void)hipMemsetAsync((char*)d_ws + O_BAR, 0, XCD_BAR_WORDS * 4, stream);
  void* args[] = {&p};
  hipError_t e = hipLaunchCooperativeKernel((void*)mk, dim3(grid_blocks), dim3(512), args, kLds, stream);
  if (e != hipSuccess) fprintf(stderr, "cooperative launch failed: %s (grid %d)\n", hipGetErrorString(e), grid_blocks);
}
```

```cpp
#include <hip/hip_runtime.h>
#include <hip/hip_cooperative_groups.h>
#include <cstdio>
#include <cstdint>
namespace cg = cooperative_groups;

#define DI __device__ __forceinline__
typedef __attribute__((ext_vector_type(8))) short bf16x8;
typedef __attribute__((ext_vector_type(16))) float f32x16;
typedef __attribute__((ext_vector_type(2))) float f32x2;
typedef __attribute__((ext_vector_type(2))) __bf16 bf16x2_t;
#define MFMA(a, b, c) __builtin_amdgcn_mfma_f32_32x32x16_bf16((a), (b), (c), 0, 0, 0)

constexpr int L_ = 16384, DM = 1024, NIN = 6728, NPAD = 6912, DEPTH_ = 4;
constexpr float ALPHA_ = 1.681792830507429f;
constexpr size_t MiB = 1048576;
constexpr size_t O_WTIN = 0 * MiB, O_WUA = 14 * MiB, O_WUB = 15 * MiB, O_WOUT = 16 * MiB, O_HB = 18 * MiB,
                 O_QA = 50 * MiB, O_G = 66 * MiB, O_KK = 98 * MiB, O_IA = 114 * MiB, O_ZA = 130 * MiB,
                 O_QB = 146 * MiB, O_KB = 162 * MiB, O_VB = 178 * MiB, O_ZB = 194 * MiB, O_QI = 210 * MiB,
                 O_KI = 226 * MiB, O_WI = 228 * MiB, O_D = 228 * MiB + 512 * 1024, O_SGA = 229 * MiB,
                 O_SGB = 261 * MiB, O_US = 293 * MiB, O_SEL = 325 * MiB, O_LBS = 333 * MiB,
                 O_BAR = 333 * MiB + 65536, O_AA = 334 * MiB, O_AB = 350 * MiB, O_MG = 366 * MiB, WS_NEED = 398 * MiB;

struct Params {
  const float *x, *w_in, *b_in, *w_up_a, *w_up_b, *w_out, *lb_logits, *norm_a_g, *rel_bias, *ln_g, *ln_b;
  float* out;
  char* ws;
};

extern __shared__ __attribute__((aligned(16))) char smem[];

DI unsigned cvtpk(float lo, float hi) {
  f32x2 v = {lo, hi};
  bf16x2_t b = __builtin_convertvector(v, bf16x2_t);
  return __builtin_bit_cast(unsigned, b);
}
DI unsigned short f2bf(float x) { return (unsigned short)(cvtpk(x, 0.f) & 0xffffu); }
DI float bflo(unsigned u) { return __uint_as_float(u << 16); }
DI float bfhi(unsigned u) { return __uint_as_float(u & 0xffff0000u); }
DI float bf2f(unsigned short s) { return __uint_as_float(((unsigned)s) << 16); }
DI float sigm(float x) { return 1.f / (1.f + __expf(-x)); }
DI float silu(float x) { return x / (1.f + __expf(-x)); }
DI int crow(int r, int hi) { return (r & 3) + 8 * (r >> 2) + 4 * hi; }
DI size_t tiled_unit(int r, int k, int KS) {
  return ((size_t)(r >> 5) * KS + (k >> 4)) * 64 + (r & 31) + 32 * ((k >> 3) & 1);
}
DI float dot2(unsigned a, unsigned b, float acc) {
  asm volatile("v_dot2c_f32_bf16 %0, %1, %2" : "+v"(acc) : "v"(a), "v"(b));
  return acc;
}
template <typename T> DI T* opq(T* x) { asm volatile("" : "+s"(x)); return x; }
#define LAUNDER(pin) Params p; p.x = opq((pin).x); p.w_in = (pin).w_in; p.b_in = (pin).b_in; p.w_up_a = (pin).w_up_a; p.w_up_b = (pin).w_up_b; \
  p.w_out = (pin).w_out; p.lb_logits = (pin).lb_logits; p.norm_a_g = (pin).norm_a_g; p.rel_bias = (pin).rel_bias; p.ln_g = (pin).ln_g; \
  p.ln_b = (pin).ln_b; p.out = opq((pin).out); p.ws = opq((pin).ws);
DI int vtid() { int t = threadIdx.x; asm volatile("" : "+v"(t)); return t; }
DI unsigned vzero() { unsigned z; asm volatile("v_mov_b32 %0, 0" : "=v"(z)); return z; }
DI void cbar() { asm volatile("" ::: "memory"); }
DI void lds_fence() { asm volatile("s_waitcnt lgkmcnt(0)" ::: "memory"); }

DI int colmap(int np) {
  if (np < 4608) return np;
  if (np < 5632) return 4680 + (np - 4608);
  if (np < 6656) return 5704 + (np - 5632);
  if (np < 6720) return 4608 + (np - 6656);
  if (np < 6728) return 4672 + (np - 6720);
  return -1;
}

DI void conv_weight(const float* __restrict__ src, int K, int ldn, int Npad, bool useMap, uint4* __restrict__ dst,
                    int gtid, int gthreads) {
  const int KS = K >> 4;
  const int total = Npad * (K >> 3);
  for (int u = gtid; u < total; u += gthreads) {
    int kg = u / Npad, n = u - kg * Npad;
    int col = useMap ? colmap(n) : n;
    float v[8];
#pragma unroll
    for (int j = 0; j < 8; ++j) v[j] = (col >= 0) ? src[(size_t)(kg * 8 + j) * ldn + col] : 0.f;
    uint4 o;
    o.x = cvtpk(v[0], v[1]); o.y = cvtpk(v[2], v[3]); o.z = cvtpk(v[4], v[5]); o.w = cvtpk(v[6], v[7]);
    dst[tiled_unit(n, kg * 8, KS)] = o;
  }
}

DI void conv_weight_rm(const float* __restrict__ src, int K, int ldn, int Npad, bool useMap, uint4* __restrict__ dst,
                       int gtid, int gthreads) {
  const int total = Npad * (K >> 3);
  for (int u = gtid; u < total; u += gthreads) {
    int kg = u / Npad, n = u - kg * Npad;
    int col = useMap ? colmap(n) : n;
    float v[8];
#pragma unroll
    for (int j = 0; j < 8; ++j) v[j] = (col >= 0) ? src[(size_t)(kg * 8 + j) * ldn + col] : 0.f;
    uint4 o;
    o.x = cvtpk(v[0], v[1]); o.y = cvtpk(v[2], v[3]); o.z = cvtpk(v[4], v[5]); o.w = cvtpk(v[6], v[7]);
    dst[(size_t)n * (K >> 3) + kg] = o;
  }
}

DI void phase0(const Params& p) {
  const int gtid = blockIdx.x * 512 + vtid(), gthreads = gridDim.x * 512;
  conv_weight_rm(p.w_in, 1024, NIN, NPAD, true, (uint4*)(p.ws + O_WTIN), gtid, gthreads);
  uint4* hb = (uint4*)(p.ws + O_HB);
  for (int u = gtid; u < L_ * 128; u += gthreads) {
    const float4* s_ = (const float4*)(p.x + (size_t)u * 8);
    const float4 a = s_[0], b = s_[1];
    uint4 o;
    o.x = cvtpk(a.x, a.y); o.y = cvtpk(a.z, a.w); o.z = cvtpk(b.x, b.y); o.w = cvtpk(b.z, b.w);
    hb[u] = o;
  }
  float* lbs = (float*)(p.ws + O_LBS);
  for (int c = gtid; c < 512; c += gthreads) {
    float l0 = p.lb_logits[c], l1 = p.lb_logits[512 + c], l2 = p.lb_logits[1024 + c], l3 = p.lb_logits[1536 + c];
    float m = fmaxf(fmaxf(l0, l1), fmaxf(l2, l3));
    float e0 = expf(l0 - m), e1 = expf(l1 - m), e2 = expf(l2 - m), e3 = expf(l3 - m);
    float inv = 1.f / (e0 + e1 + e2 + e3);
    lbs[c] = 0.f; lbs[512 + c] = e1 * inv; lbs[1024 + c] = (e1 + e2) * inv; lbs[1536 + c] = (e1 + e2 + e3) * inv;
  }
}

DI void gemm_core(const uint4* __restrict__ A, int mt0, const uint4* __restrict__ B, int nt0, int KS,
                  f32x16 (&acc)[2][2], uint4* lds) {
  const int tid = vtid(), lane = tid & 63, w = tid >> 6, wm = w >> 1, wn = w & 1;
  const int nk = KS >> 2;
  const uint4* sp[6];
#pragma unroll
  for (int r = 0; r < 6; ++r) {
    int u = tid + 512 * r;
    if (u < 2048) sp[r] = A + ((size_t)(mt0 + (u >> 8)) * KS) * 64 + (u & 255);
    else { int u2 = u - 2048; sp[r] = B + ((size_t)(nt0 + (u2 >> 8)) * KS) * 64 + (u2 & 255); }
  }
#pragma unroll
  for (int r = 0; r < 6; ++r)
    __builtin_amdgcn_global_load_lds((const unsigned*)sp[r], (unsigned*)(lds + tid + 512 * r), 16, 0, 0);
  if (nk > 1) {
#pragma unroll
    for (int r = 0; r < 6; ++r)
      __builtin_amdgcn_global_load_lds((const unsigned*)(sp[r] + 256), (unsigned*)(lds + 3072 + tid + 512 * r), 16, 0, 0);
  }
  int cb = 0;
  for (int kt = 0; kt < nk; ++kt) {
    if (kt + 1 < nk) asm volatile("s_waitcnt vmcnt(6)" ::: "memory");
    else asm volatile("s_waitcnt vmcnt(0)" ::: "memory");
    __builtin_amdgcn_s_barrier();
    asm volatile("" ::: "memory");
    if (kt + 2 < nk) {
      int nb2 = cb + 2; if (nb2 >= 3) nb2 -= 3;
      uint4* nxt = lds + nb2 * 3072;
#pragma unroll
      for (int r = 0; r < 6; ++r)
        __builtin_amdgcn_global_load_lds((const unsigned*)(sp[r] + (size_t)(kt + 2) * 256), (unsigned*)(nxt + tid + 512 * r), 16, 0, 0);
    }
    const uint4* cur = lds + cb * 3072;
#pragma unroll
    for (int ks = 0; ks < 4; ++ks) {
      bf16x8 a0 = __builtin_bit_cast(bf16x8, cur[(2 * wm + 0) * 256 + ks * 64 + lane]);
      bf16x8 a1 = __builtin_bit_cast(bf16x8, cur[(2 * wm + 1) * 256 + ks * 64 + lane]);
      bf16x8 b0 = __builtin_bit_cast(bf16x8, cur[2048 + (2 * wn + 0) * 256 + ks * 64 + lane]);
      bf16x8 b1 = __builtin_bit_cast(bf16x8, cur[2048 + (2 * wn + 1) * 256 + ks * 64 + lane]);
      acc[0][0] = MFMA(a0, b0, acc[0][0]);
      acc[0][1] = MFMA(a0, b1, acc[0][1]);
      acc[1][0] = MFMA(a1, b0, acc[1][0]);
      acc[1][1] = MFMA(a1, b1, acc[1][1]);
    }
    cb = (cb == 2) ? 0 : cb + 1;
  }
  __syncthreads();
}

DI void zero_acc(f32x16 (&acc)[2][2]) {
#pragma unroll
  for (int i = 0; i < 2; ++i)
#pragma unroll
    for (int j = 0; j < 2; ++j)
#pragma unroll
      for (int r = 0; r < 16; ++r) acc[i][j][r] = 0.f;
}

typedef __attribute__((ext_vector_type(4))) float f32x4g;
DI int g8_lds_byte(int r, int c) {
  int st = (r >> 4) * 2 + (c >> 5), rr = r & 15, cc = c & 31, ob = rr * 64 + cc * 2;
  return st * 1024 + (ob ^ (((ob >> 9) & 1) << 5));
}
DI void g8_stage_rc(int b, int& R, int& C) {
  int st = b / 1024, sb = b % 1024, swz = sb ^ (((sb >> 9) & 1) << 5);
  R = (st >> 1) * 16 + swz / 64; C = (st & 1) * 32 + (swz % 64) / 2;
}
DI void gemm8p(const unsigned short* __restrict__ A, const unsigned short* __restrict__ Bt, const int K, const int brow, const int bcol,
               f32x4g (&acc)[2][2][4][2], unsigned short* shm) {
  constexpr int BK = 64, HALF = 128, HT = HALF * BK;
  const int tidx = vtid();
  #define G8_SA(b,h) (shm+((b)*2+(h))*HT)
  #define G8_SB(b,h) (shm+(4+(b)*2+(h))*HT)
  int g8vo[2];
  { int r_, c_; g8_stage_rc(tidx * 16, r_, c_); g8vo[0] = (r_ * K + c_) * 2; g8_stage_rc(tidx * 16 + 8192, r_, c_); g8vo[1] = (r_ * K + c_) * 2; }
  const __amdgpu_buffer_rsrc_t g8rA = __builtin_amdgcn_make_buffer_rsrc((void*)A, 0, 16384 * 1024 * 2, 0x00020000);
  const __amdgpu_buffer_rsrc_t g8rBt = __builtin_amdgcn_make_buffer_rsrc((void*)Bt, 0, 6912 * 1024 * 2, 0x00020000);
  #define G8_STAGE(P,BASE,br,kt) do{ const int _so = ((br) * K + (kt) * BK) * 2; \
    for(int _i=0;_i<2;++_i){ \
      __builtin_amdgcn_raw_ptr_buffer_load_lds(g8r##BASE, (__attribute__((address_space(3))) void*)((char*)(P)+tidx*16+_i*8192), 16, g8vo[_i], _so, 0, 0);}}while(0)
  #define G8_LDA(dst,b,h) for(int m=0;m<4;++m)for(int k=0;k<2;++k) \
    dst[m][k]=*reinterpret_cast<const bf16x8*>((char*)G8_SA(b,h)+g8_lds_byte(wr*64+m*16+fr,k*32+fq*8))
  #define G8_LDB(dst,b,h) for(int n=0;n<2;++n)for(int k=0;k<2;++k) \
    dst[n][k]=*reinterpret_cast<const bf16x8*>((char*)G8_SB(b,h)+g8_lds_byte(wc*32+n*16+fr,k*32+fq*8))
  #define G8_MMA(ai,bj,At,Bt_) do{__builtin_amdgcn_s_setprio(1); \
    for(int m=0;m<4;++m)for(int n=0;n<2;++n)for(int k=0;k<2;++k) \
      acc[ai][bj][m][n]=__builtin_amdgcn_mfma_f32_16x16x32_bf16(At[m][k],Bt_[n][k],acc[ai][bj][m][n],0,0,0); \
    __builtin_amdgcn_s_setprio(0);}while(0)
  #define G8_WV(n) asm volatile("s_waitcnt vmcnt(" #n ")":::"memory")
  #define G8_WL(n) asm volatile("s_waitcnt lgkmcnt(" #n ")":::"memory")
  #define G8_BAR __builtin_amdgcn_s_barrier()
  #define G8_SCHED __builtin_amdgcn_sched_barrier(0)
  const int wid = tidx >> 6, lane = tidx & 63, wr = wid >> 2, wc = wid & 3, fr = lane & 15, fq = lane >> 4;
  bf16x8 At[4][2], B0[2][2], B1[2][2];
  const int nt = K / BK;
  G8_STAGE(G8_SB(0,0),Bt,bcol,0); G8_STAGE(G8_SA(0,0),A,brow,0);
  G8_STAGE(G8_SB(0,1),Bt,bcol+HALF,0); G8_STAGE(G8_SA(0,1),A,brow+HALF,0);
  if(wr==1)G8_BAR;
  G8_WV(4); G8_BAR;
  G8_STAGE(G8_SB(1,0),Bt,bcol,1); G8_STAGE(G8_SA(1,0),A,brow,1); G8_STAGE(G8_SB(1,1),Bt,bcol+HALF,1);
  G8_WV(6); G8_BAR;
  for(int t=0;t<nt-2;t+=2){
    G8_LDB(B0,0,0); G8_SCHED; G8_LDA(At,0,0); G8_STAGE(G8_SA(1,1),A,brow+HALF,t+1);
    G8_WL(8); G8_BAR; G8_WL(0); G8_MMA(0,0,At,B0); G8_BAR; G8_SCHED;
    G8_LDB(B1,0,1); G8_STAGE(G8_SB(0,0),Bt,bcol,t+2);
    G8_BAR; G8_WL(0); G8_MMA(0,1,At,B1); G8_BAR;
    G8_LDA(At,0,1); G8_STAGE(G8_SA(0,0),A,brow,t+2);
    G8_BAR; G8_WL(0); G8_MMA(1,0,At,B0); G8_BAR; G8_SCHED;
    G8_STAGE(G8_SB(0,1),Bt,bcol+HALF,t+2);
    G8_WV(6); G8_BAR; G8_MMA(1,1,At,B1); G8_BAR;
    G8_LDB(B0,1,0); G8_SCHED; G8_LDA(At,1,0); G8_STAGE(G8_SA(0,1),A,brow+HALF,t+2);
    G8_WL(8); G8_BAR; G8_WL(0); G8_MMA(0,0,At,B0); G8_BAR; G8_SCHED;
    G8_LDB(B1,1,1); G8_STAGE(G8_SB(1,0),Bt,bcol,t+3);
    G8_BAR; G8_WL(0); G8_MMA(0,1,At,B1); G8_BAR;
    G8_LDA(At,1,1); G8_STAGE(G8_SA(1,0),A,brow,t+3);
    G8_BAR; G8_WL(0); G8_MMA(1,0,At,B0); G8_BAR; G8_SCHED;
    G8_STAGE(G8_SB(1,1),Bt,bcol+HALF,t+3);
    G8_WV(6); G8_BAR; G8_MMA(1,1,At,B1); G8_BAR;
  }
  { G8_LDB(B0,0,0); G8_LDA(At,0,0); G8_STAGE(G8_SA(1,1),A,brow+HALF,nt-1);
    G8_BAR; G8_WL(0); G8_MMA(0,0,At,B0); G8_BAR;
    G8_LDB(B1,0,1); G8_BAR; G8_WL(0); G8_MMA(0,1,At,B1); G8_BAR;
    G8_LDA(At,0,1); G8_WV(4); G8_BAR; G8_WL(0); G8_MMA(1,0,At,B0); G8_MMA(1,1,At,B1); G8_BAR; }
  { G8_LDB(B0,1,0); G8_LDA(At,1,0); G8_WV(2); G8_BAR; G8_WL(0); G8_MMA(0,0,At,B0); G8_BAR;
    G8_LDB(B1,1,1); G8_WV(0); G8_BAR; G8_WL(0); G8_MMA(0,1,At,B1); G8_BAR;
    G8_LDA(At,1,1); G8_BAR; G8_WL(0); G8_MMA(1,0,At,B0); G8_MMA(1,1,At,B1); G8_BAR; }
  if(wr==0)G8_BAR;
  __syncthreads();
}

DI void p1_tile(const Params& p, int layer, int mb, int nt) {
  const int tid = vtid(), lane = tid & 63, w = tid >> 6, wm = w >> 1, wn = w & 1, hi = lane >> 5, c31 = lane & 31;
  f32x16 acc[2][2];
  zero_acc(acc);
  gemm_core((const uint4*)(p.ws + O_HB), mb * 8, (const uint4*)(p.ws + O_WTIN), nt * 4, 64, acc, (uint4*)smem);
  unsigned short* tile = (unsigned short*)smem;
  const int row0 = mb * 256;
  const float* bin = p.b_in + (size_t)layer * NIN;
  const float* lbs = (const float*)(p.ws + O_LBS) + layer * 512;
#pragma unroll
  for (int j = 0; j < 2; ++j) {
    const int col = 64 * wn + 32 * j + c31;
    const int np = nt * 128 + col;
    const int oc = colmap(np);
    const float bias = oc >= 0 ? bin[oc] : 0.f;
    float lb = 0.f;
    if (nt >= 4 && nt < 8) lb = lbs[(nt - 4) * 128 + col];
#pragma unroll
    for (int i = 0; i < 2; ++i) {
#pragma unroll
      for (int r = 0; r < 16; ++r) {
        const int row = 64 * wm + 32 * i + crow(r, hi);
        float v = acc[i][j][r] + bias;
        float o;
        if (nt < 4) o = v;
        else if (nt < 8) {
          float sg = sigm(v);
          float f = lb + (1.f - lb) * sg;
          ((float*)(p.ws + O_G))[(size_t)(row0 + row) * 512 + (nt - 4) * 128 + col] = __logf(f);
          o = (1.f - lb) * (1.f - sg);
        } else if (nt < 12) o = v;
        else if (nt < 16) o = silu(v);
        else if (nt < 20) o = v * 0.125f;
        else if (nt < 28) o = v;
        else if (nt < 32) o = silu(v);
        else if (nt < 36) o = v;
        else if (nt < 52) o = sigm(v);
        else {
          o = v;
          if (col >= 64 && col < 72)
            ((float*)(p.ws + O_WI))[(size_t)(row0 + row) * 8 + (col - 64)] = v * 0.044194173824159216f;
        }
        tile[row * 128 + col] = f2bf(o);
      }
    }
  }
  __syncthreads();
#pragma unroll
  for (int q = 0; q < 8; ++q) {
    const int u = tid + 512 * q, r = u >> 4, c8 = u & 15;
    const uint4 val = *(const uint4*)&tile[r * 128 + c8 * 8];
    const int t = row0 + r;
    if (nt >= 20 && nt < 28) {
      int w0 = __builtin_amdgcn_cvt_pk_fp8_f32(bflo(val.x), bfhi(val.x), 0, false);
      w0 = __builtin_amdgcn_cvt_pk_fp8_f32(bflo(val.y), bfhi(val.y), w0, true);
      int w1 = __builtin_amdgcn_cvt_pk_fp8_f32(bflo(val.z), bfhi(val.z), 0, false);
      w1 = __builtin_amdgcn_cvt_pk_fp8_f32(bflo(val.w), bfhi(val.w), w1, true);
      const size_t base8 = (nt < 24) ? O_KB : O_VB;
      *(uint2*)(p.ws + base8 + (size_t)t * 512 + (nt & 3) * 128 + c8 * 8) = make_uint2((unsigned)w0, (unsigned)w1);
    } else if (nt < 32) {
      size_t base;
      switch (nt >> 2) {
        case 0: base = O_QA; break; case 1: base = O_KK; break; case 2: base = O_IA; break; case 3: base = O_ZA; break;
        case 4: base = O_QB; break; case 5: base = O_KB; break; case 6: base = O_VB; break; default: base = O_ZB; break;
      }
      *(uint4*)(p.ws + base + ((size_t)t * 512 + (nt & 3) * 128 + c8 * 8) * 2) = val;
    } else if (nt < 36) {
      const int head = 2 * (nt - 32) + (c8 >> 3), d0 = (c8 & 7) * 8;
      const int item = t >> 5, tq = t & 31, mtile = tq >> 2, q4 = tq & 3;
      const int rr = (head & 3) + 4 * (q4 >> 1) + 8 * (head >> 2) + 16 * (q4 & 1);
      const int laneA = rr + 32 * ((d0 >> 3) & 1), ks = d0 >> 4;
      ((uint4*)(p.ws + O_QI))[((size_t)(item * 8 + mtile) * 4 + ks) * 64 + laneA] = val;
    } else if (nt < 44) {
      *(uint4*)(p.ws + O_SGA + ((size_t)t * 1024 + (nt - 36) * 128 + c8 * 8) * 2) = val;
    } else if (nt < 52) {
      *(uint4*)(p.ws + O_SGB + ((size_t)t * 1024 + (nt - 44) * 128 + c8 * 8) * 2) = val;
    } else {
      if (c8 < 8) {
        const int d0 = c8 * 8;
        ((uint4*)(p.ws + O_KI))[((size_t)(t >> 5) * 4 + (d0 >> 4)) * 64 + (t & 31) + 32 * ((d0 >> 3) & 1)] = val;
      }
    }
  }
  __syncthreads();
}

DI void p1_tile8(const Params& p, int layer, int mb, int nt2) {
  f32x4g acc[2][2][4][2];
#pragma unroll
  for (int a = 0; a < 2; ++a)
#pragma unroll
    for (int b = 0; b < 2; ++b)
#pragma unroll
      for (int m = 0; m < 4; ++m)
#pragma unroll
        for (int n = 0; n < 2; ++n) acc[a][b][m][n] = f32x4g{0.f, 0.f, 0.f, 0.f};
  gemm8p((const unsigned short*)(p.ws + O_HB), (const unsigned short*)(p.ws + O_WTIN), 1024, mb * 256, nt2 * 256, acc, (unsigned short*)smem);
  __builtin_amdgcn_sched_barrier(0);
  asm volatile("" ::: "memory");
  const int tid = vtid(), wid = tid >> 6, lane = tid & 63, wr = wid >> 2, wc = wid & 3, fr = lane & 15, fq = lane >> 4;
  unsigned short* tile = (unsigned short*)smem;
  const int row0 = mb * 256;
  const float* bin = p.b_in + (size_t)layer * NIN;
  const float* lbs = (const float*)(p.ws + O_LBS) + layer * 512;
#pragma unroll
  for (int bj = 0; bj < 2; ++bj) {
    const int nt = 2 * nt2 + bj;
#pragma unroll
    for (int n = 0; n < 2; ++n) {
      const int col = wc * 32 + n * 16 + fr;
      const int np = nt * 128 + col;
      const int oc = colmap(np);
      const float bias = oc >= 0 ? bin[oc] : 0.f;
      float lb = 0.f;
      if (nt >= 4 && nt < 8) lb = lbs[(nt - 4) * 128 + col];
#pragma unroll
      for (int ai = 0; ai < 2; ++ai)
#pragma unroll
        for (int m = 0; m < 4; ++m)
#pragma unroll
          for (int j = 0; j < 4; ++j) {
            const int row = ai * 128 + wr * 64 + m * 16 + fq * 4 + j;
            float v = acc[ai][bj][m][n][j] + bias;
            float o;
            if (nt < 4) o = v;
            else if (nt < 8) {
              float sg = sigm(v);
              float f = lb + (1.f - lb) * sg;
              ((float*)(p.ws + O_G))[(size_t)(row0 + row) * 512 + (nt - 4) * 128 + col] = __logf(f);
              o = (1.f - lb) * (1.f - sg);
            } else if (nt < 12) o = v;
            else if (nt < 16) o = silu(v);
            else if (nt < 20) o = v * 0.125f;
            else if (nt < 28) o = v;
            else if (nt < 32) o = silu(v);
            else if (nt < 36) o = v;
            else if (nt < 52) o = sigm(v);
            else {
              o = v;
              if (nt == 52 && col >= 64 && col < 72)
                ((float*)(p.ws + O_WI))[(size_t)(row0 + row) * 8 + (col - 64)] = v * 0.044194173824159216f;
            }
            tile[row * 256 + 128 * bj + col] = f2bf(o);
          }
    }
  }
  __syncthreads();
#pragma unroll 4
  for (int q = 0; q < 16; ++q) {
    const int u = tid + 512 * q, r = u >> 5, c32 = u & 31;
    const int ntu = 2 * nt2 + (c32 >> 4), c8 = c32 & 15;
    const uint4 val = *(const uint4*)&tile[r * 256 + c32 * 8];
    const int t = row0 + r;
    if (ntu >= 20 && ntu < 28) {
      int w0 = __builtin_amdgcn_cvt_pk_fp8_f32(bflo(val.x), bfhi(val.x), 0, false);
      w0 = __builtin_amdgcn_cvt_pk_fp8_f32(bflo(val.y), bfhi(val.y), w0, true);
      int w1 = __builtin_amdgcn_cvt_pk_fp8_f32(bflo(val.z), bfhi(val.z), 0, false);
      w1 = __builtin_amdgcn_cvt_pk_fp8_f32(bflo(val.w), bfhi(val.w), w1, true);
      const size_t base8 = (ntu < 24) ? O_KB : O_VB;
      *(uint2*)(p.ws + base8 + (size_t)t * 512 + (ntu & 3) * 128 + c8 * 8) = make_uint2((unsigned)w0, (unsigned)w1);
    } else if (ntu < 32) {
      size_t base;
      switch (ntu >> 2) {
        case 0: base = O_QA; break; case 1: base = O_KK; break; case 2: base = O_IA; break; case 3: base = O_ZA; break;
        case 4: base = O_QB; break; case 5: base = O_KB; break; case 6: base = O_VB; break; default: base = O_ZB; break;
      }
      *(uint4*)(p.ws + base + ((size_t)t * 512 + (ntu & 3) * 128 + c8 * 8) * 2) = val;
    } else if (ntu < 36) {
      const int head = 2 * (ntu - 32) + (c8 >> 3), d0 = (c8 & 7) * 8;
      const int item = t >> 5, tq = t & 31, mtile = tq >> 2, q4 = tq & 3;
      const int rr = (head & 3) + 4 * (q4 >> 1) + 8 * (head >> 2) + 16 * (q4 & 1);
      const int laneA = rr + 32 * ((d0 >> 3) & 1), ks = d0 >> 4;
      ((uint4*)(p.ws + O_QI))[((size_t)(item * 8 + mtile) * 4 + ks) * 64 + laneA] = val;
    } else if (ntu < 44) {
      *(uint4*)(p.ws + O_SGA + ((size_t)t * 1024 + (ntu - 36) * 128 + c8 * 8) * 2) = val;
    } else if (ntu < 52) {
      *(uint4*)(p.ws + O_SGB + ((size_t)t * 1024 + (ntu - 44) * 128 + c8 * 8) * 2) = val;
    } else if (ntu == 52) {
      if (c8 < 8) {
        const int d0 = c8 * 8;
        ((uint4*)(p.ws + O_KI))[((size_t)(t >> 5) * 4 + (d0 >> 4)) * 64 + (t & 31) + 32 * ((d0 >> 3) & 1)] = val;
      }
    }
  }
  __syncthreads();
}

constexpr int CAP = 1000, SEGCAP = 250, SEGTRIG = 186;
constexpr int IX_SC = 0, IX_IX = 64000, IX_RING = 96000, IX_CNT = 161536, IX_TAU = 161792, IX_FLAG = 161856, IX_WL = 161872;

DI float key2float(unsigned k) {
  unsigned b = (k & 0x80000000u) ? (k ^ 0x80000000u) : ~k;
  return __uint_as_float(b);
}
DI unsigned float2key(float f) {
  unsigned b = __float_as_uint(f);
  return (b & 0x80000000u) ? ~b : (b ^ 0x80000000u);
}
DI int wave_prefix_incl(int x) {
  int v = x;
  v += __builtin_amdgcn_update_dpp(0, v, 0x111, 0xf, 0xf, false);
  v += __builtin_amdgcn_update_dpp(0, v, 0x112, 0xf, 0xf, false);
  v += __builtin_amdgcn_update_dpp(0, v, 0x114, 0xf, 0xf, false);
  v += __builtin_amdgcn_update_dpp(0, v, 0x118, 0xf, 0xf, false);
  v += __builtin_amdgcn_update_dpp(0, v, 0x142, 0xa, 0xf, false);
  v += __builtin_amdgcn_update_dpp(0, v, 0x143, 0xc, 0xf, false);
  return v;
}

#define SEG_ADDR(j_) (((j_) >> 2) * SEGCAP + lane + 64 * ((j_) & 3))
DI int seg_count(const int4 c4, int s_) { return s_ == 0 ? c4.x : (s_ == 1 ? c4.y : (s_ == 2 ? c4.z : c4.w)); }

DI void wave_select(float* scq, unsigned short* ixq, int* cnt4q, float* tauq, unsigned* hist, int lane, unsigned short* final_sel) {
  lds_fence();
  const int4 c4 = *(const int4*)cnt4q;
  const int n = c4.x + c4.y + c4.z + c4.w;
  unsigned u[16], v16[16];
  unsigned mm = 0, am = 0;
#pragma unroll
  for (int j = 0; j < 16; ++j) {
    const bool valid = (lane + 64 * (j & 3)) < seg_count(c4, j >> 2);
    const float sv = valid ? scq[SEG_ADDR(j)] : 0.f;
    const unsigned id = valid ? (unsigned)ixq[SEG_ADDR(j)] : 0u;
    u[j] = float2key(sv);
    v16[j] = 0xFFFFu - id;
    mm |= (((unsigned)(lane + 64 * (j & 3)) - (unsigned)seg_count(c4, j >> 2)) >> 31) << j;
  }
  unsigned prefix_u = 0;
  if (n > 256) {
    int need = 256;
    int r0 = 0;
    {
      unsigned ref = 0; bool have = false;
#pragma unroll
      for (int j = 15; j >= 0; --j) if ((mm >> j) & 1u) { ref = u[j] >> 24; have = true; }
      const unsigned long long hm = __ballot(have);
      const int fl = __ffsll((long long)hm) - 1;
      ref = (unsigned)__builtin_amdgcn_readlane((int)ref, fl);
      bool same = true;
#pragma unroll
      for (int j = 0; j < 16; ++j) same = same && (!((mm >> j) & 1u) || ((u[j] >> 24) == ref));
      if (__all(same)) { prefix_u = ref << 24; r0 = 1; }
    }
    for (int r = r0; r < 6; ++r) {
      const int sh = (r < 4) ? (24 - 8 * r) : (r == 4 ? 8 : 0);
      { const unsigned z_ = vzero(); ((uint4*)hist)[lane] = make_uint4(z_, z_, z_, z_); }
      lds_fence();
#pragma unroll
      for (int j = 0; j < 16; ++j) {
        const unsigned src = (r < 4) ? u[j] : v16[j];
        const unsigned dgt = ((mm >> j) & 1u) ? ((src >> sh) & 255u) : 256u + lane;
        atomicAdd(&hist[dgt], 1u);
      }
      lds_fence();
      const uint4 hv = ((const uint4*)hist)[lane];
      const int c0 = hv.x, c1 = hv.y, c2 = hv.z, c3 = hv.w;
      const int Lsum = c0 + c1 + c2 + c3;
      const int Pfx = wave_prefix_incl(Lsum);
      const int total = __builtin_amdgcn_readlane(Pfx, 63);
      const int S = total - Pfx + Lsum;
      const unsigned long long mask = __ballot(S >= need);
      const int lstar = 63 - __clzll((long long)mask);
      int d_, ca_, cd_;
      {
        const int accu = S - Lsum;
        if (accu + c3 >= need) { d_ = 3; ca_ = accu; cd_ = c3; }
        else if (accu + c3 + c2 >= need) { d_ = 2; ca_ = accu + c3; cd_ = c2; }
        else if (accu + c3 + c2 + c1 >= need) { d_ = 1; ca_ = accu + c3 + c2; cd_ = c1; }
        else { d_ = 0; ca_ = accu + c3 + c2 + c1; cd_ = c0; }
      }
      const int D = __builtin_amdgcn_readlane(4 * lane + d_, lstar);
      const int cntAbove = __builtin_amdgcn_readlane(ca_, lstar);
      const int cntD = __builtin_amdgcn_readlane(cd_, lstar);
#pragma unroll
      for (int j = 0; j < 16; ++j) {
        const unsigned src = (r < 4) ? u[j] : v16[j];
        const int dgt = (int)((src >> sh) & 255u);
        const unsigned bit = mm & (1u << j);
        const unsigned dd = (unsigned)D - (unsigned)dgt, de = (unsigned)dgt - (unsigned)D;
        const unsigned gtm = (unsigned)((int)dd >> 31);
        const unsigned nem = (unsigned)((int)(dd | de) >> 31);
        am |= bit & gtm;
        mm ^= bit & nem;
      }
      need -= cntAbove;
      if (r < 4) prefix_u |= ((unsigned)D) << sh;
      if (cntD == need) break;
    }
  }
  const unsigned km = am | mm;
  int base = 0;
#pragma unroll
  for (int j = 0; j < 16; ++j) {
    const bool keep = (km >> j) & 1u;
    const unsigned long long m = __ballot(keep);
    const int rk = base + __popcll(m & ((1ull << lane) - 1ull));
    if (keep) {
      if (final_sel) { if (rk < 256) final_sel[rk] = (unsigned short)(0xFFFFu - v16[j]); }
      else { const int ad = (rk & 3) * SEGCAP + (rk >> 2); scq[ad] = key2float(u[j]); ixq[ad] = (unsigned short)(0xFFFFu - v16[j]); }
    }
    base += __popcll(m);
  }
  if (!final_sel && lane == 0) {
    *(int4*)cnt4q = make_int4((base + 3) >> 2, (base + 2) >> 2, (base + 1) >> 2, base >> 2);
    if (n > 256) *tauq = key2float(prefix_u);
  }
  lds_fence();
}

typedef float f32x2v __attribute__((ext_vector_type(2)));
DI float relu_(float x) { int i = __float_as_int(x); i = i > 0 ? i : 0; return __int_as_float(i); }

DI unsigned wave_umin(unsigned v) {
#define UMIN_STEP(ctrl, rm) { const unsigned o_ = (unsigned)__builtin_amdgcn_update_dpp((int)0xFFFFFFFFu, (int)v, ctrl, rm, 0xf, false); v = o_ < v ? o_ : v; }
  UMIN_STEP(0x111, 0xf) UMIN_STEP(0x112, 0xf) UMIN_STEP(0x114, 0xf) UMIN_STEP(0x118, 0xf) UMIN_STEP(0x142, 0xa) UMIN_STEP(0x143, 0xc)
#undef UMIN_STEP
  return (unsigned)__builtin_amdgcn_readlane((int)v, 63);
}
DI unsigned wave_umax(unsigned v) {
#define UMAX_STEP(ctrl, rm) { const unsigned o_ = (unsigned)__builtin_amdgcn_update_dpp(0, (int)v, ctrl, rm, 0xf, false); v = o_ > v ? o_ : v; }
  UMAX_STEP(0x111, 0xf) UMAX_STEP(0x112, 0xf) UMAX_STEP(0x114, 0xf) UMAX_STEP(0x118, 0xf) UMAX_STEP(0x142, 0xa) UMAX_STEP(0x143, 0xc)
#undef UMAX_STEP
  return (unsigned)__builtin_amdgcn_readlane((int)v, 63);
}
DI void wave_compact(float* scq, unsigned short* ixq, int* cnt4q, float* tauq, unsigned* hist, int lane) {
  lds_fence();
  const int4 c4 = *(const int4*)cnt4q;
  const int n = c4.x + c4.y + c4.z + c4.w;
  if (n <= 320) return;
  unsigned u[16], idv[16];
  unsigned vm = 0;
  unsigned umin = 0xFFFFFFFFu, umax = 0u;
  { const unsigned z_ = vzero(); ((uint4*)hist)[lane] = make_uint4(z_, z_, z_, z_); }

#pragma unroll
  for (int j = 0; j < 16; ++j) {
    const bool valid = (lane + 64 * (j & 3)) < seg_count(c4, j >> 2);
    u[j] = valid ? float2key(scq[SEG_ADDR(j)]) : 0u;
    idv[j] = valid ? (unsigned)ixq[SEG_ADDR(j)] : 0u;
    vm |= (((unsigned)(lane + 64 * (j & 3)) - (unsigned)seg_count(c4, j >> 2)) >> 31) << j;
    umin = valid ? (u[j] < umin ? u[j] : umin) : umin;
    umax = valid ? (u[j] > umax ? u[j] : umax) : umax;
  }
  umin = wave_umin(umin);
  umax = wave_umax(umax);
  const unsigned range = umax - umin;
  const int sh = range < 256u ? 0 : (24 - __clz((int)range));
#pragma unroll
  for (int j = 0; j < 16; ++j) {
    const unsigned bin = ((vm >> j) & 1u) ? ((u[j] - umin) >> sh) : 256u + lane;
    atomicAdd(&hist[bin], 1u);
  }
  lds_fence();
  const uint4 hv = ((const uint4*)hist)[lane];
  const int c0 = hv.x, c1 = hv.y, c2 = hv.z, c3 = hv.w;
  const int Lsum = c0 + c1 + c2 + c3;
  const int Pfx = wave_prefix_incl(Lsum);
  const int total = __builtin_amdgcn_readlane(Pfx, 63);
  const int S = total - Pfx + Lsum;
  const unsigned long long mask = __ballot(S >= 256);
  const int lstar = 63 - __clzll((long long)mask);
  int d_, kept_;
  {
    const int accu = S - Lsum;
    if (accu + c3 >= 256) { d_ = 3; kept_ = accu + c3; }
    else if (accu + c3 + c2 >= 256) { d_ = 2; kept_ = accu + c3 + c2; }
    else if (accu + c3 + c2 + c1 >= 256) { d_ = 1; kept_ = accu + c3 + c2 + c1; }
    else { d_ = 0; kept_ = accu + Lsum; }
  }
  const int D = __builtin_amdgcn_readlane(4 * lane + d_, lstar);
  const int kept = __builtin_amdgcn_readlane(kept_, lstar);
  if (kept > 400) return;
  int base = 0;
#pragma unroll
  for (int j = 0; j < 16; ++j) {
    const bool keep = ((vm >> j) & 1u) && ((int)((u[j] - umin) >> sh) >= D);
    const unsigned long long m = __ballot(keep);
    const int rk = base + __popcll(m & ((1ull << lane) - 1ull));
    if (keep) { const int ad = (rk & 3) * SEGCAP + (rk >> 2); scq[ad] = key2float(u[j]); ixq[ad] = (unsigned short)idv[j]; }
    base += __popcll(m);
  }
  if (lane == 0) {
    *(int4*)cnt4q = make_int4((base + 3) >> 2, (base + 2) >> 2, (base + 1) >> 2, base >> 2);
    *tauq = key2float(umin + ((unsigned)D << sh));
  }
  lds_fence();
}

#define IDX_GLDS(step, bufi) do { _Pragma("unroll") for (int r_ = 0; r_ < 4; ++r_) \
    __builtin_amdgcn_global_load_lds((const unsigned*)(ki + (size_t)(step) * 2048 + tid + 512 * r_), \
                                     (unsigned*)(ring + (bufi) * 2048 + tid + 512 * r_), 16, 0, 0); } while (0)

DI void indexer_item(const Params& p, int item) {
  const int tid = vtid(), lane = tid & 63, w = tid >> 6, g = w & 1, kg = w >> 1, hi = lane >> 5, c31 = lane & 31;
  float* sc = (float*)(smem + IX_SC);
  unsigned short* ix = (unsigned short*)(smem + IX_IX);
  uint4* ring = (uint4*)(smem + IX_RING);
  int* cnt = (int*)(smem + IX_CNT);
  volatile int* flag = (volatile int*)(smem + IX_FLAG);
  float* tauv = (float*)(smem + IX_TAU);
  const uint4* qi = (const uint4*)(p.ws + O_QI);
  const uint4* ki = (const uint4*)(p.ws + O_KI);
  const float* wi = (const float*)(p.ws + O_WI);
  const int t0 = 16 * item;
  bf16x8 a[2][4];
#pragma unroll
  for (int mt = 0; mt < 2; ++mt)
#pragma unroll
    for (int ks = 0; ks < 4; ++ks)
      a[mt][ks] = __builtin_bit_cast(bf16x8, qi[((size_t)((item >> 1) * 8 + (item & 1) * 4 + 2 * g + mt) * 4 + ks) * 64 + lane]);
  float* wl = (float*)(smem + IX_WL);
  if (tid < 128) wl[tid] = wi[(size_t)t0 * 8 + tid];
  float tau[2][2];
#pragma unroll
  for (int mt = 0; mt < 2; ++mt) { tau[mt][0] = -INFINITY; tau[mt][1] = -INFINITY; }
  if (tid < 64) cnt[tid] = 0;
  if (tid < 16) tauv[tid] = -INFINITY;
  int cntv[2][2] = {{0, 0}, {0, 0}};
  if (tid < 2) flag[tid] = 0;
  const int nsteps = (t0 + 16 + 255) >> 8;
  asm volatile("s_waitcnt vmcnt(0)" ::: "memory");
  IDX_GLDS(0, 0);
  if (nsteps > 1) { IDX_GLDS(1, 1); asm volatile("s_waitcnt vmcnt(4)" ::: "memory"); }
  else asm volatile("s_waitcnt vmcnt(0)" ::: "memory");
  __syncthreads();
  const f32x16 z = {0.f, 0.f, 0.f, 0.f, 0.f, 0.f, 0.f, 0.f, 0.f, 0.f, 0.f, 0.f, 0.f, 0.f, 0.f, 0.f};
  f32x16 Ca0, Ca1, Cb0, Cb1;
  {
    const uint4* cur = ring;
    const uint4* bp = cur + ((2 * kg + 0) * 4) * 64 + lane;
    bf16x8 b0 = __builtin_bit_cast(bf16x8, bp[0]), b1 = __builtin_bit_cast(bf16x8, bp[64]);
    bf16x8 b2 = __builtin_bit_cast(bf16x8, bp[128]), b3 = __builtin_bit_cast(bf16x8, bp[192]);
    Ca0 = MFMA(a[0][0], b0, z); Ca1 = MFMA(a[1][0], b0, z);
    Ca0 = MFMA(a[0][1], b1, Ca0); Ca1 = MFMA(a[1][1], b1, Ca1);
    Ca0 = MFMA(a[0][2], b2, Ca0); Ca1 = MFMA(a[1][2], b2, Ca1);
    Ca0 = MFMA(a[0][3], b3, Ca0); Ca1 = MFMA(a[1][3], b3, Ca1);
  }
#define IDX_SCORE(Cx, mt_, aa_, sout) do { const float4 wa_ = *(const float4*)(wl + (8 * g + 4 * (mt_) + 2 * hi + (aa_)) * 8); \
    const float4 wb_ = *(const float4*)(wl + (8 * g + 4 * (mt_) + 2 * hi + (aa_)) * 8 + 4); \
    f32x2v r0_ = {relu_(Cx[8 * (aa_) + 0]), relu_(Cx[8 * (aa_) + 1])}, r1_ = {relu_(Cx[8 * (aa_) + 2]), relu_(Cx[8 * (aa_) + 3])}; \
    f32x2v r2_ = {relu_(Cx[8 * (aa_) + 4]), relu_(Cx[8 * (aa_) + 5])}, r3_ = {relu_(Cx[8 * (aa_) + 6]), relu_(Cx[8 * (aa_) + 7])}; \
    const f32x2v w0_ = {wa_.x, wa_.y}, w1_ = {wa_.z, wa_.w}, w2_ = {wb_.x, wb_.y}, w3_ = {wb_.z, wb_.w}; \
    f32x2v ac_ = r0_ * w0_; ac_ = r1_ * w1_ + ac_; ac_ = r2_ * w2_ + ac_; ac_ = r3_ * w3_ + ac_; \
    sout = ac_.x + ac_.y; } while (0)
  const unsigned ltm = (1u << c31) - 1u;
  const int tqb = t0 + 8 * g + 2 * hi;
  const int sb0 = ((8 * g + 2 * hi) * CAP + kg * SEGCAP) * 4;
#define IDX_APPEND(sval, mt_, aa_, keyv) do { \
    const bool pr_ = ((keyv) <= tqb + 4 * (mt_) + (aa_)) && ((sval) >= tau[mt_][aa_]); \
    const unsigned long long bm_ = __builtin_amdgcn_ballot_w64(pr_); \
    const unsigned half_ = hi ? (unsigned)(bm_ >> 32) : (unsigned)bm_; \
    const int pos_ = cntv[mt_][aa_] + __popc(half_ & ltm); \
    if (pr_) { const int bo_ = sb0 + (4 * (mt_) + (aa_)) * CAP * 4 + pos_ * 4; \
      *(float*)((char*)sc + bo_) = (sval); *(unsigned short*)((char*)ix + (bo_ >> 1)) = (unsigned short)(keyv); } \
    cntv[mt_][aa_] += __popc(half_); } while (0)
#define IDX_PUBLISH() do { if (c31 == 0) { _Pragma("unroll") for (int mt_ = 0; mt_ < 2; ++mt_) _Pragma("unroll") for (int aa_ = 0; aa_ < 2; ++aa_) \
    cnt[4 * (8 * g + 4 * mt_ + 2 * hi + aa_) + kg] = cntv[mt_][aa_]; } } while (0)
  for (int j = 0; j < nsteps; ++j) {
    const uint4* cur = ring + (j & 1) * 2048;
    {
      const uint4* bp = cur + ((2 * kg + 1) * 4) * 64 + lane;
      bf16x8 b0 = __builtin_bit_cast(bf16x8, bp[0]), b1 = __builtin_bit_cast(bf16x8, bp[64]);
      bf16x8 b2 = __builtin_bit_cast(bf16x8, bp[128]), b3 = __builtin_bit_cast(bf16x8, bp[192]);
      Cb0 = MFMA(a[0][0], b0, z); Cb1 = MFMA(a[1][0], b0, z);
      Cb0 = MFMA(a[0][1], b1, Cb0); Cb1 = MFMA(a[1][1], b1, Cb1);
      Cb0 = MFMA(a[0][2], b2, Cb0); Cb1 = MFMA(a[1][2], b2, Cb1);
      Cb0 = MFMA(a[0][3], b3, Cb0); Cb1 = MFMA(a[1][3], b3, Cb1);
    }
    {
      const int key = 256 * j + 64 * kg + c31;
      float s00, s01, s10, s11;
      IDX_SCORE(Ca0, 0, 0, s00); IDX_SCORE(Ca0, 0, 1, s01); IDX_SCORE(Ca1, 1, 0, s10); IDX_SCORE(Ca1, 1, 1, s11);
#pragma unroll
      for (int q_ = 0; q_ < 8; ++q_) { __builtin_amdgcn_sched_group_barrier(0x008, 1, 0); __builtin_amdgcn_sched_group_barrier(0x002, 9, 0); }
      IDX_APPEND(s00, 0, 0, key); IDX_APPEND(s01, 0, 1, key); IDX_APPEND(s10, 1, 0, key); IDX_APPEND(s11, 1, 1, key);
    }
    IDX_PUBLISH();
    {
      const int mxc = max(max(cntv[0][0], cntv[0][1]), max(cntv[1][0], cntv[1][1]));
      if (__ballot(mxc > SEGTRIG) != 0ull) { if (lane == 0) flag[j & 1] = j + 1; }
    }
    __syncthreads();
    if (flag[j & 1] == j + 1) {
      unsigned* hist = (unsigned*)(ring + (j & 1) * 2048) + w * 512;
#pragma unroll 1
      for (int k = 0; k < 2; ++k) {
        const int q = 2 * w + k;
        wave_compact(sc + q * CAP, ix + q * CAP, cnt + 4 * q, tauv + q, hist, lane);
        lds_fence();
        { const int4 cc = *(const int4*)(cnt + 4 * q); if (cc.x + cc.y + cc.z + cc.w > 400) wave_select(sc + q * CAP, ix + q * CAP, cnt + 4 * q, tauv + q, hist, lane, nullptr); }
      }
      __syncthreads();
#pragma unroll
      for (int mt = 0; mt < 2; ++mt)
#pragma unroll
        for (int aa = 0; aa < 2; ++aa) { const int ql = 8 * g + 4 * mt + 2 * hi + aa; tau[mt][aa] = tauv[ql]; cntv[mt][aa] = cnt[4 * ql + kg]; }
    }
    if (j + 2 < nsteps) IDX_GLDS(j + 2, j & 1);
    if (j + 1 < nsteps) {
      const uint4* nxt = ring + ((j + 1) & 1) * 2048;
      const uint4* bp = nxt + ((2 * kg + 0) * 4) * 64 + lane;
      bf16x8 b0 = __builtin_bit_cast(bf16x8, bp[0]), b1 = __builtin_bit_cast(bf16x8, bp[64]);
      bf16x8 b2 = __builtin_bit_cast(bf16x8, bp[128]), b3 = __builtin_bit_cast(bf16x8, bp[192]);
      Ca0 = MFMA(a[0][0], b0, z); Ca1 = MFMA(a[1][0], b0, z);
      Ca0 = MFMA(a[0][1], b1, Ca0); Ca1 = MFMA(a[1][1], b1, Ca1);
      Ca0 = MFMA(a[0][2], b2, Ca0); Ca1 = MFMA(a[1][2], b2, Ca1);
      Ca0 = MFMA(a[0][3], b3, Ca0); Ca1 = MFMA(a[1][3], b3, Ca1);
    }
    {
      const int key = 256 * j + 64 * kg + 32 + c31;
      float s00, s01, s10, s11;
      IDX_SCORE(Cb0, 0, 0, s00); IDX_SCORE(Cb0, 0, 1, s01); IDX_SCORE(Cb1, 1, 0, s10); IDX_SCORE(Cb1, 1, 1, s11);
#pragma unroll
      for (int q_ = 0; q_ < 8; ++q_) { __builtin_amdgcn_sched_group_barrier(0x008, 1, 0); __builtin_amdgcn_sched_group_barrier(0x002, 9, 0); }
      IDX_APPEND(s00, 0, 0, key); IDX_APPEND(s01, 0, 1, key); IDX_APPEND(s10, 1, 0, key); IDX_APPEND(s11, 1, 1, key);
    }
  }
  IDX_PUBLISH();
  __syncthreads();
  unsigned short* sel = (unsigned short*)(p.ws + O_SEL);
  unsigned* hist = (unsigned*)ring + w * 512;
#pragma unroll 1
  for (int k = 0; k < 2; ++k) {
    const int q = 2 * w + k;
    wave_select(sc + q * CAP, ix + q * CAP, cnt + 4 * q, tauv + q, hist, lane, sel + (size_t)(t0 + q) * 256);
  }
  __syncthreads();
}

DI void hgrn_a_item(const Params& p, int c, int h) {
  const int tid = vtid(), lane = tid & 63, w = tid >> 6, hi = lane >> 5, c31 = lane & 31;
  float* tot = (float*)smem;
  unsigned short* kT = (unsigned short*)(smem + 2048);
  unsigned short* vT = (unsigned short*)(smem + 2048 + 18432);
  const int seg = tid >> 7, k = tid & 127;
  const float* G = (const float*)(p.ws + O_G);
  const unsigned short* KK = (const unsigned short*)(p.ws + O_KK);
  const unsigned short* IA = (const unsigned short*)(p.ws + O_IA);
  const size_t rowbase = (size_t)(64 * c + 16 * seg);
  float b[16];
  {
    float run = 0.f;
#pragma unroll
    for (int i = 0; i < 16; ++i) { run += G[(rowbase + i) * 512 + 128 * h + k]; b[i] = run; }
    tot[seg * 128 + k] = run;
  }
  __syncthreads();
  float off = 0.f, blast = 0.f;
#pragma unroll
  for (int s2 = 0; s2 < 4; ++s2) { float tv = tot[s2 * 128 + k]; if (s2 < seg) off += tv; blast += tv; }
  {
    unsigned pk[8], pv[8];
#pragma unroll
    for (int i = 0; i < 16; i += 2) {
      float k0 = bf2f(KK[(rowbase + i) * 512 + 128 * h + k]) * __expf(blast - (b[i] + off));
      float k1 = bf2f(KK[(rowbase + i + 1) * 512 + 128 * h + k]) * __expf(blast - (b[i + 1] + off));
      pk[i >> 1] = cvtpk(k0, k1);
      unsigned v0 = IA[(rowbase + i) * 512 + 128 * h + k], v1 = IA[(rowbase + i + 1) * 512 + 128 * h + k];
      pv[i >> 1] = v0 | (v1 << 16);
    }
    uint4* dk = (uint4*)(kT + k * 72 + 16 * seg);
    dk[0] = make_uint4(pk[0], pk[1], pk[2], pk[3]); dk[1] = make_uint4(pk[4], pk[5], pk[6], pk[7]);
    uint4* dv = (uint4*)(vT + k * 72 + 16 * seg);
    dv[0] = make_uint4(pv[0], pv[1], pv[2], pv[3]); dv[1] = make_uint4(pv[4], pv[5], pv[6], pv[7]);
    if (seg == 0) ((float*)(p.ws + O_D))[(size_t)(c * 4 + h) * 128 + k] = __expf(blast);
  }
  __syncthreads();
  const int mt = w >> 1;
  f32x16 acc[2];
#pragma unroll
  for (int r = 0; r < 16; ++r) { acc[0][r] = 0.f; acc[1][r] = 0.f; }
#pragma unroll
  for (int ks = 0; ks < 4; ++ks) {
    bf16x8 af = __builtin_bit_cast(bf16x8, *(const uint4*)(kT + (32 * mt + c31) * 72 + 16 * ks + 8 * hi));
#pragma unroll
    for (int jn = 0; jn < 2; ++jn) {
      const int nt = 2 * (w & 1) + jn;
      bf16x8 bfv = __builtin_bit_cast(bf16x8, *(const uint4*)(vT + (32 * nt + c31) * 72 + 16 * ks + 8 * hi));
      acc[jn] = MFMA(af, bfv, acc[jn]);
    }
  }
  char* us = p.ws + O_US + (size_t)(c * 4 + h) * 32768;
#pragma unroll
  for (int jn = 0; jn < 2; ++jn) {
    const int nt = 2 * (w & 1) + jn;
    const int v = 32 * nt + c31;
#pragma unroll
    for (int gq = 0; gq < 4; ++gq) {
      const int k0 = 32 * mt + 8 * gq;
      const size_t unit = ((size_t)(v >> 5) * 8 + (k0 >> 4)) * 64 + (v & 31) + 32 * ((k0 >> 3) & 1);
      uint2 val;
      val.x = cvtpk(acc[jn][4 * gq + 0], acc[jn][4 * gq + 1]);
      val.y = cvtpk(acc[jn][4 * gq + 2], acc[jn][4 * gq + 3]);
      *(uint2*)(us + unit * 16 + 8 * hi) = val;
    }
  }
  __syncthreads();
}

DI void hgrn_scan(const Params& p) {
  const int tid = vtid();
  if (tid >= 128) return;
  for (int pid = blockIdx.x * 128 + tid; pid < 32768; pid += gridDim.x * 128) {
    const int q4 = pid & 3, unit = (pid >> 2) & 2047, h = pid >> 13;
    const int lanep = unit & 63, ks = (unit >> 6) & 7;
    const int k = ks * 16 + 8 * (lanep >> 5) + 2 * q4;
    unsigned* us = (unsigned*)(p.ws + O_US) + (size_t)h * 8192 + unit * 4 + q4;
    const float* dd = (const float*)(p.ws + O_D) + h * 128 + k;
    float s0 = 0.f, s1 = 0.f;
    for (int c0 = 0; c0 < 256; c0 += 16) {
      unsigned uv[16];
      float2 dv[16];
#pragma unroll
      for (int i = 0; i < 16; ++i) {
        uv[i] = us[(size_t)(c0 + i) * 32768];
        dv[i] = *(const float2*)(dd + (size_t)(c0 + i) * 512);
      }
#pragma unroll
      for (int i = 0; i < 16; ++i) {
        us[(size_t)(c0 + i) * 32768] = cvtpk(s0, s1);
        s0 = fmaf(dv[i].x, s0, bflo(uv[i]));
        s1 = fmaf(dv[i].y, s1, bfhi(uv[i]));
      }
    }
  }
}

constexpr int AT_LUT = 0, AT_RB = 512, AT_WAVE = 2048, AT_WSZ = 8192 + 1024 + 16 * 528;
DI void attn_setup() {
  const int tid = vtid();
  int* lut = (int*)(smem + AT_LUT);
  if (tid < 128) {
    int d = tid;
    int bk;
    if (d < 16) bk = d;
    else {
      float df = (float)d;
      int lg = 16 + (int)(logf(df / 16.f) / 2.0794415416798357f * 16.f);
      bk = lg < 31 ? lg : 31;
    }
    lut[tid] = bk;
  }
}
DI float dppf(float v, int ctrl_sel) {
  const int iv = __builtin_bit_cast(int, v);
  int r;
  if (ctrl_sel == 0) r = __builtin_amdgcn_update_dpp(0, iv, 0xB1, 0xf, 0xf, false);
  else if (ctrl_sel == 1) r = __builtin_amdgcn_update_dpp(0, iv, 0x4E, 0xf, 0xf, false);
  else r = __builtin_amdgcn_update_dpp(0, iv, 0x141, 0xf, 0xf, false);
  return __builtin_bit_cast(float, r);
}
DI float sum8(float v) { v += dppf(v, 0); v += dppf(v, 1); v += dppf(v, 2); return v; }
DI float max8(float v) { v = fmaxf(v, dppf(v, 0)); v = fmaxf(v, dppf(v, 1)); v = fmaxf(v, dppf(v, 2)); return v; }

DI size_t prob_off(int t) {
  return t < 8192 ? O_MG + (size_t)t * 4096 : (t < 12288 ? O_AA + (size_t)(t - 8192) * 4096 : O_QI + (size_t)(t - 12288) * 4096);
}
#define MFMA8S(a, b, c) __builtin_amdgcn_mfma_f32_16x16x32_fp8_fp8((a), (b), (c), 0, 0, 0)
typedef __attribute__((ext_vector_type(4))) float f32x4v;
constexpr int AT_KROW = 528;
struct QKPF { int s0, s1, s2, s3; uint4 q0, q1; };
DI void qk_fetch(const Params& p, int t, int lane, QKPF& f) {
  const int nsel = t + 1 < 256 ? t + 1 : 256;
  const unsigned short* sel = (const unsigned short*)(p.ws + O_SEL) + (size_t)t * 256;
  f.s0 = lane < nsel ? (int)sel[lane] : 0; f.s1 = lane + 64 < nsel ? (int)sel[lane + 64] : 0;
  f.s2 = lane + 128 < nsel ? (int)sel[lane + 128] : 0; f.s3 = lane + 192 < nsel ? (int)sel[lane + 192] : 0;
  const unsigned short* qp = (const unsigned short*)(p.ws + O_QB) + (size_t)t * 512 + (lane & 7) * 64 + 8 * (lane >> 4);
  f.q0 = *(const uint4*)qp; f.q1 = *(const uint4*)(qp + 32);
}
DI void attn_query(const Params& p, int t, int tnext, int w, int lane, QKPF& pf) {
  const int h = lane >> 3, dg = lane & 7, n15 = lane & 15, quad = lane >> 4, hi = lane >> 5, c31 = lane & 31;
  const int* lut = (const int*)(smem + AT_LUT);
  const float* rb = (const float*)(smem + AT_RB);
  float* lgw = (float*)(smem + AT_WAVE + w * AT_WSZ);
  int* ixw = (int*)(smem + AT_WAVE + w * AT_WSZ + 8192);
  char* kst = smem + AT_WAVE + w * AT_WSZ + 9216;
  const int nsel = t + 1 < 256 ? t + 1 : 256;
  ixw[lane] = pf.s0; ixw[lane + 64] = pf.s1; ixw[lane + 128] = pf.s2; ixw[lane + 192] = pf.s3;
  const uint4 qcur0 = pf.q0, qcur1 = pf.q1;
  qk_fetch(p, tnext < L_ ? tnext : t, lane, pf);
  long qreg[2];
  {
#pragma unroll
    for (int c = 0; c < 2; ++c) {
      const uint4 qv = c == 0 ? qcur0 : qcur1;
      int w0 = __builtin_amdgcn_cvt_pk_fp8_f32(bflo(qv.x) * 8.f, bfhi(qv.x) * 8.f, 0, false);
      w0 = __builtin_amdgcn_cvt_pk_fp8_f32(bflo(qv.y) * 8.f, bfhi(qv.y) * 8.f, w0, true);
      int w1 = __builtin_amdgcn_cvt_pk_fp8_f32(bflo(qv.z) * 8.f, bfhi(qv.z) * 8.f, 0, false);
      w1 = __builtin_amdgcn_cvt_pk_fp8_f32(bflo(qv.w) * 8.f, bfhi(qv.w) * 8.f, w1, true);
      const long v = (long)(((unsigned long long)(unsigned)w1 << 32) | (unsigned long long)(unsigned)w0);
      qreg[c] = (n15 < 8) ? v : 0L;
    }
  }
  long bsel[16];
#pragma unroll
  for (int ks = 0; ks < 16; ++ks) bsel[ks] = (n15 == (ks >> 1)) ? qreg[ks & 1] : 0L;
  lds_fence();
  const uint4* KB16 = (const uint4*)(p.ws + O_KB);
  const uint2* VB = (const uint2*)(p.ws + O_VB);
  const int ntile = (nsel + 15) >> 4;
#define AT_KMMA(kt_) do { f32x4v acc0 = {0.f, 0.f, 0.f, 0.f}, acc1 = acc0, acc2 = acc0, acc3 = acc0; \
    const char* ar = kst + n15 * AT_KROW + 8 * quad; \
    _Pragma("unroll") for (int ks = 0; ks < 16; ks += 4) { \
      acc0 = MFMA8S(*(const long*)(ar + 32 * ks), bsel[ks], acc0); \
      acc1 = MFMA8S(*(const long*)(ar + 32 * ks + 32), bsel[ks + 1], acc1); \
      acc2 = MFMA8S(*(const long*)(ar + 32 * ks + 64), bsel[ks + 2], acc2); \
      acc3 = MFMA8S(*(const long*)(ar + 32 * ks + 96), bsel[ks + 3], acc3); } \
    const f32x4v acc = (acc0 + acc1) + (acc2 + acc3); \
    if (n15 < 8) { _Pragma("unroll") for (int i = 0; i < 4; ++i) lgw[(16 * (kt_) + 4 * quad + i) * 8 + n15] = acc[i] * 0.125f; } \
    cbar(); } while (0)
  uint4 kgA0, kgA1, kgA2, kgA3, kgA4, kgA5, kgA6, kgA7, kgB0, kgB1, kgB2, kgB3, kgB4, kgB5, kgB6, kgB7, kgC0, kgC1, kgC2, kgC3, kgC4, kgC5, kgC6, kgC7;
    { const int tl_ = (0) < ntile ? (0) : ntile - 1;
      const int4 ia_ = *(const int4*)(ixw + 16 * tl_ + 8 * hi), ib_ = *(const int4*)(ixw + 16 * tl_ + 8 * hi + 4);
      kgA0 = KB16[(size_t)ia_.x * 32 + c31]; kgA1 = KB16[(size_t)ia_.y * 32 + c31]; kgA2 = KB16[(size_t)ia_.z * 32 + c31]; kgA3 = KB16[(size_t)ia_.w * 32 + c31];
      kgA4 = KB16[(size_t)ib_.x * 32 + c31]; kgA5 = KB16[(size_t)ib_.y * 32 + c31]; kgA6 = KB16[(size_t)ib_.z * 32 + c31]; kgA7 = KB16[(size_t)ib_.w * 32 + c31]; }
    { const int tl_ = (1) < ntile ? (1) : ntile - 1;
      const int4 ia_ = *(const int4*)(ixw + 16 * tl_ + 8 * hi), ib_ = *(const int4*)(ixw + 16 * tl_ + 8 * hi + 4);
      kgB0 = KB16[(size_t)ia_.x * 32 + c31]; kgB1 = KB16[(size_t)ia_.y * 32 + c31]; kgB2 = KB16[(size_t)ia_.z * 32 + c31]; kgB3 = KB16[(size_t)ia_.w * 32 + c31];
      kgB4 = KB16[(size_t)ib_.x * 32 + c31]; kgB5 = KB16[(size_t)ib_.y * 32 + c31]; kgB6 = KB16[(size_t)ib_.z * 32 + c31]; kgB7 = KB16[(size_t)ib_.w * 32 + c31]; }
    { const int tl_ = (2) < ntile ? (2) : ntile - 1;
      const int4 ia_ = *(const int4*)(ixw + 16 * tl_ + 8 * hi), ib_ = *(const int4*)(ixw + 16 * tl_ + 8 * hi + 4);
      kgC0 = KB16[(size_t)ia_.x * 32 + c31]; kgC1 = KB16[(size_t)ia_.y * 32 + c31]; kgC2 = KB16[(size_t)ia_.z * 32 + c31]; kgC3 = KB16[(size_t)ia_.w * 32 + c31];
      kgC4 = KB16[(size_t)ib_.x * 32 + c31]; kgC5 = KB16[(size_t)ib_.y * 32 + c31]; kgC6 = KB16[(size_t)ib_.z * 32 + c31]; kgC7 = KB16[(size_t)ib_.w * 32 + c31]; }
  for (int kt = 0; kt < ntile; kt += 3) {
    { char* wr = kst + (8 * hi) * AT_KROW + c31 * 16; *(uint4*)(wr + 0 * AT_KROW) = kgA0; *(uint4*)(wr + 1 * AT_KROW) = kgA1; *(uint4*)(wr + 2 * AT_KROW) = kgA2; *(uint4*)(wr + 3 * AT_KROW) = kgA3; *(uint4*)(wr + 4 * AT_KROW) = kgA4; *(uint4*)(wr + 5 * AT_KROW) = kgA5; *(uint4*)(wr + 6 * AT_KROW) = kgA6; *(uint4*)(wr + 7 * AT_KROW) = kgA7; }
    { const int tl_ = ((kt) + 3) < ntile ? ((kt) + 3) : ntile - 1;
      const int4 ia_ = *(const int4*)(ixw + 16 * tl_ + 8 * hi), ib_ = *(const int4*)(ixw + 16 * tl_ + 8 * hi + 4);
      kgA0 = KB16[(size_t)ia_.x * 32 + c31]; kgA1 = KB16[(size_t)ia_.y * 32 + c31]; kgA2 = KB16[(size_t)ia_.z * 32 + c31]; kgA3 = KB16[(size_t)ia_.w * 32 + c31];
      kgA4 = KB16[(size_t)ib_.x * 32 + c31]; kgA5 = KB16[(size_t)ib_.y * 32 + c31]; kgA6 = KB16[(size_t)ib_.z * 32 + c31]; kgA7 = KB16[(size_t)ib_.w * 32 + c31]; }
    cbar();
    AT_KMMA(kt);
    if (kt + 1 < ntile) {
    { char* wr = kst + (8 * hi) * AT_KROW + c31 * 16; *(uint4*)(wr + 0 * AT_KROW) = kgB0; *(uint4*)(wr + 1 * AT_KROW) = kgB1; *(uint4*)(wr + 2 * AT_KROW) = kgB2; *(uint4*)(wr + 3 * AT_KROW) = kgB3; *(uint4*)(wr + 4 * AT_KROW) = kgB4; *(uint4*)(wr + 5 * AT_KROW) = kgB5; *(uint4*)(wr + 6 * AT_KROW) = kgB6; *(uint4*)(wr + 7 * AT_KROW) = kgB7; }
    { const int tl_ = ((kt + 1) + 3) < ntile ? ((kt + 1) + 3) : ntile - 1;
      const int4 ia_ = *(const int4*)(ixw + 16 * tl_ + 8 * hi), ib_ = *(const int4*)(ixw + 16 * tl_ + 8 * hi + 4);
      kgB0 = KB16[(size_t)ia_.x * 32 + c31]; kgB1 = KB16[(size_t)ia_.y * 32 + c31]; kgB2 = KB16[(size_t)ia_.z * 32 + c31]; kgB3 = KB16[(size_t)ia_.w * 32 + c31];
      kgB4 = KB16[(size_t)ib_.x * 32 + c31]; kgB5 = KB16[(size_t)ib_.y * 32 + c31]; kgB6 = KB16[(size_t)ib_.z * 32 + c31]; kgB7 = KB16[(size_t)ib_.w * 32 + c31]; }
    cbar();
    AT_KMMA(kt + 1);
    }
    if (kt + 2 < ntile) {
    { char* wr = kst + (8 * hi) * AT_KROW + c31 * 16; *(uint4*)(wr + 0 * AT_KROW) = kgC0; *(uint4*)(wr + 1 * AT_KROW) = kgC1; *(uint4*)(wr + 2 * AT_KROW) = kgC2; *(uint4*)(wr + 3 * AT_KROW) = kgC3; *(uint4*)(wr + 4 * AT_KROW) = kgC4; *(uint4*)(wr + 5 * AT_KROW) = kgC5; *(uint4*)(wr + 6 * AT_KROW) = kgC6; *(uint4*)(wr + 7 * AT_KROW) = kgC7; }
    { const int tl_ = ((kt + 2) + 3) < ntile ? ((kt + 2) + 3) : ntile - 1;
      const int4 ia_ = *(const int4*)(ixw + 16 * tl_ + 8 * hi), ib_ = *(const int4*)(ixw + 16 * tl_ + 8 * hi + 4);
      kgC0 = KB16[(size_t)ia_.x * 32 + c31]; kgC1 = KB16[(size_t)ia_.y * 32 + c31]; kgC2 = KB16[(size_t)ia_.z * 32 + c31]; kgC3 = KB16[(size_t)ia_.w * 32 + c31];
      kgC4 = KB16[(size_t)ib_.x * 32 + c31]; kgC5 = KB16[(size_t)ib_.y * 32 + c31]; kgC6 = KB16[(size_t)ib_.z * 32 + c31]; kgC7 = KB16[(size_t)ib_.w * 32 + c31]; }
    cbar();
    AT_KMMA(kt + 2);
    }
  }
  lds_fence();
  const int ngroups = (nsel + 7) >> 3;
  float mx = -INFINITY;
#pragma unroll 8
  for (int i = 0; i < 32; ++i) {
    const int kk = 8 * i + dg;
    const int myidx = ixw[kk];
    const int dist = t - myidx;
    const int bk = dist < 128 ? lut[dist < 0 ? 0 : dist] : 31;
    const float raw = lgw[kk * 8 + h];
    const float lgt = (kk < nsel) ? raw + rb[bk * 8 + h] : -INFINITY;
    lgw[kk * 8 + h] = lgt;
    mx = fmaxf(mx, lgt);
  }
  mx = max8(mx);
  float sum = 0.f;
#pragma unroll 8
  for (int i = 0; i < 32; ++i) {
    const float pv = __expf(lgw[(8 * i + dg) * 8 + h] - mx);
    sum += pv;
    lgw[(8 * i + dg) * 8 + h] = pv;
  }
  sum = sum8(sum);
  {
    const float inv = 1.f / sum;
#pragma unroll 8
    for (int i = 0; i < 32; ++i) lgw[(8 * i + dg) * 8 + h] *= inv;
  }
  lds_fence();
  {
    uint4 pk[4];
#pragma unroll
    for (int k = 0; k < 4; ++k) {
      const float4 a_ = *(const float4*)(lgw + (4 * lane + k) * 8), b_ = *(const float4*)(lgw + (4 * lane + k) * 8 + 4);
      pk[k] = make_uint4(cvtpk(a_.x, a_.y), cvtpk(a_.z, a_.w), cvtpk(b_.x, b_.y), cvtpk(b_.z, b_.w));
    }
    uint4* pdst = (uint4*)(p.ws + prob_off(t)) + lane * 4;
    pdst[0] = pk[0]; pdst[1] = pk[1]; pdst[2] = pk[2]; pdst[3] = pk[3];
  }
  lds_fence();
}

DI void attn_pv_query(const Params& p, int t, int w, int lane) {
  const int h = lane >> 3, dg = lane & 7;
  unsigned short* pl = (unsigned short*)(smem + AT_WAVE + w * AT_WSZ);
  int* ixw = (int*)(smem + AT_WAVE + w * AT_WSZ + 8192);
  const int nsel = t + 1 < 256 ? t + 1 : 256;
  const unsigned short* sel = (const unsigned short*)(p.ws + O_SEL) + (size_t)t * 256;
#pragma unroll
  for (int j = 0; j < 4; ++j) {
    const int pos = lane + 64 * j;
    ixw[pos] = pos < nsel ? (int)sel[pos] : 0;
  }
  {
    const uint4* psrc = (const uint4*)(p.ws + prob_off(t)) + lane * 4;
    uint4* pd = (uint4*)pl + lane * 4;
    const uint4 a0 = psrc[0], a1 = psrc[1], a2 = psrc[2], a3 = psrc[3];
    pd[0] = a0; pd[1] = a1; pd[2] = a2; pd[3] = a3;
  }
  lds_fence();
  const uint2* VB = (const uint2*)(p.ws + O_VB);
  const int ngroups = (nsel + 7) >> 3;
  f32x2v o01 = {0.f, 0.f}, o23 = {0.f, 0.f}, o45 = {0.f, 0.f}, o67 = {0.f, 0.f};
  uint2 kc[16], kn[16];
#define AT_VLOAD16(dst, ib) do { _Pragma("unroll") for (int q_ = 0; q_ < 4; ++q_) { const int4 i_ = *(const int4*)(ixw + (ib) + 4 * q_); \
    dst[4 * q_ + 0] = VB[(size_t)i_.x * 64 + lane]; dst[4 * q_ + 1] = VB[(size_t)i_.y * 64 + lane]; \
    dst[4 * q_ + 2] = VB[(size_t)i_.z * 64 + lane]; dst[4 * q_ + 3] = VB[(size_t)i_.w * 64 + lane]; } } while (0)
  const int ng16 = (nsel + 15) >> 4;
  AT_VLOAD16(kc, 0);
  for (int i = 0; i < ng16; ++i) {
    { const int nx = (i + 1 < ng16) ? i + 1 : i; AT_VLOAD16(kn, 16 * nx); }
    const float pa = bf2f(pl[(16 * i + dg) * 8 + h]);
    const float pbv = bf2f(pl[(16 * i + 8 + dg) * 8 + h]);
#pragma unroll
    for (int d = 0; d < 16; ++d) {
      const float pb = __shfl(d < 8 ? pa : pbv, (lane & ~7) | (d & 7));
      const f32x2v pb2 = {pb, pb};
      o01 = __builtin_amdgcn_cvt_pk_f32_fp8(kc[d].x, false) * pb2 + o01;
      o23 = __builtin_amdgcn_cvt_pk_f32_fp8(kc[d].x, true) * pb2 + o23;
      o45 = __builtin_amdgcn_cvt_pk_f32_fp8(kc[d].y, false) * pb2 + o45;
      o67 = __builtin_amdgcn_cvt_pk_f32_fp8(kc[d].y, true) * pb2 + o67;
    }
#pragma unroll
    for (int d = 0; d < 16; ++d) kc[d] = kn[d];
  }
  const uint4 zv = ((const uint4*)(p.ws + O_ZB))[(size_t)t * 64 + lane];
  uint4 ov;
  ov.x = cvtpk(o01.x * bflo(zv.x), o01.y * bfhi(zv.x));
  ov.y = cvtpk(o23.x * bflo(zv.y), o23.y * bfhi(zv.y));
  ov.z = cvtpk(o45.x * bflo(zv.z), o45.y * bfhi(zv.z));
  ov.w = cvtpk(o67.x * bflo(zv.w), o67.y * bfhi(zv.w));
  ((uint4*)(p.ws + O_AB))[tiled_unit(t, lane * 8, 32)] = ov;
  lds_fence();
}

constexpr int HC_B = 0;
constexpr int HC_QT = 33792;
constexpr int HC_QH = HC_QT + 17408;
constexpr int HC_KH = HC_QH + 17408;
constexpr int HC_VT = HC_KH + 17408;
constexpr int HC_P = HC_VT + 18432;
constexpr int HC_TOT = HC_P + 9216;
DI void hgrn_c_item(const Params& p, int layer, int c, int h) {
  const int tid = vtid(), lane = tid & 63, w = tid >> 6, hi = lane >> 5, c31 = lane & 31;
  float* bL = (float*)(smem + HC_B);
  unsigned short* qT = (unsigned short*)(smem + HC_QT);
  unsigned short* qH = (unsigned short*)(smem + HC_QH);
  unsigned short* kH = (unsigned short*)(smem + HC_KH);
  unsigned short* vT = (unsigned short*)(smem + HC_VT);
  unsigned short* P = (unsigned short*)(smem + HC_P);
  float* tot = (float*)(smem + HC_TOT);
  const float* G = (const float*)(p.ws + O_G);
  const unsigned short* KK = (const unsigned short*)(p.ws + O_KK);
  const unsigned short* IA = (const unsigned short*)(p.ws + O_IA);
  const unsigned short* QA = (const unsigned short*)(p.ws + O_QA);
  const int mt = w >> 2, nv = w & 3;
  const uint4* us = (const uint4*)(p.ws + O_US + (size_t)(c * 4 + h) * 32768);
  uint4 sfr[8];
#pragma unroll
  for (int ks = 0; ks < 8; ++ks) sfr[ks] = us[(nv * 8 + ks) * 64 + lane];
  uint4 qv_pre[2], kv_pre[2];
#pragma unroll
  for (int rep = 0; rep < 2; ++rep) {
    const int pr = tid + 512 * rep, t = pr >> 4, oc = pr & 15;
    qv_pre[rep] = *(const uint4*)(QA + (size_t)(64 * c + t) * 512 + 128 * h + oc * 8);
    kv_pre[rep] = *(const uint4*)(KK + (size_t)(64 * c + t) * 512 + 128 * h + oc * 8);
  }
  const uint4 z0_pre = *(const uint4*)((const unsigned short*)(p.ws + O_ZA) + (size_t)(64 * c + (tid >> 3)) * 512 + 128 * h + 16 * (tid & 7));
  const uint4 z1_pre = *(const uint4*)((const unsigned short*)(p.ws + O_ZA) + (size_t)(64 * c + (tid >> 3)) * 512 + 128 * h + 16 * (tid & 7) + 8);
  {
    const int seg = tid >> 7, k = tid & 127;
    const size_t rowbase = (size_t)(64 * c + 16 * seg);
    float b[16];
    float run = 0.f;
#pragma unroll
    for (int i = 0; i < 16; ++i) { run += G[(rowbase + i) * 512 + 128 * h + k]; b[i] = run; }
    tot[seg * 128 + k] = run;
    unsigned pv[8];
#pragma unroll
    for (int i = 0; i < 16; i += 2) {
      unsigned v0 = IA[(rowbase + i) * 512 + 128 * h + k], v1 = IA[(rowbase + i + 1) * 512 + 128 * h + k];
      pv[i >> 1] = v0 | (v1 << 16);
    }
    uint4* dv = (uint4*)(vT + k * 72 + 16 * seg);
    dv[0] = make_uint4(pv[0], pv[1], pv[2], pv[3]); dv[1] = make_uint4(pv[4], pv[5], pv[6], pv[7]);
    __syncthreads();
    float off = 0.f;
#pragma unroll
    for (int s2 = 0; s2 < 4; ++s2) { float tv = tot[s2 * 128 + k]; if (s2 < seg) off += tv; }
#pragma unroll
    for (int i = 0; i < 16; ++i) bL[(16 * seg + i) * 132 + k] = b[i] + off;
  }
  __syncthreads();
#pragma unroll
  for (int rep = 0; rep < 2; ++rep) {
    const int pr = tid + 512 * rep, t = pr >> 4, oc = pr & 15;
    const float4 b0 = *(const float4*)(bL + t * 132 + oc * 8), b1 = *(const float4*)(bL + t * 132 + oc * 8 + 4);
    const float4 r0 = *(const float4*)(bL + 31 * 132 + oc * 8), r1 = *(const float4*)(bL + 31 * 132 + oc * 8 + 4);
    const uint4 qv = qv_pre[rep];
    const uint4 kv = kv_pre[rep];
    const float bb[8] = {b0.x, b0.y, b0.z, b0.w, b1.x, b1.y, b1.z, b1.w};
    const float rr[8] = {r0.x, r0.y, r0.z, r0.w, r1.x, r1.y, r1.z, r1.w};
    const float qq[8] = {bflo(qv.x), bfhi(qv.x), bflo(qv.y), bfhi(qv.y), bflo(qv.z), bfhi(qv.z), bflo(qv.w), bfhi(qv.w)};
    const float kq[8] = {bflo(kv.x), bfhi(kv.x), bflo(kv.y), bfhi(kv.y), bflo(kv.z), bfhi(kv.z), bflo(kv.w), bfhi(kv.w)};
    float a1[8], a2[8], a3[8];
#pragma unroll
    for (int e = 0; e < 8; ++e) {
      a1[e] = qq[e] * __expf(bb[e]);
      a2[e] = qq[e] * __expf(bb[e] - rr[e]);
      a3[e] = kq[e] * __expf(rr[e] - bb[e]);
    }
    *(uint4*)(qT + t * 136 + oc * 8) = make_uint4(cvtpk(a1[0], a1[1]), cvtpk(a1[2], a1[3]), cvtpk(a1[4], a1[5]), cvtpk(a1[6], a1[7]));
    *(uint4*)(qH + t * 136 + oc * 8) = make_uint4(cvtpk(a2[0], a2[1]), cvtpk(a2[2], a2[3]), cvtpk(a2[4], a2[5]), cvtpk(a2[6], a2[7]));
    *(uint4*)(kH + t * 136 + oc * 8) = make_uint4(cvtpk(a3[0], a3[1]), cvtpk(a3[2], a3[3]), cvtpk(a3[4], a3[5]), cvtpk(a3[6], a3[7]));
  }
  __syncthreads();
  if (w < 4) {
    const int ms = w >> 1, ntq = w & 1;
    f32x16 sacc;
#pragma unroll
    for (int r = 0; r < 16; ++r) sacc[r] = 0.f;
#pragma unroll
    for (int ks = 0; ks < 8; ++ks) {
      bf16x8 af = __builtin_bit_cast(bf16x8, *(const uint4*)(kH + (32 * ms + c31) * 136 + 16 * ks + 8 * hi));
      bf16x8 bfv = __builtin_bit_cast(bf16x8, *(const uint4*)(qH + (32 * ntq + c31) * 136 + 16 * ks + 8 * hi));
      sacc = MFMA(af, bfv, sacc);
    }
    const int t = 32 * ntq + c31;
#pragma unroll
    for (int gq = 0; gq < 4; ++gq) {
      const int s0 = 32 * ms + 8 * gq + 4 * hi;
      float v0 = (s0 + 0 <= t) ? sacc[4 * gq + 0] : 0.f;
      float v1 = (s0 + 1 <= t) ? sacc[4 * gq + 1] : 0.f;
      float v2 = (s0 + 2 <= t) ? sacc[4 * gq + 2] : 0.f;
      float v3 = (s0 + 3 <= t) ? sacc[4 * gq + 3] : 0.f;
      uint2 val; val.x = cvtpk(v0, v1); val.y = cvtpk(v2, v3);
      *(uint2*)(P + t * 72 + s0) = val;
    }
  }
  f32x16 oacc;
#pragma unroll
  for (int r = 0; r < 16; ++r) oacc[r] = 0.f;
#pragma unroll
  for (int ks = 0; ks < 8; ++ks) {
    bf16x8 af = __builtin_bit_cast(bf16x8, *(const uint4*)(qT + (32 * mt + c31) * 136 + 16 * ks + 8 * hi));
    oacc = MFMA(af, __builtin_bit_cast(bf16x8, sfr[ks]), oacc);
  }
  __syncthreads();
#pragma unroll
  for (int ks = 0; ks < 4; ++ks) {
    bf16x8 af = __builtin_bit_cast(bf16x8, *(const uint4*)(P + (32 * mt + c31) * 72 + 16 * ks + 8 * hi));
    bf16x8 bfv = __builtin_bit_cast(bf16x8, *(const uint4*)(vT + (32 * nv + c31) * 72 + 16 * ks + 8 * hi));
    oacc = MFMA(af, bfv, oacc);
  }
  float* oL = bL;
#pragma unroll
  for (int r = 0; r < 16; ++r) oL[(32 * mt + crow(r, hi)) * 132 + 32 * nv + c31] = oacc[r];
  __syncthreads();
  {
    const int t = tid >> 3, sg = tid & 7;
    float ov[16];
#pragma unroll
    for (int e = 0; e < 16; e += 4) {
      const float4 f = *(const float4*)(oL + t * 132 + 16 * sg + e);
      ov[e] = f.x; ov[e + 1] = f.y; ov[e + 2] = f.z; ov[e + 3] = f.w;
    }
    float ss = 0.f;
#pragma unroll
    for (int e = 0; e < 16; ++e) ss = fmaf(ov[e], ov[e], ss);
    ss += __shfl_xor(ss, 1);
    ss += __shfl_xor(ss, 2);
    ss += __shfl_xor(ss, 4);
    const float rs = rsqrtf(ss * (1.f / 128.f) + 1e-6f);
    const int tg = 64 * c + t, k0 = 128 * h + 16 * sg;
    const float* ng = p.norm_a_g + (size_t)layer * 512 + k0;
    const uint4 z0 = z0_pre, z1 = z1_pre;
    const float zz[16] = {bflo(z0.x), bfhi(z0.x), bflo(z0.y), bfhi(z0.y), bflo(z0.z), bfhi(z0.z), bflo(z0.w), bfhi(z0.w),
                          bflo(z1.x), bfhi(z1.x), bflo(z1.y), bfhi(z1.y), bflo(z1.z), bfhi(z1.z), bflo(z1.w), bfhi(z1.w)};
    float rr[16];
#pragma unroll
    for (int e = 0; e < 16; ++e) rr[e] = ov[e] * rs * ng[e] * zz[e];
    uint4* aa = (uint4*)(p.ws + O_AA);
    aa[tiled_unit(tg, k0, 32)] = make_uint4(cvtpk(rr[0], rr[1]), cvtpk(rr[2], rr[3]), cvtpk(rr[4], rr[5]), cvtpk(rr[6], rr[7]));
    aa[tiled_unit(tg, k0 + 8, 32)] = make_uint4(cvtpk(rr[8], rr[9]), cvtpk(rr[10], rr[11]), cvtpk(rr[12], rr[13]), cvtpk(rr[14], rr[15]));
  }
  __syncthreads();
}

DI void acc_to_lds_bf16(f32x16 (&acc)[2][2], unsigned short* tile) {
  const int tid = vtid(), lane = tid & 63, w = tid >> 6, wm = w >> 1, wn = w & 1, hi = lane >> 5, c31 = lane & 31;
#pragma unroll
  for (int i = 0; i < 2; ++i)
#pragma unroll
    for (int j = 0; j < 2; ++j)
#pragma unroll
      for (int r = 0; r < 16; ++r)
        tile[(64 * wm + 32 * i + crow(r, hi)) * 128 + 64 * wn + 32 * j + c31] = f2bf(acc[i][j][r]);
}
DI void p5_tile(const Params& p, int mb, int nt) {
  const int tid = vtid(), lane = tid & 63, w = tid >> 6, wm = w >> 1, wn = w & 1, hi = lane >> 5, c31 = lane & 31;
  f32x16 acc[2][2];
  zero_acc(acc);
  gemm_core((const uint4*)(p.ws + O_AA), mb * 8, (const uint4*)(p.ws + O_WUA), nt * 4, 32, acc, (uint4*)smem);
  unsigned uap[2][2][8];
#pragma unroll
  for (int i = 0; i < 2; ++i)
#pragma unroll
    for (int j = 0; j < 2; ++j)
#pragma unroll
      for (int r = 0; r < 16; r += 2) uap[i][j][r >> 1] = cvtpk(acc[i][j][r], acc[i][j][r + 1]);
  zero_acc(acc);
  gemm_core((const uint4*)(p.ws + O_AB), mb * 8, (const uint4*)(p.ws + O_WUB), nt * 4, 32, acc, (uint4*)smem);
  unsigned short* tA = (unsigned short*)smem;
  unsigned short* tB = (unsigned short*)(smem + 65536);
#pragma unroll
  for (int i = 0; i < 2; ++i)
#pragma unroll
    for (int j = 0; j < 2; ++j)
#pragma unroll
      for (int r = 0; r < 16; r += 2) {
        const int o0 = (64 * wm + 32 * i + crow(r, hi)) * 128 + 64 * wn + 32 * j + c31;
        tA[o0] = (unsigned short)(uap[i][j][r >> 1] & 0xffffu);
        tA[o0 + 128] = (unsigned short)(uap[i][j][r >> 1] >> 16);
        tB[o0] = f2bf(acc[i][j][r]);
        tB[o0 + 128] = f2bf(acc[i][j][r + 1]);
      }
  __syncthreads();
  const int row0 = mb * 256;
#pragma unroll 2
  for (int q = 0; q < 8; ++q) {
    const int u = tid + 512 * q, r = u >> 4, c8 = u & 15;
    const uint4 ua = *(const uint4*)&tA[r * 128 + c8 * 8];
    const uint4 ub = *(const uint4*)&tB[r * 128 + c8 * 8];
    const int t = row0 + r, n0 = nt * 128 + c8 * 8;
    const uint4 ga = *(const uint4*)(p.ws + O_SGA + ((size_t)t * 1024 + n0) * 2);
    const uint4 gb = *(const uint4*)(p.ws + O_SGB + ((size_t)t * 1024 + n0) * 2);
    uint4 o;
    o.x = cvtpk(bflo(ga.x) * bflo(ua.x) + bflo(gb.x) * bflo(ub.x), bfhi(ga.x) * bfhi(ua.x) + bfhi(gb.x) * bfhi(ub.x));
    o.y = cvtpk(bflo(ga.y) * bflo(ua.y) + bflo(gb.y) * bflo(ub.y), bfhi(ga.y) * bfhi(ua.y) + bfhi(gb.y) * bfhi(ub.y));
    o.z = cvtpk(bflo(ga.z) * bflo(ua.z) + bflo(gb.z) * bflo(ub.z), bfhi(ga.z) * bfhi(ua.z) + bfhi(gb.z) * bfhi(ub.z));
    o.w = cvtpk(bflo(ga.w) * bflo(ua.w) + bflo(gb.w) * bflo(ub.w), bfhi(ga.w) * bfhi(ua.w) + bfhi(gb.w) * bfhi(ub.w));
    ((uint4*)(p.ws + O_MG))[tiled_unit(t, n0, 64)] = o;
  }
  __syncthreads();
}

DI void p6_tile(const Params& p, int layer, int mb, int nt) {
  const int tid = vtid(), lane = tid & 63, w = tid >> 6, wm = w >> 1, wn = w & 1, hi = lane >> 5, c31 = lane & 31;
  f32x16 acc[2][2];
  zero_acc(acc);
  gemm_core((const uint4*)(p.ws + O_MG), mb * 8, (const uint4*)(p.ws + O_WOUT), nt * 4, 64, acc, (uint4*)smem);
  const float* hin = (layer == 0) ? p.x : p.out;
#pragma unroll
  for (int i = 0; i < 2; ++i)
#pragma unroll
    for (int j = 0; j < 2; ++j)
#pragma unroll
      for (int r = 0; r < 16; ++r) {
        const size_t idx = (size_t)(mb * 256 + 64 * wm + 32 * i + crow(r, hi)) * DM + nt * 128 + 64 * wn + 32 * j + c31;
        p.out[idx] = fmaf(ALPHA_, hin[idx], acc[i][j][r]);
      }
}

DI float dpp_add_f(float v, int which) {
  const int iv = __builtin_bit_cast(int, v);
  int r;
  switch (which) {
    case 0: r = __builtin_amdgcn_update_dpp(0, iv, 0x111, 0xf, 0xf, true); break;
    case 1: r = __builtin_amdgcn_update_dpp(0, iv, 0x112, 0xf, 0xf, true); break;
    case 2: r = __builtin_amdgcn_update_dpp(0, iv, 0x114, 0xf, 0xf, true); break;
    case 3: r = __builtin_amdgcn_update_dpp(0, iv, 0x118, 0xf, 0xf, true); break;
    default: r = __builtin_amdgcn_update_dpp(0, iv, 0x142, 0xa, 0xf, false); break;
  }
  return v + __builtin_bit_cast(float, r);
}
DI float half_sum_to_last(float v) {
  v = dpp_add_f(v, 0); v = dpp_add_f(v, 1); v = dpp_add_f(v, 2); v = dpp_add_f(v, 3); v = dpp_add_f(v, 4);
  return v;
}
DI void fused_out_ln(const Params& p, int layer, int mb64) {
  const int tid = vtid(), lane = tid & 63, w = tid >> 6, hi = lane >> 5, c31 = lane & 31;
  uint4* lds = (uint4*)smem;
  const uint4* A = (const uint4*)(p.ws + O_MG) + (size_t)(2 * mb64) * 64 * 64;
#pragma unroll
  for (int r = 0; r < 16; ++r)
    __builtin_amdgcn_global_load_lds((const unsigned*)(A + tid + 512 * r), (unsigned*)(lds + tid + 512 * r), 16, 0, 0);
  const uint4* Bw = (const uint4*)(p.ws + O_WOUT) + (size_t)(4 * w) * 64 * 64 + lane;
  uint4 bq[4][4];
#pragma unroll
  for (int s_ = 0; s_ < 4; ++s_)
#pragma unroll
    for (int j = 0; j < 4; ++j) bq[s_][j] = Bw[(size_t)(j * 64 + s_) * 64];
  f32x16 acc[2][4];
#pragma unroll
  for (int i = 0; i < 2; ++i)
#pragma unroll
    for (int j = 0; j < 4; ++j)
#pragma unroll
      for (int r = 0; r < 16; ++r) acc[i][j][r] = 0.f;
  __syncthreads();
#pragma unroll 1
  for (int k4 = 0; k4 < 16; ++k4) {
#pragma unroll
    for (int s_ = 0; s_ < 4; ++s_) {
      const int ks = 4 * k4 + s_;
      const bf16x8 a0 = __builtin_bit_cast(bf16x8, lds[ks * 64 + lane]);
      const bf16x8 a1 = __builtin_bit_cast(bf16x8, lds[4096 + ks * 64 + lane]);
#pragma unroll
      for (int j = 0; j < 4; ++j) {
        const bf16x8 b = __builtin_bit_cast(bf16x8, bq[s_][j]);
        acc[0][j] = MFMA(a0, b, acc[0][j]);
        acc[1][j] = MFMA(a1, b, acc[1][j]);
      }
      if (k4 < 15) {
#pragma unroll
        for (int j = 0; j < 4; ++j) bq[s_][j] = Bw[(size_t)(j * 64 + ks + 4) * 64];
      }
    }
  }
  const float* hin = (layer == 0) ? p.x : p.out;
  float* ft = (float*)smem;
  uint2* hb2 = (uint2*)(p.ws + O_HB);
  const int rr = tid >> 4, seg = tid & 15;
#pragma unroll
  for (int i = 0; i < 2; ++i) {
    __syncthreads();
    {
      float* b0 = ft + (4 * hi) * 1024 + 128 * w + c31;
      float* b1 = b0 + 16 * 1024;
#pragma unroll
      for (int j = 0; j < 4; ++j)
#pragma unroll
        for (int r = 0; r < 16; ++r) {
          float* bp = (r < 8) ? b0 : b1;
          bp[((r & 3) + 8 * ((r >> 2) & 1)) * 1024 + 32 * j] = acc[i][j][r];
        }
    }
    __syncthreads();
    const int trow = 64 * mb64 + 32 * i + rr;
    const float* hrow = hin + (size_t)trow * DM;
    float s1 = 0.f, s2 = 0.f;
    float* frow = ft + rr * 1024 + 4 * seg;
#pragma unroll 4
    for (int e = 0; e < 16; ++e) {
      const float4 y = *(const float4*)(frow + 64 * e);
      const float4 hv = *(const float4*)(hrow + 64 * e + 4 * seg);
      float4 pre;
      pre.x = fmaf(ALPHA_, hv.x, y.x); pre.y = fmaf(ALPHA_, hv.y, y.y); pre.z = fmaf(ALPHA_, hv.z, y.z); pre.w = fmaf(ALPHA_, hv.w, y.w);
      s1 += (pre.x + pre.y) + (pre.z + pre.w);
      s2 = fmaf(pre.x, pre.x, s2); s2 = fmaf(pre.y, pre.y, s2); s2 = fmaf(pre.z, pre.z, s2); s2 = fmaf(pre.w, pre.w, s2);
      *(float4*)(frow + 64 * e) = pre;
    }
    s1 += __shfl_xor(s1, 1); s1 += __shfl_xor(s1, 2); s1 += __shfl_xor(s1, 4); s1 += __shfl_xor(s1, 8);
    s2 += __shfl_xor(s2, 1); s2 += __shfl_xor(s2, 2); s2 += __shfl_xor(s2, 4); s2 += __shfl_xor(s2, 8);
    const float mu = s1 * (1.f / 1024.f);
    const float rs = rsqrtf(fmaxf(s2 * (1.f / 1024.f) - mu * mu, 0.f) + 1e-5f);
    const float* gp = p.ln_g + (size_t)layer * DM;
    const float* bp2 = p.ln_b + (size_t)layer * DM;
    float* orow = p.out + (size_t)trow * DM;
#pragma unroll 4
    for (int e = 0; e < 16; ++e) {
      const int c0 = 64 * e + 4 * seg;
      const float4 pre = *(const float4*)(frow + 64 * e);
      const float4 g4 = *(const float4*)(gp + c0), b4 = *(const float4*)(bp2 + c0);
      float4 o;
      o.x = (pre.x - mu) * rs * g4.x + b4.x; o.y = (pre.y - mu) * rs * g4.y + b4.y;
      o.z = (pre.z - mu) * rs * g4.z + b4.z; o.w = (pre.w - mu) * rs * g4.w + b4.w;
      *(float4*)(orow + c0) = o;
      hb2[((size_t)trow * 1024 + c0) >> 2] = make_uint2(cvtpk(o.x, o.y), cvtpk(o.z, o.w));
    }
  }
  __syncthreads();
}

DI void p7_rows(const Params& p, int layer) {
  const int tid = vtid();
  const int lane = tid & 63, gw = blockIdx.x * 8 + (tid >> 6), nw = gridDim.x * 8;
  const float* g = p.ln_g + (size_t)layer * DM;
  const float* bb = p.ln_b + (size_t)layer * DM;
  uint4* hb = (uint4*)(p.ws + O_HB);
  for (int t = gw; t < L_; t += nw) {
    float* row = p.out + (size_t)t * DM;
    float v[16];
#pragma unroll
    for (int q = 0; q < 2; ++q) {
      const float4 a = *(const float4*)(row + q * 512 + lane * 8), b = *(const float4*)(row + q * 512 + lane * 8 + 4);
      v[8 * q + 0] = a.x; v[8 * q + 1] = a.y; v[8 * q + 2] = a.z; v[8 * q + 3] = a.w;
      v[8 * q + 4] = b.x; v[8 * q + 5] = b.y; v[8 * q + 6] = b.z; v[8 * q + 7] = b.w;
    }
    float s = 0.f;
#pragma unroll
    for (int e = 0; e < 16; ++e) s += v[e];
#pragma unroll
    for (int off = 1; off < 64; off <<= 1) s += __shfl_xor(s, off);
    const float mu = s * (1.f / 1024.f);
    float ss = 0.f;
#pragma unroll
    for (int e = 0; e < 16; ++e) { const float d = v[e] - mu; ss = fmaf(d, d, ss); }
#pragma unroll
    for (int off = 1; off < 64; off <<= 1) ss += __shfl_xor(ss, off);
    const float rs = rsqrtf(ss * (1.f / 1024.f) + 1e-5f);
#pragma unroll
    for (int q = 0; q < 2; ++q) {
      const int k0 = q * 512 + lane * 8;
      float o[8];
#pragma unroll
      for (int e = 0; e < 8; ++e) o[e] = (v[8 * q + e] - mu) * rs * g[k0 + e] + bb[k0 + e];
      *(float4*)(row + k0) = make_float4(o[0], o[1], o[2], o[3]);
      *(float4*)(row + k0 + 4) = make_float4(o[4], o[5], o[6], o[7]);
      hb[tiled_unit(t, k0, 64)] = make_uint4(cvtpk(o[0], o[1]), cvtpk(o[2], o[3]), cvtpk(o[4], o[5]), cvtpk(o[6], o[7]));
    }
  }
}


#define XB_TMO      128
#define XB_XCNT(j)  (256  + 64 * (j))
#define XB_XSUB(j)  (1280 + 64 * (j))
#define XB_XGEN(j)  (2304 + 64 * (j))
#define XB_TOP      3328
#define XB_TOPGEN   3392
#define XCD_BAR_WORDS 3456
#define XB_SPIN_CAP (1u << 22)
#define LAS __attribute__((address_space(3)))
DI unsigned xb_ld(unsigned* p)              { return __hip_atomic_load(p, __ATOMIC_RELAXED, __HIP_MEMORY_SCOPE_AGENT); }
DI unsigned xb_add(unsigned* p, unsigned v) { return __hip_atomic_fetch_add(p, v, __ATOMIC_RELAXED, __HIP_MEMORY_SCOPE_AGENT); }
DI unsigned xb_xcc_id() { return (unsigned)__builtin_amdgcn_s_getreg((3 << 11) | 20) & 0xFu; }
#define XB_SPIN(cond, bar) do { unsigned _sp = 0; while (cond) { __builtin_amdgcn_s_sleep(1); \
    if ((++_sp & 255u) == 0u) { if (xb_ld(&(bar)[XB_TMO])) break; if (_sp > XB_SPIN_CAP) { atomicAdd(&(bar)[XB_TMO], 1u); break; } } } } while (0)
struct XcdBarrier { unsigned* bar; unsigned x; volatile LAS unsigned* st; };
DI XcdBarrier xcd_barrier_post(unsigned* bar, volatile LAS unsigned* st) {
  XcdBarrier b; b.bar = bar; b.x = xb_xcc_id(); b.st = st;
  if (threadIdx.x == 0) (void)xb_add(&bar[XB_XCNT(b.x)], 1u);
  return b;
}
DI void xcd_barrier_complete(unsigned* bar, unsigned x, unsigned& nloc, unsigned& nx) {
  const unsigned G = gridDim.x * gridDim.y * gridDim.z;
  unsigned sum, cnt, mine, sp = 0u;
  for (;;) {
    sum = 0u; cnt = 0u; mine = 0u;
#pragma unroll
    for (unsigned j = 0; j < 16; ++j) { const unsigned c = xb_ld(&bar[XB_XCNT(j)]); sum += c; cnt += (c > 0u) ? 1u : 0u; mine = (j == x) ? c : mine; }
    if (sum == G) break;
    __builtin_amdgcn_s_sleep(1);
    if ((++sp & 255u) == 0u) { if (xb_ld(&bar[XB_TMO])) break; if (sp > XB_SPIN_CAP) { atomicAdd(&bar[XB_TMO], 1u); break; } }
  }
  nloc = mine > 0u ? mine : 1u; nx = cnt > 0u ? cnt : 1u;
}
DI void xcd_barrier(const XcdBarrier& b) {
  asm volatile("s_waitcnt vmcnt(0)" ::: "memory");
  __syncthreads();
  if (threadIdx.x == 0) {
    unsigned* bar = b.bar;
    __builtin_amdgcn_s_waitcnt(0);
    unsigned nloc = b.st[0], nx = b.st[1];
    if (nloc == 0u) { xcd_barrier_complete(bar, b.x, nloc, nx); b.st[0] = nloc; b.st[1] = nx; }
    const unsigned old = xb_add(&bar[XB_XSUB(b.x)], 1u);
    const unsigned gen = old / nloc;
    if (old + 1u == (gen + 1u) * nloc) {
      __builtin_amdgcn_fence(__ATOMIC_RELEASE, "agent");
      asm volatile("s_waitcnt vmcnt(0)" ::: "memory");
      const unsigned og = xb_add(&bar[XB_TOP], 1u);
      const unsigned tg = og / nx;
      if (og + 1u == (tg + 1u) * nx) xb_add(&bar[XB_TOPGEN], 1u);
      else XB_SPIN(xb_ld(&bar[XB_TOPGEN]) == tg, bar);
      __builtin_amdgcn_fence(__ATOMIC_ACQUIRE, "agent");
      xb_add(&bar[XB_XGEN(b.x)], 1u);
      asm volatile("s_waitcnt vmcnt(0)" ::: "memory");
    } else {
      XB_SPIN(xb_ld(&bar[XB_XGEN(b.x)]) == gen, bar);
      __builtin_amdgcn_fence(__ATOMIC_ACQUIRE, "agent");
      asm volatile("s_waitcnt vmcnt(0)" ::: "memory");
    }
  }
  __syncthreads();
}
constexpr int LDS_BARST = 163840 - 16;

__global__ void __launch_bounds__(512) mk(Params p) {
  cg::grid_group grid = cg::this_grid();
  const int nb = gridDim.x, bid = blockIdx.x;
  volatile LAS unsigned* bst_ = (volatile LAS unsigned*)(smem + LDS_BARST);
  if (threadIdx.x < 4) bst_[threadIdx.x] = 0u;
  __syncthreads();
  (void)xcd_barrier_post((unsigned*)(p.ws + O_BAR), bst_);
#define XB_NOW() XcdBarrier{(unsigned*)(p.ws + O_BAR), xb_xcc_id(), (volatile LAS unsigned*)(smem + LDS_BARST)}
  phase0(p);
  grid.sync();
  for (int layer = 0; layer < DEPTH_; ++layer) {
    {
      const int gtid = bid * 512 + vtid(), gthreads = nb * 512;
      conv_weight(p.w_up_a + (size_t)layer * 512 * 1024, 512, 1024, 1024, false, (uint4*)(p.ws + O_WUA), gtid, gthreads);
      conv_weight(p.w_up_b + (size_t)layer * 512 * 1024, 512, 1024, 1024, false, (uint4*)(p.ws + O_WUB), gtid, gthreads);
      conv_weight(p.w_out + (size_t)layer * 1024 * 1024, 1024, 1024, 1024, false, (uint4*)(p.ws + O_WOUT), gtid, gthreads);
#ifndef NO_P1
      for (int id = bid; id < 64 * 27; id += nb) p1_tile8(p, layer, id & 63, id >> 6);
#endif
    }
    xcd_barrier(XB_NOW());
    {
      if (layer + 1 < DEPTH_) {
        const int gtid = bid * 512 + vtid(), gthreads = nb * 512;
        conv_weight_rm(p.w_in + (size_t)(layer + 1) * 1024 * NIN, 1024, NIN, NPAD, true, (uint4*)(p.ws + O_WTIN), gtid, gthreads);
      }
#ifndef NO_HA
      for (int id = bid; id < 1024; id += nb) hgrn_a_item(p, id >> 2, id & 3);
#endif
      for (int s = bid; s < 1024; s += nb) {
        const int rnd = s / nb, pos = s - rnd * nb;
        const int rem = 1024 - rnd * nb, count = rem < nb ? rem : nb;
        const int sp = (rnd & 1) ? (rnd * nb + count - 1 - pos) : s;
        indexer_item(p, 1023 - sp);
      }
    }
    xcd_barrier(XB_NOW());
    {
      attn_setup();
      const int tid = vtid();
      if (tid < 256) ((float*)(smem + AT_RB))[tid] = p.rel_bias[tid];
      __syncthreads();
#ifndef NO_SCAN
      hgrn_scan(p);
#endif
      const int w = tid >> 6, lane = tid & 63;
#ifndef NO_ATT
      { QKPF pf; qk_fetch(p, bid * 8 + w, lane, pf);
        for (int t = bid * 8 + w; t < L_; t += nb * 8) attn_query(p, t, t + nb * 8, w, lane, pf); }
#endif
      __syncthreads();
    }
    xcd_barrier(XB_NOW());
    {
      const int tid = vtid();
      const int w = tid >> 6, lane = tid & 63;
      for (int t = bid * 8 + w; t < L_; t += nb * 8) attn_pv_query(p, t, w, lane);
      __syncthreads();
    }
    xcd_barrier(XB_NOW());
#ifndef NO_HC
    for (int id = bid; id < 1024; id += nb) hgrn_c_item(p, layer, id >> 2, id & 3);
#endif
    xcd_barrier(XB_NOW());
#ifndef NO_P5
    for (int id = bid; id < 64 * 8; id += nb) p5_tile(p, id & 63, id >> 6);
#endif
    xcd_barrier(XB_NOW());
    for (int id = bid; id < 256; id += nb) fused_out_ln(p, layer, id);
    xcd_barrier(XB_NOW());
  }}

extern "C" void kernel_launch(void* const* d_in, const int* in_sizes, int n_in, void* d_out, int out_size, void* d_ws,
                              size_t ws_size, hipStream_t stream) {
  constexpr size_t kLds = 160 * 1024;
  static int grid_blocks = 0;
  if (!grid_blocks) {
    int dev = 0, cus = 0, per_cu = 0;
    (void)hipGetDevice(&dev);
    (void)hipDeviceGetAttribute(&cus, hipDeviceAttributeMultiprocessorCount, dev);
    (void)hipFuncSetAttribute((const void*)mk, hipFuncAttributeMaxDynamicSharedMemorySize, (int)kLds);
    (void)hipOccupancyMaxActiveBlocksPerMultiprocessor(&per_cu, mk, 512, kLds);
    if (per_cu > 1) per_cu = 1;
    grid_blocks = cus * per_cu;
  }
  if (ws_size < WS_NEED || grid_blocks <= 0) { fprintf(stderr, "ws too small or no occupancy\n"); return; }
  Params p{};
  p.x = (const float*)d_in[0]; p.w_in = (const float*)d_in[1]; p.b_in = (const float*)d_in[2];
  p.w_up_a = (const float*)d_in[3]; p.w_up_b = (const float*)d_in[4]; p.w_out = (const float*)d_in[5];
  p.lb_logits = (const float*)d_in[6]; p.norm_a_g = (const float*)d_in[7]; p.rel_bias = (const float*)d_in[8];
  p.ln_g = (const float*)d_in[9]; p.ln_b = (const float*)d_in[10];
  p.out = (float*)d_out; p.ws = (char*)d_ws;
  (void)hipMemsetAsync((char*)d_ws + O_BAR, 0, XCD_BAR_WORDS * 4, stream);
  void* args[] = {&p};
  hipError_t e = hipLaunchCooperativeKernel((void*)mk, dim3(grid_blocks), dim3(512), args, kLds, stream);
  if (e != hipSuccess) fprintf(stderr, "cooperative launch failed: %s (grid %d)\n", hipGetErrorString(e), grid_blocks);
}
```

```cpp
#include <hip/hip_runtime.h>
#include <hip/hip_cooperative_groups.h>
#include <cstdio>
#include <cstdint>
namespace cg = cooperative_groups;

#define DI __device__ __forceinline__
typedef __attribute__((ext_vector_type(8))) short bf16x8;
typedef __attribute__((ext_vector_type(16))) float f32x16;
typedef __attribute__((ext_vector_type(2))) float f32x2;
typedef __attribute__((ext_vector_type(2))) __bf16 bf16x2_t;
#define MFMA(a, b, c) __builtin_amdgcn_mfma_f32_32x32x16_bf16((a), (b), (c), 0, 0, 0)

constexpr int L_ = 16384, DM = 1024, NIN = 6728, NPAD = 6912, DEPTH_ = 4;
constexpr float ALPHA_ = 1.681792830507429f;
constexpr size_t MiB = 1048576;
constexpr size_t O_WTIN = 0 * MiB, O_WUA = 14 * MiB, O_WUB = 15 * MiB, O_WOUT = 16 * MiB, O_HB = 18 * MiB,
                 O_QA = 50 * MiB, O_G = 66 * MiB, O_KK = 98 * MiB, O_IA = 114 * MiB, O_ZA = 130 * MiB,
                 O_QB = 146 * MiB, O_KB = 162 * MiB, O_VB = 178 * MiB, O_ZB = 194 * MiB, O_QI = 210 * MiB,
                 O_KI = 226 * MiB, O_WI = 228 * MiB, O_D = 228 * MiB + 512 * 1024, O_SGA = 229 * MiB,
                 O_SGB = 261 * MiB, O_US = 293 * MiB, O_SEL = 325 * MiB, O_LBS = 333 * MiB,
                 O_BAR = 333 * MiB + 65536, O_AA = 334 * MiB, O_AB = 350 * MiB, O_MG = 366 * MiB, WS_NEED = 398 * MiB;

struct Params {
  const float *x, *w_in, *b_in, *w_up_a, *w_up_b, *w_out, *lb_logits, *norm_a_g, *rel_bias, *ln_g, *ln_b;
  float* out;
  char* ws;
};

extern __shared__ __attribute__((aligned(16))) char smem[];

DI unsigned cvtpk(float lo, float hi) {
  f32x2 v = {lo, hi};
  bf16x2_t b = __builtin_convertvector(v, bf16x2_t);
  return __builtin_bit_cast(unsigned, b);
}
DI unsigned short f2bf(float x) { return (unsigned short)(cvtpk(x, 0.f) & 0xffffu); }
DI float bflo(unsigned u) { return __uint_as_float(u << 16); }
DI float bfhi(unsigned u) { return __uint_as_float(u & 0xffff0000u); }
DI float bf2f(unsigned short s) { return __uint_as_float(((unsigned)s) << 16); }
DI float sigm(float x) { return 1.f / (1.f + __expf(-x)); }
DI float silu(float x) { return x / (1.f + __expf(-x)); }
DI int crow(int r, int hi) { return (r & 3) + 8 * (r >> 2) + 4 * hi; }
DI size_t tiled_unit(int r, int k, int KS) {
  return ((size_t)(r >> 5) * KS + (k >> 4)) * 64 + (r & 31) + 32 * ((k >> 3) & 1);
}
DI float dot2(unsigned a, unsigned b, float acc) {
  asm volatile("v_dot2c_f32_bf16 %0, %1, %2" : "+v"(acc) : "v"(a), "v"(b));
  return acc;
}
template <typename T> DI T* opq(T* x) { asm volatile("" : "+s"(x)); return x; }
#define LAUNDER(pin) Params p; p.x = opq((pin).x); p.w_in = (pin).w_in; p.b_in = (pin).b_in; p.w_up_a = (pin).w_up_a; p.w_up_b = (pin).w_up_b; \
  p.w_out = (pin).w_out; p.lb_logits = (pin).lb_logits; p.norm_a_g = (pin).norm_a_g; p.rel_bias = (pin).rel_bias; p.ln_g = (pin).ln_g; \
  p.ln_b = (pin).ln_b; p.out = opq((pin).out); p.ws = opq((pin).ws);
DI int vtid() { int t = threadIdx.x; asm volatile("" : "+v"(t)); return t; }
DI unsigned vzero() { unsigned z; asm volatile("v_mov_b32 %0, 0" : "=v"(z)); return z; }
DI void cbar() { asm volatile("" ::: "memory"); }
DI void lds_fence() { asm volatile("s_waitcnt lgkmcnt(0)" ::: "memory"); }

DI int colmap(int np) {
  if (np < 4608) return np;
  if (np < 5632) return 4680 + (np - 4608);
  if (np < 6656) return 5704 + (np - 5632);
  if (np < 6720) return 4608 + (np - 6656);
  if (np < 6728) return 4672 + (np - 6720);
  return -1;
}

DI void conv_weight(const float* __restrict__ src, int K, int ldn, int Npad, bool useMap, uint4* __restrict__ dst,
                    int gtid, int gthreads) {
  const int KS = K >> 4;
  const int total = Npad * (K >> 3);
  for (int u = gtid; u < total; u += gthreads) {
    int kg = u / Npad, n = u - kg * Npad;
    int col = useMap ? colmap(n) : n;
    float v[8];
#pragma unroll
    for (int j = 0; j < 8; ++j) v[j] = (col >= 0) ? src[(size_t)(kg * 8 + j) * ldn + col] : 0.f;
    uint4 o;
    o.x = cvtpk(v[0], v[1]); o.y = cvtpk(v[2], v[3]); o.z = cvtpk(v[4], v[5]); o.w = cvtpk(v[6], v[7]);
    dst[tiled_unit(n, kg * 8, KS)] = o;
  }
}

DI void conv_weight_rm(const float* __restrict__ src, int K, int ldn, int Npad, bool useMap, uint4* __restrict__ dst,
                       int gtid, int gthreads) {
  const int total = Npad * (K >> 3);
  for (int u = gtid; u < total; u += gthreads) {
    int kg = u / Npad, n = u - kg * Npad;
    int col = useMap ? colmap(n) : n;
    float v[8];
#pragma unroll
    for (int j = 0; j < 8; ++j) v[j] = (col >= 0) ? src[(size_t)(kg * 8 + j) * ldn + col] : 0.f;
    uint4 o;
    o.x = cvtpk(v[0], v[1]); o.y = cvtpk(v[2], v[3]); o.z = cvtpk(v[4], v[5]); o.w = cvtpk(v[6], v[7]);
    dst[(size_t)n * (K >> 3) + kg] = o;
  }
}

DI void phase0(const Params& p) {
  const int gtid = blockIdx.x * 512 + vtid(), gthreads = gridDim.x * 512;
  conv_weight_rm(p.w_in, 1024, NIN, NPAD, true, (uint4*)(p.ws + O_WTIN), gtid, gthreads);
  uint4* hb = (uint4*)(p.ws + O_HB);
  for (int u = gtid; u < L_ * 128; u += gthreads) {
    const float4* s_ = (const float4*)(p.x + (size_t)u * 8);
    const float4 a = s_[0], b = s_[1];
    uint4 o;
    o.x = cvtpk(a.x, a.y); o.y = cvtpk(a.z, a.w); o.z = cvtpk(b.x, b.y); o.w = cvtpk(b.z, b.w);
    hb[u] = o;
  }
  float* lbs = (float*)(p.ws + O_LBS);
  for (int c = gtid; c < 512; c += gthreads) {
    float l0 = p.lb_logits[c], l1 = p.lb_logits[512 + c], l2 = p.lb_logits[1024 + c], l3 = p.lb_logits[1536 + c];
    float m = fmaxf(fmaxf(l0, l1), fmaxf(l2, l3));
    float e0 = expf(l0 - m), e1 = expf(l1 - m), e2 = expf(l2 - m), e3 = expf(l3 - m);
    float inv = 1.f / (e0 + e1 + e2 + e3);
    lbs[c] = 0.f; lbs[512 + c] = e1 * inv; lbs[1024 + c] = (e1 + e2) * inv; lbs[1536 + c] = (e1 + e2 + e3) * inv;
  }
}

DI void gemm_core(const uint4* __restrict__ A, int mt0, const uint4* __restrict__ B, int nt0, int KS,
                  f32x16 (&acc)[2][2], uint4* lds) {
  const int tid = vtid(), lane = tid & 63, w = tid >> 6, wm = w >> 1, wn = w & 1;
  const int nk = KS >> 2;
  const uint4* sp[6];
#pragma unroll
  for (int r = 0; r < 6; ++r) {
    int u = tid + 512 * r;
    if (u < 2048) sp[r] = A + ((size_t)(mt0 + (u >> 8)) * KS) * 64 + (u & 255);
    else { int u2 = u - 2048; sp[r] = B + ((size_t)(nt0 + (u2 >> 8)) * KS) * 64 + (u2 & 255); }
  }
#pragma unroll
  for (int r = 0; r < 6; ++r)
    __builtin_amdgcn_global_load_lds((const unsigned*)sp[r], (unsigned*)(lds + tid + 512 * r), 16, 0, 0);
  if (nk > 1) {
#pragma unroll
    for (int r = 0; r < 6; ++r)
      __builtin_amdgcn_global_load_lds((const unsigned*)(sp[r] + 256), (unsigned*)(lds + 3072 + tid + 512 * r), 16, 0, 0);
  }
  int cb = 0;
  for (int kt = 0; kt < nk; ++kt) {
    if (kt + 1 < nk) asm volatile("s_waitcnt vmcnt(6)" ::: "memory");
    else asm volatile("s_waitcnt vmcnt(0)" ::: "memory");
    __builtin_amdgcn_s_barrier();
    asm volatile("" ::: "memory");
    if (kt + 2 < nk) {
      int nb2 = cb + 2; if (nb2 >= 3) nb2 -= 3;
      uint4* nxt = lds + nb2 * 3072;
#pragma unroll
      for (int r = 0; r < 6; ++r)
        __builtin_amdgcn_global_load_lds((const unsigned*)(sp[r] + (size_t)(kt + 2) * 256), (unsigned*)(nxt + tid + 512 * r), 16, 0, 0);
    }
    const uint4* cur = lds + cb * 3072;
#pragma unroll
    for (int ks = 0; ks < 4; ++ks) {
      bf16x8 a0 = __builtin_bit_cast(bf16x8, cur[(2 * wm + 0) * 256 + ks * 64 + lane]);
      bf16x8 a1 = __builtin_bit_cast(bf16x8, cur[(2 * wm + 1) * 256 + ks * 64 + lane]);
      bf16x8 b0 = __builtin_bit_cast(bf16x8, cur[2048 + (2 * wn + 0) * 256 + ks * 64 + lane]);
      bf16x8 b1 = __builtin_bit_cast(bf16x8, cur[2048 + (2 * wn + 1) * 256 + ks * 64 + lane]);
      acc[0][0] = MFMA(a0, b0, acc[0][0]);
      acc[0][1] = MFMA(a0, b1, acc[0][1]);
      acc[1][0] = MFMA(a1, b0, acc[1][0]);
      acc[1][1] = MFMA(a1, b1, acc[1][1]);
    }
    cb = (cb == 2) ? 0 : cb + 1;
  }
  __syncthreads();
}

DI void zero_acc(f32x16 (&acc)[2][2]) {
#pragma unroll
  for (int i = 0; i < 2; ++i)
#pragma unroll
    for (int j = 0; j < 2; ++j)
#pragma unroll
      for (int r = 0; r < 16; ++r) acc[i][j][r] = 0.f;
}

typedef __attribute__((ext_vector_type(4))) float f32x4g;
DI int g8_lds_byte(int r, int c) {
  int st = (r >> 4) * 2 + (c >> 5), rr = r & 15, cc = c & 31, ob = rr * 64 + cc * 2;
  return st * 1024 + (ob ^ (((ob >> 9) & 1) << 5));
}
DI void g8_stage_rc(int b, int& R, int& C) {
  int st = b / 1024, sb = b % 1024, swz = sb ^ (((sb >> 9) & 1) << 5);
  R = (st >> 1) * 16 + swz / 64; C = (st & 1) * 32 + (swz % 64) / 2;
}
DI void gemm8p(const unsigned short* __restrict__ A, const unsigned short* __restrict__ Bt, const int K, const int brow, const int bcol,
               f32x4g (&acc)[2][2][4][2], unsigned short* shm) {
  constexpr int BK = 64, HALF = 128, HT = HALF * BK;
  const int tidx = vtid();
  #define G8_SA(b,h) (shm+((b)*2+(h))*HT)
  #define G8_SB(b,h) (shm+(4+(b)*2+(h))*HT)
  int g8vo[2];
  { int r_, c_; g8_stage_rc(tidx * 16, r_, c_); g8vo[0] = (r_ * K + c_) * 2; g8_stage_rc(tidx * 16 + 8192, r_, c_); g8vo[1] = (r_ * K + c_) * 2; }
  const __amdgpu_buffer_rsrc_t g8rA = __builtin_amdgcn_make_buffer_rsrc((void*)A, 0, 16384 * 1024 * 2, 0x00020000);
  const __amdgpu_buffer_rsrc_t g8rBt = __builtin_amdgcn_make_buffer_rsrc((void*)Bt, 0, 6912 * 1024 * 2, 0x00020000);
  #define G8_STAGE(P,BASE,br,kt) do{ const int _so = ((br) * K + (kt) * BK) * 2; \
    for(int _i=0;_i<2;++_i){ \
      __builtin_amdgcn_raw_ptr_buffer_load_lds(g8r##BASE, (__attribute__((address_space(3))) void*)((char*)(P)+tidx*16+_i*8192), 16, g8vo[_i], _so, 0, 0);}}while(0)
  #define G8_LDA(dst,b,h) for(int m=0;m<4;++m)for(int k=0;k<2;++k) \
    dst[m][k]=*reinterpret_cast<const bf16x8*>((char*)G8_SA(b,h)+g8_lds_byte(wr*64+m*16+fr,k*32+fq*8))
  #define G8_LDB(dst,b,h) for(int n=0;n<2;++n)for(int k=0;k<2;++k) \
    dst[n][k]=*reinterpret_cast<const bf16x8*>((char*)G8_SB(b,h)+g8_lds_byte(wc*32+n*16+fr,k*32+fq*8))
  #define G8_MMA(ai,bj,At,Bt_) do{__builtin_amdgcn_s_setprio(1); \
    for(int m=0;m<4;++m)for(int n=0;n<2;++n)for(int k=0;k<2;++k) \
      acc[ai][bj][m][n]=__builtin_amdgcn_mfma_f32_16x16x32_bf16(Bt_[n][k],At[m][k],acc[ai][bj][m][n],0,0,0); \
    __builtin_amdgcn_s_setprio(0);}while(0)
  #define G8_WV(n) asm volatile("s_waitcnt vmcnt(" #n ")":::"memory")
  #define G8_WL(n) asm volatile("s_waitcnt lgkmcnt(" #n ")":::"memory")
  #define G8_BAR __builtin_amdgcn_s_barrier()
  #define G8_SCHED __builtin_amdgcn_sched_barrier(0)
  const int wid = tidx >> 6, lane = tidx & 63, wr = wid >> 2, wc = wid & 3, fr = lane & 15, fq = lane >> 4;
  bf16x8 At[4][2], B0[2][2], B1[2][2];
  const int nt = K / BK;
  G8_STAGE(G8_SB(0,0),Bt,bcol,0); G8_STAGE(G8_SA(0,0),A,brow,0);
  G8_STAGE(G8_SB(0,1),Bt,bcol+HALF,0); G8_STAGE(G8_SA(0,1),A,brow+HALF,0);
  if(wr==1)G8_BAR;
  G8_WV(4); G8_BAR;
  G8_STAGE(G8_SB(1,0),Bt,bcol,1); G8_STAGE(G8_SA(1,0),A,brow,1); G8_STAGE(G8_SB(1,1),Bt,bcol+HALF,1);
  G8_WV(6); G8_BAR;
  for(int t=0;t<nt-2;t+=2){
    G8_LDB(B0,0,0); G8_SCHED; G8_LDA(At,0,0); G8_STAGE(G8_SA(1,1),A,brow+HALF,t+1);
    G8_WL(8); G8_BAR; G8_WL(0); G8_MMA(0,0,At,B0); G8_BAR; G8_SCHED;
    G8_LDB(B1,0,1); G8_STAGE(G8_SB(0,0),Bt,bcol,t+2);
    G8_BAR; G8_WL(0); G8_MMA(0,1,At,B1); G8_BAR;
    G8_LDA(At,0,1); G8_STAGE(G8_SA(0,0),A,brow,t+2);
    G8_BAR; G8_WL(0); G8_MMA(1,0,At,B0); G8_BAR; G8_SCHED;
    G8_STAGE(G8_SB(0,1),Bt,bcol+HALF,t+2);
    G8_WV(6); G8_BAR; G8_MMA(1,1,At,B1); G8_BAR;
    G8_LDB(B0,1,0); G8_SCHED; G8_LDA(At,1,0); G8_STAGE(G8_SA(0,1),A,brow+HALF,t+2);
    G8_WL(8); G8_BAR; G8_WL(0); G8_MMA(0,0,At,B0); G8_BAR; G8_SCHED;
    G8_LDB(B1,1,1); G8_STAGE(G8_SB(1,0),Bt,bcol,t+3);
    G8_BAR; G8_WL(0); G8_MMA(0,1,At,B1); G8_BAR;
    G8_LDA(At,1,1); G8_STAGE(G8_SA(1,0),A,brow,t+3);
    G8_BAR; G8_WL(0); G8_MMA(1,0,At,B0); G8_BAR; G8_SCHED;
    G8_STAGE(G8_SB(1,1),Bt,bcol+HALF,t+3);
    G8_WV(6); G8_BAR; G8_MMA(1,1,At,B1); G8_BAR;
  }
  { G8_LDB(B0,0,0); G8_LDA(At,0,0); G8_STAGE(G8_SA(1,1),A,brow+HALF,nt-1);
    G8_BAR; G8_WL(0); G8_MMA(0,0,At,B0); G8_BAR;
    G8_LDB(B1,0,1); G8_BAR; G8_WL(0); G8_MMA(0,1,At,B1); G8_BAR;
    G8_LDA(At,0,1); G8_WV(4); G8_BAR; G8_WL(0); G8_MMA(1,0,At,B0); G8_MMA(1,1,At,B1); G8_BAR; }
  { G8_LDB(B0,1,0); G8_LDA(At,1,0); G8_WV(2); G8_BAR; G8_WL(0); G8_MMA(0,0,At,B0); G8_BAR;
    G8_LDB(B1,1,1); G8_WV(0); G8_BAR; G8_WL(0); G8_MMA(0,1,At,B1); G8_BAR;
    G8_LDA(At,1,1); G8_BAR; G8_WL(0); G8_MMA(1,0,At,B0); G8_MMA(1,1,At,B1); G8_BAR; }
  if(wr==0)G8_BAR;
  __syncthreads();
}

DI void p1_tile(const Params& p, int layer, int mb, int nt) {
  const int tid = vtid(), lane = tid & 63, w = tid >> 6, wm = w >> 1, wn = w & 1, hi = lane >> 5, c31 = lane & 31;
  f32x16 acc[2][2];
  zero_acc(acc);
  gemm_core((const uint4*)(p.ws + O_HB), mb * 8, (const uint4*)(p.ws + O_WTIN), nt * 4, 64, acc, (uint4*)smem);
  unsigned short* tile = (unsigned short*)smem;
  const int row0 = mb * 256;
  const float* bin = p.b_in + (size_t)layer * NIN;
  const float* lbs = (const float*)(p.ws + O_LBS) + layer * 512;
#pragma unroll
  for (int j = 0; j < 2; ++j) {
    const int col = 64 * wn + 32 * j + c31;
    const int np = nt * 128 + col;
    const int oc = colmap(np);
    const float bias = oc >= 0 ? bin[oc] : 0.f;
    float lb = 0.f;
    if (nt >= 4 && nt < 8) lb = lbs[(nt - 4) * 128 + col];
#pragma unroll
    for (int i = 0; i < 2; ++i) {
#pragma unroll
      for (int r = 0; r < 16; ++r) {
        const int row = 64 * wm + 32 * i + crow(r, hi);
        float v = acc[i][j][r] + bias;
        float o;
        if (nt < 4) o = v;
        else if (nt < 8) {
          float sg = sigm(v);
          float f = lb + (1.f - lb) * sg;
          ((float*)(p.ws + O_G))[(size_t)(row0 + row) * 512 + (nt - 4) * 128 + col] = __logf(f);
          o = (1.f - lb) * (1.f - sg);
        } else if (nt < 12) o = v;
        else if (nt < 16) o = silu(v);
        else if (nt < 20) o = v * 0.125f;
        else if (nt < 28) o = v;
        else if (nt < 32) o = silu(v);
        else if (nt < 36) o = v;
        else if (nt < 52) o = sigm(v);
        else {
          o = v;
          if (col >= 64 && col < 72)
            ((float*)(p.ws + O_WI))[(size_t)(row0 + row) * 8 + (col - 64)] = v * 0.044194173824159216f;
        }
        tile[row * 128 + col] = f2bf(o);
      }
    }
  }
  __syncthreads();
#pragma unroll
  for (int q = 0; q < 8; ++q) {
    const int u = tid + 512 * q, r = u >> 4, c8 = u & 15;
    const uint4 val = *(const uint4*)&tile[r * 128 + c8 * 8];
    const int t = row0 + r;
    if (nt >= 20 && nt < 28) {
      int w0 = __builtin_amdgcn_cvt_pk_fp8_f32(bflo(val.x), bfhi(val.x), 0, false);
      w0 = __builtin_amdgcn_cvt_pk_fp8_f32(bflo(val.y), bfhi(val.y), w0, true);
      int w1 = __builtin_amdgcn_cvt_pk_fp8_f32(bflo(val.z), bfhi(val.z), 0, false);
      w1 = __builtin_amdgcn_cvt_pk_fp8_f32(bflo(val.w), bfhi(val.w), w1, true);
      const size_t base8 = (nt < 24) ? O_KB : O_VB;
      *(uint2*)(p.ws + base8 + (size_t)t * 512 + (nt & 3) * 128 + c8 * 8) = make_uint2((unsigned)w0, (unsigned)w1);
    } else if (nt < 32) {
      size_t base;
      switch (nt >> 2) {
        case 0: base = O_QA; break; case 1: base = O_KK; break; case 2: base = O_IA; break; case 3: base = O_ZA; break;
        case 4: base = O_QB; break; case 5: base = O_KB; break; case 6: base = O_VB; break; default: base = O_ZB; break;
      }
      *(uint4*)(p.ws + base + ((size_t)t * 512 + (nt & 3) * 128 + c8 * 8) * 2) = val;
    } else if (nt < 36) {
      const int head = 2 * (nt - 32) + (c8 >> 3), d0 = (c8 & 7) * 8;
      const int item = t >> 5, tq = t & 31, mtile = tq >> 2, q4 = tq & 3;
      const int rr = (head & 3) + 4 * (q4 >> 1) + 8 * (head >> 2) + 16 * (q4 & 1);
      const int laneA = rr + 32 * ((d0 >> 3) & 1), ks = d0 >> 4;
      ((uint4*)(p.ws + O_QI))[((size_t)(item * 8 + mtile) * 4 + ks) * 64 + laneA] = val;
    } else if (nt < 44) {
      *(uint4*)(p.ws + O_SGA + ((size_t)t * 1024 + (nt - 36) * 128 + c8 * 8) * 2) = val;
    } else if (nt < 52) {
      *(uint4*)(p.ws + O_SGB + ((size_t)t * 1024 + (nt - 44) * 128 + c8 * 8) * 2) = val;
    } else {
      if (c8 < 8) {
        const int d0 = c8 * 8;
        ((uint4*)(p.ws + O_KI))[((size_t)(t >> 5) * 4 + (d0 >> 4)) * 64 + (t & 31) + 32 * ((d0 >> 3) & 1)] = val;
      }
    }
  }
  __syncthreads();
}

constexpr int T8S = 264;
enum { C_PLAIN = 0, C_FA = 1, C_SILU = 2, C_QB = 3, C_SIGM = 4, C_KIWI = 5 };
DI float sigm_fast(float x) { return __builtin_amdgcn_rcpf(1.f + __builtin_amdgcn_exp2f(-1.4426950408889634f * x)); }
template <int CLS>
DI void p1_epi_write(const Params& p, f32x4g (&acc)[2][2][4][2], int layer, int nt2, int row0) {
  const int tid = vtid(), wid = tid >> 6, lane = tid & 63, wr = wid >> 2, wc = wid & 3, fr = lane & 15, fq = lane >> 4;
  unsigned short* tile = (unsigned short*)smem;
  const float* bin = p.b_in + (size_t)layer * NIN;
  const float* lbs = (const float*)(p.ws + O_LBS) + layer * 512;
  const int rbase = wr * 64 + fr;
#pragma unroll
  for (int bj = 0; bj < 2; ++bj) {
    if (CLS == C_KIWI && bj == 1) break;
    const int nt = 2 * nt2 + bj;
#pragma unroll
    for (int n = 0; n < 2; ++n) {
      const int c4 = wc * 32 + n * 16 + 4 * fq;
      const int np = nt * 128 + c4;
      float4 b4;
      if (CLS == C_KIWI) b4 = (c4 < 72) ? *(const float4*)(bin + (np - 2048)) : make_float4(0.f, 0.f, 0.f, 0.f);
      else if (CLS == C_SIGM) b4 = *(const float4*)(bin + (np + 72));
      else b4 = *(const float4*)(bin + np);
      float4 l4 = make_float4(0.f, 0.f, 0.f, 0.f);
      if (CLS == C_FA) l4 = *(const float4*)(lbs + (nt - 4) * 128 + c4);
#pragma unroll
      for (int ai = 0; ai < 2; ++ai)
#pragma unroll
        for (int m = 0; m < 4; ++m) {
          const int row = ai * 128 + m * 16 + rbase;
          const f32x4g a = acc[ai][bj][m][n];
          const float v0 = a[0] + b4.x, v1 = a[1] + b4.y, v2 = a[2] + b4.z, v3 = a[3] + b4.w;
          float o0, o1, o2, o3;
          if (CLS == C_PLAIN) { o0 = v0; o1 = v1; o2 = v2; o3 = v3; }
          else if (CLS == C_QB) { o0 = v0 * 0.125f; o1 = v1 * 0.125f; o2 = v2 * 0.125f; o3 = v3 * 0.125f; }
          else if (CLS == C_SILU) { o0 = v0 * sigm_fast(v0); o1 = v1 * sigm_fast(v1); o2 = v2 * sigm_fast(v2); o3 = v3 * sigm_fast(v3); }
          else if (CLS == C_SIGM) { o0 = sigm_fast(v0); o1 = sigm_fast(v1); o2 = sigm_fast(v2); o3 = sigm_fast(v3); }
          else if (CLS == C_FA) {
            const float s0 = sigm_fast(v0), s1 = sigm_fast(v1), s2 = sigm_fast(v2), s3 = sigm_fast(v3);
            float4 g;
            g.x = __logf(l4.x + (1.f - l4.x) * s0); g.y = __logf(l4.y + (1.f - l4.y) * s1);
            g.z = __logf(l4.z + (1.f - l4.z) * s2); g.w = __logf(l4.w + (1.f - l4.w) * s3);
            *(float4*)((float*)(p.ws + O_G) + (size_t)(row0 + row) * 512 + (nt - 4) * 128 + c4) = g;
            o0 = (1.f - l4.x) * (1.f - s0); o1 = (1.f - l4.y) * (1.f - s1); o2 = (1.f - l4.z) * (1.f - s2); o3 = (1.f - l4.w) * (1.f - s3);
          } else {
            o0 = v0; o1 = v1; o2 = v2; o3 = v3;
            if (c4 >= 64 && c4 < 72) {
              const float sc = 0.044194173824159216f;
              *(float4*)((float*)(p.ws + O_WI) + (size_t)(row0 + row) * 8 + (c4 - 64)) = make_float4(v0 * sc, v1 * sc, v2 * sc, v3 * sc);
            }
          }
          *(uint2*)(tile + row * T8S + 128 * bj + c4) = make_uint2(cvtpk(o0, o1), cvtpk(o2, o3));
        }
    }
  }
}

DI void p1_tile8(const Params& p, int layer, int mb, int nt2) {
  f32x4g acc[2][2][4][2];
#pragma unroll
  for (int a = 0; a < 2; ++a)
#pragma unroll
    for (int b = 0; b < 2; ++b)
#pragma unroll
      for (int m = 0; m < 4; ++m)
#pragma unroll
        for (int n = 0; n < 2; ++n) acc[a][b][m][n] = f32x4g{0.f, 0.f, 0.f, 0.f};
  gemm8p((const unsigned short*)(p.ws + O_HB), (const unsigned short*)(p.ws + O_WTIN), 1024, mb * 256, nt2 * 256, acc, (unsigned short*)smem);
  __builtin_amdgcn_sched_barrier(0);
  asm volatile("" ::: "memory");
  const int row0 = mb * 256;
  if (nt2 < 2) p1_epi_write<C_PLAIN>(p, acc, layer, nt2, row0);
  else if (nt2 < 4) p1_epi_write<C_FA>(p, acc, layer, nt2, row0);
  else if (nt2 < 6) p1_epi_write<C_PLAIN>(p, acc, layer, nt2, row0);
  else if (nt2 < 8) p1_epi_write<C_SILU>(p, acc, layer, nt2, row0);
  else if (nt2 < 10) p1_epi_write<C_QB>(p, acc, layer, nt2, row0);
  else if (nt2 < 14) p1_epi_write<C_PLAIN>(p, acc, layer, nt2, row0);
  else if (nt2 < 16) p1_epi_write<C_SILU>(p, acc, layer, nt2, row0);
  else if (nt2 < 18) p1_epi_write<C_PLAIN>(p, acc, layer, nt2, row0);
  else if (nt2 < 26) p1_epi_write<C_SIGM>(p, acc, layer, nt2, row0);
  else p1_epi_write<C_KIWI>(p, acc, layer, nt2, row0);
  __syncthreads();
  const int tid = vtid();
  const unsigned short* tile = (const unsigned short*)smem;
  const int c32 = tid & 31, rq = tid >> 5;
  if (nt2 >= 10 && nt2 < 14) {
    char* dst = p.ws + (nt2 < 12 ? O_KB : O_VB) + (size_t)row0 * 512 + (nt2 & 1) * 256 + c32 * 8;
#pragma unroll 4
    for (int q = 0; q < 16; ++q) {
      const int r = rq + 16 * q;
      const uint4 val = *(const uint4*)(tile + r * T8S + c32 * 8);
      int w0 = __builtin_amdgcn_cvt_pk_fp8_f32(bflo(val.x), bfhi(val.x), 0, false);
      w0 = __builtin_amdgcn_cvt_pk_fp8_f32(bflo(val.y), bfhi(val.y), w0, true);
      int w1 = __builtin_amdgcn_cvt_pk_fp8_f32(bflo(val.z), bfhi(val.z), 0, false);
      w1 = __builtin_amdgcn_cvt_pk_fp8_f32(bflo(val.w), bfhi(val.w), w1, true);
      *(uint2*)(dst + (size_t)r * 512) = make_uint2((unsigned)w0, (unsigned)w1);
    }
  } else if (nt2 < 16) {
    size_t base;
    switch (nt2 >> 1) {
      case 0: base = O_QA; break; case 1: base = O_KK; break; case 2: base = O_IA; break; case 3: base = O_ZA; break;
      case 4: base = O_QB; break; default: base = O_ZB; break;
    }
    char* dst = p.ws + base + ((size_t)row0 * 512 + (nt2 & 1) * 256 + c32 * 8) * 2;
#pragma unroll 4
    for (int q = 0; q < 16; ++q) {
      const int r = rq + 16 * q;
      *(uint4*)(dst + (size_t)r * 1024) = *(const uint4*)(tile + r * T8S + c32 * 8);
    }
  } else if (nt2 < 18) {
    const int head = 4 * (nt2 - 16) + (c32 >> 3), d0 = (c32 & 7) * 8;
#pragma unroll 4
    for (int q = 0; q < 16; ++q) {
      const int r = rq + 16 * q, t = row0 + r;
      const int item = t >> 5, tq = t & 31, mtile = tq >> 2, q4 = tq & 3;
      const int rr = (head & 3) + 4 * (q4 >> 1) + 8 * (head >> 2) + 16 * (q4 & 1);
      const int laneA = rr + 32 * ((d0 >> 3) & 1), ks = d0 >> 4;
      ((uint4*)(p.ws + O_QI))[((size_t)(item * 8 + mtile) * 4 + ks) * 64 + laneA] = *(const uint4*)(tile + r * T8S + c32 * 8);
    }
  } else if (nt2 < 26) {
    char* dst = p.ws + (nt2 < 22 ? O_SGA : O_SGB) + ((size_t)row0 * 1024 + ((nt2 - 18) & 3) * 256 + c32 * 8) * 2;
#pragma unroll 4
    for (int q = 0; q < 16; ++q) {
      const int r = rq + 16 * q;
      *(uint4*)(dst + (size_t)r * 2048) = *(const uint4*)(tile + r * T8S + c32 * 8);
    }
  } else {
    if (c32 < 8) {
      const int d0 = c32 * 8;
#pragma unroll 4
      for (int q = 0; q < 16; ++q) {
        const int r = rq + 16 * q, t = row0 + r;
        ((uint4*)(p.ws + O_KI))[((size_t)(t >> 5) * 4 + (d0 >> 4)) * 64 + (t & 31) + 32 * ((d0 >> 3) & 1)] = *(const uint4*)(tile + r * T8S + c32 * 8);
      }
    }
  }
  asm volatile("s_waitcnt lgkmcnt(0)" ::: "memory");
  __builtin_amdgcn_s_barrier();
}

constexpr int CAP = 1000, SEGCAP = 250, SEGTRIG = 186;
constexpr int IX_SC = 0, IX_IX = 64000, IX_RING = 96000, IX_CNT = 161536, IX_TAU = 161792, IX_FLAG = 161856, IX_WL = 161872;

DI float key2float(unsigned k) {
  unsigned b = (k & 0x80000000u) ? (k ^ 0x80000000u) : ~k;
  return __uint_as_float(b);
}
DI unsigned float2key(float f) {
  unsigned b = __float_as_uint(f);
  return (b & 0x80000000u) ? ~b : (b ^ 0x80000000u);
}
DI int wave_prefix_incl(int x) {
  int v = x;
  v += __builtin_amdgcn_update_dpp(0, v, 0x111, 0xf, 0xf, false);
  v += __builtin_amdgcn_update_dpp(0, v, 0x112, 0xf, 0xf, false);
  v += __builtin_amdgcn_update_dpp(0, v, 0x114, 0xf, 0xf, false);
  v += __builtin_amdgcn_update_dpp(0, v, 0x118, 0xf, 0xf, false);
  v += __builtin_amdgcn_update_dpp(0, v, 0x142, 0xa, 0xf, false);
  v += __builtin_amdgcn_update_dpp(0, v, 0x143, 0xc, 0xf, false);
  return v;
}

#define SEG_ADDR(j_) (((j_) >> 2) * SEGCAP + lane + 64 * ((j_) & 3))
DI int seg_count(const int4 c4, int s_) { return s_ == 0 ? c4.x : (s_ == 1 ? c4.y : (s_ == 2 ? c4.z : c4.w)); }

DI void wave_select(float* scq, unsigned short* ixq, int* cnt4q, float* tauq, unsigned* hist, int lane, unsigned short* final_sel) {
  lds_fence();
  const int4 c4 = *(const int4*)cnt4q;
  const int n = c4.x + c4.y + c4.z + c4.w;
  unsigned u[16], v16[16];
  unsigned mm = 0, am = 0;
#pragma unroll
  for (int j = 0; j < 16; ++j) {
    const bool valid = (lane + 64 * (j & 3)) < seg_count(c4, j >> 2);
    const float sv = valid ? scq[SEG_ADDR(j)] : 0.f;
    const unsigned id = valid ? (unsigned)ixq[SEG_ADDR(j)] : 0u;
    u[j] = float2key(sv);
    v16[j] = 0xFFFFu - id;
    mm |= (((unsigned)(lane + 64 * (j & 3)) - (unsigned)seg_count(c4, j >> 2)) >> 31) << j;
  }
  unsigned prefix_u = 0;
  if (n > 256) {
    int need = 256;
    int r0 = 0;
    {
      unsigned ref = 0; bool have = false;
#pragma unroll
      for (int j = 15; j >= 0; --j) if ((mm >> j) & 1u) { ref = u[j] >> 24; have = true; }
      const unsigned long long hm = __ballot(have);
      const int fl = __ffsll((long long)hm) - 1;
      ref = (unsigned)__builtin_amdgcn_readlane((int)ref, fl);
      bool same = true;
#pragma unroll
      for (int j = 0; j < 16; ++j) same = same && (!((mm >> j) & 1u) || ((u[j] >> 24) == ref));
      if (__all(same)) { prefix_u = ref << 24; r0 = 1; }
    }
    for (int r = r0; r < 6; ++r) {
      const int sh = (r < 4) ? (24 - 8 * r) : (r == 4 ? 8 : 0);
      { const unsigned z_ = vzero(); ((uint4*)hist)[lane] = make_uint4(z_, z_, z_, z_); }
      lds_fence();
#pragma unroll
      for (int j = 0; j < 16; ++j) {
        const unsigned src = (r < 4) ? u[j] : v16[j];
        const unsigned dgt = ((mm >> j) & 1u) ? ((src >> sh) & 255u) : 256u + lane;
        atomicAdd(&hist[dgt], 1u);
      }
      lds_fence();
      const uint4 hv = ((const uint4*)hist)[lane];
      const int c0 = hv.x, c1 = hv.y, c2 = hv.z, c3 = hv.w;
      const int Lsum = c0 + c1 + c2 + c3;
      const int Pfx = wave_prefix_incl(Lsum);
      const int total = __builtin_amdgcn_readlane(Pfx, 63);
      const int S = total - Pfx + Lsum;
      const unsigned long long mask = __ballot(S >= need);
      const int lstar = 63 - __clzll((long long)mask);
      int d_, ca_, cd_;
      {
        const int accu = S - Lsum;
        if (accu + c3 >= need) { d_ = 3; ca_ = accu; cd_ = c3; }
        else if (accu + c3 + c2 >= need) { d_ = 2; ca_ = accu + c3; cd_ = c2; }
        else if (accu + c3 + c2 + c1 >= need) { d_ = 1; ca_ = accu + c3 + c2; cd_ = c1; }
        else { d_ = 0; ca_ = accu + c3 + c2 + c1; cd_ = c0; }
      }
      const int D = __builtin_amdgcn_readlane(4 * lane + d_, lstar);
      const int cntAbove = __builtin_amdgcn_readlane(ca_, lstar);
      const int cntD = __builtin_amdgcn_readlane(cd_, lstar);
#pragma unroll
      for (int j = 0; j < 16; ++j) {
        const unsigned src = (r < 4) ? u[j] : v16[j];
        const int dgt = (int)((src >> sh) & 255u);
        const unsigned bit = mm & (1u << j);
        const unsigned dd = (unsigned)D - (unsigned)dgt, de = (unsigned)dgt - (unsigned)D;
        const unsigned gtm = (unsigned)((int)dd >> 31);
        const unsigned nem = (unsigned)((int)(dd | de) >> 31);
        am |= bit & gtm;
        mm ^= bit & nem;
      }
      need -= cntAbove;
      if (r < 4) prefix_u |= ((unsigned)D) << sh;
      if (cntD == need) break;
    }
  }
  const unsigned km = am | mm;
  int base = 0;
#pragma unroll
  for (int j = 0; j < 16; ++j) {
    const bool keep = (km >> j) & 1u;
    const unsigned long long m = __ballot(keep);
    const int rk = base + __popcll(m & ((1ull << lane) - 1ull));
    if (keep) {
      if (final_sel) { if (rk < 256) final_sel[rk] = (unsigned short)(0xFFFFu - v16[j]); }
      else { const int ad = (rk & 3) * SEGCAP + (rk >> 2); scq[ad] = key2float(u[j]); ixq[ad] = (unsigned short)(0xFFFFu - v16[j]); }
    }
    base += __popcll(m);
  }
  if (!final_sel && lane == 0) {
    *(int4*)cnt4q = make_int4((base + 3) >> 2, (base + 2) >> 2, (base + 1) >> 2, base >> 2);
    if (n > 256) *tauq = key2float(prefix_u);
  }
  lds_fence();
}

typedef float f32x2v __attribute__((ext_vector_type(2)));
DI float relu_(float x) { int i = __float_as_int(x); i = i > 0 ? i : 0; return __int_as_float(i); }

DI unsigned wave_umin(unsigned v) {
#define UMIN_STEP(ctrl, rm) { const unsigned o_ = (unsigned)__builtin_amdgcn_update_dpp((int)0xFFFFFFFFu, (int)v, ctrl, rm, 0xf, false); v = o_ < v ? o_ : v; }
  UMIN_STEP(0x111, 0xf) UMIN_STEP(0x112, 0xf) UMIN_STEP(0x114, 0xf) UMIN_STEP(0x118, 0xf) UMIN_STEP(0x142, 0xa) UMIN_STEP(0x143, 0xc)
#undef UMIN_STEP
  return (unsigned)__builtin_amdgcn_readlane((int)v, 63);
}
DI unsigned wave_umax(unsigned v) {
#define UMAX_STEP(ctrl, rm) { const unsigned o_ = (unsigned)__builtin_amdgcn_update_dpp(0, (int)v, ctrl, rm, 0xf, false); v = o_ > v ? o_ : v; }
  UMAX_STEP(0x111, 0xf) UMAX_STEP(0x112, 0xf) UMAX_STEP(0x114, 0xf) UMAX_STEP(0x118, 0xf) UMAX_STEP(0x142, 0xa) UMAX_STEP(0x143, 0xc)
#undef UMAX_STEP
  return (unsigned)__builtin_amdgcn_readlane((int)v, 63);
}
DI void wave_compact(float* scq, unsigned short* ixq, int* cnt4q, float* tauq, unsigned* hist, int lane) {
  lds_fence();
  const int4 c4 = *(const int4*)cnt4q;
  const int n = c4.x + c4.y + c4.z + c4.w;
  if (n <= 320) return;
  unsigned u[16], idv[16];
  unsigned vm = 0;
  unsigned umin = 0xFFFFFFFFu, umax = 0u;
  { const unsigned z_ = vzero(); ((uint4*)hist)[lane] = make_uint4(z_, z_, z_, z_); }

#pragma unroll
  for (int j = 0; j < 16; ++j) {
    const bool valid = (lane + 64 * (j & 3)) < seg_count(c4, j >> 2);
    u[j] = valid ? float2key(scq[SEG_ADDR(j)]) : 0u;
    idv[j] = valid ? (unsigned)ixq[SEG_ADDR(j)] : 0u;
    vm |= (((unsigned)(lane + 64 * (j & 3)) - (unsigned)seg_count(c4, j >> 2)) >> 31) << j;
    umin = valid ? (u[j] < umin ? u[j] : umin) : umin;
    umax = valid ? (u[j] > umax ? u[j] : umax) : umax;
  }
  umin = wave_umin(umin);
  umax = wave_umax(umax);
  const unsigned range = umax - umin;
  const int sh = range < 256u ? 0 : (24 - __clz((int)range));
#pragma unroll
  for (int j = 0; j < 16; ++j) {
    const unsigned bin = ((vm >> j) & 1u) ? ((u[j] - umin) >> sh) : 256u + lane;
    atomicAdd(&hist[bin], 1u);
  }
  lds_fence();
  const uint4 hv = ((const uint4*)hist)[lane];
  const int c0 = hv.x, c1 = hv.y, c2 = hv.z, c3 = hv.w;
  const int Lsum = c0 + c1 + c2 + c3;
  const int Pfx = wave_prefix_incl(Lsum);
  const int total = __builtin_amdgcn_readlane(Pfx, 63);
  const int S = total - Pfx + Lsum;
  const unsigned long long mask = __ballot(S >= 256);
  const int lstar = 63 - __clzll((long long)mask);
  int d_, kept_;
  {
    const int accu = S - Lsum;
    if (accu + c3 >= 256) { d_ = 3; kept_ = accu + c3; }
    else if (accu + c3 + c2 >= 256) { d_ = 2; kept_ = accu + c3 + c2; }
    else if (accu + c3 + c2 + c1 >= 256) { d_ = 1; kept_ = accu + c3 + c2 + c1; }
    else { d_ = 0; kept_ = accu + Lsum; }
  }
  const int D = __builtin_amdgcn_readlane(4 * lane + d_, lstar);
  const int kept = __builtin_amdgcn_readlane(kept_, lstar);
  if (kept > 400) return;
  int base = 0;
#pragma unroll
  for (int j = 0; j < 16; ++j) {
    const bool keep = ((vm >> j) & 1u) && ((int)((u[j] - umin) >> sh) >= D);
    const unsigned long long m = __ballot(keep);
    const int rk = base + __popcll(m & ((1ull << lane) - 1ull));
    if (keep) { const int ad = (rk & 3) * SEGCAP + (rk >> 2); scq[ad] = key2float(u[j]); ixq[ad] = (unsigned short)idv[j]; }
    base += __popcll(m);
  }
  if (lane == 0) {
    *(int4*)cnt4q = make_int4((base + 3) >> 2, (base + 2) >> 2, (base + 1) >> 2, base >> 2);
    *tauq = key2float(umin + ((unsigned)D << sh));
  }
  lds_fence();
}

#define IDX_GLDS(step, bufi) do { _Pragma("unroll") for (int r_ = 0; r_ < 4; ++r_) \
    __builtin_amdgcn_global_load_lds((const unsigned*)(ki + (size_t)(step) * 2048 + tid + 512 * r_), \
                                     (unsigned*)(ring + (bufi) * 2048 + tid + 512 * r_), 16, 0, 0); } while (0)

DI void indexer_item(const Params& p, int item) {
  const int tid = vtid(), lane = tid & 63, w = tid >> 6, g = w & 1, kg = w >> 1, hi = lane >> 5, c31 = lane & 31;
  float* sc = (float*)(smem + IX_SC);
  unsigned short* ix = (unsigned short*)(smem + IX_IX);
  uint4* ring = (uint4*)(smem + IX_RING);
  int* cnt = (int*)(smem + IX_CNT);
  volatile int* flag = (volatile int*)(smem + IX_FLAG);
  float* tauv = (float*)(smem + IX_TAU);
  const uint4* qi = (const uint4*)(p.ws + O_QI);
  const uint4* ki = (const uint4*)(p.ws + O_KI);
  const float* wi = (const float*)(p.ws + O_WI);
  const int t0 = 16 * item;
  bf16x8 a[2][4];
#pragma unroll
  for (int mt = 0; mt < 2; ++mt)
#pragma unroll
    for (int ks = 0; ks < 4; ++ks)
      a[mt][ks] = __builtin_bit_cast(bf16x8, qi[((size_t)((item >> 1) * 8 + (item & 1) * 4 + 2 * g + mt) * 4 + ks) * 64 + lane]);
  float* wl = (float*)(smem + IX_WL);
  if (tid < 128) wl[tid] = wi[(size_t)t0 * 8 + tid];
  float tau[2][2];
#pragma unroll
  for (int mt = 0; mt < 2; ++mt) { tau[mt][0] = -INFINITY; tau[mt][1] = -INFINITY; }
  if (tid < 64) cnt[tid] = 0;
  if (tid < 16) tauv[tid] = -INFINITY;
  int cntv[2][2] = {{0, 0}, {0, 0}};
  if (tid < 2) flag[tid] = 0;
  const int nsteps = (t0 + 16 + 255) >> 8;
  asm volatile("s_waitcnt vmcnt(0)" ::: "memory");
  IDX_GLDS(0, 0);
  if (nsteps > 1) { IDX_GLDS(1, 1); asm volatile("s_waitcnt vmcnt(4)" ::: "memory"); }
  else asm volatile("s_waitcnt vmcnt(0)" ::: "memory");
  __syncthreads();
  const f32x16 z = {0.f, 0.f, 0.f, 0.f, 0.f, 0.f, 0.f, 0.f, 0.f, 0.f, 0.f, 0.f, 0.f, 0.f, 0.f, 0.f};
  f32x16 Ca0, Ca1, Cb0, Cb1;
  {
    const uint4* cur = ring;
    const uint4* bp = cur + ((2 * kg + 0) * 4) * 64 + lane;
    bf16x8 b0 = __builtin_bit_cast(bf16x8, bp[0]), b1 = __builtin_bit_cast(bf16x8, bp[64]);
    bf16x8 b2 = __builtin_bit_cast(bf16x8, bp[128]), b3 = __builtin_bit_cast(bf16x8, bp[192]);
    Ca0 = MFMA(a[0][0], b0, z); Ca1 = MFMA(a[1][0], b0, z);
    Ca0 = MFMA(a[0][1], b1, Ca0); Ca1 = MFMA(a[1][1], b1, Ca1);
    Ca0 = MFMA(a[0][2], b2, Ca0); Ca1 = MFMA(a[1][2], b2, Ca1);
    Ca0 = MFMA(a[0][3], b3, Ca0); Ca1 = MFMA(a[1][3], b3, Ca1);
  }
#define IDX_SCORE(Cx, mt_, aa_, sout) do { const float4 wa_ = *(const float4*)(wl + (8 * g + 4 * (mt_) + 2 * hi + (aa_)) * 8); \
    const float4 wb_ = *(const float4*)(wl + (8 * g + 4 * (mt_) + 2 * hi + (aa_)) * 8 + 4); \
    f32x2v r0_ = {relu_(Cx[8 * (aa_) + 0]), relu_(Cx[8 * (aa_) + 1])}, r1_ = {relu_(Cx[8 * (aa_) + 2]), relu_(Cx[8 * (aa_) + 3])}; \
    f32x2v r2_ = {relu_(Cx[8 * (aa_) + 4]), relu_(Cx[8 * (aa_) + 5])}, r3_ = {relu_(Cx[8 * (aa_) + 6]), relu_(Cx[8 * (aa_) + 7])}; \
    const f32x2v w0_ = {wa_.x, wa_.y}, w1_ = {wa_.z, wa_.w}, w2_ = {wb_.x, wb_.y}, w3_ = {wb_.z, wb_.w}; \
    f32x2v ac_ = r0_ * w0_; ac_ = r1_ * w1_ + ac_; ac_ = r2_ * w2_ + ac_; ac_ = r3_ * w3_ + ac_; \
    sout = ac_.x + ac_.y; } while (0)
  const unsigned ltm = (1u << c31) - 1u;
  const int tqb = t0 + 8 * g + 2 * hi;
  const int sb0 = ((8 * g + 2 * hi) * CAP + kg * SEGCAP) * 4;
#define IDX_APPEND(sval, mt_, aa_, keyv) do { \
    const bool pr_ = ((keyv) <= tqb + 4 * (mt_) + (aa_)) && ((sval) >= tau[mt_][aa_]); \
    const unsigned long long bm_ = __builtin_amdgcn_ballot_w64(pr_); \
    const unsigned half_ = hi ? (unsigned)(bm_ >> 32) : (unsigned)bm_; \
    const int pos_ = cntv[mt_][aa_] + __popc(half_ & ltm); \
    if (pr_) { const int bo_ = sb0 + (4 * (mt_) + (aa_)) * CAP * 4 + pos_ * 4; \
      *(float*)((char*)sc + bo_) = (sval); *(unsigned short*)((char*)ix + (bo_ >> 1)) = (unsigned short)(keyv); } \
    cntv[mt_][aa_] += __popc(half_); } while (0)
#define IDX_PUBLISH() do { if (c31 == 0) { _Pragma("unroll") for (int mt_ = 0; mt_ < 2; ++mt_) _Pragma("unroll") for (int aa_ = 0; aa_ < 2; ++aa_) \
    cnt[4 * (8 * g + 4 * mt_ + 2 * hi + aa_) + kg] = cntv[mt_][aa_]; } } while (0)
  for (int j = 0; j < nsteps; ++j) {
    const uint4* cur = ring + (j & 1) * 2048;
    {
      const uint4* bp = cur + ((2 * kg + 1) * 4) * 64 + lane;
      bf16x8 b0 = __builtin_bit_cast(bf16x8, bp[0]), b1 = __builtin_bit_cast(bf16x8, bp[64]);
      bf16x8 b2 = __builtin_bit_cast(bf16x8, bp[128]), b3 = __builtin_bit_cast(bf16x8, bp[192]);
      Cb0 = MFMA(a[0][0], b0, z); Cb1 = MFMA(a[1][0], b0, z);
      Cb0 = MFMA(a[0][1], b1, Cb0); Cb1 = MFMA(a[1][1], b1, Cb1);
      Cb0 = MFMA(a[0][2], b2, Cb0); Cb1 = MFMA(a[1][2], b2, Cb1);
      Cb0 = MFMA(a[0][3], b3, Cb0); Cb1 = MFMA(a[1][3], b3, Cb1);
    }
    {
      const int key = 256 * j + 64 * kg + c31;
      float s00, s01, s10, s11;
      IDX_SCORE(Ca0, 0, 0, s00); IDX_SCORE(Ca0, 0, 1, s01); IDX_SCORE(Ca1, 1, 0, s10); IDX_SCORE(Ca1, 1, 1, s11);
#pragma unroll
      for (int q_ = 0; q_ < 8; ++q_) { __builtin_amdgcn_sched_group_barrier(0x008, 1, 0); __builtin_amdgcn_sched_group_barrier(0x002, 9, 0); }
      IDX_APPEND(s00, 0, 0, key); IDX_APPEND(s01, 0, 1, key); IDX_APPEND(s10, 1, 0, key); IDX_APPEND(s11, 1, 1, key);
    }
    IDX_PUBLISH();
    {
      const int mxc = max(max(cntv[0][0], cntv[0][1]), max(cntv[1][0], cntv[1][1]));
      if (__ballot(mxc > SEGTRIG) != 0ull) { if (lane == 0) flag[j & 1] = j + 1; }
    }
    __syncthreads();
    if (flag[j & 1] == j + 1) {
      unsigned* hist = (unsigned*)(ring + (j & 1) * 2048) + w * 512;
#pragma unroll 1
      for (int k = 0; k < 2; ++k) {
        const int q = 2 * w + k;
        wave_compact(sc + q * CAP, ix + q * CAP, cnt + 4 * q, tauv + q, hist, lane);
        lds_fence();
        { const int4 cc = *(const int4*)(cnt + 4 * q); if (cc.x + cc.y + cc.z + cc.w > 400) wave_select(sc + q * CAP, ix + q * CAP, cnt + 4 * q, tauv + q, hist, lane, nullptr); }
      }
      __syncthreads();
#pragma unroll
      for (int mt = 0; mt < 2; ++mt)
#pragma unroll
        for (int aa = 0; aa < 2; ++aa) { const int ql = 8 * g + 4 * mt + 2 * hi + aa; tau[mt][aa] = tauv[ql]; cntv[mt][aa] = cnt[4 * ql + kg]; }
    }
    if (j + 2 < nsteps) IDX_GLDS(j + 2, j & 1);
    if (j + 1 < nsteps) {
      const uint4* nxt = ring + ((j + 1) & 1) * 2048;
      const uint4* bp = nxt + ((2 * kg + 0) * 4) * 64 + lane;
      bf16x8 b0 = __builtin_bit_cast(bf16x8, bp[0]), b1 = __builtin_bit_cast(bf16x8, bp[64]);
      bf16x8 b2 = __builtin_bit_cast(bf16x8, bp[128]), b3 = __builtin_bit_cast(bf16x8, bp[192]);
      Ca0 = MFMA(a[0][0], b0, z); Ca1 = MFMA(a[1][0], b0, z);
      Ca0 = MFMA(a[0][1], b1, Ca0); Ca1 = MFMA(a[1][1], b1, Ca1);
      Ca0 = MFMA(a[0][2], b2, Ca0); Ca1 = MFMA(a[1][2], b2, Ca1);
      Ca0 = MFMA(a[0][3], b3, Ca0); Ca1 = MFMA(a[1][3], b3, Ca1);
    }
    {
      const int key = 256 * j + 64 * kg + 32 + c31;
      float s00, s01, s10, s11;
      IDX_SCORE(Cb0, 0, 0, s00); IDX_SCORE(Cb0, 0, 1, s01); IDX_SCORE(Cb1, 1, 0, s10); IDX_SCORE(Cb1, 1, 1, s11);
#pragma unroll
      for (int q_ = 0; q_ < 8; ++q_) { __builtin_amdgcn_sched_group_barrier(0x008, 1, 0); __builtin_amdgcn_sched_group_barrier(0x002, 9, 0); }
      IDX_APPEND(s00, 0, 0, key); IDX_APPEND(s01, 0, 1, key); IDX_APPEND(s10, 1, 0, key); IDX_APPEND(s11, 1, 1, key);
    }
  }
  IDX_PUBLISH();
  __syncthreads();
  unsigned short* sel = (unsigned short*)(p.ws + O_SEL);
  unsigned* hist = (unsigned*)ring + w * 512;
#pragma unroll 1
  for (int k = 0; k < 2; ++k) {
    const int q = 2 * w + k;
    wave_select(sc + q * CAP, ix + q * CAP, cnt + 4 * q, tauv + q, hist, lane, sel + (size_t)(t0 + q) * 256);
  }
  __syncthreads();
}

DI void hgrn_a_item(const Params& p, int c, int h) {
  const int tid = vtid(), lane = tid & 63, w = tid >> 6, hi = lane >> 5, c31 = lane & 31;
  float* tot = (float*)smem;
  unsigned short* kT = (unsigned short*)(smem + 2048);
  unsigned short* vT = (unsigned short*)(smem + 2048 + 18432);
  const int seg = tid >> 7, k = tid & 127;
  const float* G = (const float*)(p.ws + O_G);
  const unsigned short* KK = (const unsigned short*)(p.ws + O_KK);
  const unsigned short* IA = (const unsigned short*)(p.ws + O_IA);
  const size_t rowbase = (size_t)(64 * c + 16 * seg);
  float b[16];
  {
    float run = 0.f;
#pragma unroll
    for (int i = 0; i < 16; ++i) { run += G[(rowbase + i) * 512 + 128 * h + k]; b[i] = run; }
    tot[seg * 128 + k] = run;
  }
  __syncthreads();
  float off = 0.f, blast = 0.f;
#pragma unroll
  for (int s2 = 0; s2 < 4; ++s2) { float tv = tot[s2 * 128 + k]; if (s2 < seg) off += tv; blast += tv; }
  {
    unsigned pk[8], pv[8];
#pragma unroll
    for (int i = 0; i < 16; i += 2) {
      float k0 = bf2f(KK[(rowbase + i) * 512 + 128 * h + k]) * __expf(blast - (b[i] + off));
      float k1 = bf2f(KK[(rowbase + i + 1) * 512 + 128 * h + k]) * __expf(blast - (b[i + 1] + off));
      pk[i >> 1] = cvtpk(k0, k1);
      unsigned v0 = IA[(rowbase + i) * 512 + 128 * h + k], v1 = IA[(rowbase + i + 1) * 512 + 128 * h + k];
      pv[i >> 1] = v0 | (v1 << 16);
    }
    uint4* dk = (uint4*)(kT + k * 72 + 16 * seg);
    dk[0] = make_uint4(pk[0], pk[1], pk[2], pk[3]); dk[1] = make_uint4(pk[4], pk[5], pk[6], pk[7]);
    uint4* dv = (uint4*)(vT + k * 72 + 16 * seg);
    dv[0] = make_uint4(pv[0], pv[1], pv[2], pv[3]); dv[1] = make_uint4(pv[4], pv[5], pv[6], pv[7]);
    if (seg == 0) ((float*)(p.ws + O_D))[(size_t)(c * 4 + h) * 128 + k] = __expf(blast);
  }
  __syncthreads();
  const int mt = w >> 1;
  f32x16 acc[2];
#pragma unroll
  for (int r = 0; r < 16; ++r) { acc[0][r] = 0.f; acc[1][r] = 0.f; }
#pragma unroll
  for (int ks = 0; ks < 4; ++ks) {
    bf16x8 af = __builtin_bit_cast(bf16x8, *(const uint4*)(kT + (32 * mt + c31) * 72 + 16 * ks + 8 * hi));
#pragma unroll
    for (int jn = 0; jn < 2; ++jn) {
      const int nt = 2 * (w & 1) + jn;
      bf16x8 bfv = __builtin_bit_cast(bf16x8, *(const uint4*)(vT + (32 * nt + c31) * 72 + 16 * ks + 8 * hi));
      acc[jn] = MFMA(af, bfv, acc[jn]);
    }
  }
  char* us = p.ws + O_US + (size_t)(c * 4 + h) * 32768;
#pragma unroll
  for (int jn = 0; jn < 2; ++jn) {
    const int nt = 2 * (w & 1) + jn;
    const int v = 32 * nt + c31;
#pragma unroll
    for (int gq = 0; gq < 4; ++gq) {
      const int k0 = 32 * mt + 8 * gq;
      const size_t unit = ((size_t)(v >> 5) * 8 + (k0 >> 4)) * 64 + (v & 31) + 32 * ((k0 >> 3) & 1);
      uint2 val;
      val.x = cvtpk(acc[jn][4 * gq + 0], acc[jn][4 * gq + 1]);
      val.y = cvtpk(acc[jn][4 * gq + 2], acc[jn][4 * gq + 3]);
      *(uint2*)(us + unit * 16 + 8 * hi) = val;
    }
  }
  __syncthreads();
}

DI void hgrn_scan(const Params& p) {
  const int tid = vtid();
  if (tid >= 128) return;
  for (int pid = blockIdx.x * 128 + tid; pid < 32768; pid += gridDim.x * 128) {
    const int q4 = pid & 3, unit = (pid >> 2) & 2047, h = pid >> 13;
    const int lanep = unit & 63, ks = (unit >> 6) & 7;
    const int k = ks * 16 + 8 * (lanep >> 5) + 2 * q4;
    unsigned* us = (unsigned*)(p.ws + O_US) + (size_t)h * 8192 + unit * 4 + q4;
    const float* dd = (const float*)(p.ws + O_D) + h * 128 + k;
    float s0 = 0.f, s1 = 0.f;
    for (int c0 = 0; c0 < 256; c0 += 16) {
      unsigned uv[16];
      float2 dv[16];
#pragma unroll
      for (int i = 0; i < 16; ++i) {
        uv[i] = us[(size_t)(c0 + i) * 32768];
        dv[i] = *(const float2*)(dd + (size_t)(c0 + i) * 512);
      }
#pragma unroll
      for (int i = 0; i < 16; ++i) {
        us[(size_t)(c0 + i) * 32768] = cvtpk(s0, s1);
        s0 = fmaf(dv[i].x, s0, bflo(uv[i]));
        s1 = fmaf(dv[i].y, s1, bfhi(uv[i]));
      }
    }
  }
}

constexpr int AT_LUT = 0, AT_RB = 512, AT_WAVE = 2048, AT_WSZ = 8192 + 1024 + 16 * 528;
DI void attn_setup() {
  const int tid = vtid();
  int* lut = (int*)(smem + AT_LUT);
  if (tid < 128) {
    int d = tid;
    int bk;
    if (d < 16) bk = d;
    else {
      float df = (float)d;
      int lg = 16 + (int)(logf(df / 16.f) / 2.0794415416798357f * 16.f);
      bk = lg < 31 ? lg : 31;
    }
    lut[tid] = bk;
  }
}
DI float dppf(float v, int ctrl_sel) {
  const int iv = __builtin_bit_cast(int, v);
  int r;
  if (ctrl_sel == 0) r = __builtin_amdgcn_update_dpp(0, iv, 0xB1, 0xf, 0xf, false);
  else if (ctrl_sel == 1) r = __builtin_amdgcn_update_dpp(0, iv, 0x4E, 0xf, 0xf, false);
  else r = __builtin_amdgcn_update_dpp(0, iv, 0x141, 0xf, 0xf, false);
  return __builtin_bit_cast(float, r);
}
DI float sum8(float v) { v += dppf(v, 0); v += dppf(v, 1); v += dppf(v, 2); return v; }
DI float max8(float v) { v = fmaxf(v, dppf(v, 0)); v = fmaxf(v, dppf(v, 1)); v = fmaxf(v, dppf(v, 2)); return v; }

DI size_t prob_off(int t) {
  return t < 8192 ? O_MG + (size_t)t * 4096 : (t < 12288 ? O_AA + (size_t)(t - 8192) * 4096 : O_QI + (size_t)(t - 12288) * 4096);
}
#define MFMA8S(a, b, c) __builtin_amdgcn_mfma_f32_16x16x32_fp8_fp8((a), (b), (c), 0, 0, 0)
typedef __attribute__((ext_vector_type(4))) float f32x4v;
constexpr int AT_KROW = 528;
struct QKPF { int s0, s1, s2, s3; uint4 q0, q1; };
DI void qk_fetch(const Params& p, int t, int lane, QKPF& f) {
  const int nsel = t + 1 < 256 ? t + 1 : 256;
  const unsigned short* sel = (const unsigned short*)(p.ws + O_SEL) + (size_t)t * 256;
  f.s0 = lane < nsel ? (int)sel[lane] : 0; f.s1 = lane + 64 < nsel ? (int)sel[lane + 64] : 0;
  f.s2 = lane + 128 < nsel ? (int)sel[lane + 128] : 0; f.s3 = lane + 192 < nsel ? (int)sel[lane + 192] : 0;
  const unsigned short* qp = (const unsigned short*)(p.ws + O_QB) + (size_t)t * 512 + (lane & 7) * 64 + 8 * (lane >> 4);
  f.q0 = *(const uint4*)qp; f.q1 = *(const uint4*)(qp + 32);
}
DI void attn_query(const Params& p, int t, int tnext, int w, int lane, QKPF& pf) {
  const int h = lane >> 3, dg = lane & 7, n15 = lane & 15, quad = lane >> 4, hi = lane >> 5, c31 = lane & 31;
  const int* lut = (const int*)(smem + AT_LUT);
  const float* rb = (const float*)(smem + AT_RB);
  float* lgw = (float*)(smem + AT_WAVE + w * AT_WSZ);
  int* ixw = (int*)(smem + AT_WAVE + w * AT_WSZ + 8192);
  char* kst = smem + AT_WAVE + w * AT_WSZ + 9216;
  const int nsel = t + 1 < 256 ? t + 1 : 256;
  ixw[lane] = pf.s0; ixw[lane + 64] = pf.s1; ixw[lane + 128] = pf.s2; ixw[lane + 192] = pf.s3;
  const uint4 qcur0 = pf.q0, qcur1 = pf.q1;
  qk_fetch(p, tnext < L_ ? tnext : t, lane, pf);
  long qreg[2];
  {
#pragma unroll
    for (int c = 0; c < 2; ++c) {
      const uint4 qv = c == 0 ? qcur0 : qcur1;
      int w0 = __builtin_amdgcn_cvt_pk_fp8_f32(bflo(qv.x) * 8.f, bfhi(qv.x) * 8.f, 0, false);
      w0 = __builtin_amdgcn_cvt_pk_fp8_f32(bflo(qv.y) * 8.f, bfhi(qv.y) * 8.f, w0, true);
      int w1 = __builtin_amdgcn_cvt_pk_fp8_f32(bflo(qv.z) * 8.f, bfhi(qv.z) * 8.f, 0, false);
      w1 = __builtin_amdgcn_cvt_pk_fp8_f32(bflo(qv.w) * 8.f, bfhi(qv.w) * 8.f, w1, true);
      const long v = (long)(((unsigned long long)(unsigned)w1 << 32) | (unsigned long long)(unsigned)w0);
      qreg[c] = (n15 < 8) ? v : 0L;
    }
  }
  long bsel[16];
#pragma unroll
  for (int ks = 0; ks < 16; ++ks) bsel[ks] = (n15 == (ks >> 1)) ? qreg[ks & 1] : 0L;
  lds_fence();
  const uint4* KB16 = (const uint4*)(p.ws + O_KB);
  const uint2* VB = (const uint2*)(p.ws + O_VB);
  const int ntile = (nsel + 15) >> 4;
#define AT_KMMA(kt_) do { f32x4v acc0 = {0.f, 0.f, 0.f, 0.f}, acc1 = acc0, acc2 = acc0, acc3 = acc0; \
    const char* ar = kst + n15 * AT_KROW + 8 * quad; \
    _Pragma("unroll") for (int ks = 0; ks < 16; ks += 4) { \
      acc0 = MFMA8S(*(const long*)(ar + 32 * ks), bsel[ks], acc0); \
      acc1 = MFMA8S(*(const long*)(ar + 32 * ks + 32), bsel[ks + 1], acc1); \
      acc2 = MFMA8S(*(const long*)(ar + 32 * ks + 64), bsel[ks + 2], acc2); \
      acc3 = MFMA8S(*(const long*)(ar + 32 * ks + 96), bsel[ks + 3], acc3); } \
    const f32x4v acc = (acc0 + acc1) + (acc2 + acc3); \
    if (n15 < 8) { _Pragma("unroll") for (int i = 0; i < 4; ++i) lgw[(16 * (kt_) + 4 * quad + i) * 8 + n15] = acc[i] * 0.125f; } \
    cbar(); } while (0)
  uint4 kgA0, kgA1, kgA2, kgA3, kgA4, kgA5, kgA6, kgA7, kgB0, kgB1, kgB2, kgB3, kgB4, kgB5, kgB6, kgB7, kgC0, kgC1, kgC2, kgC3, kgC4, kgC5, kgC6, kgC7;
    { const int tl_ = (0) < ntile ? (0) : ntile - 1;
      const int4 ia_ = *(const int4*)(ixw + 16 * tl_ + 8 * hi), ib_ = *(const int4*)(ixw + 16 * tl_ + 8 * hi + 4);
      kgA0 = KB16[(size_t)ia_.x * 32 + c31]; kgA1 = KB16[(size_t)ia_.y * 32 + c31]; kgA2 = KB16[(size_t)ia_.z * 32 + c31]; kgA3 = KB16[(size_t)ia_.w * 32 + c31];
      kgA4 = KB16[(size_t)ib_.x * 32 + c31]; kgA5 = KB16[(size_t)ib_.y * 32 + c31]; kgA6 = KB16[(size_t)ib_.z * 32 + c31]; kgA7 = KB16[(size_t)ib_.w * 32 + c31]; }
    { const int tl_ = (1) < ntile ? (1) : ntile - 1;
      const int4 ia_ = *(const int4*)(ixw + 16 * tl_ + 8 * hi), ib_ = *(const int4*)(ixw + 16 * tl_ + 8 * hi + 4);
      kgB0 = KB16[(size_t)ia_.x * 32 + c31]; kgB1 = KB16[(size_t)ia_.y * 32 + c31]; kgB2 = KB16[(size_t)ia_.z * 32 + c31]; kgB3 = KB16[(size_t)ia_.w * 32 + c31];
      kgB4 = KB16[(size_t)ib_.x * 32 + c31]; kgB5 = KB16[(size_t)ib_.y * 32 + c31]; kgB6 = KB16[(size_t)ib_.z * 32 + c31]; kgB7 = KB16[(size_t)ib_.w * 32 + c31]; }
    { const int tl_ = (2) < ntile ? (2) : ntile - 1;
      const int4 ia_ = *(const int4*)(ixw + 16 * tl_ + 8 * hi), ib_ = *(const int4*)(ixw + 16 * tl_ + 8 * hi + 4);
      kgC0 = KB16[(size_t)ia_.x * 32 + c31]; kgC1 = KB16[(size_t)ia_.y * 32 + c31]; kgC2 = KB16[(size_t)ia_.z * 32 + c31]; kgC3 = KB16[(size_t)ia_.w * 32 + c31];
      kgC4 = KB16[(size_t)ib_.x * 32 + c31]; kgC5 = KB16[(size_t)ib_.y * 32 + c31]; kgC6 = KB16[(size_t)ib_.z * 32 + c31]; kgC7 = KB16[(size_t)ib_.w * 32 + c31]; }
  for (int kt = 0; kt < ntile; kt += 3) {
    { char* wr = kst + (8 * hi) * AT_KROW + c31 * 16; *(uint4*)(wr + 0 * AT_KROW) = kgA0; *(uint4*)(wr + 1 * AT_KROW) = kgA1; *(uint4*)(wr + 2 * AT_KROW) = kgA2; *(uint4*)(wr + 3 * AT_KROW) = kgA3; *(uint4*)(wr + 4 * AT_KROW) = kgA4; *(uint4*)(wr + 5 * AT_KROW) = kgA5; *(uint4*)(wr + 6 * AT_KROW) = kgA6; *(uint4*)(wr + 7 * AT_KROW) = kgA7; }
    { const int tl_ = ((kt) + 3) < ntile ? ((kt) + 3) : ntile - 1;
      const int4 ia_ = *(const int4*)(ixw + 16 * tl_ + 8 * hi), ib_ = *(const int4*)(ixw + 16 * tl_ + 8 * hi + 4);
      kgA0 = KB16[(size_t)ia_.x * 32 + c31]; kgA1 = KB16[(size_t)ia_.y * 32 + c31]; kgA2 = KB16[(size_t)ia_.z * 32 + c31]; kgA3 = KB16[(size_t)ia_.w * 32 + c31];
      kgA4 = KB16[(size_t)ib_.x * 32 + c31]; kgA5 = KB16[(size_t)ib_.y * 32 + c31]; kgA6 = KB16[(size_t)ib_.z * 32 + c31]; kgA7 = KB16[(size_t)ib_.w * 32 + c31]; }
    cbar();
    AT_KMMA(kt);
    if (kt + 1 < ntile) {
    { char* wr = kst + (8 * hi) * AT_KROW + c31 * 16; *(uint4*)(wr + 0 * AT_KROW) = kgB0; *(uint4*)(wr + 1 * AT_KROW) = kgB1; *(uint4*)(wr + 2 * AT_KROW) = kgB2; *(uint4*)(wr + 3 * AT_KROW) = kgB3; *(uint4*)(wr + 4 * AT_KROW) = kgB4; *(uint4*)(wr + 5 * AT_KROW) = kgB5; *(uint4*)(wr + 6 * AT_KROW) = kgB6; *(uint4*)(wr + 7 * AT_KROW) = kgB7; }
    { const int tl_ = ((kt + 1) + 3) < ntile ? ((kt + 1) + 3) : ntile - 1;
      const int4 ia_ = *(const int4*)(ixw + 16 * tl_ + 8 * hi), ib_ = *(const int4*)(ixw + 16 * tl_ + 8 * hi + 4);
      kgB0 = KB16[(size_t)ia_.x * 32 + c31]; kgB1 = KB16[(size_t)ia_.y * 32 + c31]; kgB2 = KB16[(size_t)ia_.z * 32 + c31]; kgB3 = KB16[(size_t)ia_.w * 32 + c31];
      kgB4 = KB16[(size_t)ib_.x * 32 + c31]; kgB5 = KB16[(size_t)ib_.y * 32 + c31]; kgB6 = KB16[(size_t)ib_.z * 32 + c31]; kgB7 = KB16[(size_t)ib_.w * 32 + c31]; }
    cbar();
    AT_KMMA(kt + 1);
    }
    if (kt + 2 < ntile) {
    { char* wr = kst + (8 * hi) * AT_KROW + c31 * 16; *(uint4*)(wr + 0 * AT_KROW) = kgC0; *(uint4*)(wr + 1 * AT_KROW) = kgC1; *(uint4*)(wr + 2 * AT_KROW) = kgC2; *(uint4*)(wr + 3 * AT_KROW) = kgC3; *(uint4*)(wr + 4 * AT_KROW) = kgC4; *(uint4*)(wr + 5 * AT_KROW) = kgC5; *(uint4*)(wr + 6 * AT_KROW) = kgC6; *(uint4*)(wr + 7 * AT_KROW) = kgC7; }
    { const int tl_ = ((kt + 2) + 3) < ntile ? ((kt + 2) + 3) : ntile - 1;
      const int4 ia_ = *(const int4*)(ixw + 16 * tl_ + 8 * hi), ib_ = *(const int4*)(ixw + 16 * tl_ + 8 * hi + 4);
      kgC0 = KB16[(size_t)ia_.x * 32 + c31]; kgC1 = KB16[(size_t)ia_.y * 32 + c31]; kgC2 = KB16[(size_t)ia_.z * 32 + c31]; kgC3 = KB16[(size_t)ia_.w * 32 + c31];
      kgC4 = KB16[(size_t)ib_.x * 32 + c31]; kgC5 = KB16[(size_t)ib_.y * 32 + c31]; kgC6 = KB16[(size_t)ib_.z * 32 + c31]; kgC7 = KB16[(size_t)ib_.w * 32 + c31]; }
    cbar();
    AT_KMMA(kt + 2);
    }
  }
  lds_fence();
  const int ngroups = (nsel + 7) >> 3;
  float mx = -INFINITY;
#pragma unroll 8
  for (int i = 0; i < 32; ++i) {
    const int kk = 8 * i + dg;
    const int myidx = ixw[kk];
    const int dist = t - myidx;
    const int bk = dist < 128 ? lut[dist < 0 ? 0 : dist] : 31;
    const float raw = lgw[kk * 8 + h];
    const float lgt = (kk < nsel) ? raw + rb[bk * 8 + h] : -INFINITY;
    lgw[kk * 8 + h] = lgt;
    mx = fmaxf(mx, lgt);
  }
  mx = max8(mx);
  float sum = 0.f;
#pragma unroll 8
  for (int i = 0; i < 32; ++i) {
    const float pv = __expf(lgw[(8 * i + dg) * 8 + h] - mx);
    sum += pv;
    lgw[(8 * i + dg) * 8 + h] = pv;
  }
  sum = sum8(sum);
  {
    const float inv = 1.f / sum;
#pragma unroll 8
    for (int i = 0; i < 32; ++i) lgw[(8 * i + dg) * 8 + h] *= inv;
  }
  lds_fence();
  {
    uint4 pk[4];
#pragma unroll
    for (int k = 0; k < 4; ++k) {
      const float4 a_ = *(const float4*)(lgw + (4 * lane + k) * 8), b_ = *(const float4*)(lgw + (4 * lane + k) * 8 + 4);
      pk[k] = make_uint4(cvtpk(a_.x, a_.y), cvtpk(a_.z, a_.w), cvtpk(b_.x, b_.y), cvtpk(b_.z, b_.w));
    }
    uint4* pdst = (uint4*)(p.ws + prob_off(t)) + lane * 4;
    pdst[0] = pk[0]; pdst[1] = pk[1]; pdst[2] = pk[2]; pdst[3] = pk[3];
  }
  lds_fence();
}

DI void attn_pv_query(const Params& p, int t, int w, int lane) {
  const int h = lane >> 3, dg = lane & 7;
  unsigned short* pl = (unsigned short*)(smem + AT_WAVE + w * AT_WSZ);
  int* ixw = (int*)(smem + AT_WAVE + w * AT_WSZ + 8192);
  const int nsel = t + 1 < 256 ? t + 1 : 256;
  const unsigned short* sel = (const unsigned short*)(p.ws + O_SEL) + (size_t)t * 256;
#pragma unroll
  for (int j = 0; j < 4; ++j) {
    const int pos = lane + 64 * j;
    ixw[pos] = pos < nsel ? (int)sel[pos] : 0;
  }
  {
    const uint4* psrc = (const uint4*)(p.ws + prob_off(t)) + lane * 4;
    uint4* pd = (uint4*)pl + lane * 4;
    const uint4 a0 = psrc[0], a1 = psrc[1], a2 = psrc[2], a3 = psrc[3];
    pd[0] = a0; pd[1] = a1; pd[2] = a2; pd[3] = a3;
  }
  lds_fence();
  const uint2* VB = (const uint2*)(p.ws + O_VB);
  const int ngroups = (nsel + 7) >> 3;
  f32x2v o01 = {0.f, 0.f}, o23 = {0.f, 0.f}, o45 = {0.f, 0.f}, o67 = {0.f, 0.f};
  uint2 kc[16], kn[16];
#define AT_VLOAD16(dst, ib) do { _Pragma("unroll") for (int q_ = 0; q_ < 4; ++q_) { const int4 i_ = *(const int4*)(ixw + (ib) + 4 * q_); \
    dst[4 * q_ + 0] = VB[(size_t)i_.x * 64 + lane]; dst[4 * q_ + 1] = VB[(size_t)i_.y * 64 + lane]; \
    dst[4 * q_ + 2] = VB[(size_t)i_.z * 64 + lane]; dst[4 * q_ + 3] = VB[(size_t)i_.w * 64 + lane]; } } while (0)
  const int ng16 = (nsel + 15) >> 4;
  AT_VLOAD16(kc, 0);
  for (int i = 0; i < ng16; ++i) {
    { const int nx = (i + 1 < ng16) ? i + 1 : i; AT_VLOAD16(kn, 16 * nx); }
    const float pa = bf2f(pl[(16 * i + dg) * 8 + h]);
    const float pbv = bf2f(pl[(16 * i + 8 + dg) * 8 + h]);
#pragma unroll
    for (int d = 0; d < 16; ++d) {
      const float pb = __shfl(d < 8 ? pa : pbv, (lane & ~7) | (d & 7));
      const f32x2v pb2 = {pb, pb};
      o01 = __builtin_amdgcn_cvt_pk_f32_fp8(kc[d].x, false) * pb2 + o01;
      o23 = __builtin_amdgcn_cvt_pk_f32_fp8(kc[d].x, true) * pb2 + o23;
      o45 = __builtin_amdgcn_cvt_pk_f32_fp8(kc[d].y, false) * pb2 + o45;
      o67 = __builtin_amdgcn_cvt_pk_f32_fp8(kc[d].y, true) * pb2 + o67;
    }
#pragma unroll
    for (int d = 0; d < 16; ++d) kc[d] = kn[d];
  }
  const uint4 zv = ((const uint4*)(p.ws + O_ZB))[(size_t)t * 64 + lane];
  uint4 ov;
  ov.x = cvtpk(o01.x * bflo(zv.x), o01.y * bfhi(zv.x));
  ov.y = cvtpk(o23.x * bflo(zv.y), o23.y * bfhi(zv.y));
  ov.z = cvtpk(o45.x * bflo(zv.z), o45.y * bfhi(zv.z));
  ov.w = cvtpk(o67.x * bflo(zv.w), o67.y * bfhi(zv.w));
  ((uint4*)(p.ws + O_AB))[tiled_unit(t, lane * 8, 32)] = ov;
  lds_fence();
}

constexpr int HC_B = 0;
constexpr int HC_QT = 33792;
constexpr int HC_QH = HC_QT + 17408;
constexpr int HC_KH = HC_QH + 17408;
constexpr int HC_VT = HC_KH + 17408;
constexpr int HC_P = HC_VT + 18432;
constexpr int HC_TOT = HC_P + 9216;
DI void hgrn_c_item(const Params& p, int layer, int c, int h) {
  const int tid = vtid(), lane = tid & 63, w = tid >> 6, hi = lane >> 5, c31 = lane & 31;
  float* bL = (float*)(smem + HC_B);
  unsigned short* qT = (unsigned short*)(smem + HC_QT);
  unsigned short* qH = (unsigned short*)(smem + HC_QH);
  unsigned short* kH = (unsigned short*)(smem + HC_KH);
  unsigned short* vT = (unsigned short*)(smem + HC_VT);
  unsigned short* P = (unsigned short*)(smem + HC_P);
  float* tot = (float*)(smem + HC_TOT);
  const float* G = (const float*)(p.ws + O_G);
  const unsigned short* KK = (const unsigned short*)(p.ws + O_KK);
  const unsigned short* IA = (const unsigned short*)(p.ws + O_IA);
  const unsigned short* QA = (const unsigned short*)(p.ws + O_QA);
  const int mt = w >> 2, nv = w & 3;
  const uint4* us = (const uint4*)(p.ws + O_US + (size_t)(c * 4 + h) * 32768);
  uint4 sfr[8];
#pragma unroll
  for (int ks = 0; ks < 8; ++ks) sfr[ks] = us[(nv * 8 + ks) * 64 + lane];
  uint4 qv_pre[2], kv_pre[2];
#pragma unroll
  for (int rep = 0; rep < 2; ++rep) {
    const int pr = tid + 512 * rep, t = pr >> 4, oc = pr & 15;
    qv_pre[rep] = *(const uint4*)(QA + (size_t)(64 * c + t) * 512 + 128 * h + oc * 8);
    kv_pre[rep] = *(const uint4*)(KK + (size_t)(64 * c + t) * 512 + 128 * h + oc * 8);
  }
  const uint4 z0_pre = *(const uint4*)((const unsigned short*)(p.ws + O_ZA) + (size_t)(64 * c + (tid >> 3)) * 512 + 128 * h + 16 * (tid & 7));
  const uint4 z1_pre = *(const uint4*)((const unsigned short*)(p.ws + O_ZA) + (size_t)(64 * c + (tid >> 3)) * 512 + 128 * h + 16 * (tid & 7) + 8);
  {
    const int seg = tid >> 7, k = tid & 127;
    const size_t rowbase = (size_t)(64 * c + 16 * seg);
    float b[16];
    float run = 0.f;
#pragma unroll
    for (int i = 0; i < 16; ++i) { run += G[(rowbase + i) * 512 + 128 * h + k]; b[i] = run; }
    tot[seg * 128 + k] = run;
    unsigned pv[8];
#pragma unroll
    for (int i = 0; i < 16; i += 2) {
      unsigned v0 = IA[(rowbase + i) * 512 + 128 * h + k], v1 = IA[(rowbase + i + 1) * 512 + 128 * h + k];
      pv[i >> 1] = v0 | (v1 << 16);
    }
    uint4* dv = (uint4*)(vT + k * 72 + 16 * seg);
    dv[0] = make_uint4(pv[0], pv[1], pv[2], pv[3]); dv[1] = make_uint4(pv[4], pv[5], pv[6], pv[7]);
    __syncthreads();
    float off = 0.f;
#pragma unroll
    for (int s2 = 0; s2 < 4; ++s2) { float tv = tot[s2 * 128 + k]; if (s2 < seg) off += tv; }
#pragma unroll
    for (int i = 0; i < 16; ++i) bL[(16 * seg + i) * 132 + k] = b[i] + off;
  }
  __syncthreads();
#pragma unroll
  for (int rep = 0; rep < 2; ++rep) {
    const int pr = tid + 512 * rep, t = pr >> 4, oc = pr & 15;
    const float4 b0 = *(const float4*)(bL + t * 132 + oc * 8), b1 = *(const float4*)(bL + t * 132 + oc * 8 + 4);
    const float4 r0 = *(const float4*)(bL + 31 * 132 + oc * 8), r1 = *(const float4*)(bL + 31 * 132 + oc * 8 + 4);
    const uint4 qv = qv_pre[rep];
    const uint4 kv = kv_pre[rep];
    const float bb[8] = {b0.x, b0.y, b0.z, b0.w, b1.x, b1.y, b1.z, b1.w};
    const float rr[8] = {r0.x, r0.y, r0.z, r0.w, r1.x, r1.y, r1.z, r1.w};
    const float qq[8] = {bflo(qv.x), bfhi(qv.x), bflo(qv.y), bfhi(qv.y), bflo(qv.z), bfhi(qv.z), bflo(qv.w), bfhi(qv.w)};
    const float kq[8] = {bflo(kv.x), bfhi(kv.x), bflo(kv.y), bfhi(kv.y), bflo(kv.z), bfhi(kv.z), bflo(kv.w), bfhi(kv.w)};
    float a1[8], a2[8], a3[8];
#pragma unroll
    for (int e = 0; e < 8; ++e) {
      a1[e] = qq[e] * __expf(bb[e]);
      a2[e] = qq[e] * __expf(bb[e] - rr[e]);
      a3[e] = kq[e] * __expf(rr[e] - bb[e]);
    }
    *(uint4*)(qT + t * 136 + oc * 8) = make_uint4(cvtpk(a1[0], a1[1]), cvtpk(a1[2], a1[3]), cvtpk(a1[4], a1[5]), cvtpk(a1[6], a1[7]));
    *(uint4*)(qH + t * 136 + oc * 8) = make_uint4(cvtpk(a2[0], a2[1]), cvtpk(a2[2], a2[3]), cvtpk(a2[4], a2[5]), cvtpk(a2[6], a2[7]));
    *(uint4*)(kH + t * 136 + oc * 8) = make_uint4(cvtpk(a3[0], a3[1]), cvtpk(a3[2], a3[3]), cvtpk(a3[4], a3[5]), cvtpk(a3[6], a3[7]));
  }
  __syncthreads();
  if (w < 4) {
    const int ms = w >> 1, ntq = w & 1;
    f32x16 sacc;
#pragma unroll
    for (int r = 0; r < 16; ++r) sacc[r] = 0.f;
#pragma unroll
    for (int ks = 0; ks < 8; ++ks) {
      bf16x8 af = __builtin_bit_cast(bf16x8, *(const uint4*)(kH + (32 * ms + c31) * 136 + 16 * ks + 8 * hi));
      bf16x8 bfv = __builtin_bit_cast(bf16x8, *(const uint4*)(qH + (32 * ntq + c31) * 136 + 16 * ks + 8 * hi));
      sacc = MFMA(af, bfv, sacc);
    }
    const int t = 32 * ntq + c31;
#pragma unroll
    for (int gq = 0; gq < 4; ++gq) {
      const int s0 = 32 * ms + 8 * gq + 4 * hi;
      float v0 = (s0 + 0 <= t) ? sacc[4 * gq + 0] : 0.f;
      float v1 = (s0 + 1 <= t) ? sacc[4 * gq + 1] : 0.f;
      float v2 = (s0 + 2 <= t) ? sacc[4 * gq + 2] : 0.f;
      float v3 = (s0 + 3 <= t) ? sacc[4 * gq + 3] : 0.f;
      uint2 val; val.x = cvtpk(v0, v1); val.y = cvtpk(v2, v3);
      *(uint2*)(P + t * 72 + s0) = val;
    }
  }
  f32x16 oacc;
#pragma unroll
  for (int r = 0; r < 16; ++r) oacc[r] = 0.f;
#pragma unroll
  for (int ks = 0; ks < 8; ++ks) {
    bf16x8 af = __builtin_bit_cast(bf16x8, *(const uint4*)(qT + (32 * mt + c31) * 136 + 16 * ks + 8 * hi));
    oacc = MFMA(af, __builtin_bit_cast(bf16x8, sfr[ks]), oacc);
  }
  __syncthreads();
#pragma unroll
  for (int ks = 0; ks < 4; ++ks) {
    bf16x8 af = __builtin_bit_cast(bf16x8, *(const uint4*)(P + (32 * mt + c31) * 72 + 16 * ks + 8 * hi));
    bf16x8 bfv = __builtin_bit_cast(bf16x8, *(const uint4*)(vT + (32 * nv + c31) * 72 + 16 * ks + 8 * hi));
    oacc = MFMA(af, bfv, oacc);
  }
  float* oL = bL;
#pragma unroll
  for (int r = 0; r < 16; ++r) oL[(32 * mt + crow(r, hi)) * 132 + 32 * nv + c31] = oacc[r];
  __syncthreads();
  {
    const int t = tid >> 3, sg = tid & 7;
    float ov[16];
#pragma unroll
    for (int e = 0; e < 16; e += 4) {
      const float4 f = *(const float4*)(oL + t * 132 + 16 * sg + e);
      ov[e] = f.x; ov[e + 1] = f.y; ov[e + 2] = f.z; ov[e + 3] = f.w;
    }
    float ss = 0.f;
#pragma unroll
    for (int e = 0; e < 16; ++e) ss = fmaf(ov[e], ov[e], ss);
    ss += __shfl_xor(ss, 1);
    ss += __shfl_xor(ss, 2);
    ss += __shfl_xor(ss, 4);
    const float rs = rsqrtf(ss * (1.f / 128.f) + 1e-6f);
    const int tg = 64 * c + t, k0 = 128 * h + 16 * sg;
    const float* ng = p.norm_a_g + (size_t)layer * 512 + k0;
    const uint4 z0 = z0_pre, z1 = z1_pre;
    const float zz[16] = {bflo(z0.x), bfhi(z0.x), bflo(z0.y), bfhi(z0.y), bflo(z0.z), bfhi(z0.z), bflo(z0.w), bfhi(z0.w),
                          bflo(z1.x), bfhi(z1.x), bflo(z1.y), bfhi(z1.y), bflo(z1.z), bfhi(z1.z), bflo(z1.w), bfhi(z1.w)};
    float rr[16];
#pragma unroll
    for (int e = 0; e < 16; ++e) rr[e] = ov[e] * rs * ng[e] * zz[e];
    uint4* aa = (uint4*)(p.ws + O_AA);
    aa[tiled_unit(tg, k0, 32)] = make_uint4(cvtpk(rr[0], rr[1]), cvtpk(rr[2], rr[3]), cvtpk(rr[4], rr[5]), cvtpk(rr[6], rr[7]));
    aa[tiled_unit(tg, k0 + 8, 32)] = make_uint4(cvtpk(rr[8], rr[9]), cvtpk(rr[10], rr[11]), cvtpk(rr[12], rr[13]), cvtpk(rr[14], rr[15]));
  }
  __syncthreads();
}

DI void acc_to_lds_bf16(f32x16 (&acc)[2][2], unsigned short* tile) {
  const int tid = vtid(), lane = tid & 63, w = tid >> 6, wm = w >> 1, wn = w & 1, hi = lane >> 5, c31 = lane & 31;
#pragma unroll
  for (int i = 0; i < 2; ++i)
#pragma unroll
    for (int j = 0; j < 2; ++j)
#pragma unroll
      for (int r = 0; r < 16; ++r)
        tile[(64 * wm + 32 * i + crow(r, hi)) * 128 + 64 * wn + 32 * j + c31] = f2bf(acc[i][j][r]);
}
DI void p5_tile(const Params& p, int mb, int nt) {
  const int tid = vtid(), lane = tid & 63, w = tid >> 6, wm = w >> 1, wn = w & 1, hi = lane >> 5, c31 = lane & 31;
  f32x16 acc[2][2];
  zero_acc(acc);
  gemm_core((const uint4*)(p.ws + O_AA), mb * 8, (const uint4*)(p.ws + O_WUA), nt * 4, 32, acc, (uint4*)smem);
  unsigned uap[2][2][8];
#pragma unroll
  for (int i = 0; i < 2; ++i)
#pragma unroll
    for (int j = 0; j < 2; ++j)
#pragma unroll
      for (int r = 0; r < 16; r += 2) uap[i][j][r >> 1] = cvtpk(acc[i][j][r], acc[i][j][r + 1]);
  zero_acc(acc);
  gemm_core((const uint4*)(p.ws + O_AB), mb * 8, (const uint4*)(p.ws + O_WUB), nt * 4, 32, acc, (uint4*)smem);
  unsigned short* tA = (unsigned short*)smem;
  unsigned short* tB = (unsigned short*)(smem + 65536);
#pragma unroll
  for (int i = 0; i < 2; ++i)
#pragma unroll
    for (int j = 0; j < 2; ++j)
#pragma unroll
      for (int r = 0; r < 16; r += 2) {
        const int o0 = (64 * wm + 32 * i + crow(r, hi)) * 128 + 64 * wn + 32 * j + c31;
        tA[o0] = (unsigned short)(uap[i][j][r >> 1] & 0xffffu);
        tA[o0 + 128] = (unsigned short)(uap[i][j][r >> 1] >> 16);
        tB[o0] = f2bf(acc[i][j][r]);
        tB[o0 + 128] = f2bf(acc[i][j][r + 1]);
      }
  __syncthreads();
  const int row0 = mb * 256;
#pragma unroll 2
  for (int q = 0; q < 8; ++q) {
    const int u = tid + 512 * q, r = u >> 4, c8 = u & 15;
    const uint4 ua = *(const uint4*)&tA[r * 128 + c8 * 8];
    const uint4 ub = *(const uint4*)&tB[r * 128 + c8 * 8];
    const int t = row0 + r, n0 = nt * 128 + c8 * 8;
    const uint4 ga = *(const uint4*)(p.ws + O_SGA + ((size_t)t * 1024 + n0) * 2);
    const uint4 gb = *(const uint4*)(p.ws + O_SGB + ((size_t)t * 1024 + n0) * 2);
    uint4 o;
    o.x = cvtpk(bflo(ga.x) * bflo(ua.x) + bflo(gb.x) * bflo(ub.x), bfhi(ga.x) * bfhi(ua.x) + bfhi(gb.x) * bfhi(ub.x));
    o.y = cvtpk(bflo(ga.y) * bflo(ua.y) + bflo(gb.y) * bflo(ub.y), bfhi(ga.y) * bfhi(ua.y) + bfhi(gb.y) * bfhi(ub.y));
    o.z = cvtpk(bflo(ga.z) * bflo(ua.z) + bflo(gb.z) * bflo(ub.z), bfhi(ga.z) * bfhi(ua.z) + bfhi(gb.z) * bfhi(ub.z));
    o.w = cvtpk(bflo(ga.w) * bflo(ua.w) + bflo(gb.w) * bflo(ub.w), bfhi(ga.w) * bfhi(ua.w) + bfhi(gb.w) * bfhi(ub.w));
    ((uint4*)(p.ws + O_MG))[tiled_unit(t, n0, 64)] = o;
  }
  __syncthreads();
}

DI void p6_tile(const Params& p, int layer, int mb, int nt) {
  const int tid = vtid(), lane = tid & 63, w = tid >> 6, wm = w >> 1, wn = w & 1, hi = lane >> 5, c31 = lane & 31;
  f32x16 acc[2][2];
  zero_acc(acc);
  gemm_core((const uint4*)(p.ws + O_MG), mb * 8, (const uint4*)(p.ws + O_WOUT), nt * 4, 64, acc, (uint4*)smem);
  const float* hin = (layer == 0) ? p.x : p.out;
#pragma unroll
  for (int i = 0; i < 2; ++i)
#pragma unroll
    for (int j = 0; j < 2; ++j)
#pragma unroll
      for (int r = 0; r < 16; ++r) {
        const size_t idx = (size_t)(mb * 256 + 64 * wm + 32 * i + crow(r, hi)) * DM + nt * 128 + 64 * wn + 32 * j + c31;
        p.out[idx] = fmaf(ALPHA_, hin[idx], acc[i][j][r]);
      }
}

DI float dpp_add_f(float v, int which) {
  const int iv = __builtin_bit_cast(int, v);
  int r;
  switch (which) {
    case 0: r = __builtin_amdgcn_update_dpp(0, iv, 0x111, 0xf, 0xf, true); break;
    case 1: r = __builtin_amdgcn_update_dpp(0, iv, 0x112, 0xf, 0xf, true); break;
    case 2: r = __builtin_amdgcn_update_dpp(0, iv, 0x114, 0xf, 0xf, true); break;
    case 3: r = __builtin_amdgcn_update_dpp(0, iv, 0x118, 0xf, 0xf, true); break;
    default: r = __builtin_amdgcn_update_dpp(0, iv, 0x142, 0xa, 0xf, false); break;
  }
  return v + __builtin_bit_cast(float, r);
}
DI float half_sum_to_last(float v) {
  v = dpp_add_f(v, 0); v = dpp_add_f(v, 1); v = dpp_add_f(v, 2); v = dpp_add_f(v, 3); v = dpp_add_f(v, 4);
  return v;
}
DI void fused_out_ln(const Params& p, int layer, int mb64) {
  const int tid = vtid(), lane = tid & 63, w = tid >> 6, hi = lane >> 5, c31 = lane & 31;
  uint4* lds = (uint4*)smem;
  const uint4* A = (const uint4*)(p.ws + O_MG) + (size_t)(2 * mb64) * 64 * 64;
#pragma unroll
  for (int r = 0; r < 16; ++r)
    __builtin_amdgcn_global_load_lds((const unsigned*)(A + tid + 512 * r), (unsigned*)(lds + tid + 512 * r), 16, 0, 0);
  const uint4* Bw = (const uint4*)(p.ws + O_WOUT) + (size_t)(4 * w) * 64 * 64 + lane;
  uint4 bq[4][4];
#pragma unroll
  for (int s_ = 0; s_ < 4; ++s_)
#pragma unroll
    for (int j = 0; j < 4; ++j) bq[s_][j] = Bw[(size_t)(j * 64 + s_) * 64];
  f32x16 acc[2][4];
#pragma unroll
  for (int i = 0; i < 2; ++i)
#pragma unroll
    for (int j = 0; j < 4; ++j)
#pragma unroll
      for (int r = 0; r < 16; ++r) acc[i][j][r] = 0.f;
  __syncthreads();
#pragma unroll 1
  for (int k4 = 0; k4 < 16; ++k4) {
#pragma unroll
    for (int s_ = 0; s_ < 4; ++s_) {
      const int ks = 4 * k4 + s_;
      const bf16x8 a0 = __builtin_bit_cast(bf16x8, lds[ks * 64 + lane]);
      const bf16x8 a1 = __builtin_bit_cast(bf16x8, lds[4096 + ks * 64 + lane]);
#pragma unroll
      for (int j = 0; j < 4; ++j) {
        const bf16x8 b = __builtin_bit_cast(bf16x8, bq[s_][j]);
        acc[0][j] = MFMA(a0, b, acc[0][j]);
        acc[1][j] = MFMA(a1, b, acc[1][j]);
      }
      if (k4 < 15) {
#pragma unroll
        for (int j = 0; j < 4; ++j) bq[s_][j] = Bw[(size_t)(j * 64 + ks + 4) * 64];
      }
    }
  }
  const float* hin = (layer == 0) ? p.x : p.out;
  float* ft = (float*)smem;
  uint2* hb2 = (uint2*)(p.ws + O_HB);
  const int rr = tid >> 4, seg = tid & 15;
#pragma unroll
  for (int i = 0; i < 2; ++i) {
    __syncthreads();
    {
      float* b0 = ft + (4 * hi) * 1024 + 128 * w + c31;
      float* b1 = b0 + 16 * 1024;
#pragma unroll
      for (int j = 0; j < 4; ++j)
#pragma unroll
        for (int r = 0; r < 16; ++r) {
          float* bp = (r < 8) ? b0 : b1;
          bp[((r & 3) + 8 * ((r >> 2) & 1)) * 1024 + 32 * j] = acc[i][j][r];
        }
    }
    __syncthreads();
    const int trow = 64 * mb64 + 32 * i + rr;
    const float* hrow = hin + (size_t)trow * DM;
    float s1 = 0.f, s2 = 0.f;
    float* frow = ft + rr * 1024 + 4 * seg;
#pragma unroll 4
    for (int e = 0; e < 16; ++e) {
      const float4 y = *(const float4*)(frow + 64 * e);
      const float4 hv = *(const float4*)(hrow + 64 * e + 4 * seg);
      float4 pre;
      pre.x = fmaf(ALPHA_, hv.x, y.x); pre.y = fmaf(ALPHA_, hv.y, y.y); pre.z = fmaf(ALPHA_, hv.z, y.z); pre.w = fmaf(ALPHA_, hv.w, y.w);
      s1 += (pre.x + pre.y) + (pre.z + pre.w);
      s2 = fmaf(pre.x, pre.x, s2); s2 = fmaf(pre.y, pre.y, s2); s2 = fmaf(pre.z, pre.z, s2); s2 = fmaf(pre.w, pre.w, s2);
      *(float4*)(frow + 64 * e) = pre;
    }
    s1 += __shfl_xor(s1, 1); s1 += __shfl_xor(s1, 2); s1 += __shfl_xor(s1, 4); s1 += __shfl_xor(s1, 8);
    s2 += __shfl_xor(s2, 1); s2 += __shfl_xor(s2, 2); s2 += __shfl_xor(s2, 4); s2 += __shfl_xor(s2, 8);
    const float mu = s1 * (1.f / 1024.f);
    const float rs = rsqrtf(fmaxf(s2 * (1.f / 1024.f) - mu * mu, 0.f) + 1e-5f);
    const float* gp = p.ln_g + (size_t)layer * DM;
    const float* bp2 = p.ln_b + (size_t)layer * DM;
    float* orow = p.out + (size_t)trow * DM;
#pragma unroll 4
    for (int e = 0; e < 16; ++e) {
      const int c0 = 64 * e + 4 * seg;
      const float4 pre = *(const float4*)(frow + 64 * e);
      const float4 g4 = *(const float4*)(gp + c0), b4 = *(const float4*)(bp2 + c0);
      float4 o;
      o.x = (pre.x - mu) * rs * g4.x + b4.x; o.y = (pre.y - mu) * rs * g4.y + b4.y;
      o.z = (pre.z - mu) * rs * g4.z + b4.z; o.w = (pre.w - mu) * rs * g4.w + b4.w;
      *(float4*)(orow + c0) = o;
      hb2[((size_t)trow * 1024 + c0) >> 2] = make_uint2(cvtpk(o.x, o.y), cvtpk(o.z, o.w));
    }
  }
  __syncthreads();
}

DI void p7_rows(const Params& p, int layer) {
  const int tid = vtid();
  const int lane = tid & 63, gw = blockIdx.x * 8 + (tid >> 6), nw = gridDim.x * 8;
  const float* g = p.ln_g + (size_t)layer * DM;
  const float* bb = p.ln_b + (size_t)layer * DM;
  uint4* hb = (uint4*)(p.ws + O_HB);
  for (int t = gw; t < L_; t += nw) {
    float* row = p.out + (size_t)t * DM;
    float v[16];
#pragma unroll
    for (int q = 0; q < 2; ++q) {
      const float4 a = *(const float4*)(row + q * 512 + lane * 8), b = *(const float4*)(row + q * 512 + lane * 8 + 4);
      v[8 * q + 0] = a.x; v[8 * q + 1] = a.y; v[8 * q + 2] = a.z; v[8 * q + 3] = a.w;
      v[8 * q + 4] = b.x; v[8 * q + 5] = b.y; v[8 * q + 6] = b.z; v[8 * q + 7] = b.w;
    }
    float s = 0.f;
#pragma unroll
    for (int e = 0; e < 16; ++e) s += v[e];
#pragma unroll
    for (int off = 1; off < 64; off <<= 1) s += __shfl_xor(s, off);
    const float mu = s * (1.f / 1024.f);
    float ss = 0.f;
#pragma unroll
    for (int e = 0; e < 16; ++e) { const float d = v[e] - mu; ss = fmaf(d, d, ss); }
#pragma unroll
    for (int off = 1; off < 64; off <<= 1) ss += __shfl_xor(ss, off);
    const float rs = rsqrtf(ss * (1.f / 1024.f) + 1e-5f);
#pragma unroll
    for (int q = 0; q < 2; ++q) {
      const int k0 = q * 512 + lane * 8;
      float o[8];
#pragma unroll
      for (int e = 0; e < 8; ++e) o[e] = (v[8 * q + e] - mu) * rs * g[k0 + e] + bb[k0 + e];
      *(float4*)(row + k0) = make_float4(o[0], o[1], o[2], o[3]);
      *(float4*)(row + k0 + 4) = make_float4(o[4], o[5], o[6], o[7]);
      hb[tiled_unit(t, k0, 64)] = make_uint4(cvtpk(o[0], o[1]), cvtpk(o[2], o[3]), cvtpk(o[4], o[5]), cvtpk(o[6], o[7]));
    }
  }
}


#define XB_TMO      128
#define XB_XCNT(j)  (256  + 64 * (j))
#define XB_XSUB(j)  (1280 + 64 * (j))
#define XB_XGEN(j)  (2304 + 64 * (j))
#define XB_TOP      3328
#define XB_TOPGEN   3392
#define XCD_BAR_WORDS 3456
#define XB_SPIN_CAP (1u << 22)
#define LAS __attribute__((address_space(3)))
DI unsigned xb_ld(unsigned* p)              { return __hip_atomic_load(p, __ATOMIC_RELAXED, __HIP_MEMORY_SCOPE_AGENT); }
DI unsigned xb_add(unsigned* p, unsigned v) { return __hip_atomic_fetch_add(p, v, __ATOMIC_RELAXED, __HIP_MEMORY_SCOPE_AGENT); }
DI unsigned xb_xcc_id() { return (unsigned)__builtin_amdgcn_s_getreg((3 << 11) | 20) & 0xFu; }
#define XB_SPIN(cond, bar) do { unsigned _sp = 0; while (cond) { __builtin_amdgcn_s_sleep(1); \
    if ((++_sp & 255u) == 0u) { if (xb_ld(&(bar)[XB_TMO])) break; if (_sp > XB_SPIN_CAP) { atomicAdd(&(bar)[XB_TMO], 1u); break; } } } } while (0)
struct XcdBarrier { unsigned* bar; unsigned x; volatile LAS unsigned* st; };
DI XcdBarrier xcd_barrier_post(unsigned* bar, volatile LAS unsigned* st) {
  XcdBarrier b; b.bar = bar; b.x = xb_xcc_id(); b.st = st;
  if (threadIdx.x == 0) (void)xb_add(&bar[XB_XCNT(b.x)], 1u);
  return b;
}
DI void xcd_barrier_complete(unsigned* bar, unsigned x, unsigned& nloc, unsigned& nx) {
  const unsigned G = gridDim.x * gridDim.y * gridDim.z;
  unsigned sum, cnt, mine, sp = 0u;
  for (;;) {
    sum = 0u; cnt = 0u; mine = 0u;
#pragma unroll
    for (unsigned j = 0; j < 16; ++j) { const unsigned c = xb_ld(&bar[XB_XCNT(j)]); sum += c; cnt += (c > 0u) ? 1u : 0u; mine = (j == x) ? c : mine; }
    if (sum == G) break;
    __builtin_amdgcn_s_sleep(1);
    if ((++sp & 255u) == 0u) { if (xb_ld(&bar[XB_TMO])) break; if (sp > XB_SPIN_CAP) { atomicAdd(&bar[XB_TMO], 1u); break; } }
  }
  nloc = mine > 0u ? mine : 1u; nx = cnt > 0u ? cnt : 1u;
}
DI void xcd_barrier(const XcdBarrier& b) {
  asm volatile("s_waitcnt vmcnt(0)" ::: "memory");
  __syncthreads();
  if (threadIdx.x == 0) {
    unsigned* bar = b.bar;
    __builtin_amdgcn_s_waitcnt(0);
    unsigned nloc = b.st[0], nx = b.st[1];
    if (nloc == 0u) { xcd_barrier_complete(bar, b.x, nloc, nx); b.st[0] = nloc; b.st[1] = nx; }
    const unsigned old = xb_add(&bar[XB_XSUB(b.x)], 1u);
    const unsigned gen = old / nloc;
    if (old + 1u == (gen + 1u) * nloc) {
      __builtin_amdgcn_fence(__ATOMIC_RELEASE, "agent");
      asm volatile("s_waitcnt vmcnt(0)" ::: "memory");
      const unsigned og = xb_add(&bar[XB_TOP], 1u);
      const unsigned tg = og / nx;
      if (og + 1u == (tg + 1u) * nx) xb_add(&bar[XB_TOPGEN], 1u);
      else XB_SPIN(xb_ld(&bar[XB_TOPGEN]) == tg, bar);
      __builtin_amdgcn_fence(__ATOMIC_ACQUIRE, "agent");
      xb_add(&bar[XB_XGEN(b.x)], 1u);
      asm volatile("s_waitcnt vmcnt(0)" ::: "memory");
    } else {
      XB_SPIN(xb_ld(&bar[XB_XGEN(b.x)]) == gen, bar);
      __builtin_amdgcn_fence(__ATOMIC_ACQUIRE, "agent");
      asm volatile("s_waitcnt vmcnt(0)" ::: "memory");
    }
  }
  __syncthreads();
}
constexpr int LDS_BARST = 163840 - 16;

__global__ void __launch_bounds__(512) mk(Params p) {
  cg::grid_group grid = cg::this_grid();
  const int nb = gridDim.x, bid = blockIdx.x;
  volatile LAS unsigned* bst_ = (volatile LAS unsigned*)(smem + LDS_BARST);
  if (threadIdx.x < 4) bst_[threadIdx.x] = 0u;
  __syncthreads();
  (void)xcd_barrier_post((unsigned*)(p.ws + O_BAR), bst_);
#define XB_NOW() XcdBarrier{(unsigned*)(p.ws + O_BAR), xb_xcc_id(), (volatile LAS unsigned*)(smem + LDS_BARST)}
  phase0(p);
  grid.sync();
  for (int layer = 0; layer < DEPTH_; ++layer) {
    {
      const int gtid = bid * 512 + vtid(), gthreads = nb * 512;
      conv_weight(p.w_up_a + (size_t)layer * 512 * 1024, 512, 1024, 1024, false, (uint4*)(p.ws + O_WUA), gtid, gthreads);
      conv_weight(p.w_up_b + (size_t)layer * 512 * 1024, 512, 1024, 1024, false, (uint4*)(p.ws + O_WUB), gtid, gthreads);
      conv_weight(p.w_out + (size_t)layer * 1024 * 1024, 1024, 1024, 1024, false, (uint4*)(p.ws + O_WOUT), gtid, gthreads);
#ifndef NO_P1
      for (int id = bid; id < 64 * 27; id += nb) p1_tile8(p, layer, id & 63, id >> 6);
#endif
    }
    xcd_barrier(XB_NOW());
    {
      if (layer + 1 < DEPTH_) {
        const int gtid = bid * 512 + vtid(), gthreads = nb * 512;
        conv_weight_rm(p.w_in + (size_t)(layer + 1) * 1024 * NIN, 1024, NIN, NPAD, true, (uint4*)(p.ws + O_WTIN), gtid, gthreads);
      }
#ifndef NO_HA
      for (int id = bid; id < 1024; id += nb) hgrn_a_item(p, id >> 2, id & 3);
#endif
      for (int s = bid; s < 1024; s += nb) {
        const int rnd = s / nb, pos = s - rnd * nb;
        const int rem = 1024 - rnd * nb, count = rem < nb ? rem : nb;
        const int sp = (rnd & 1) ? (rnd * nb + count - 1 - pos) : s;
        indexer_item(p, 1023 - sp);
      }
    }
    xcd_barrier(XB_NOW());
    {
      attn_setup();
      const int tid = vtid();
      if (tid < 256) ((float*)(smem + AT_RB))[tid] = p.rel_bias[tid];
      __syncthreads();
#ifndef NO_SCAN
      hgrn_scan(p);
#endif
      const int w = tid >> 6, lane = tid & 63;
#ifndef NO_ATT
      { QKPF pf; qk_fetch(p, bid * 8 + w, lane, pf);
        for (int t = bid * 8 + w; t < L_; t += nb * 8) attn_query(p, t, t + nb * 8, w, lane, pf); }
#endif
      __syncthreads();
    }
    xcd_barrier(XB_NOW());
    {
      const int tid = vtid();
      const int w = tid >> 6, lane = tid & 63;
      for (int t = bid * 8 + w; t < L_; t += nb * 8) attn_pv_query(p, t, w, lane);
      __syncthreads();
    }
    xcd_barrier(XB_NOW());
#ifndef NO_HC
    for (int id = bid; id < 1024; id += nb) hgrn_c_item(p, layer, id >> 2, id & 3);
#endif
    xcd_barrier(XB_NOW());
#ifndef NO_P5
    for (int id = bid; id < 64 * 8; id += nb) p5_tile(p, id & 63, id >> 6);
#endif
    xcd_barrier(XB_NOW());
    for (int id = bid; id < 256; id += nb) fused_out_ln(p, layer, id);
    xcd_barrier(XB_NOW());
  }}

extern "C" void kernel_launch(void* const* d_in, const int* in_sizes, int n_in, void* d_out, int out_size, void* d_ws,
                              size_t ws_size, hipStream_t stream) {
  constexpr size_t kLds = 160 * 1024;
  static int grid_blocks = 0;
  if (!grid_blocks) {
    int dev = 0, cus = 0, per_cu = 0;
    (void)hipGetDevice(&dev);
    (void)hipDeviceGetAttribute(&cus, hipDeviceAttributeMultiprocessorCount, dev);
    (void)hipFuncSetAttribute((const void*)mk, hipFuncAttributeMaxDynamicSharedMemorySize, (int)kLds);
    (void)hipOccupancyMaxActiveBlocksPerMultiprocessor(&per_cu, mk, 512, kLds);
    if (per_cu > 1) per_cu = 1;
    grid_blocks = cus * per_cu;
  }
  if (ws_size < WS_NEED || grid_blocks <= 0) { fprintf(stderr, "ws too small or no occupancy\n"); return; }
  Params p{};
  p.x = (const float*)d_in[0]; p.w_in = (const float*)d_in[1]; p.b_in = (const float*)d_in[2];
  p.w_up_a = (const float*)d_in[3]; p.w_up_b = (const float*)d_in[4]; p.w_out = (const float*)d_in[5];
  p.lb_logits = (const float*)d_in[6]; p.norm_a_g = (const float*)d_in[7]; p.rel_bias = (const float*)d_in[8];
  p.ln_g = (const float*)d_in[9]; p.ln_b = (const float*)d_in[10];
  p.out = (float*)d_out; p.ws = (char*)d_ws;
  (void)hipMemsetAsync((char*)d_ws + O_BAR, 0, XCD_BAR_WORDS * 4, stream);
  void* args[] = {&p};
  hipError_t e = hipLaunchCooperativeKernel((void*)mk, dim3(grid_blocks), dim3(512), args, kLds, stream);
  if (e != hipSuccess) fprintf(stderr, "cooperative launch failed: %s (grid %d)\n", hipGetErrorString(e), grid_blocks);
}
```

```cpp
#include <hip/hip_runtime.h>
#include <hip/hip_cooperative_groups.h>
#include <cstdio>
#include <cstdint>
namespace cg = cooperative_groups;

#define DI __device__ __forceinline__
typedef __attribute__((ext_vector_type(8))) short bf16x8;
typedef __attribute__((ext_vector_type(16))) float f32x16;
typedef __attribute__((ext_vector_type(2))) float f32x2;
typedef __attribute__((ext_vector_type(2))) __bf16 bf16x2_t;
#define MFMA(a, b, c) __builtin_amdgcn_mfma_f32_32x32x16_bf16((a), (b), (c), 0, 0, 0)

constexpr int L_ = 16384, DM = 1024, NIN = 6728, NPAD = 6912, DEPTH_ = 4;
constexpr float ALPHA_ = 1.681792830507429f;
constexpr size_t MiB = 1048576;
constexpr size_t O_WTIN = 0 * MiB, O_WUA = 14 * MiB, O_WUB = 15 * MiB, O_WOUT = 16 * MiB, O_HB = 18 * MiB,
                 O_QA = 50 * MiB, O_G = 66 * MiB, O_KK = 98 * MiB, O_IA = 114 * MiB, O_ZA = 130 * MiB,
                 O_QB = 146 * MiB, O_KB = 162 * MiB, O_VB = 178 * MiB, O_ZB = 194 * MiB, O_QI = 210 * MiB,
                 O_KI = 226 * MiB, O_WI = 228 * MiB, O_D = 228 * MiB + 512 * 1024, O_SGA = 229 * MiB,
                 O_SGB = 261 * MiB, O_US = 293 * MiB, O_SEL = 325 * MiB, O_LBS = 333 * MiB,
                 O_BAR = 333 * MiB + 65536, O_AA = 334 * MiB, O_AB = 350 * MiB, O_MG = 366 * MiB, WS_NEED = 398 * MiB;

struct Params {
  const float *x, *w_in, *b_in, *w_up_a, *w_up_b, *w_out, *lb_logits, *norm_a_g, *rel_bias, *ln_g, *ln_b;
  float* out;
  char* ws;
};

extern __shared__ __attribute__((aligned(16))) char smem[];

DI unsigned cvtpk(float lo, float hi) {
  f32x2 v = {lo, hi};
  bf16x2_t b = __builtin_convertvector(v, bf16x2_t);
  return __builtin_bit_cast(unsigned, b);
}
DI unsigned short f2bf(float x) { return (unsigned short)(cvtpk(x, 0.f) & 0xffffu); }
DI float bflo(unsigned u) { return __uint_as_float(u << 16); }
DI float bfhi(unsigned u) { return __uint_as_float(u & 0xffff0000u); }
DI float bf2f(unsigned short s) { return __uint_as_float(((unsigned)s) << 16); }
DI float sigm(float x) { return 1.f / (1.f + __expf(-x)); }
DI float silu(float x) { return x / (1.f + __expf(-x)); }
DI int crow(int r, int hi) { return (r & 3) + 8 * (r >> 2) + 4 * hi; }
DI size_t tiled_unit(int r, int k, int KS) {
  return ((size_t)(r >> 5) * KS + (k >> 4)) * 64 + (r & 31) + 32 * ((k >> 3) & 1);
}
DI float dot2(unsigned a, unsigned b, float acc) {
  asm volatile("v_dot2c_f32_bf16 %0, %1, %2" : "+v"(acc) : "v"(a), "v"(b));
  return acc;
}
template <typename T> DI T* opq(T* x) { asm volatile("" : "+s"(x)); return x; }
#define LAUNDER(pin) Params p; p.x = opq((pin).x); p.w_in = (pin).w_in; p.b_in = (pin).b_in; p.w_up_a = (pin).w_up_a; p.w_up_b = (pin).w_up_b; \
  p.w_out = (pin).w_out; p.lb_logits = (pin).lb_logits; p.norm_a_g = (pin).norm_a_g; p.rel_bias = (pin).rel_bias; p.ln_g = (pin).ln_g; \
  p.ln_b = (pin).ln_b; p.out = opq((pin).out); p.ws = opq((pin).ws);
DI int vtid() { int t = threadIdx.x; asm volatile("" : "+v"(t)); return t; }
DI unsigned vzero() { unsigned z; asm volatile("v_mov_b32 %0, 0" : "=v"(z)); return z; }
DI void cbar() { asm volatile("" ::: "memory"); }
DI void lds_fence() { asm volatile("s_waitcnt lgkmcnt(0)" ::: "memory"); }

DI int colmap(int np) {
  if (np < 4608) return np;
  if (np < 5632) return 4680 + (np - 4608);
  if (np < 6656) return 5704 + (np - 5632);
  if (np < 6720) return 4608 + (np - 6656);
  if (np < 6728) return 4672 + (np - 6720);
  return -1;
}

DI void conv_weight(const float* __restrict__ src, int K, int ldn, int Npad, bool useMap, uint4* __restrict__ dst,
                    int gtid, int gthreads) {
  const int KS = K >> 4;
  const int total = Npad * (K >> 3);
  for (int u = gtid; u < total; u += gthreads) {
    int kg = u / Npad, n = u - kg * Npad;
    int col = useMap ? colmap(n) : n;
    float v[8];
#pragma unroll
    for (int j = 0; j < 8; ++j) v[j] = (col >= 0) ? src[(size_t)(kg * 8 + j) * ldn + col] : 0.f;
    uint4 o;
    o.x = cvtpk(v[0], v[1]); o.y = cvtpk(v[2], v[3]); o.z = cvtpk(v[4], v[5]); o.w = cvtpk(v[6], v[7]);
    dst[tiled_unit(n, kg * 8, KS)] = o;
  }
}

DI void conv_weight_rm(const float* __restrict__ src, int K, int ldn, int Npad, bool useMap, uint4* __restrict__ dst,
                       int gtid, int gthreads) {
  const int total = Npad * (K >> 3);
  for (int u = gtid; u < total; u += gthreads) {
    int kg = u / Npad, n = u - kg * Npad;
    int col = useMap ? colmap(n) : n;
    float v[8];
#pragma unroll
    for (int j = 0; j < 8; ++j) v[j] = (col >= 0) ? src[(size_t)(kg * 8 + j) * ldn + col] : 0.f;
    uint4 o;
    o.x = cvtpk(v[0], v[1]); o.y = cvtpk(v[2], v[3]); o.z = cvtpk(v[4], v[5]); o.w = cvtpk(v[6], v[7]);
    dst[(size_t)n * (K >> 3) + kg] = o;
  }
}

DI void phase0(const Params& p) {
  const int gtid = blockIdx.x * 512 + vtid(), gthreads = gridDim.x * 512;
  conv_weight_rm(p.w_in, 1024, NIN, NPAD, true, (uint4*)(p.ws + O_WTIN), gtid, gthreads);
  uint4* hb = (uint4*)(p.ws + O_HB);
  for (int u = gtid; u < L_ * 128; u += gthreads) {
    const float4* s_ = (const float4*)(p.x + (size_t)u * 8);
    const float4 a = s_[0], b = s_[1];
    uint4 o;
    o.x = cvtpk(a.x, a.y); o.y = cvtpk(a.z, a.w); o.z = cvtpk(b.x, b.y); o.w = cvtpk(b.z, b.w);
    hb[u] = o;
  }
  float* lbs = (float*)(p.ws + O_LBS);
  for (int c = gtid; c < 512; c += gthreads) {
    float l0 = p.lb_logits[c], l1 = p.lb_logits[512 + c], l2 = p.lb_logits[1024 + c], l3 = p.lb_logits[1536 + c];
    float m = fmaxf(fmaxf(l0, l1), fmaxf(l2, l3));
    float e0 = expf(l0 - m), e1 = expf(l1 - m), e2 = expf(l2 - m), e3 = expf(l3 - m);
    float inv = 1.f / (e0 + e1 + e2 + e3);
    lbs[c] = 0.f; lbs[512 + c] = e1 * inv; lbs[1024 + c] = (e1 + e2) * inv; lbs[1536 + c] = (e1 + e2 + e3) * inv;
  }
}

DI void gemm_core(const uint4* __restrict__ A, int mt0, const uint4* __restrict__ B, int nt0, int KS,
                  f32x16 (&acc)[2][2], uint4* lds) {
  const int tid = vtid(), lane = tid & 63, w = tid >> 6, wm = w >> 1, wn = w & 1;
  const int nk = KS >> 2;
  const uint4* sp[6];
#pragma unroll
  for (int r = 0; r < 6; ++r) {
    int u = tid + 512 * r;
    if (u < 2048) sp[r] = A + ((size_t)(mt0 + (u >> 8)) * KS) * 64 + (u & 255);
    else { int u2 = u - 2048; sp[r] = B + ((size_t)(nt0 + (u2 >> 8)) * KS) * 64 + (u2 & 255); }
  }
#pragma unroll
  for (int r = 0; r < 6; ++r)
    __builtin_amdgcn_global_load_lds((const unsigned*)sp[r], (unsigned*)(lds + tid + 512 * r), 16, 0, 0);
  if (nk > 1) {
#pragma unroll
    for (int r = 0; r < 6; ++r)
      __builtin_amdgcn_global_load_lds((const unsigned*)(sp[r] + 256), (unsigned*)(lds + 3072 + tid + 512 * r), 16, 0, 0);
  }
  int cb = 0;
  for (int kt = 0; kt < nk; ++kt) {
    if (kt + 1 < nk) asm volatile("s_waitcnt vmcnt(6)" ::: "memory");
    else asm volatile("s_waitcnt vmcnt(0)" ::: "memory");
    __builtin_amdgcn_s_barrier();
    asm volatile("" ::: "memory");
    if (kt + 2 < nk) {
      int nb2 = cb + 2; if (nb2 >= 3) nb2 -= 3;
      uint4* nxt = lds + nb2 * 3072;
#pragma unroll
      for (int r = 0; r < 6; ++r)
        __builtin_amdgcn_global_load_lds((const unsigned*)(sp[r] + (size_t)(kt + 2) * 256), (unsigned*)(nxt + tid + 512 * r), 16, 0, 0);
    }
    const uint4* cur = lds + cb * 3072;
#pragma unroll
    for (int ks = 0; ks < 4; ++ks) {
      bf16x8 a0 = __builtin_bit_cast(bf16x8, cur[(2 * wm + 0) * 256 + ks * 64 + lane]);
      bf16x8 a1 = __builtin_bit_cast(bf16x8, cur[(2 * wm + 1) * 256 + ks * 64 + lane]);
      bf16x8 b0 = __builtin_bit_cast(bf16x8, cur[2048 + (2 * wn + 0) * 256 + ks * 64 + lane]);
      bf16x8 b1 = __builtin_bit_cast(bf16x8, cur[2048 + (2 * wn + 1) * 256 + ks * 64 + lane]);
      acc[0][0] = MFMA(a0, b0, acc[0][0]);
      acc[0][1] = MFMA(a0, b1, acc[0][1]);
      acc[1][0] = MFMA(a1, b0, acc[1][0]);
      acc[1][1] = MFMA(a1, b1, acc[1][1]);
    }
    cb = (cb == 2) ? 0 : cb + 1;
  }
  __syncthreads();
}

DI void zero_acc(f32x16 (&acc)[2][2]) {
#pragma unroll
  for (int i = 0; i < 2; ++i)
#pragma unroll
    for (int j = 0; j < 2; ++j)
#pragma unroll
      for (int r = 0; r < 16; ++r) acc[i][j][r] = 0.f;
}

typedef __attribute__((ext_vector_type(4))) float f32x4g;
DI int g8_lds_byte(int r, int c) {
  int st = (r >> 4) * 2 + (c >> 5), rr = r & 15, cc = c & 31, ob = rr * 64 + cc * 2;
  return st * 1024 + (ob ^ (((ob >> 9) & 1) << 5));
}
DI void g8_stage_rc(int b, int& R, int& C) {
  int st = b / 1024, sb = b % 1024, swz = sb ^ (((sb >> 9) & 1) << 5);
  R = (st >> 1) * 16 + swz / 64; C = (st & 1) * 32 + (swz % 64) / 2;
}
DI void gemm8p(const unsigned short* __restrict__ A, const unsigned short* __restrict__ Bt, const int K, const int brow, const int bcol,
               f32x4g (&acc)[2][2][4][2], unsigned short* shm) {
  constexpr int BK = 64, HALF = 128, HT = HALF * BK;
  const int tidx = vtid();
  #define G8_SA(b,h) (shm+((b)*2+(h))*HT)
  #define G8_SB(b,h) (shm+(4+(b)*2+(h))*HT)
  int g8vo[2];
  { int r_, c_; g8_stage_rc(tidx * 16, r_, c_); g8vo[0] = (r_ * K + c_) * 2; g8_stage_rc(tidx * 16 + 8192, r_, c_); g8vo[1] = (r_ * K + c_) * 2; }
  const __amdgpu_buffer_rsrc_t g8rA = __builtin_amdgcn_make_buffer_rsrc((void*)A, 0, 16384 * 1024 * 2, 0x00020000);
  const __amdgpu_buffer_rsrc_t g8rBt = __builtin_amdgcn_make_buffer_rsrc((void*)Bt, 0, 6912 * 1024 * 2, 0x00020000);
  #define G8_STAGE(P,BASE,br,kt) do{ const int _so = ((br) * K + (kt) * BK) * 2; \
    for(int _i=0;_i<2;++_i){ \
      __builtin_amdgcn_raw_ptr_buffer_load_lds(g8r##BASE, (__attribute__((address_space(3))) void*)((char*)(P)+tidx*16+_i*8192), 16, g8vo[_i], _so, 0, 0);}}while(0)
  #define G8_LDA(dst,b,h) for(int m=0;m<4;++m)for(int k=0;k<2;++k) \
    dst[m][k]=*reinterpret_cast<const bf16x8*>((char*)G8_SA(b,h)+g8_lds_byte(wr*64+m*16+fr,k*32+fq*8))
  #define G8_LDB(dst,b,h) for(int n=0;n<2;++n)for(int k=0;k<2;++k) \
    dst[n][k]=*reinterpret_cast<const bf16x8*>((char*)G8_SB(b,h)+g8_lds_byte(wc*32+n*16+fr,k*32+fq*8))
  #define G8_MMA(ai,bj,At,Bt_) do{__builtin_amdgcn_s_setprio(1); \
    for(int m=0;m<4;++m)for(int n=0;n<2;++n)for(int k=0;k<2;++k) \
      acc[ai][bj][m][n]=__builtin_amdgcn_mfma_f32_16x16x32_bf16(Bt_[n][k],At[m][k],acc[ai][bj][m][n],0,0,0); \
    __builtin_amdgcn_s_setprio(0);}while(0)
  #define G8_WV(n) asm volatile("s_waitcnt vmcnt(" #n ")":::"memory")
  #define G8_WL(n) asm volatile("s_waitcnt lgkmcnt(" #n ")":::"memory")
  #define G8_BAR __builtin_amdgcn_s_barrier()
  #define G8_SCHED __builtin_amdgcn_sched_barrier(0)
  const int wid = tidx >> 6, lane = tidx & 63, wr = wid >> 2, wc = wid & 3, fr = lane & 15, fq = lane >> 4;
  bf16x8 At[4][2], B0[2][2], B1[2][2];
  const int nt = K / BK;
  G8_STAGE(G8_SB(0,0),Bt,bcol,0); G8_STAGE(G8_SA(0,0),A,brow,0);
  G8_STAGE(G8_SB(0,1),Bt,bcol+HALF,0); G8_STAGE(G8_SA(0,1),A,brow+HALF,0);
  if(wr==1)G8_BAR;
  G8_WV(4); G8_BAR;
  G8_STAGE(G8_SB(1,0),Bt,bcol,1); G8_STAGE(G8_SA(1,0),A,brow,1); G8_STAGE(G8_SB(1,1),Bt,bcol+HALF,1);
  G8_WV(6); G8_BAR;
  for(int t=0;t<nt-2;t+=2){
    G8_LDB(B0,0,0); G8_SCHED; G8_LDA(At,0,0); G8_STAGE(G8_SA(1,1),A,brow+HALF,t+1);
    G8_WL(8); G8_BAR; G8_WL(0); G8_MMA(0,0,At,B0); G8_BAR; G8_SCHED;
    G8_LDB(B1,0,1); G8_STAGE(G8_SB(0,0),Bt,bcol,t+2);
    G8_BAR; G8_WL(0); G8_MMA(0,1,At,B1); G8_BAR;
    G8_LDA(At,0,1); G8_STAGE(G8_SA(0,0),A,brow,t+2);
    G8_BAR; G8_WL(0); G8_MMA(1,0,At,B0); G8_BAR; G8_SCHED;
    G8_STAGE(G8_SB(0,1),Bt,bcol+HALF,t+2);
    G8_WV(6); G8_BAR; G8_MMA(1,1,At,B1); G8_BAR;
    G8_LDB(B0,1,0); G8_SCHED; G8_LDA(At,1,0); G8_STAGE(G8_SA(0,1),A,brow+HALF,t+2);
    G8_WL(8); G8_BAR; G8_WL(0); G8_MMA(0,0,At,B0); G8_BAR; G8_SCHED;
    G8_LDB(B1,1,1); G8_STAGE(G8_SB(1,0),Bt,bcol,t+3);
    G8_BAR; G8_WL(0); G8_MMA(0,1,At,B1); G8_BAR;
    G8_LDA(At,1,1); G8_STAGE(G8_SA(1,0),A,brow,t+3);
    G8_BAR; G8_WL(0); G8_MMA(1,0,At,B0); G8_BAR; G8_SCHED;
    G8_STAGE(G8_SB(1,1),Bt,bcol+HALF,t+3);
    G8_WV(6); G8_BAR; G8_MMA(1,1,At,B1); G8_BAR;
  }
  { G8_LDB(B0,0,0); G8_LDA(At,0,0); G8_STAGE(G8_SA(1,1),A,brow+HALF,nt-1);
    G8_BAR; G8_WL(0); G8_MMA(0,0,At,B0); G8_BAR;
    G8_LDB(B1,0,1); G8_BAR; G8_WL(0); G8_MMA(0,1,At,B1); G8_BAR;
    G8_LDA(At,0,1); G8_WV(4); G8_BAR; G8_WL(0); G8_MMA(1,0,At,B0); G8_MMA(1,1,At,B1); G8_BAR; }
  { G8_LDB(B0,1,0); G8_LDA(At,1,0); G8_WV(2); G8_BAR; G8_WL(0); G8_MMA(0,0,At,B0); G8_BAR;
    G8_LDB(B1,1,1); G8_WV(0); G8_BAR; G8_WL(0); G8_MMA(0,1,At,B1); G8_BAR;
    G8_LDA(At,1,1); G8_BAR; G8_WL(0); G8_MMA(1,0,At,B0); G8_MMA(1,1,At,B1); G8_BAR; }
  if(wr==0)G8_BAR;
  __syncthreads();
}

DI void p1_tile(const Params& p, int layer, int mb, int nt) {
  const int tid = vtid(), lane = tid & 63, w = tid >> 6, wm = w >> 1, wn = w & 1, hi = lane >> 5, c31 = lane & 31;
  f32x16 acc[2][2];
  zero_acc(acc);
  gemm_core((const uint4*)(p.ws + O_HB), mb * 8, (const uint4*)(p.ws + O_WTIN), nt * 4, 64, acc, (uint4*)smem);
  unsigned short* tile = (unsigned short*)smem;
  const int row0 = mb * 256;
  const float* bin = p.b_in + (size_t)layer * NIN;
  const float* lbs = (const float*)(p.ws + O_LBS) + layer * 512;
#pragma unroll
  for (int j = 0; j < 2; ++j) {
    const int col = 64 * wn + 32 * j + c31;
    const int np = nt * 128 + col;
    const int oc = colmap(np);
    const float bias = oc >= 0 ? bin[oc] : 0.f;
    float lb = 0.f;
    if (nt >= 4 && nt < 8) lb = lbs[(nt - 4) * 128 + col];
#pragma unroll
    for (int i = 0; i < 2; ++i) {
#pragma unroll
      for (int r = 0; r < 16; ++r) {
        const int row = 64 * wm + 32 * i + crow(r, hi);
        float v = acc[i][j][r] + bias;
        float o;
        if (nt < 4) o = v;
        else if (nt < 8) {
          float sg = sigm(v);
          float f = lb + (1.f - lb) * sg;
          ((float*)(p.ws + O_G))[(size_t)(row0 + row) * 512 + (nt - 4) * 128 + col] = __logf(f);
          o = (1.f - lb) * (1.f - sg);
        } else if (nt < 12) o = v;
        else if (nt < 16) o = silu(v);
        else if (nt < 20) o = v * 0.125f;
        else if (nt < 28) o = v;
        else if (nt < 32) o = silu(v);
        else if (nt < 36) o = v;
        else if (nt < 52) o = sigm(v);
        else {
          o = v;
          if (col >= 64 && col < 72)
            ((float*)(p.ws + O_WI))[(size_t)(row0 + row) * 8 + (col - 64)] = v * 0.044194173824159216f;
        }
        tile[row * 128 + col] = f2bf(o);
      }
    }
  }
  __syncthreads();
#pragma unroll
  for (int q = 0; q < 8; ++q) {
    const int u = tid + 512 * q, r = u >> 4, c8 = u & 15;
    const uint4 val = *(const uint4*)&tile[r * 128 + c8 * 8];
    const int t = row0 + r;
    if (nt >= 20 && nt < 28) {
      int w0 = __builtin_amdgcn_cvt_pk_fp8_f32(bflo(val.x), bfhi(val.x), 0, false);
      w0 = __builtin_amdgcn_cvt_pk_fp8_f32(bflo(val.y), bfhi(val.y), w0, true);
      int w1 = __builtin_amdgcn_cvt_pk_fp8_f32(bflo(val.z), bfhi(val.z), 0, false);
      w1 = __builtin_amdgcn_cvt_pk_fp8_f32(bflo(val.w), bfhi(val.w), w1, true);
      const size_t base8 = (nt < 24) ? O_KB : O_VB;
      *(uint2*)(p.ws + base8 + (size_t)t * 512 + (nt & 3) * 128 + c8 * 8) = make_uint2((unsigned)w0, (unsigned)w1);
    } else if (nt < 32) {
      size_t base;
      switch (nt >> 2) {
        case 0: base = O_QA; break; case 1: base = O_KK; break; case 2: base = O_IA; break; case 3: base = O_ZA; break;
        case 4: base = O_QB; break; case 5: base = O_KB; break; case 6: base = O_VB; break; default: base = O_ZB; break;
      }
      *(uint4*)(p.ws + base + ((size_t)t * 512 + (nt & 3) * 128 + c8 * 8) * 2) = val;
    } else if (nt < 36) {
      const int head = 2 * (nt - 32) + (c8 >> 3), d0 = (c8 & 7) * 8;
      const int item = t >> 5, tq = t & 31, mtile = tq >> 2, q4 = tq & 3;
      const int rr = (head & 3) + 4 * (q4 >> 1) + 8 * (head >> 2) + 16 * (q4 & 1);
      const int laneA = rr + 32 * ((d0 >> 3) & 1), ks = d0 >> 4;
      ((uint4*)(p.ws + O_QI))[((size_t)(item * 8 + mtile) * 4 + ks) * 64 + laneA] = val;
    } else if (nt < 44) {
      *(uint4*)(p.ws + O_SGA + ((size_t)t * 1024 + (nt - 36) * 128 + c8 * 8) * 2) = val;
    } else if (nt < 52) {
      *(uint4*)(p.ws + O_SGB + ((size_t)t * 1024 + (nt - 44) * 128 + c8 * 8) * 2) = val;
    } else {
      if (c8 < 8) {
        const int d0 = c8 * 8;
        ((uint4*)(p.ws + O_KI))[((size_t)(t >> 5) * 4 + (d0 >> 4)) * 64 + (t & 31) + 32 * ((d0 >> 3) & 1)] = val;
      }
    }
  }
  __syncthreads();
}

constexpr int T8S = 264;
enum { C_PLAIN = 0, C_FA = 1, C_SILU = 2, C_QB = 3, C_SIGM = 4, C_KIWI = 5 };
DI float sigm_fast(float x) { return __builtin_amdgcn_rcpf(1.f + __builtin_amdgcn_exp2f(-1.4426950408889634f * x)); }
template <int CLS>
DI void p1_epi_write(const Params& p, f32x4g (&acc)[2][2][4][2], int layer, int nt2, int row0) {
  const int tid = vtid(), wid = tid >> 6, lane = tid & 63, wr = wid >> 2, wc = wid & 3, fr = lane & 15, fq = lane >> 4;
  unsigned short* tile = (unsigned short*)smem;
  const float* bin = p.b_in + (size_t)layer * NIN;
  const float* lbs = (const float*)(p.ws + O_LBS) + layer * 512;
  const int rbase = wr * 64 + fr;
#pragma unroll
  for (int bj = 0; bj < 2; ++bj) {
    if (CLS == C_KIWI && bj == 1) break;
    const int nt = 2 * nt2 + bj;
#pragma unroll
    for (int n = 0; n < 2; ++n) {
      const int c4 = wc * 32 + n * 16 + 4 * fq;
      const int np = nt * 128 + c4;
      float4 b4;
      if (CLS == C_KIWI) b4 = (c4 < 72) ? *(const float4*)(bin + (np - 2048)) : make_float4(0.f, 0.f, 0.f, 0.f);
      else if (CLS == C_SIGM) b4 = *(const float4*)(bin + (np + 72));
      else b4 = *(const float4*)(bin + np);
      float4 l4 = make_float4(0.f, 0.f, 0.f, 0.f);
      if (CLS == C_FA) l4 = *(const float4*)(lbs + (nt - 4) * 128 + c4);
#pragma unroll
      for (int ai = 0; ai < 2; ++ai)
#pragma unroll
        for (int m = 0; m < 4; ++m) {
          const int row = ai * 128 + m * 16 + rbase;
          const f32x4g a = acc[ai][bj][m][n];
          const float v0 = a[0] + b4.x, v1 = a[1] + b4.y, v2 = a[2] + b4.z, v3 = a[3] + b4.w;
          float o0, o1, o2, o3;
          if (CLS == C_PLAIN) { o0 = v0; o1 = v1; o2 = v2; o3 = v3; }
          else if (CLS == C_QB) { o0 = v0 * 0.125f; o1 = v1 * 0.125f; o2 = v2 * 0.125f; o3 = v3 * 0.125f; }
          else if (CLS == C_SILU) { o0 = v0 * sigm_fast(v0); o1 = v1 * sigm_fast(v1); o2 = v2 * sigm_fast(v2); o3 = v3 * sigm_fast(v3); }
          else if (CLS == C_SIGM) { o0 = sigm_fast(v0); o1 = sigm_fast(v1); o2 = sigm_fast(v2); o3 = sigm_fast(v3); }
          else if (CLS == C_FA) {
            const float s0 = sigm_fast(v0), s1 = sigm_fast(v1), s2 = sigm_fast(v2), s3 = sigm_fast(v3);
            float4 g;
            g.x = __logf(l4.x + (1.f - l4.x) * s0); g.y = __logf(l4.y + (1.f - l4.y) * s1);
            g.z = __logf(l4.z + (1.f - l4.z) * s2); g.w = __logf(l4.w + (1.f - l4.w) * s3);
            *(float4*)((float*)(p.ws + O_G) + (size_t)(row0 + row) * 512 + (nt - 4) * 128 + c4) = g;
            o0 = (1.f - l4.x) * (1.f - s0); o1 = (1.f - l4.y) * (1.f - s1); o2 = (1.f - l4.z) * (1.f - s2); o3 = (1.f - l4.w) * (1.f - s3);
          } else {
            o0 = v0; o1 = v1; o2 = v2; o3 = v3;
            if (c4 >= 64 && c4 < 72) {
              const float sc = 0.044194173824159216f;
              *(float4*)((float*)(p.ws + O_WI) + (size_t)(row0 + row) * 8 + (c4 - 64)) = make_float4(v0 * sc, v1 * sc, v2 * sc, v3 * sc);
            }
          }
          *(uint2*)(tile + row * T8S + 128 * bj + c4) = make_uint2(cvtpk(o0, o1), cvtpk(o2, o3));
        }
    }
  }
}

DI void p1_tile8(const Params& p, int layer, int mb, int nt2) {
  f32x4g acc[2][2][4][2];
#pragma unroll
  for (int a = 0; a < 2; ++a)
#pragma unroll
    for (int b = 0; b < 2; ++b)
#pragma unroll
      for (int m = 0; m < 4; ++m)
#pragma unroll
        for (int n = 0; n < 2; ++n) acc[a][b][m][n] = f32x4g{0.f, 0.f, 0.f, 0.f};
  gemm8p((const unsigned short*)(p.ws + O_HB), (const unsigned short*)(p.ws + O_WTIN), 1024, mb * 256, nt2 * 256, acc, (unsigned short*)smem);
  __builtin_amdgcn_sched_barrier(0);
  asm volatile("" ::: "memory");
  const int row0 = mb * 256;
  if (nt2 < 2) p1_epi_write<C_PLAIN>(p, acc, layer, nt2, row0);
  else if (nt2 < 4) p1_epi_write<C_FA>(p, acc, layer, nt2, row0);
  else if (nt2 < 6) p1_epi_write<C_PLAIN>(p, acc, layer, nt2, row0);
  else if (nt2 < 8) p1_epi_write<C_SILU>(p, acc, layer, nt2, row0);
  else if (nt2 < 10) p1_epi_write<C_QB>(p, acc, layer, nt2, row0);
  else if (nt2 < 14) p1_epi_write<C_PLAIN>(p, acc, layer, nt2, row0);
  else if (nt2 < 16) p1_epi_write<C_SILU>(p, acc, layer, nt2, row0);
  else if (nt2 < 18) p1_epi_write<C_PLAIN>(p, acc, layer, nt2, row0);
  else if (nt2 < 26) p1_epi_write<C_SIGM>(p, acc, layer, nt2, row0);
  else p1_epi_write<C_KIWI>(p, acc, layer, nt2, row0);
  __syncthreads();
  const int tid = vtid();
  const unsigned short* tile = (const unsigned short*)smem;
  const int c32 = tid & 31, rq = tid >> 5;
  if (nt2 >= 10 && nt2 < 14) {
    char* dst = p.ws + (nt2 < 12 ? O_KB : O_VB) + (size_t)row0 * 512 + (nt2 & 1) * 256 + c32 * 8;
#pragma unroll 4
    for (int q = 0; q < 16; ++q) {
      const int r = rq + 16 * q;
      const uint4 val = *(const uint4*)(tile + r * T8S + c32 * 8);
      int w0 = __builtin_amdgcn_cvt_pk_fp8_f32(bflo(val.x), bfhi(val.x), 0, false);
      w0 = __builtin_amdgcn_cvt_pk_fp8_f32(bflo(val.y), bfhi(val.y), w0, true);
      int w1 = __builtin_amdgcn_cvt_pk_fp8_f32(bflo(val.z), bfhi(val.z), 0, false);
      w1 = __builtin_amdgcn_cvt_pk_fp8_f32(bflo(val.w), bfhi(val.w), w1, true);
      *(uint2*)(dst + (size_t)r * 512) = make_uint2((unsigned)w0, (unsigned)w1);
    }
  } else if (nt2 < 16) {
    size_t base;
    switch (nt2 >> 1) {
      case 0: base = O_QA; break; case 1: base = O_KK; break; case 2: base = O_IA; break; case 3: base = O_ZA; break;
      case 4: base = O_QB; break; default: base = O_ZB; break;
    }
    char* dst = p.ws + base + ((size_t)row0 * 512 + (nt2 & 1) * 256 + c32 * 8) * 2;
#pragma unroll 4
    for (int q = 0; q < 16; ++q) {
      const int r = rq + 16 * q;
      *(uint4*)(dst + (size_t)r * 1024) = *(const uint4*)(tile + r * T8S + c32 * 8);
    }
  } else if (nt2 < 18) {
    const int head = 4 * (nt2 - 16) + (c32 >> 3), d0 = (c32 & 7) * 8;
#pragma unroll 4
    for (int q = 0; q < 16; ++q) {
      const int r = rq + 16 * q, t = row0 + r;
      const int item = t >> 5, tq = t & 31, mtile = tq >> 2, q4 = tq & 3;
      const int rr = (head & 3) + 4 * (q4 >> 1) + 8 * (head >> 2) + 16 * (q4 & 1);
      const int laneA = rr + 32 * ((d0 >> 3) & 1), ks = d0 >> 4;
      ((uint4*)(p.ws + O_QI))[((size_t)(item * 8 + mtile) * 4 + ks) * 64 + laneA] = *(const uint4*)(tile + r * T8S + c32 * 8);
    }
  } else if (nt2 < 26) {
    char* dst = p.ws + (nt2 < 22 ? O_SGA : O_SGB) + ((size_t)row0 * 1024 + ((nt2 - 18) & 3) * 256 + c32 * 8) * 2;
#pragma unroll 4
    for (int q = 0; q < 16; ++q) {
      const int r = rq + 16 * q;
      *(uint4*)(dst + (size_t)r * 2048) = *(const uint4*)(tile + r * T8S + c32 * 8);
    }
  } else {
    if (c32 < 8) {
      const int d0 = c32 * 8;
#pragma unroll 4
      for (int q = 0; q < 16; ++q) {
        const int r = rq + 16 * q, t = row0 + r;
        ((uint4*)(p.ws + O_KI))[((size_t)(t >> 5) * 4 + (d0 >> 4)) * 64 + (t & 31) + 32 * ((d0 >> 3) & 1)] = *(const uint4*)(tile + r * T8S + c32 * 8);
      }
    }
  }
  asm volatile("s_waitcnt lgkmcnt(0)" ::: "memory");
  __builtin_amdgcn_s_barrier();
}

constexpr int CAP = 1000, SEGCAP = 250, SEGTRIG = 186;
constexpr int IX_SC = 0, IX_IX = 64000, IX_RING = 96000, IX_CNT = 161536, IX_TAU = 161792, IX_FLAG = 161856, IX_WL = 161872;

DI float key2float(unsigned k) {
  unsigned b = (k & 0x80000000u) ? (k ^ 0x80000000u) : ~k;
  return __uint_as_float(b);
}
DI unsigned float2key(float f) {
  unsigned b = __float_as_uint(f);
  return (b & 0x80000000u) ? ~b : (b ^ 0x80000000u);
}
DI int wave_prefix_incl(int x) {
  int v = x;
  v += __builtin_amdgcn_update_dpp(0, v, 0x111, 0xf, 0xf, false);
  v += __builtin_amdgcn_update_dpp(0, v, 0x112, 0xf, 0xf, false);
  v += __builtin_amdgcn_update_dpp(0, v, 0x114, 0xf, 0xf, false);
  v += __builtin_amdgcn_update_dpp(0, v, 0x118, 0xf, 0xf, false);
  v += __builtin_amdgcn_update_dpp(0, v, 0x142, 0xa, 0xf, false);
  v += __builtin_amdgcn_update_dpp(0, v, 0x143, 0xc, 0xf, false);
  return v;
}

#define SEG_ADDR(j_) (((j_) >> 2) * SEGCAP + lane + 64 * ((j_) & 3))
DI int seg_count(const int4 c4, int s_) { return s_ == 0 ? c4.x : (s_ == 1 ? c4.y : (s_ == 2 ? c4.z : c4.w)); }

DI void wave_select(float* scq, unsigned short* ixq, int* cnt4q, float* tauq, unsigned* hist, int lane, unsigned short* final_sel) {
  lds_fence();
  const int4 c4 = *(const int4*)cnt4q;
  const int n = c4.x + c4.y + c4.z + c4.w;
  unsigned u[16], v16[16];
  unsigned mm = 0, am = 0;
#pragma unroll
  for (int j = 0; j < 16; ++j) {
    const bool valid = (lane + 64 * (j & 3)) < seg_count(c4, j >> 2);
    const float sv = valid ? scq[SEG_ADDR(j)] : 0.f;
    const unsigned id = valid ? (unsigned)ixq[SEG_ADDR(j)] : 0u;
    u[j] = float2key(sv);
    v16[j] = 0xFFFFu - id;
    mm |= (((unsigned)(lane + 64 * (j & 3)) - (unsigned)seg_count(c4, j >> 2)) >> 31) << j;
  }
  unsigned prefix_u = 0;
  if (n > 256) {
    int need = 256;
    int r0 = 0;
    {
      unsigned ref = 0; bool have = false;
#pragma unroll
      for (int j = 15; j >= 0; --j) if ((mm >> j) & 1u) { ref = u[j] >> 24; have = true; }
      const unsigned long long hm = __ballot(have);
      const int fl = __ffsll((long long)hm) - 1;
      ref = (unsigned)__builtin_amdgcn_readlane((int)ref, fl);
      bool same = true;
#pragma unroll
      for (int j = 0; j < 16; ++j) same = same && (!((mm >> j) & 1u) || ((u[j] >> 24) == ref));
      if (__all(same)) { prefix_u = ref << 24; r0 = 1; }
    }
    for (int r = r0; r < 6; ++r) {
      const int sh = (r < 4) ? (24 - 8 * r) : (r == 4 ? 8 : 0);
      { const unsigned z_ = vzero(); ((uint4*)hist)[lane] = make_uint4(z_, z_, z_, z_); }
      lds_fence();
#pragma unroll
      for (int j = 0; j < 16; ++j) {
        const unsigned src = (r < 4) ? u[j] : v16[j];
        const unsigned dgt = ((mm >> j) & 1u) ? ((src >> sh) & 255u) : 256u + lane;
        atomicAdd(&hist[dgt], 1u);
      }
      lds_fence();
      const uint4 hv = ((const uint4*)hist)[lane];
      const int c0 = hv.x, c1 = hv.y, c2 = hv.z, c3 = hv.w;
      const int Lsum = c0 + c1 + c2 + c3;
      const int Pfx = wave_prefix_incl(Lsum);
      const int total = __builtin_amdgcn_readlane(Pfx, 63);
      const int S = total - Pfx + Lsum;
      const unsigned long long mask = __ballot(S >= need);
      const int lstar = 63 - __clzll((long long)mask);
      int d_, ca_, cd_;
      {
        const int accu = S - Lsum;
        if (accu + c3 >= need) { d_ = 3; ca_ = accu; cd_ = c3; }
        else if (accu + c3 + c2 >= need) { d_ = 2; ca_ = accu + c3; cd_ = c2; }
        else if (accu + c3 + c2 + c1 >= need) { d_ = 1; ca_ = accu + c3 + c2; cd_ = c1; }
        else { d_ = 0; ca_ = accu + c3 + c2 + c1; cd_ = c0; }
      }
      const int D = __builtin_amdgcn_readlane(4 * lane + d_, lstar);
      const int cntAbove = __builtin_amdgcn_readlane(ca_, lstar);
      const int cntD = __builtin_amdgcn_readlane(cd_, lstar);
#pragma unroll
      for (int j = 0; j < 16; ++j) {
        const unsigned src = (r < 4) ? u[j] : v16[j];
        const int dgt = (int)((src >> sh) & 255u);
        const unsigned bit = mm & (1u << j);
        const unsigned dd = (unsigned)D - (unsigned)dgt, de = (unsigned)dgt - (unsigned)D;
        const unsigned gtm = (unsigned)((int)dd >> 31);
        const unsigned nem = (unsigned)((int)(dd | de) >> 31);
        am |= bit & gtm;
        mm ^= bit & nem;
      }
      need -= cntAbove;
      if (r < 4) prefix_u |= ((unsigned)D) << sh;
      if (cntD == need) break;
    }
  }
  const unsigned km = am | mm;
  int base = 0;
#pragma unroll
  for (int j = 0; j < 16; ++j) {
    const bool keep = (km >> j) & 1u;
    const unsigned long long m = __ballot(keep);
    const int rk = base + __popcll(m & ((1ull << lane) - 1ull));
    if (keep) {
      if (final_sel) { if (rk < 256) final_sel[rk] = (unsigned short)(0xFFFFu - v16[j]); }
      else { const int ad = (rk & 3) * SEGCAP + (rk >> 2); scq[ad] = key2float(u[j]); ixq[ad] = (unsigned short)(0xFFFFu - v16[j]); }
    }
    base += __popcll(m);
  }
  if (!final_sel && lane == 0) {
    *(int4*)cnt4q = make_int4((base + 3) >> 2, (base + 2) >> 2, (base + 1) >> 2, base >> 2);
    if (n > 256) *tauq = key2float(prefix_u);
  }
  lds_fence();
}

typedef float f32x2v __attribute__((ext_vector_type(2)));
DI float relu_(float x) { int i = __float_as_int(x); i = i > 0 ? i : 0; return __int_as_float(i); }

DI unsigned wave_umin(unsigned v) {
#define UMIN_STEP(ctrl, rm) { const unsigned o_ = (unsigned)__builtin_amdgcn_update_dpp((int)0xFFFFFFFFu, (int)v, ctrl, rm, 0xf, false); v = o_ < v ? o_ : v; }
  UMIN_STEP(0x111, 0xf) UMIN_STEP(0x112, 0xf) UMIN_STEP(0x114, 0xf) UMIN_STEP(0x118, 0xf) UMIN_STEP(0x142, 0xa) UMIN_STEP(0x143, 0xc)
#undef UMIN_STEP
  return (unsigned)__builtin_amdgcn_readlane((int)v, 63);
}
DI unsigned wave_umax(unsigned v) {
#define UMAX_STEP(ctrl, rm) { const unsigned o_ = (unsigned)__builtin_amdgcn_update_dpp(0, (int)v, ctrl, rm, 0xf, false); v = o_ > v ? o_ : v; }
  UMAX_STEP(0x111, 0xf) UMAX_STEP(0x112, 0xf) UMAX_STEP(0x114, 0xf) UMAX_STEP(0x118, 0xf) UMAX_STEP(0x142, 0xa) UMAX_STEP(0x143, 0xc)
#undef UMAX_STEP
  return (unsigned)__builtin_amdgcn_readlane((int)v, 63);
}
DI void wave_compact(float* scq, unsigned short* ixq, int* cnt4q, float* tauq, unsigned* hist, int lane) {
  lds_fence();
  const int4 c4 = *(const int4*)cnt4q;
  const int n = c4.x + c4.y + c4.z + c4.w;
  if (n <= 320) return;
  unsigned u[16], idv[16];
  unsigned vm = 0;
  unsigned umin = 0xFFFFFFFFu, umax = 0u;
  { const unsigned z_ = vzero(); ((uint4*)hist)[lane] = make_uint4(z_, z_, z_, z_); }

#pragma unroll
  for (int j = 0; j < 16; ++j) {
    const bool valid = (lane + 64 * (j & 3)) < seg_count(c4, j >> 2);
    u[j] = valid ? float2key(scq[SEG_ADDR(j)]) : 0u;
    idv[j] = valid ? (unsigned)ixq[SEG_ADDR(j)] : 0u;
    vm |= (((unsigned)(lane + 64 * (j & 3)) - (unsigned)seg_count(c4, j >> 2)) >> 31) << j;
    umin = valid ? (u[j] < umin ? u[j] : umin) : umin;
    umax = valid ? (u[j] > umax ? u[j] : umax) : umax;
  }
  umin = wave_umin(umin);
  umax = wave_umax(umax);
  const unsigned range = umax - umin;
  const int sh = range < 256u ? 0 : (24 - __clz((int)range));
#pragma unroll
  for (int j = 0; j < 16; ++j) {
    const unsigned bin = ((vm >> j) & 1u) ? ((u[j] - umin) >> sh) : 256u + lane;
    atomicAdd(&hist[bin], 1u);
  }
  lds_fence();
  const uint4 hv = ((const uint4*)hist)[lane];
  const int c0 = hv.x, c1 = hv.y, c2 = hv.z, c3 = hv.w;
  const int Lsum = c0 + c1 + c2 + c3;
  const int Pfx = wave_prefix_incl(Lsum);
  const int total = __builtin_amdgcn_readlane(Pfx, 63);
  const int S = total - Pfx + Lsum;
  const unsigned long long mask = __ballot(S >= 256);
  const int lstar = 63 - __clzll((long long)mask);
  int d_, kept_;
  {
    const int accu = S - Lsum;
    if (accu + c3 >= 256) { d_ = 3; kept_ = accu + c3; }
    else if (accu + c3 + c2 >= 256) { d_ = 2; kept_ = accu + c3 + c2; }
    else if (accu + c3 + c2 + c1 >= 256) { d_ = 1; kept_ = accu + c3 + c2 + c1; }
    else { d_ = 0; kept_ = accu + Lsum; }
  }
  const int D = __builtin_amdgcn_readlane(4 * lane + d_, lstar);
  const int kept = __builtin_amdgcn_readlane(kept_, lstar);
  if (kept > 400) return;
  int base = 0;
#pragma unroll
  for (int j = 0; j < 16; ++j) {
    const bool keep = ((vm >> j) & 1u) && ((int)((u[j] - umin) >> sh) >= D);
    const unsigned long long m = __ballot(keep);
    const int rk = base + __popcll(m & ((1ull << lane) - 1ull));
    if (keep) { const int ad = (rk & 3) * SEGCAP + (rk >> 2); scq[ad] = key2float(u[j]); ixq[ad] = (unsigned short)idv[j]; }
    base += __popcll(m);
  }
  if (lane == 0) {
    *(int4*)cnt4q = make_int4((base + 3) >> 2, (base + 2) >> 2, (base + 1) >> 2, base >> 2);
    *tauq = key2float(umin + ((unsigned)D << sh));
  }
  lds_fence();
}

#define IDX_GLDS(step, bufi) do { _Pragma("unroll") for (int r_ = 0; r_ < 4; ++r_) \
    __builtin_amdgcn_global_load_lds((const unsigned*)(ki + (size_t)(step) * 2048 + tid + 512 * r_), \
                                     (unsigned*)(ring + (bufi) * 2048 + tid + 512 * r_), 16, 0, 0); } while (0)

DI void indexer_item(const Params& p, int item) {
  const int tid = vtid(), lane = tid & 63, w = tid >> 6, g = w & 1, kg = w >> 1, hi = lane >> 5, c31 = lane & 31;
  float* sc = (float*)(smem + IX_SC);
  unsigned short* ix = (unsigned short*)(smem + IX_IX);
  uint4* ring = (uint4*)(smem + IX_RING);
  int* cnt = (int*)(smem + IX_CNT);
  volatile int* flag = (volatile int*)(smem + IX_FLAG);
  float* tauv = (float*)(smem + IX_TAU);
  const uint4* qi = (const uint4*)(p.ws + O_QI);
  const uint4* ki = (const uint4*)(p.ws + O_KI);
  const float* wi = (const float*)(p.ws + O_WI);
  const int t0 = 16 * item;
  bf16x8 a[2][4];
#pragma unroll
  for (int mt = 0; mt < 2; ++mt)
#pragma unroll
    for (int ks = 0; ks < 4; ++ks)
      a[mt][ks] = __builtin_bit_cast(bf16x8, qi[((size_t)((item >> 1) * 8 + (item & 1) * 4 + 2 * g + mt) * 4 + ks) * 64 + lane]);
  float* wl = (float*)(smem + IX_WL);
  if (tid < 128) wl[tid] = wi[(size_t)t0 * 8 + tid];
  float tau[2][2];
#pragma unroll
  for (int mt = 0; mt < 2; ++mt) { tau[mt][0] = -INFINITY; tau[mt][1] = -INFINITY; }
  if (tid < 64) cnt[tid] = 0;
  if (tid < 16) tauv[tid] = -INFINITY;
  int cntv[2][2] = {{0, 0}, {0, 0}};
  if (tid < 2) flag[tid] = 0;
  const int nsteps = (t0 + 16 + 255) >> 8;
  asm volatile("s_waitcnt vmcnt(0)" ::: "memory");
  IDX_GLDS(0, 0);
  if (nsteps > 1) { IDX_GLDS(1, 1); asm volatile("s_waitcnt vmcnt(4)" ::: "memory"); }
  else asm volatile("s_waitcnt vmcnt(0)" ::: "memory");
  __syncthreads();
  const f32x16 z = {0.f, 0.f, 0.f, 0.f, 0.f, 0.f, 0.f, 0.f, 0.f, 0.f, 0.f, 0.f, 0.f, 0.f, 0.f, 0.f};
  f32x16 Ca0, Ca1, Cb0, Cb1;
  {
    const uint4* cur = ring;
    const uint4* bp = cur + ((2 * kg + 0) * 4) * 64 + lane;
    bf16x8 b0 = __builtin_bit_cast(bf16x8, bp[0]), b1 = __builtin_bit_cast(bf16x8, bp[64]);
    bf16x8 b2 = __builtin_bit_cast(bf16x8, bp[128]), b3 = __builtin_bit_cast(bf16x8, bp[192]);
    Ca0 = MFMA(a[0][0], b0, z); Ca1 = MFMA(a[1][0], b0, z);
    Ca0 = MFMA(a[0][1], b1, Ca0); Ca1 = MFMA(a[1][1], b1, Ca1);
    Ca0 = MFMA(a[0][2], b2, Ca0); Ca1 = MFMA(a[1][2], b2, Ca1);
    Ca0 = MFMA(a[0][3], b3, Ca0); Ca1 = MFMA(a[1][3], b3, Ca1);
  }
#define IDX_SCORE(Cx, mt_, aa_, sout) do { const float4 wa_ = *(const float4*)(wl + (8 * g + 4 * (mt_) + 2 * hi + (aa_)) * 8); \
    const float4 wb_ = *(const float4*)(wl + (8 * g + 4 * (mt_) + 2 * hi + (aa_)) * 8 + 4); \
    f32x2v r0_ = {relu_(Cx[8 * (aa_) + 0]), relu_(Cx[8 * (aa_) + 1])}, r1_ = {relu_(Cx[8 * (aa_) + 2]), relu_(Cx[8 * (aa_) + 3])}; \
    f32x2v r2_ = {relu_(Cx[8 * (aa_) + 4]), relu_(Cx[8 * (aa_) + 5])}, r3_ = {relu_(Cx[8 * (aa_) + 6]), relu_(Cx[8 * (aa_) + 7])}; \
    const f32x2v w0_ = {wa_.x, wa_.y}, w1_ = {wa_.z, wa_.w}, w2_ = {wb_.x, wb_.y}, w3_ = {wb_.z, wb_.w}; \
    f32x2v ac_ = r0_ * w0_; ac_ = r1_ * w1_ + ac_; ac_ = r2_ * w2_ + ac_; ac_ = r3_ * w3_ + ac_; \
    sout = ac_.x + ac_.y; } while (0)
  const unsigned ltm = (1u << c31) - 1u;
  const int tqb = t0 + 8 * g + 2 * hi;
  const int sb0 = ((8 * g + 2 * hi) * CAP + kg * SEGCAP) * 4;
#define IDX_APPEND(sval, mt_, aa_, keyv) do { \
    const bool pr_ = ((keyv) <= tqb + 4 * (mt_) + (aa_)) && ((sval) >= tau[mt_][aa_]); \
    const unsigned long long bm_ = __builtin_amdgcn_ballot_w64(pr_); \
    const unsigned half_ = hi ? (unsigned)(bm_ >> 32) : (unsigned)bm_; \
    const int pos_ = cntv[mt_][aa_] + __popc(half_ & ltm); \
    if (pr_) { const int bo_ = sb0 + (4 * (mt_) + (aa_)) * CAP * 4 + pos_ * 4; \
      *(float*)((char*)sc + bo_) = (sval); *(unsigned short*)((char*)ix + (bo_ >> 1)) = (unsigned short)(keyv); } \
    cntv[mt_][aa_] += __popc(half_); } while (0)
#define IDX_PUBLISH() do { if (c31 == 0) { _Pragma("unroll") for (int mt_ = 0; mt_ < 2; ++mt_) _Pragma("unroll") for (int aa_ = 0; aa_ < 2; ++aa_) \
    cnt[4 * (8 * g + 4 * mt_ + 2 * hi + aa_) + kg] = cntv[mt_][aa_]; } } while (0)
  for (int j = 0; j < nsteps; ++j) {
    const uint4* cur = ring + (j & 1) * 2048;
    {
      const uint4* bp = cur + ((2 * kg + 1) * 4) * 64 + lane;
      bf16x8 b0 = __builtin_bit_cast(bf16x8, bp[0]), b1 = __builtin_bit_cast(bf16x8, bp[64]);
      bf16x8 b2 = __builtin_bit_cast(bf16x8, bp[128]), b3 = __builtin_bit_cast(bf16x8, bp[192]);
      Cb0 = MFMA(a[0][0], b0, z); Cb1 = MFMA(a[1][0], b0, z);
      Cb0 = MFMA(a[0][1], b1, Cb0); Cb1 = MFMA(a[1][1], b1, Cb1);
      Cb0 = MFMA(a[0][2], b2, Cb0); Cb1 = MFMA(a[1][2], b2, Cb1);
      Cb0 = MFMA(a[0][3], b3, Cb0); Cb1 = MFMA(a[1][3], b3, Cb1);
    }
    {
      const int key = 256 * j + 64 * kg + c31;
      float s00, s01, s10, s11;
      IDX_SCORE(Ca0, 0, 0, s00); IDX_SCORE(Ca0, 0, 1, s01); IDX_SCORE(Ca1, 1, 0, s10); IDX_SCORE(Ca1, 1, 1, s11);
#pragma unroll
      for (int q_ = 0; q_ < 8; ++q_) { __builtin_amdgcn_sched_group_barrier(0x008, 1, 0); __builtin_amdgcn_sched_group_barrier(0x002, 9, 0); }
      IDX_APPEND(s00, 0, 0, key); IDX_APPEND(s01, 0, 1, key); IDX_APPEND(s10, 1, 0, key); IDX_APPEND(s11, 1, 1, key);
    }
    IDX_PUBLISH();
    {
      const int mxc = max(max(cntv[0][0], cntv[0][1]), max(cntv[1][0], cntv[1][1]));
      if (__ballot(mxc > SEGTRIG) != 0ull) { if (lane == 0) flag[j & 1] = j + 1; }
    }
    __syncthreads();
    if (flag[j & 1] == j + 1) {
      unsigned* hist = (unsigned*)(ring + (j & 1) * 2048) + w * 512;
#pragma unroll 1
      for (int k = 0; k < 2; ++k) {
        const int q = 2 * w + k;
        wave_compact(sc + q * CAP, ix + q * CAP, cnt + 4 * q, tauv + q, hist, lane);
        lds_fence();
        { const int4 cc = *(const int4*)(cnt + 4 * q); if (cc.x + cc.y + cc.z + cc.w > 400) wave_select(sc + q * CAP, ix + q * CAP, cnt + 4 * q, tauv + q, hist, lane, nullptr); }
      }
      __syncthreads();
#pragma unroll
      for (int mt = 0; mt < 2; ++mt)
#pragma unroll
        for (int aa = 0; aa < 2; ++aa) { const int ql = 8 * g + 4 * mt + 2 * hi + aa; tau[mt][aa] = tauv[ql]; cntv[mt][aa] = cnt[4 * ql + kg]; }
    }
    if (j + 2 < nsteps) IDX_GLDS(j + 2, j & 1);
    if (j + 1 < nsteps) {
      const uint4* nxt = ring + ((j + 1) & 1) * 2048;
      const uint4* bp = nxt + ((2 * kg + 0) * 4) * 64 + lane;
      bf16x8 b0 = __builtin_bit_cast(bf16x8, bp[0]), b1 = __builtin_bit_cast(bf16x8, bp[64]);
      bf16x8 b2 = __builtin_bit_cast(bf16x8, bp[128]), b3 = __builtin_bit_cast(bf16x8, bp[192]);
      Ca0 = MFMA(a[0][0], b0, z); Ca1 = MFMA(a[1][0], b0, z);
      Ca0 = MFMA(a[0][1], b1, Ca0); Ca1 = MFMA(a[1][1], b1, Ca1);
      Ca0 = MFMA(a[0][2], b2, Ca0); Ca1 = MFMA(a[1][2], b2, Ca1);
      Ca0 = MFMA(a[0][3], b3, Ca0); Ca1 = MFMA(a[1][3], b3, Ca1);
    }
    {
      const int key = 256 * j + 64 * kg + 32 + c31;
      float s00, s01, s10, s11;
      IDX_SCORE(Cb0, 0, 0, s00); IDX_SCORE(Cb0, 0, 1, s01); IDX_SCORE(Cb1, 1, 0, s10); IDX_SCORE(Cb1, 1, 1, s11);
#pragma unroll
      for (int q_ = 0; q_ < 8; ++q_) { __builtin_amdgcn_sched_group_barrier(0x008, 1, 0); __builtin_amdgcn_sched_group_barrier(0x002, 9, 0); }
      IDX_APPEND(s00, 0, 0, key); IDX_APPEND(s01, 0, 1, key); IDX_APPEND(s10, 1, 0, key); IDX_APPEND(s11, 1, 1, key);
    }
  }
  IDX_PUBLISH();
  __syncthreads();
  unsigned short* sel = (unsigned short*)(p.ws + O_SEL);
  unsigned* hist = (unsigned*)ring + w * 512;
#pragma unroll 1
  for (int k = 0; k < 2; ++k) {
    const int q = 2 * w + k;
    wave_select(sc + q * CAP, ix + q * CAP, cnt + 4 * q, tauv + q, hist, lane, sel + (size_t)(t0 + q) * 256);
  }
  __syncthreads();
}

DI void hgrn_a_item(const Params& p, int c, int h) {
  const int tid = vtid(), lane = tid & 63, w = tid >> 6, hi = lane >> 5, c31 = lane & 31;
  float* tot = (float*)smem;
  unsigned short* kT = (unsigned short*)(smem + 2048);
  unsigned short* vT = (unsigned short*)(smem + 2048 + 18432);
  const int seg = tid >> 7, k = tid & 127;
  const float* G = (const float*)(p.ws + O_G);
  const unsigned short* KK = (const unsigned short*)(p.ws + O_KK);
  const unsigned short* IA = (const unsigned short*)(p.ws + O_IA);
  const size_t rowbase = (size_t)(64 * c + 16 * seg);
  float b[16];
  {
    float run = 0.f;
#pragma unroll
    for (int i = 0; i < 16; ++i) { run += G[(rowbase + i) * 512 + 128 * h + k]; b[i] = run; }
    tot[seg * 128 + k] = run;
  }
  __syncthreads();
  float off = 0.f, blast = 0.f;
#pragma unroll
  for (int s2 = 0; s2 < 4; ++s2) { float tv = tot[s2 * 128 + k]; if (s2 < seg) off += tv; blast += tv; }
  {
    unsigned pk[8], pv[8];
#pragma unroll
    for (int i = 0; i < 16; i += 2) {
      float k0 = bf2f(KK[(rowbase + i) * 512 + 128 * h + k]) * __expf(blast - (b[i] + off));
      float k1 = bf2f(KK[(rowbase + i + 1) * 512 + 128 * h + k]) * __expf(blast - (b[i + 1] + off));
      pk[i >> 1] = cvtpk(k0, k1);
      unsigned v0 = IA[(rowbase + i) * 512 + 128 * h + k], v1 = IA[(rowbase + i + 1) * 512 + 128 * h + k];
      pv[i >> 1] = v0 | (v1 << 16);
    }
    uint4* dk = (uint4*)(kT + k * 72 + 16 * seg);
    dk[0] = make_uint4(pk[0], pk[1], pk[2], pk[3]); dk[1] = make_uint4(pk[4], pk[5], pk[6], pk[7]);
    uint4* dv = (uint4*)(vT + k * 72 + 16 * seg);
    dv[0] = make_uint4(pv[0], pv[1], pv[2], pv[3]); dv[1] = make_uint4(pv[4], pv[5], pv[6], pv[7]);
    if (seg == 0) ((float*)(p.ws + O_D))[(size_t)(c * 4 + h) * 128 + k] = __expf(blast);
  }
  __syncthreads();
  const int mt = w >> 1;
  f32x16 acc[2];
#pragma unroll
  for (int r = 0; r < 16; ++r) { acc[0][r] = 0.f; acc[1][r] = 0.f; }
#pragma unroll
  for (int ks = 0; ks < 4; ++ks) {
    bf16x8 af = __builtin_bit_cast(bf16x8, *(const uint4*)(kT + (32 * mt + c31) * 72 + 16 * ks + 8 * hi));
#pragma unroll
    for (int jn = 0; jn < 2; ++jn) {
      const int nt = 2 * (w & 1) + jn;
      bf16x8 bfv = __builtin_bit_cast(bf16x8, *(const uint4*)(vT + (32 * nt + c31) * 72 + 16 * ks + 8 * hi));
      acc[jn] = MFMA(af, bfv, acc[jn]);
    }
  }
  char* us = p.ws + O_US + (size_t)(c * 4 + h) * 32768;
#pragma unroll
  for (int jn = 0; jn < 2; ++jn) {
    const int nt = 2 * (w & 1) + jn;
    const int v = 32 * nt + c31;
#pragma unroll
    for (int gq = 0; gq < 4; ++gq) {
      const int k0 = 32 * mt + 8 * gq;
      const size_t unit = ((size_t)(v >> 5) * 8 + (k0 >> 4)) * 64 + (v & 31) + 32 * ((k0 >> 3) & 1);
      uint2 val;
      val.x = cvtpk(acc[jn][4 * gq + 0], acc[jn][4 * gq + 1]);
      val.y = cvtpk(acc[jn][4 * gq + 2], acc[jn][4 * gq + 3]);
      *(uint2*)(us + unit * 16 + 8 * hi) = val;
    }
  }
  __syncthreads();
}

DI void hgrn_scan(const Params& p) {
  const int tid = vtid();
  if (tid >= 128) return;
  for (int pid = blockIdx.x * 128 + tid; pid < 32768; pid += gridDim.x * 128) {
    const int q4 = pid & 3, unit = (pid >> 2) & 2047, h = pid >> 13;
    const int lanep = unit & 63, ks = (unit >> 6) & 7;
    const int k = ks * 16 + 8 * (lanep >> 5) + 2 * q4;
    unsigned* us = (unsigned*)(p.ws + O_US) + (size_t)h * 8192 + unit * 4 + q4;
    const float* dd = (const float*)(p.ws + O_D) + h * 128 + k;
    float s0 = 0.f, s1 = 0.f;
    unsigned uv[16], un[16];
    float2 dv[16], dn[16];
#pragma unroll
    for (int i = 0; i < 16; ++i) { uv[i] = us[(size_t)i * 32768]; dv[i] = *(const float2*)(dd + (size_t)i * 512); }
#pragma unroll 1
    for (int c0 = 0; c0 < 256; c0 += 16) {
      const int cn = (c0 + 16 < 256) ? c0 + 16 : c0;
#pragma unroll
      for (int i = 0; i < 16; ++i) { un[i] = us[(size_t)(cn + i) * 32768]; dn[i] = *(const float2*)(dd + (size_t)(cn + i) * 512); }
      asm volatile("" ::: "memory");
#pragma unroll
      for (int i = 0; i < 16; ++i) {
        us[(size_t)(c0 + i) * 32768] = cvtpk(s0, s1);
        s0 = fmaf(dv[i].x, s0, bflo(uv[i]));
        s1 = fmaf(dv[i].y, s1, bfhi(uv[i]));
      }
      asm volatile("" ::: "memory");
#pragma unroll
      for (int i = 0; i < 16; ++i) { uv[i] = un[i]; dv[i] = dn[i]; }
    }
  }
}

constexpr int AT_LUT = 0, AT_RB = 512, AT_WAVE = 2048, AT_WSZ = 8192 + 1024 + 16 * 528;
DI void attn_setup() {
  const int tid = vtid();
  int* lut = (int*)(smem + AT_LUT);
  if (tid < 128) {
    int d = tid;
    int bk;
    if (d < 16) bk = d;
    else {
      float df = (float)d;
      int lg = 16 + (int)(logf(df / 16.f) / 2.0794415416798357f * 16.f);
      bk = lg < 31 ? lg : 31;
    }
    lut[tid] = bk;
  }
}
DI float dppf(float v, int ctrl_sel) {
  const int iv = __builtin_bit_cast(int, v);
  int r;
  if (ctrl_sel == 0) r = __builtin_amdgcn_update_dpp(0, iv, 0xB1, 0xf, 0xf, false);
  else if (ctrl_sel == 1) r = __builtin_amdgcn_update_dpp(0, iv, 0x4E, 0xf, 0xf, false);
  else r = __builtin_amdgcn_update_dpp(0, iv, 0x141, 0xf, 0xf, false);
  return __builtin_bit_cast(float, r);
}
DI float sum8(float v) { v += dppf(v, 0); v += dppf(v, 1); v += dppf(v, 2); return v; }
DI float max8(float v) { v = fmaxf(v, dppf(v, 0)); v = fmaxf(v, dppf(v, 1)); v = fmaxf(v, dppf(v, 2)); return v; }

DI size_t prob_off(int t) {
  return t < 8192 ? O_MG + (size_t)t * 4096 : (t < 12288 ? O_AA + (size_t)(t - 8192) * 4096 : O_QI + (size_t)(t - 12288) * 4096);
}
#define MFMA8S(a, b, c) __builtin_amdgcn_mfma_f32_16x16x32_fp8_fp8((a), (b), (c), 0, 0, 0)
typedef __attribute__((ext_vector_type(4))) float f32x4v;
constexpr int AT_KROW = 528;
struct QKPF { int s0, s1, s2, s3; uint4 q0, q1; };
DI void qk_fetch(const Params& p, int t, int lane, QKPF& f) {
  const int nsel = t + 1 < 256 ? t + 1 : 256;
  const unsigned short* sel = (const unsigned short*)(p.ws + O_SEL) + (size_t)t * 256;
  f.s0 = lane < nsel ? (int)sel[lane] : 0; f.s1 = lane + 64 < nsel ? (int)sel[lane + 64] : 0;
  f.s2 = lane + 128 < nsel ? (int)sel[lane + 128] : 0; f.s3 = lane + 192 < nsel ? (int)sel[lane + 192] : 0;
  const unsigned short* qp = (const unsigned short*)(p.ws + O_QB) + (size_t)t * 512 + (lane & 7) * 64 + 8 * (lane >> 4);
  f.q0 = *(const uint4*)qp; f.q1 = *(const uint4*)(qp + 32);
}
DI void attn_query(const Params& p, int t, int tnext, int w, int lane, QKPF& pf) {
  const int h = lane >> 3, dg = lane & 7, n15 = lane & 15, quad = lane >> 4, hi = lane >> 5, c31 = lane & 31;
  const int* lut = (const int*)(smem + AT_LUT);
  const float* rb = (const float*)(smem + AT_RB);
  float* lgw = (float*)(smem + AT_WAVE + w * AT_WSZ);
  int* ixw = (int*)(smem + AT_WAVE + w * AT_WSZ + 8192);
  char* kst = smem + AT_WAVE + w * AT_WSZ + 9216;
  const int nsel = t + 1 < 256 ? t + 1 : 256;
  ixw[lane] = pf.s0; ixw[lane + 64] = pf.s1; ixw[lane + 128] = pf.s2; ixw[lane + 192] = pf.s3;
  const uint4 qcur0 = pf.q0, qcur1 = pf.q1;
  qk_fetch(p, tnext < L_ ? tnext : t, lane, pf);
  long qreg[2];
  {
#pragma unroll
    for (int c = 0; c < 2; ++c) {
      const uint4 qv = c == 0 ? qcur0 : qcur1;
      int w0 = __builtin_amdgcn_cvt_pk_fp8_f32(bflo(qv.x) * 8.f, bfhi(qv.x) * 8.f, 0, false);
      w0 = __builtin_amdgcn_cvt_pk_fp8_f32(bflo(qv.y) * 8.f, bfhi(qv.y) * 8.f, w0, true);
      int w1 = __builtin_amdgcn_cvt_pk_fp8_f32(bflo(qv.z) * 8.f, bfhi(qv.z) * 8.f, 0, false);
      w1 = __builtin_amdgcn_cvt_pk_fp8_f32(bflo(qv.w) * 8.f, bfhi(qv.w) * 8.f, w1, true);
      const long v = (long)(((unsigned long long)(unsigned)w1 << 32) | (unsigned long long)(unsigned)w0);
      qreg[c] = (n15 < 8) ? v : 0L;
    }
  }
  long bsel[16];
#pragma unroll
  for (int ks = 0; ks < 16; ++ks) bsel[ks] = (n15 == (ks >> 1)) ? qreg[ks & 1] : 0L;
  lds_fence();
  const uint4* KB16 = (const uint4*)(p.ws + O_KB);
  const uint2* VB = (const uint2*)(p.ws + O_VB);
  const int ntile = (nsel + 15) >> 4;
#define AT_KMMA(kt_) do { f32x4v acc0 = {0.f, 0.f, 0.f, 0.f}, acc1 = acc0, acc2 = acc0, acc3 = acc0; \
    const char* ar = kst + n15 * AT_KROW + 8 * quad; \
    _Pragma("unroll") for (int ks = 0; ks < 16; ks += 4) { \
      acc0 = MFMA8S(*(const long*)(ar + 32 * ks), bsel[ks], acc0); \
      acc1 = MFMA8S(*(const long*)(ar + 32 * ks + 32), bsel[ks + 1], acc1); \
      acc2 = MFMA8S(*(const long*)(ar + 32 * ks + 64), bsel[ks + 2], acc2); \
      acc3 = MFMA8S(*(const long*)(ar + 32 * ks + 96), bsel[ks + 3], acc3); } \
    const f32x4v acc = (acc0 + acc1) + (acc2 + acc3); \
    if (n15 < 8) { _Pragma("unroll") for (int i = 0; i < 4; ++i) lgw[(16 * (kt_) + 4 * quad + i) * 8 + n15] = acc[i] * 0.125f; } \
    cbar(); } while (0)
  uint4 kgA0, kgA1, kgA2, kgA3, kgA4, kgA5, kgA6, kgA7, kgB0, kgB1, kgB2, kgB3, kgB4, kgB5, kgB6, kgB7, kgC0, kgC1, kgC2, kgC3, kgC4, kgC5, kgC6, kgC7;
    { const int tl_ = (0) < ntile ? (0) : ntile - 1;
      const int4 ia_ = *(const int4*)(ixw + 16 * tl_ + 8 * hi), ib_ = *(const int4*)(ixw + 16 * tl_ + 8 * hi + 4);
      kgA0 = KB16[(size_t)ia_.x * 32 + c31]; kgA1 = KB16[(size_t)ia_.y * 32 + c31]; kgA2 = KB16[(size_t)ia_.z * 32 + c31]; kgA3 = KB16[(size_t)ia_.w * 32 + c31];
      kgA4 = KB16[(size_t)ib_.x * 32 + c31]; kgA5 = KB16[(size_t)ib_.y * 32 + c31]; kgA6 = KB16[(size_t)ib_.z * 32 + c31]; kgA7 = KB16[(size_t)ib_.w * 32 + c31]; }
    { const int tl_ = (1) < ntile ? (1) : ntile - 1;
      const int4 ia_ = *(const int4*)(ixw + 16 * tl_ + 8 * hi), ib_ = *(const int4*)(ixw + 16 * tl_ + 8 * hi + 4);
      kgB0 = KB16[(size_t)ia_.x * 32 + c31]; kgB1 = KB16[(size_t)ia_.y * 32 + c31]; kgB2 = KB16[(size_t)ia_.z * 32 + c31]; kgB3 = KB16[(size_t)ia_.w * 32 + c31];
      kgB4 = KB16[(size_t)ib_.x * 32 + c31]; kgB5 = KB16[(size_t)ib_.y * 32 + c31]; kgB6 = KB16[(size_t)ib_.z * 32 + c31]; kgB7 = KB16[(size_t)ib_.w * 32 + c31]; }
    { const int tl_ = (2) < ntile ? (2) : ntile - 1;
      const int4 ia_ = *(const int4*)(ixw + 16 * tl_ + 8 * hi), ib_ = *(const int4*)(ixw + 16 * tl_ + 8 * hi + 4);
      kgC0 = KB16[(size_t)ia_.x * 32 + c31]; kgC1 = KB16[(size_t)ia_.y * 32 + c31]; kgC2 = KB16[(size_t)ia_.z * 32 + c31]; kgC3 = KB16[(size_t)ia_.w * 32 + c31];
      kgC4 = KB16[(size_t)ib_.x * 32 + c31]; kgC5 = KB16[(size_t)ib_.y * 32 + c31]; kgC6 = KB16[(size_t)ib_.z * 32 + c31]; kgC7 = KB16[(size_t)ib_.w * 32 + c31]; }
  for (int kt = 0; kt < ntile; kt += 3) {
    { char* wr = kst + (8 * hi) * AT_KROW + c31 * 16; *(uint4*)(wr + 0 * AT_KROW) = kgA0; *(uint4*)(wr + 1 * AT_KROW) = kgA1; *(uint4*)(wr + 2 * AT_KROW) = kgA2; *(uint4*)(wr + 3 * AT_KROW) = kgA3; *(uint4*)(wr + 4 * AT_KROW) = kgA4; *(uint4*)(wr + 5 * AT_KROW) = kgA5; *(uint4*)(wr + 6 * AT_KROW) = kgA6; *(uint4*)(wr + 7 * AT_KROW) = kgA7; }
    { const int tl_ = ((kt) + 3) < ntile ? ((kt) + 3) : ntile - 1;
      const int4 ia_ = *(const int4*)(ixw + 16 * tl_ + 8 * hi), ib_ = *(const int4*)(ixw + 16 * tl_ + 8 * hi + 4);
      kgA0 = KB16[(size_t)ia_.x * 32 + c31]; kgA1 = KB16[(size_t)ia_.y * 32 + c31]; kgA2 = KB16[(size_t)ia_.z * 32 + c31]; kgA3 = KB16[(size_t)ia_.w * 32 + c31];
      kgA4 = KB16[(size_t)ib_.x * 32 + c31]; kgA5 = KB16[(size_t)ib_.y * 32 + c31]; kgA6 = KB16[(size_t)ib_.z * 32 + c31]; kgA7 = KB16[(size_t)ib_.w * 32 + c31]; }
    cbar();
    AT_KMMA(kt);
    if (kt + 1 < ntile) {
    { char* wr = kst + (8 * hi) * AT_KROW + c31 * 16; *(uint4*)(wr + 0 * AT_KROW) = kgB0; *(uint4*)(wr + 1 * AT_KROW) = kgB1; *(uint4*)(wr + 2 * AT_KROW) = kgB2; *(uint4*)(wr + 3 * AT_KROW) = kgB3; *(uint4*)(wr + 4 * AT_KROW) = kgB4; *(uint4*)(wr + 5 * AT_KROW) = kgB5; *(uint4*)(wr + 6 * AT_KROW) = kgB6; *(uint4*)(wr + 7 * AT_KROW) = kgB7; }
    { const int tl_ = ((kt + 1) + 3) < ntile ? ((kt + 1) + 3) : ntile - 1;
      const int4 ia_ = *(const int4*)(ixw + 16 * tl_ + 8 * hi), ib_ = *(const int4*)(ixw + 16 * tl_ + 8 * hi + 4);
      kgB0 = KB16[(size_t)ia_.x * 32 + c31]; kgB1 = KB16[(size_t)ia_.y * 32 + c31]; kgB2 = KB16[(size_t)ia_.z * 32 + c31]; kgB3 = KB16[(size_t)ia_.w * 32 + c31];
      kgB4 = KB16[(size_t)ib_.x * 32 + c31]; kgB5 = KB16[(size_t)ib_.y * 32 + c31]; kgB6 = KB16[(size_t)ib_.z * 32 + c31]; kgB7 = KB16[(size_t)ib_.w * 32 + c31]; }
    cbar();
    AT_KMMA(kt + 1);
    }
    if (kt + 2 < ntile) {
    { char* wr = kst + (8 * hi) * AT_KROW + c31 * 16; *(uint4*)(wr + 0 * AT_KROW) = kgC0; *(uint4*)(wr + 1 * AT_KROW) = kgC1; *(uint4*)(wr + 2 * AT_KROW) = kgC2; *(uint4*)(wr + 3 * AT_KROW) = kgC3; *(uint4*)(wr + 4 * AT_KROW) = kgC4; *(uint4*)(wr + 5 * AT_KROW) = kgC5; *(uint4*)(wr + 6 * AT_KROW) = kgC6; *(uint4*)(wr + 7 * AT_KROW) = kgC7; }
    { const int tl_ = ((kt + 2) + 3) < ntile ? ((kt + 2) + 3) : ntile - 1;
      const int4 ia_ = *(const int4*)(ixw + 16 * tl_ + 8 * hi), ib_ = *(const int4*)(ixw + 16 * tl_ + 8 * hi + 4);
      kgC0 = KB16[(size_t)ia_.x * 32 + c31]; kgC1 = KB16[(size_t)ia_.y * 32 + c31]; kgC2 = KB16[(size_t)ia_.z * 32 + c31]; kgC3 = KB16[(size_t)ia_.w * 32 + c31];
      kgC4 = KB16[(size_t)ib_.x * 32 + c31]; kgC5 = KB16[(size_t)ib_.y * 32 + c31]; kgC6 = KB16[(size_t)ib_.z * 32 + c31]; kgC7 = KB16[(size_t)ib_.w * 32 + c31]; }
    cbar();
    AT_KMMA(kt + 2);
    }
  }
  lds_fence();
  const int ngroups = (nsel + 7) >> 3;
  float mx = -INFINITY;
#pragma unroll 8
  for (int i = 0; i < 32; ++i) {
    const int kk = 8 * i + dg;
    const int myidx = ixw[kk];
    const int dist = t - myidx;
    const int bk = dist < 128 ? lut[dist < 0 ? 0 : dist] : 31;
    const float raw = lgw[kk * 8 + h];
    const float lgt = (kk < nsel) ? raw + rb[bk * 8 + h] : -INFINITY;
    lgw[kk * 8 + h] = lgt;
    mx = fmaxf(mx, lgt);
  }
  mx = max8(mx);
  float sum = 0.f;
#pragma unroll 8
  for (int i = 0; i < 32; ++i) {
    const float pv = __expf(lgw[(8 * i + dg) * 8 + h] - mx);
    sum += pv;
    lgw[(8 * i + dg) * 8 + h] = pv;
  }
  sum = sum8(sum);
  {
    const float inv = 1.f / sum;
#pragma unroll 8
    for (int i = 0; i < 32; ++i) lgw[(8 * i + dg) * 8 + h] *= inv;
  }
  lds_fence();
  {
    uint4 pk[4];
#pragma unroll
    for (int k = 0; k < 4; ++k) {
      const float4 a_ = *(const float4*)(lgw + (4 * lane + k) * 8), b_ = *(const float4*)(lgw + (4 * lane + k) * 8 + 4);
      pk[k] = make_uint4(cvtpk(a_.x, a_.y), cvtpk(a_.z, a_.w), cvtpk(b_.x, b_.y), cvtpk(b_.z, b_.w));
    }
    uint4* pdst = (uint4*)(p.ws + prob_off(t)) + lane * 4;
    pdst[0] = pk[0]; pdst[1] = pk[1]; pdst[2] = pk[2]; pdst[3] = pk[3];
  }
  lds_fence();
}

DI void attn_pv_query(const Params& p, int t, int w, int lane) {
  const int h = lane >> 3, dg = lane & 7;
  unsigned short* pl = (unsigned short*)(smem + AT_WAVE + w * AT_WSZ);
  int* ixw = (int*)(smem + AT_WAVE + w * AT_WSZ + 8192);
  const int nsel = t + 1 < 256 ? t + 1 : 256;
  const unsigned short* sel = (const unsigned short*)(p.ws + O_SEL) + (size_t)t * 256;
#pragma unroll
  for (int j = 0; j < 4; ++j) {
    const int pos = lane + 64 * j;
    ixw[pos] = pos < nsel ? (int)sel[pos] : 0;
  }
  {
    const uint4* psrc = (const uint4*)(p.ws + prob_off(t)) + lane * 4;
    uint4* pd = (uint4*)pl + lane * 4;
    const uint4 a0 = psrc[0], a1 = psrc[1], a2 = psrc[2], a3 = psrc[3];
    pd[0] = a0; pd[1] = a1; pd[2] = a2; pd[3] = a3;
  }
  lds_fence();
  const uint2* VB = (const uint2*)(p.ws + O_VB);
  const int ngroups = (nsel + 7) >> 3;
  f32x2v o01 = {0.f, 0.f}, o23 = {0.f, 0.f}, o45 = {0.f, 0.f}, o67 = {0.f, 0.f};
  uint2 kc[16], kn[16];
#define AT_VLOAD16(dst, ib) do { _Pragma("unroll") for (int q_ = 0; q_ < 4; ++q_) { const int4 i_ = *(const int4*)(ixw + (ib) + 4 * q_); \
    dst[4 * q_ + 0] = VB[(size_t)i_.x * 64 + lane]; dst[4 * q_ + 1] = VB[(size_t)i_.y * 64 + lane]; \
    dst[4 * q_ + 2] = VB[(size_t)i_.z * 64 + lane]; dst[4 * q_ + 3] = VB[(size_t)i_.w * 64 + lane]; } } while (0)
  const int ng16 = (nsel + 15) >> 4;
  AT_VLOAD16(kc, 0);
  for (int i = 0; i < ng16; ++i) {
    { const int nx = (i + 1 < ng16) ? i + 1 : i; AT_VLOAD16(kn, 16 * nx); }
    const float pa = bf2f(pl[(16 * i + dg) * 8 + h]);
    const float pbv = bf2f(pl[(16 * i + 8 + dg) * 8 + h]);
#pragma unroll
    for (int d = 0; d < 16; ++d) {
      const float pb = __shfl(d < 8 ? pa : pbv, (lane & ~7) | (d & 7));
      const f32x2v pb2 = {pb, pb};
      o01 = __builtin_amdgcn_cvt_pk_f32_fp8(kc[d].x, false) * pb2 + o01;
      o23 = __builtin_amdgcn_cvt_pk_f32_fp8(kc[d].x, true) * pb2 + o23;
      o45 = __builtin_amdgcn_cvt_pk_f32_fp8(kc[d].y, false) * pb2 + o45;
      o67 = __builtin_amdgcn_cvt_pk_f32_fp8(kc[d].y, true) * pb2 + o67;
    }
#pragma unroll
    for (int d = 0; d < 16; ++d) kc[d] = kn[d];
  }
  const uint4 zv = ((const uint4*)(p.ws + O_ZB))[(size_t)t * 64 + lane];
  uint4 ov;
  ov.x = cvtpk(o01.x * bflo(zv.x), o01.y * bfhi(zv.x));
  ov.y = cvtpk(o23.x * bflo(zv.y), o23.y * bfhi(zv.y));
  ov.z = cvtpk(o45.x * bflo(zv.z), o45.y * bfhi(zv.z));
  ov.w = cvtpk(o67.x * bflo(zv.w), o67.y * bfhi(zv.w));
  ((uint4*)(p.ws + O_AB))[tiled_unit(t, lane * 8, 32)] = ov;
  lds_fence();
}

constexpr int HC_B = 0;
constexpr int HC_QT = 33792;
constexpr int HC_QH = HC_QT + 17408;
constexpr int HC_KH = HC_QH + 17408;
constexpr int HC_VT = HC_KH + 17408;
constexpr int HC_P = HC_VT + 18432;
constexpr int HC_TOT = HC_P + 9216;
DI void hgrn_c_item(const Params& p, int layer, int c, int h) {
  const int tid = vtid(), lane = tid & 63, w = tid >> 6, hi = lane >> 5, c31 = lane & 31;
  float* bL = (float*)(smem + HC_B);
  unsigned short* qT = (unsigned short*)(smem + HC_QT);
  unsigned short* qH = (unsigned short*)(smem + HC_QH);
  unsigned short* kH = (unsigned short*)(smem + HC_KH);
  unsigned short* vT = (unsigned short*)(smem + HC_VT);
  unsigned short* P = (unsigned short*)(smem + HC_P);
  float* tot = (float*)(smem + HC_TOT);
  const float* G = (const float*)(p.ws + O_G);
  const unsigned short* KK = (const unsigned short*)(p.ws + O_KK);
  const unsigned short* IA = (const unsigned short*)(p.ws + O_IA);
  const unsigned short* QA = (const unsigned short*)(p.ws + O_QA);
  const int mt = w >> 2, nv = w & 3;
  const uint4* us = (const uint4*)(p.ws + O_US + (size_t)(c * 4 + h) * 32768);
  uint4 sfr[8];
#pragma unroll
  for (int ks = 0; ks < 8; ++ks) sfr[ks] = us[(nv * 8 + ks) * 64 + lane];
  uint4 qv_pre[2], kv_pre[2];
#pragma unroll
  for (int rep = 0; rep < 2; ++rep) {
    const int pr = tid + 512 * rep, t = pr >> 4, oc = pr & 15;
    qv_pre[rep] = *(const uint4*)(QA + (size_t)(64 * c + t) * 512 + 128 * h + oc * 8);
    kv_pre[rep] = *(const uint4*)(KK + (size_t)(64 * c + t) * 512 + 128 * h + oc * 8);
  }
  const uint4 z0_pre = *(const uint4*)((const unsigned short*)(p.ws + O_ZA) + (size_t)(64 * c + (tid >> 3)) * 512 + 128 * h + 16 * (tid & 7));
  const uint4 z1_pre = *(const uint4*)((const unsigned short*)(p.ws + O_ZA) + (size_t)(64 * c + (tid >> 3)) * 512 + 128 * h + 16 * (tid & 7) + 8);
  {
    const int seg = tid >> 7, k = tid & 127;
    const size_t rowbase = (size_t)(64 * c + 16 * seg);
    float b[16];
    float run = 0.f;
#pragma unroll
    for (int i = 0; i < 16; ++i) { run += G[(rowbase + i) * 512 + 128 * h + k]; b[i] = run; }
    tot[seg * 128 + k] = run;
    unsigned pv[8];
#pragma unroll
    for (int i = 0; i < 16; i += 2) {
      unsigned v0 = IA[(rowbase + i) * 512 + 128 * h + k], v1 = IA[(rowbase + i + 1) * 512 + 128 * h + k];
      pv[i >> 1] = v0 | (v1 << 16);
    }
    uint4* dv = (uint4*)(vT + k * 72 + 16 * seg);
    dv[0] = make_uint4(pv[0], pv[1], pv[2], pv[3]); dv[1] = make_uint4(pv[4], pv[5], pv[6], pv[7]);
    __syncthreads();
    float off = 0.f;
#pragma unroll
    for (int s2 = 0; s2 < 4; ++s2) { float tv = tot[s2 * 128 + k]; if (s2 < seg) off += tv; }
#pragma unroll
    for (int i = 0; i < 16; ++i) bL[(16 * seg + i) * 132 + k] = b[i] + off;
  }
  __syncthreads();
#pragma unroll
  for (int rep = 0; rep < 2; ++rep) {
    const int pr = tid + 512 * rep, t = pr >> 4, oc = pr & 15;
    const float4 b0 = *(const float4*)(bL + t * 132 + oc * 8), b1 = *(const float4*)(bL + t * 132 + oc * 8 + 4);
    const float4 r0 = *(const float4*)(bL + 31 * 132 + oc * 8), r1 = *(const float4*)(bL + 31 * 132 + oc * 8 + 4);
    const uint4 qv = qv_pre[rep];
    const uint4 kv = kv_pre[rep];
    const float bb[8] = {b0.x, b0.y, b0.z, b0.w, b1.x, b1.y, b1.z, b1.w};
    const float rr[8] = {r0.x, r0.y, r0.z, r0.w, r1.x, r1.y, r1.z, r1.w};
    const float qq[8] = {bflo(qv.x), bfhi(qv.x), bflo(qv.y), bfhi(qv.y), bflo(qv.z), bfhi(qv.z), bflo(qv.w), bfhi(qv.w)};
    const float kq[8] = {bflo(kv.x), bfhi(kv.x), bflo(kv.y), bfhi(kv.y), bflo(kv.z), bfhi(kv.z), bflo(kv.w), bfhi(kv.w)};
    float a1[8], a2[8], a3[8];
#pragma unroll
    for (int e = 0; e < 8; ++e) {
      a1[e] = qq[e] * __expf(bb[e]);
      a2[e] = qq[e] * __expf(bb[e] - rr[e]);
      a3[e] = kq[e] * __expf(rr[e] - bb[e]);
    }
    *(uint4*)(qT + t * 136 + oc * 8) = make_uint4(cvtpk(a1[0], a1[1]), cvtpk(a1[2], a1[3]), cvtpk(a1[4], a1[5]), cvtpk(a1[6], a1[7]));
    *(uint4*)(qH + t * 136 + oc * 8) = make_uint4(cvtpk(a2[0], a2[1]), cvtpk(a2[2], a2[3]), cvtpk(a2[4], a2[5]), cvtpk(a2[6], a2[7]));
    *(uint4*)(kH + t * 136 + oc * 8) = make_uint4(cvtpk(a3[0], a3[1]), cvtpk(a3[2], a3[3]), cvtpk(a3[4], a3[5]), cvtpk(a3[6], a3[7]));
  }
  __syncthreads();
  if (w < 4) {
    const int ms = w >> 1, ntq = w & 1;
    f32x16 sacc;
#pragma unroll
    for (int r = 0; r < 16; ++r) sacc[r] = 0.f;
#pragma unroll
    for (int ks = 0; ks < 8; ++ks) {
      bf16x8 af = __builtin_bit_cast(bf16x8, *(const uint4*)(kH + (32 * ms + c31) * 136 + 16 * ks + 8 * hi));
      bf16x8 bfv = __builtin_bit_cast(bf16x8, *(const uint4*)(qH + (32 * ntq + c31) * 136 + 16 * ks + 8 * hi));
      sacc = MFMA(af, bfv, sacc);
    }
    const int t = 32 * ntq + c31;
#pragma unroll
    for (int gq = 0; gq < 4; ++gq) {
      const int s0 = 32 * ms + 8 * gq + 4 * hi;
      float v0 = (s0 + 0 <= t) ? sacc[4 * gq + 0] : 0.f;
      float v1 = (s0 + 1 <= t) ? sacc[4 * gq + 1] : 0.f;
      float v2 = (s0 + 2 <= t) ? sacc[4 * gq + 2] : 0.f;
      float v3 = (s0 + 3 <= t) ? sacc[4 * gq + 3] : 0.f;
      uint2 val; val.x = cvtpk(v0, v1); val.y = cvtpk(v2, v3);
      *(uint2*)(P + t * 72 + s0) = val;
    }
  }
  f32x16 oacc;
#pragma unroll
  for (int r = 0; r < 16; ++r) oacc[r] = 0.f;
#pragma unroll
  for (int ks = 0; ks < 8; ++ks) {
    bf16x8 af = __builtin_bit_cast(bf16x8, *(const uint4*)(qT + (32 * mt + c31) * 136 + 16 * ks + 8 * hi));
    oacc = MFMA(af, __builtin_bit_cast(bf16x8, sfr[ks]), oacc);
  }
  __syncthreads();
#pragma unroll
  for (int ks = 0; ks < 4; ++ks) {
    bf16x8 af = __builtin_bit_cast(bf16x8, *(const uint4*)(P + (32 * mt + c31) * 72 + 16 * ks + 8 * hi));
    bf16x8 bfv = __builtin_bit_cast(bf16x8, *(const uint4*)(vT + (32 * nv + c31) * 72 + 16 * ks + 8 * hi));
    oacc = MFMA(af, bfv, oacc);
  }
  float* oL = bL;
#pragma unroll
  for (int r = 0; r < 16; ++r) oL[(32 * mt + crow(r, hi)) * 132 + 32 * nv + c31] = oacc[r];
  __syncthreads();
  {
    const int t = tid >> 3, sg = tid & 7;
    float ov[16];
#pragma unroll
    for (int e = 0; e < 16; e += 4) {
      const float4 f = *(const float4*)(oL + t * 132 + 16 * sg + e);
      ov[e] = f.x; ov[e + 1] = f.y; ov[e + 2] = f.z; ov[e + 3] = f.w;
    }
    float ss = 0.f;
#pragma unroll
    for (int e = 0; e < 16; ++e) ss = fmaf(ov[e], ov[e], ss);
    ss += __shfl_xor(ss, 1);
    ss += __shfl_xor(ss, 2);
    ss += __shfl_xor(ss, 4);
    const float rs = rsqrtf(ss * (1.f / 128.f) + 1e-6f);
    const int tg = 64 * c + t, k0 = 128 * h + 16 * sg;
    const float* ng = p.norm_a_g + (size_t)layer * 512 + k0;
    const uint4 z0 = z0_pre, z1 = z1_pre;
    const float zz[16] = {bflo(z0.x), bfhi(z0.x), bflo(z0.y), bfhi(z0.y), bflo(z0.z), bfhi(z0.z), bflo(z0.w), bfhi(z0.w),
                          bflo(z1.x), bfhi(z1.x), bflo(z1.y), bfhi(z1.y), bflo(z1.z), bfhi(z1.z), bflo(z1.w), bfhi(z1.w)};
    float rr[16];
#pragma unroll
    for (int e = 0; e < 16; ++e) rr[e] = ov[e] * rs * ng[e] * zz[e];
    uint4* aa = (uint4*)(p.ws + O_AA);
    aa[tiled_unit(tg, k0, 32)] = make_uint4(cvtpk(rr[0], rr[1]), cvtpk(rr[2], rr[3]), cvtpk(rr[4], rr[5]), cvtpk(rr[6], rr[7]));
    aa[tiled_unit(tg, k0 + 8, 32)] = make_uint4(cvtpk(rr[8], rr[9]), cvtpk(rr[10], rr[11]), cvtpk(rr[12], rr[13]), cvtpk(rr[14], rr[15]));
  }
  __syncthreads();
}

DI void acc_to_lds_bf16(f32x16 (&acc)[2][2], unsigned short* tile) {
  const int tid = vtid(), lane = tid & 63, w = tid >> 6, wm = w >> 1, wn = w & 1, hi = lane >> 5, c31 = lane & 31;
#pragma unroll
  for (int i = 0; i < 2; ++i)
#pragma unroll
    for (int j = 0; j < 2; ++j)
#pragma unroll
      for (int r = 0; r < 16; ++r)
        tile[(64 * wm + 32 * i + crow(r, hi)) * 128 + 64 * wn + 32 * j + c31] = f2bf(acc[i][j][r]);
}
DI void p5_tile(const Params& p, int mb, int nt) {
  const int tid = vtid(), lane = tid & 63, w = tid >> 6, wm = w >> 1, wn = w & 1, hi = lane >> 5, c31 = lane & 31;
  f32x16 acc[2][2];
  zero_acc(acc);
  gemm_core((const uint4*)(p.ws + O_AA), mb * 8, (const uint4*)(p.ws + O_WUA), nt * 4, 32, acc, (uint4*)smem);
  unsigned uap[2][2][8];
#pragma unroll
  for (int i = 0; i < 2; ++i)
#pragma unroll
    for (int j = 0; j < 2; ++j)
#pragma unroll
      for (int r = 0; r < 16; r += 2) uap[i][j][r >> 1] = cvtpk(acc[i][j][r], acc[i][j][r + 1]);
  zero_acc(acc);
  gemm_core((const uint4*)(p.ws + O_AB), mb * 8, (const uint4*)(p.ws + O_WUB), nt * 4, 32, acc, (uint4*)smem);
  unsigned short* tA = (unsigned short*)smem;
  unsigned short* tB = (unsigned short*)(smem + 65536);
#pragma unroll
  for (int i = 0; i < 2; ++i)
#pragma unroll
    for (int j = 0; j < 2; ++j)
#pragma unroll
      for (int r = 0; r < 16; r += 2) {
        const int o0 = (64 * wm + 32 * i + crow(r, hi)) * 128 + 64 * wn + 32 * j + c31;
        tA[o0] = (unsigned short)(uap[i][j][r >> 1] & 0xffffu);
        tA[o0 + 128] = (unsigned short)(uap[i][j][r >> 1] >> 16);
        tB[o0] = f2bf(acc[i][j][r]);
        tB[o0 + 128] = f2bf(acc[i][j][r + 1]);
      }
  __syncthreads();
  const int row0 = mb * 256;
#pragma unroll 2
  for (int q = 0; q < 8; ++q) {
    const int u = tid + 512 * q, r = u >> 4, c8 = u & 15;
    const uint4 ua = *(const uint4*)&tA[r * 128 + c8 * 8];
    const uint4 ub = *(const uint4*)&tB[r * 128 + c8 * 8];
    const int t = row0 + r, n0 = nt * 128 + c8 * 8;
    const uint4 ga = *(const uint4*)(p.ws + O_SGA + ((size_t)t * 1024 + n0) * 2);
    const uint4 gb = *(const uint4*)(p.ws + O_SGB + ((size_t)t * 1024 + n0) * 2);
    uint4 o;
    o.x = cvtpk(bflo(ga.x) * bflo(ua.x) + bflo(gb.x) * bflo(ub.x), bfhi(ga.x) * bfhi(ua.x) + bfhi(gb.x) * bfhi(ub.x));
    o.y = cvtpk(bflo(ga.y) * bflo(ua.y) + bflo(gb.y) * bflo(ub.y), bfhi(ga.y) * bfhi(ua.y) + bfhi(gb.y) * bfhi(ub.y));
    o.z = cvtpk(bflo(ga.z) * bflo(ua.z) + bflo(gb.z) * bflo(ub.z), bfhi(ga.z) * bfhi(ua.z) + bfhi(gb.z) * bfhi(ub.z));
    o.w = cvtpk(bflo(ga.w) * bflo(ua.w) + bflo(gb.w) * bflo(ub.w), bfhi(ga.w) * bfhi(ua.w) + bfhi(gb.w) * bfhi(ub.w));
    ((uint4*)(p.ws + O_MG))[tiled_unit(t, n0, 64)] = o;
  }
  __syncthreads();
}

DI void p6_tile(const Params& p, int layer, int mb, int nt) {
  const int tid = vtid(), lane = tid & 63, w = tid >> 6, wm = w >> 1, wn = w & 1, hi = lane >> 5, c31 = lane & 31;
  f32x16 acc[2][2];
  zero_acc(acc);
  gemm_core((const uint4*)(p.ws + O_MG), mb * 8, (const uint4*)(p.ws + O_WOUT), nt * 4, 64, acc, (uint4*)smem);
  const float* hin = (layer == 0) ? p.x : p.out;
#pragma unroll
  for (int i = 0; i < 2; ++i)
#pragma unroll
    for (int j = 0; j < 2; ++j)
#pragma unroll
      for (int r = 0; r < 16; ++r) {
        const size_t idx = (size_t)(mb * 256 + 64 * wm + 32 * i + crow(r, hi)) * DM + nt * 128 + 64 * wn + 32 * j + c31;
        p.out[idx] = fmaf(ALPHA_, hin[idx], acc[i][j][r]);
      }
}

DI float dpp_add_f(float v, int which) {
  const int iv = __builtin_bit_cast(int, v);
  int r;
  switch (which) {
    case 0: r = __builtin_amdgcn_update_dpp(0, iv, 0x111, 0xf, 0xf, true); break;
    case 1: r = __builtin_amdgcn_update_dpp(0, iv, 0x112, 0xf, 0xf, true); break;
    case 2: r = __builtin_amdgcn_update_dpp(0, iv, 0x114, 0xf, 0xf, true); break;
    case 3: r = __builtin_amdgcn_update_dpp(0, iv, 0x118, 0xf, 0xf, true); break;
    default: r = __builtin_amdgcn_update_dpp(0, iv, 0x142, 0xa, 0xf, false); break;
  }
  return v + __builtin_bit_cast(float, r);
}
DI float half_sum_to_last(float v) {
  v = dpp_add_f(v, 0); v = dpp_add_f(v, 1); v = dpp_add_f(v, 2); v = dpp_add_f(v, 3); v = dpp_add_f(v, 4);
  return v;
}
DI void fused_out_ln(const Params& p, int layer, int mb64) {
  const int tid = vtid(), lane = tid & 63, w = tid >> 6, hi = lane >> 5, c31 = lane & 31;
  uint4* lds = (uint4*)smem;
  const uint4* A = (const uint4*)(p.ws + O_MG) + (size_t)(2 * mb64) * 64 * 64;
#pragma unroll
  for (int r = 0; r < 16; ++r)
    __builtin_amdgcn_global_load_lds((const unsigned*)(A + tid + 512 * r), (unsigned*)(lds + tid + 512 * r), 16, 0, 0);
  float* lnf = (float*)(smem + 131072);
  {
    const float* src_ = (tid < 256) ? (p.ln_g + (size_t)layer * DM) : (p.ln_b + (size_t)layer * DM);
    ((float4*)lnf)[tid] = ((const float4*)src_)[tid & 255];
  }
  const uint4* Bw = (const uint4*)(p.ws + O_WOUT) + (size_t)(4 * w) * 64 * 64 + lane;
  uint4 bq[4][4];
#pragma unroll
  for (int s_ = 0; s_ < 4; ++s_)
#pragma unroll
    for (int j = 0; j < 4; ++j) bq[s_][j] = Bw[(size_t)(j * 64 + s_) * 64];
  f32x16 acc[2][4];
#pragma unroll
  for (int i = 0; i < 2; ++i)
#pragma unroll
    for (int j = 0; j < 4; ++j)
#pragma unroll
      for (int r = 0; r < 16; ++r) acc[i][j][r] = 0.f;
  __syncthreads();
#pragma unroll 1
  for (int k4 = 0; k4 < 16; ++k4) {
#pragma unroll
    for (int s_ = 0; s_ < 4; ++s_) {
      const int ks = 4 * k4 + s_;
      const bf16x8 a0 = __builtin_bit_cast(bf16x8, lds[ks * 64 + lane]);
      const bf16x8 a1 = __builtin_bit_cast(bf16x8, lds[4096 + ks * 64 + lane]);
#pragma unroll
      for (int j = 0; j < 4; ++j) {
        const bf16x8 b = __builtin_bit_cast(bf16x8, bq[s_][j]);
        acc[0][j] = MFMA(a0, b, acc[0][j]);
        acc[1][j] = MFMA(a1, b, acc[1][j]);
      }
      if (k4 < 15) {
#pragma unroll
        for (int j = 0; j < 4; ++j) bq[s_][j] = Bw[(size_t)(j * 64 + ks + 4) * 64];
      }
    }
  }
  const float* hin = (layer == 0) ? p.x : p.out;
  float* ft = (float*)smem;
  uint2* hb2 = (uint2*)(p.ws + O_HB);
  const int rr = tid >> 4, seg = tid & 15;
#pragma unroll
  for (int i = 0; i < 2; ++i) {
    __syncthreads();
    float4 hvv[16];
    {
      const float* hrow_ = hin + (size_t)(64 * mb64 + 32 * i + rr) * DM + 4 * seg;
#pragma unroll
      for (int e = 0; e < 16; ++e) hvv[e] = *(const float4*)(hrow_ + 64 * e);
    }
    {
      float* b0 = ft + (4 * hi) * 1024 + 128 * w + c31;
      float* b1 = b0 + 16 * 1024;
#pragma unroll
      for (int j = 0; j < 4; ++j)
#pragma unroll
        for (int r = 0; r < 16; ++r) {
          float* bp = (r < 8) ? b0 : b1;
          bp[((r & 3) + 8 * ((r >> 2) & 1)) * 1024 + 32 * j] = acc[i][j][r];
        }
    }
    __syncthreads();
    const int trow = 64 * mb64 + 32 * i + rr;
    float s1 = 0.f, s2 = 0.f;
    float* frow = ft + rr * 1024 + 4 * seg;
#pragma unroll
    for (int e = 0; e < 16; ++e) {
      const float4 y = *(const float4*)(frow + 64 * e);
      const float4 hv = hvv[e];
      float4 pre;
      pre.x = fmaf(ALPHA_, hv.x, y.x); pre.y = fmaf(ALPHA_, hv.y, y.y); pre.z = fmaf(ALPHA_, hv.z, y.z); pre.w = fmaf(ALPHA_, hv.w, y.w);
      s1 += (pre.x + pre.y) + (pre.z + pre.w);
      s2 = fmaf(pre.x, pre.x, s2); s2 = fmaf(pre.y, pre.y, s2); s2 = fmaf(pre.z, pre.z, s2); s2 = fmaf(pre.w, pre.w, s2);
      *(float4*)(frow + 64 * e) = pre;
    }
    s1 += __shfl_xor(s1, 1); s1 += __shfl_xor(s1, 2); s1 += __shfl_xor(s1, 4); s1 += __shfl_xor(s1, 8);
    s2 += __shfl_xor(s2, 1); s2 += __shfl_xor(s2, 2); s2 += __shfl_xor(s2, 4); s2 += __shfl_xor(s2, 8);
    const float mu = s1 * (1.f / 1024.f);
    const float rs = rsqrtf(fmaxf(s2 * (1.f / 1024.f) - mu * mu, 0.f) + 1e-5f);
    float* orow = p.out + (size_t)trow * DM;
#pragma unroll 4
    for (int e = 0; e < 16; ++e) {
      const int c0 = 64 * e + 4 * seg;
      const float4 pre = *(const float4*)(frow + 64 * e);
      const float4 g4 = *(const float4*)(lnf + c0), b4 = *(const float4*)(lnf + 1024 + c0);
      float4 o;
      o.x = (pre.x - mu) * rs * g4.x + b4.x; o.y = (pre.y - mu) * rs * g4.y + b4.y;
      o.z = (pre.z - mu) * rs * g4.z + b4.z; o.w = (pre.w - mu) * rs * g4.w + b4.w;
      *(float4*)(orow + c0) = o;
      hb2[((size_t)trow * 1024 + c0) >> 2] = make_uint2(cvtpk(o.x, o.y), cvtpk(o.z, o.w));
    }
  }
  __syncthreads();
}

DI void p7_rows(const Params& p, int layer) {
  const int tid = vtid();
  const int lane = tid & 63, gw = blockIdx.x * 8 + (tid >> 6), nw = gridDim.x * 8;
  const float* g = p.ln_g + (size_t)layer * DM;
  const float* bb = p.ln_b + (size_t)layer * DM;
  uint4* hb = (uint4*)(p.ws + O_HB);
  for (int t = gw; t < L_; t += nw) {
    float* row = p.out + (size_t)t * DM;
    float v[16];
#pragma unroll
    for (int q = 0; q < 2; ++q) {
      const float4 a = *(const float4*)(row + q * 512 + lane * 8), b = *(const float4*)(row + q * 512 + lane * 8 + 4);
      v[8 * q + 0] = a.x; v[8 * q + 1] = a.y; v[8 * q + 2] = a.z; v[8 * q + 3] = a.w;
      v[8 * q + 4] = b.x; v[8 * q + 5] = b.y; v[8 * q + 6] = b.z; v[8 * q + 7] = b.w;
    }
    float s = 0.f;
#pragma unroll
    for (int e = 0; e < 16; ++e) s += v[e];
#pragma unroll
    for (int off = 1; off < 64; off <<= 1) s += __shfl_xor(s, off);
    const float mu = s * (1.f / 1024.f);
    float ss = 0.f;
#pragma unroll
    for (int e = 0; e < 16; ++e) { const float d = v[e] - mu; ss = fmaf(d, d, ss); }
#pragma unroll
    for (int off = 1; off < 64; off <<= 1) ss += __shfl_xor(ss, off);
    const float rs = rsqrtf(ss * (1.f / 1024.f) + 1e-5f);
#pragma unroll
    for (int q = 0; q < 2; ++q) {
      const int k0 = q * 512 + lane * 8;
      float o[8];
#pragma unroll
      for (int e = 0; e < 8; ++e) o[e] = (v[8 * q + e] - mu) * rs * g[k0 + e] + bb[k0 + e];
      *(float4*)(row + k0) = make_float4(o[0], o[1], o[2], o[3]);
      *(float4*)(row + k0 + 4) = make_float4(o[4], o[5], o[6], o[7]);
      hb[tiled_unit(t, k0, 64)] = make_uint4(cvtpk(o[0], o[1]), cvtpk(o[2], o[3]), cvtpk(o[4], o[5]), cvtpk(o[6], o[7]));
    }
  }
}


#define XB_TMO      128
#define XB_XCNT(j)  (256  + 64 * (j))
#define XB_XSUB(j)  (1280 + 64 * (j))
#define XB_XGEN(j)  (2304 + 64 * (j))
#define XB_TOP      3328
#define XB_TOPGEN   3392
#define XCD_BAR_WORDS 3456
#define XB_SPIN_CAP (1u << 22)
#define LAS __attribute__((address_space(3)))
DI unsigned xb_ld(unsigned* p)              { return __hip_atomic_load(p, __ATOMIC_RELAXED, __HIP_MEMORY_SCOPE_AGENT); }
DI unsigned xb_add(unsigned* p, unsigned v) { return __hip_atomic_fetch_add(p, v, __ATOMIC_RELAXED, __HIP_MEMORY_SCOPE_AGENT); }
DI unsigned xb_xcc_id() { return (unsigned)__builtin_amdgcn_s_getreg((3 << 11) | 20) & 0xFu; }
#define XB_SPIN(cond, bar) do { unsigned _sp = 0; while (cond) { __builtin_amdgcn_s_sleep(1); \
    if ((++_sp & 255u) == 0u) { if (xb_ld(&(bar)[XB_TMO])) break; if (_sp > XB_SPIN_CAP) { atomicAdd(&(bar)[XB_TMO], 1u); break; } } } } while (0)
struct XcdBarrier { unsigned* bar; unsigned x; volatile LAS unsigned* st; };
DI XcdBarrier xcd_barrier_post(unsigned* bar, volatile LAS unsigned* st) {
  XcdBarrier b; b.bar = bar; b.x = xb_xcc_id(); b.st = st;
  if (threadIdx.x == 0) (void)xb_add(&bar[XB_XCNT(b.x)], 1u);
  return b;
}
DI void xcd_barrier_complete(unsigned* bar, unsigned x, unsigned& nloc, unsigned& nx) {
  const unsigned G = gridDim.x * gridDim.y * gridDim.z;
  unsigned sum, cnt, mine, sp = 0u;
  for (;;) {
    sum = 0u; cnt = 0u; mine = 0u;
#pragma unroll
    for (unsigned j = 0; j < 16; ++j) { const unsigned c = xb_ld(&bar[XB_XCNT(j)]); sum += c; cnt += (c > 0u) ? 1u : 0u; mine = (j == x) ? c : mine; }
    if (sum == G) break;
    __builtin_amdgcn_s_sleep(1);
    if ((++sp & 255u) == 0u) { if (xb_ld(&bar[XB_TMO])) break; if (sp > XB_SPIN_CAP) { atomicAdd(&bar[XB_TMO], 1u); break; } }
  }
  nloc = mine > 0u ? mine : 1u; nx = cnt > 0u ? cnt : 1u;
}
DI void xcd_barrier(const XcdBarrier& b) {
  asm volatile("s_waitcnt vmcnt(0)" ::: "memory");
  __syncthreads();
  if (threadIdx.x == 0) {
    unsigned* bar = b.bar;
    __builtin_amdgcn_s_waitcnt(0);
    unsigned nloc = b.st[0], nx = b.st[1];
    if (nloc == 0u) { xcd_barrier_complete(bar, b.x, nloc, nx); b.st[0] = nloc; b.st[1] = nx; }
    const unsigned old = xb_add(&bar[XB_XSUB(b.x)], 1u);
    const unsigned gen = old / nloc;
    if (old + 1u == (gen + 1u) * nloc) {
      __builtin_amdgcn_fence(__ATOMIC_RELEASE, "agent");
      asm volatile("s_waitcnt vmcnt(0)" ::: "memory");
      const unsigned og = xb_add(&bar[XB_TOP], 1u);
      const unsigned tg = og / nx;
      if (og + 1u == (tg + 1u) * nx) xb_add(&bar[XB_TOPGEN], 1u);
      else XB_SPIN(xb_ld(&bar[XB_TOPGEN]) == tg, bar);
      __builtin_amdgcn_fence(__ATOMIC_ACQUIRE, "agent");
      xb_add(&bar[XB_XGEN(b.x)], 1u);
      asm volatile("s_waitcnt vmcnt(0)" ::: "memory");
    } else {
      XB_SPIN(xb_ld(&bar[XB_XGEN(b.x)]) == gen, bar);
      __builtin_amdgcn_fence(__ATOMIC_ACQUIRE, "agent");
      asm volatile("s_waitcnt vmcnt(0)" ::: "memory");
    }
  }
  __syncthreads();
}
constexpr int LDS_BARST = 163840 - 16;

__global__ void __launch_bounds__(512) mk(Params p) {
  cg::grid_group grid = cg::this_grid();
  const int nb = gridDim.x, bid = blockIdx.x;
  volatile LAS unsigned* bst_ = (volatile LAS unsigned*)(smem + LDS_BARST);
  if (threadIdx.x < 4) bst_[threadIdx.x] = 0u;
  __syncthreads();
  (void)xcd_barrier_post((unsigned*)(p.ws + O_BAR), bst_);
#define XB_NOW() XcdBarrier{(unsigned*)(p.ws + O_BAR), xb_xcc_id(), (volatile LAS unsigned*)(smem + LDS_BARST)}
  phase0(p);
  grid.sync();
  for (int layer = 0; layer < DEPTH_; ++layer) {
    {
      const int gtid = bid * 512 + vtid(), gthreads = nb * 512;
      conv_weight(p.w_up_a + (size_t)layer * 512 * 1024, 512, 1024, 1024, false, (uint4*)(p.ws + O_WUA), gtid, gthreads);
      conv_weight(p.w_up_b + (size_t)layer * 512 * 1024, 512, 1024, 1024, false, (uint4*)(p.ws + O_WUB), gtid, gthreads);
      conv_weight(p.w_out + (size_t)layer * 1024 * 1024, 1024, 1024, 1024, false, (uint4*)(p.ws + O_WOUT), gtid, gthreads);
#ifndef NO_P1
      for (int id = bid; id < 64 * 27; id += nb) p1_tile8(p, layer, id & 63, id >> 6);
#endif
    }
    xcd_barrier(XB_NOW());
    {
      if (layer + 1 < DEPTH_) {
        const int gtid = bid * 512 + vtid(), gthreads = nb * 512;
        conv_weight_rm(p.w_in + (size_t)(layer + 1) * 1024 * NIN, 1024, NIN, NPAD, true, (uint4*)(p.ws + O_WTIN), gtid, gthreads);
      }
#ifndef NO_HA
      for (int id = bid; id < 1024; id += nb) hgrn_a_item(p, id >> 2, id & 3);
#endif
      for (int s = bid; s < 1024; s += nb) {
        const int rnd = s / nb, pos = s - rnd * nb;
        const int rem = 1024 - rnd * nb, count = rem < nb ? rem : nb;
        const int sp = (rnd & 1) ? (rnd * nb + count - 1 - pos) : s;
        indexer_item(p, 1023 - sp);
      }
    }
    xcd_barrier(XB_NOW());
    {
      attn_setup();
      const int tid = vtid();
      if (tid < 256) ((float*)(smem + AT_RB))[tid] = p.rel_bias[tid];
      __syncthreads();
#ifndef NO_SCAN
      hgrn_scan(p);
#endif
      const int w = tid >> 6, lane = tid & 63;
#ifndef NO_ATT
      { QKPF pf; qk_fetch(p, bid * 8 + w, lane, pf);
        for (int t = bid * 8 + w; t < L_; t += nb * 8) attn_query(p, t, t + nb * 8, w, lane, pf); }
#endif
      __syncthreads();
    }
    {
      const int tid = vtid();
      const int w = tid >> 6, lane = tid & 63;
      for (int t = bid * 8 + w; t < L_; t += nb * 8) attn_pv_query(p, t, w, lane);
      __syncthreads();
    }
    xcd_barrier(XB_NOW());
#ifndef NO_HC
    for (int id = bid; id < 1024; id += nb) hgrn_c_item(p, layer, id >> 2, id & 3);
#endif
    xcd_barrier(XB_NOW());
#ifndef NO_P5
    for (int id = bid; id < 64 * 8; id += nb) p5_tile(p, id & 63, id >> 6);
#endif
    xcd_barrier(XB_NOW());
    for (int id = bid; id < 256; id += nb) fused_out_ln(p, layer, id);
    xcd_barrier(XB_NOW());
  }}

extern "C" void kernel_launch(void* const* d_in, const int* in_sizes, int n_in, void* d_out, int out_size, void* d_ws,
                              size_t ws_size, hipStream_t stream) {
  constexpr size_t kLds = 160 * 1024;
  static int grid_blocks = 0;
  if (!grid_blocks) {
    int dev = 0, cus = 0, per_cu = 0;
    (void)hipGetDevice(&dev);
    (void)hipDeviceGetAttribute(&cus, hipDeviceAttributeMultiprocessorCount, dev);
    (void)hipFuncSetAttribute((const void*)mk, hipFuncAttributeMaxDynamicSharedMemorySize, (int)kLds);
    (void)hipOccupancyMaxActiveBlocksPerMultiprocessor(&per_cu, mk, 512, kLds);
    if (per_cu > 1) per_cu = 1;
    grid_blocks = cus * per_cu;
  }
  if (ws_size < WS_NEED || grid_blocks <= 0) { fprintf(stderr, "ws too small or no occupancy\n"); return; }
  Params p{};
  p.x = (const float*)d_in[0]; p.w_in = (const float*)d_in[1]; p.b_in = (const float*)d_in[2];
  p.w_up_a = (const float*)d_in[3]; p.w_up_b = (const float*)d_in[4]; p.w_out = (const float*)d_in[5];
  p.lb_logits = (const float*)d_in[6]; p.norm_a_g = (const float*)d_in[7]; p.rel_bias = (const float*)d_in[8];
  p.ln_g = (const float*)d_in[9]; p.ln_b = (const float*)d_in[10];
  p.out = (float*)d_out; p.ws = (char*)d_ws;
  (void)hipMemsetAsync((char*)d_ws + O_BAR, 0, XCD_BAR_WORDS * 4, stream);
  void* args[] = {&p};
  hipError_t e = hipLaunchCooperativeKernel((void*)mk, dim3(grid_blocks), dim3(512), args, kLds, stream);
  if (e != hipSuccess) fprintf(stderr, "cooperative launch failed: %s (grid %d)\n", hipGetErrorString(e), grid_blocks);
}
```

```cpp
#include <hip/hip_runtime.h>
#include <hip/hip_cooperative_groups.h>
#include <cstdio>
#include <cstdint>
namespace cg = cooperative_groups;

#define DI __device__ __forceinline__
typedef __attribute__((ext_vector_type(8))) short bf16x8;
typedef __attribute__((ext_vector_type(16))) float f32x16;
typedef __attribute__((ext_vector_type(2))) float f32x2;
typedef __attribute__((ext_vector_type(2))) __bf16 bf16x2_t;
#define MFMA(a, b, c) __builtin_amdgcn_mfma_f32_32x32x16_bf16((a), (b), (c), 0, 0, 0)

constexpr int L_ = 16384, DM = 1024, NIN = 6728, NPAD = 6912, DEPTH_ = 4;
constexpr float ALPHA_ = 1.681792830507429f;
constexpr size_t MiB = 1048576;
constexpr size_t O_WTIN = 0 * MiB, O_WUA = 14 * MiB, O_WUB = 15 * MiB, O_WOUT = 16 * MiB, O_HB = 18 * MiB,
                 O_QA = 50 * MiB, O_G = 66 * MiB, O_KK = 98 * MiB, O_IA = 114 * MiB, O_ZA = 130 * MiB,
                 O_QB = 146 * MiB, O_KB = 162 * MiB, O_VB = 178 * MiB, O_ZB = 194 * MiB, O_QI = 210 * MiB,
                 O_KI = 226 * MiB, O_WI = 228 * MiB, O_D = 228 * MiB + 512 * 1024, O_SGA = 229 * MiB,
                 O_SGB = 261 * MiB, O_US = 293 * MiB, O_SEL = 325 * MiB, O_LBS = 333 * MiB,
                 O_BAR = 333 * MiB + 65536, O_AA = 334 * MiB, O_AB = 350 * MiB, O_MG = 366 * MiB, WS_NEED = 398 * MiB;

struct Params {
  const float *x, *w_in, *b_in, *w_up_a, *w_up_b, *w_out, *lb_logits, *norm_a_g, *rel_bias, *ln_g, *ln_b;
  float* out;
  char* ws;
};

extern __shared__ __attribute__((aligned(16))) char smem[];

DI unsigned cvtpk(float lo, float hi) {
  f32x2 v = {lo, hi};
  bf16x2_t b = __builtin_convertvector(v, bf16x2_t);
  return __builtin_bit_cast(unsigned, b);
}
DI unsigned short f2bf(float x) { return (unsigned short)(cvtpk(x, 0.f) & 0xffffu); }
DI float bflo(unsigned u) { return __uint_as_float(u << 16); }
DI float bfhi(unsigned u) { return __uint_as_float(u & 0xffff0000u); }
DI float bf2f(unsigned short s) { return __uint_as_float(((unsigned)s) << 16); }
DI float sigm(float x) { return 1.f / (1.f + __expf(-x)); }
DI float silu(float x) { return x / (1.f + __expf(-x)); }
DI int crow(int r, int hi) { return (r & 3) + 8 * (r >> 2) + 4 * hi; }
DI size_t tiled_unit(int r, int k, int KS) {
  return ((size_t)(r >> 5) * KS + (k >> 4)) * 64 + (r & 31) + 32 * ((k >> 3) & 1);
}
DI float dot2(unsigned a, unsigned b, float acc) {
  asm volatile("v_dot2c_f32_bf16 %0, %1, %2" : "+v"(acc) : "v"(a), "v"(b));
  return acc;
}
template <typename T> DI T* opq(T* x) { asm volatile("" : "+s"(x)); return x; }
#define LAUNDER(pin) Params p; p.x = opq((pin).x); p.w_in = (pin).w_in; p.b_in = (pin).b_in; p.w_up_a = (pin).w_up_a; p.w_up_b = (pin).w_up_b; \
  p.w_out = (pin).w_out; p.lb_logits = (pin).lb_logits; p.norm_a_g = (pin).norm_a_g; p.rel_bias = (pin).rel_bias; p.ln_g = (pin).ln_g; \
  p.ln_b = (pin).ln_b; p.out = opq((pin).out); p.ws = opq((pin).ws);
DI int vtid() { int t = threadIdx.x; asm volatile("" : "+v"(t)); return t; }
DI unsigned vzero() { unsigned z; asm volatile("v_mov_b32 %0, 0" : "=v"(z)); return z; }
DI void cbar() { asm volatile("" ::: "memory"); }
DI void lds_fence() { asm volatile("s_waitcnt lgkmcnt(0)" ::: "memory"); }

DI int colmap(int np) {
  if (np < 4608) return np;
  if (np < 5632) return 4680 + (np - 4608);
  if (np < 6656) return 5704 + (np - 5632);
  if (np < 6720) return 4608 + (np - 6656);
  if (np < 6728) return 4672 + (np - 6720);
  return -1;
}

DI void conv_weight(const float* __restrict__ src, int K, int ldn, int Npad, bool useMap, uint4* __restrict__ dst,
                    int gtid, int gthreads) {
  const int KS = K >> 4;
  const int total = Npad * (K >> 3);
  for (int u = gtid; u < total; u += gthreads) {
    int kg = u / Npad, n = u - kg * Npad;
    int col = useMap ? colmap(n) : n;
    float v[8];
#pragma unroll
    for (int j = 0; j < 8; ++j) v[j] = (col >= 0) ? src[(size_t)(kg * 8 + j) * ldn + col] : 0.f;
    uint4 o;
    o.x = cvtpk(v[0], v[1]); o.y = cvtpk(v[2], v[3]); o.z = cvtpk(v[4], v[5]); o.w = cvtpk(v[6], v[7]);
    dst[tiled_unit(n, kg * 8, KS)] = o;
  }
}

DI void conv_weight_rm(const float* __restrict__ src, int K, int ldn, int Npad, bool useMap, uint4* __restrict__ dst,
                       int gtid, int gthreads) {
  const int total = Npad * (K >> 3);
  for (int u = gtid; u < total; u += gthreads) {
    int kg = u / Npad, n = u - kg * Npad;
    int col = useMap ? colmap(n) : n;
    float v[8];
#pragma unroll
    for (int j = 0; j < 8; ++j) v[j] = (col >= 0) ? src[(size_t)(kg * 8 + j) * ldn + col] : 0.f;
    uint4 o;
    o.x = cvtpk(v[0], v[1]); o.y = cvtpk(v[2], v[3]); o.z = cvtpk(v[4], v[5]); o.w = cvtpk(v[6], v[7]);
    dst[(size_t)n * (K >> 3) + kg] = o;
  }
}

DI void phase0(const Params& p) {
  const int gtid = blockIdx.x * 512 + vtid(), gthreads = gridDim.x * 512;
  conv_weight_rm(p.w_in, 1024, NIN, NPAD, true, (uint4*)(p.ws + O_WTIN), gtid, gthreads);
  uint4* hb = (uint4*)(p.ws + O_HB);
  for (int u = gtid; u < L_ * 128; u += gthreads) {
    const float4* s_ = (const float4*)(p.x + (size_t)u * 8);
    const float4 a = s_[0], b = s_[1];
    uint4 o;
    o.x = cvtpk(a.x, a.y); o.y = cvtpk(a.z, a.w); o.z = cvtpk(b.x, b.y); o.w = cvtpk(b.z, b.w);
    hb[u] = o;
  }
  float* lbs = (float*)(p.ws + O_LBS);
  for (int c = gtid; c < 512; c += gthreads) {
    float l0 = p.lb_logits[c], l1 = p.lb_logits[512 + c], l2 = p.lb_logits[1024 + c], l3 = p.lb_logits[1536 + c];
    float m = fmaxf(fmaxf(l0, l1), fmaxf(l2, l3));
    float e0 = expf(l0 - m), e1 = expf(l1 - m), e2 = expf(l2 - m), e3 = expf(l3 - m);
    float inv = 1.f / (e0 + e1 + e2 + e3);
    lbs[c] = 0.f; lbs[512 + c] = e1 * inv; lbs[1024 + c] = (e1 + e2) * inv; lbs[1536 + c] = (e1 + e2 + e3) * inv;
  }
}

DI void gemm_core(const uint4* __restrict__ A, int mt0, const uint4* __restrict__ B, int nt0, int KS,
                  f32x16 (&acc)[2][2], uint4* lds) {
  const int tid = vtid(), lane = tid & 63, w = tid >> 6, wm = w >> 1, wn = w & 1;
  const int nk = KS >> 2;
  const uint4* sp[6];
#pragma unroll
  for (int r = 0; r < 6; ++r) {
    int u = tid + 512 * r;
    if (u < 2048) sp[r] = A + ((size_t)(mt0 + (u >> 8)) * KS) * 64 + (u & 255);
    else { int u2 = u - 2048; sp[r] = B + ((size_t)(nt0 + (u2 >> 8)) * KS) * 64 + (u2 & 255); }
  }
#pragma unroll
  for (int r = 0; r < 6; ++r)
    __builtin_amdgcn_global_load_lds((const unsigned*)sp[r], (unsigned*)(lds + tid + 512 * r), 16, 0, 0);
  if (nk > 1) {
#pragma unroll
    for (int r = 0; r < 6; ++r)
      __builtin_amdgcn_global_load_lds((const unsigned*)(sp[r] + 256), (unsigned*)(lds + 3072 + tid + 512 * r), 16, 0, 0);
  }
  int cb = 0;
  for (int kt = 0; kt < nk; ++kt) {
    if (kt + 1 < nk) asm volatile("s_waitcnt vmcnt(6)" ::: "memory");
    else asm volatile("s_waitcnt vmcnt(0)" ::: "memory");
    __builtin_amdgcn_s_barrier();
    asm volatile("" ::: "memory");
    if (kt + 2 < nk) {
      int nb2 = cb + 2; if (nb2 >= 3) nb2 -= 3;
      uint4* nxt = lds + nb2 * 3072;
#pragma unroll
      for (int r = 0; r < 6; ++r)
        __builtin_amdgcn_global_load_lds((const unsigned*)(sp[r] + (size_t)(kt + 2) * 256), (unsigned*)(nxt + tid + 512 * r), 16, 0, 0);
    }
    const uint4* cur = lds + cb * 3072;
#pragma unroll
    for (int ks = 0; ks < 4; ++ks) {
      bf16x8 a0 = __builtin_bit_cast(bf16x8, cur[(2 * wm + 0) * 256 + ks * 64 + lane]);
      bf16x8 a1 = __builtin_bit_cast(bf16x8, cur[(2 * wm + 1) * 256 + ks * 64 + lane]);
      bf16x8 b0 = __builtin_bit_cast(bf16x8, cur[2048 + (2 * wn + 0) * 256 + ks * 64 + lane]);
      bf16x8 b1 = __builtin_bit_cast(bf16x8, cur[2048 + (2 * wn + 1) * 256 + ks * 64 + lane]);
      acc[0][0] = MFMA(a0, b0, acc[0][0]);
      acc[0][1] = MFMA(a0, b1, acc[0][1]);
      acc[1][0] = MFMA(a1, b0, acc[1][0]);
      acc[1][1] = MFMA(a1, b1, acc[1][1]);
    }
    cb = (cb == 2) ? 0 : cb + 1;
  }
  __syncthreads();
}

DI void zero_acc(f32x16 (&acc)[2][2]) {
#pragma unroll
  for (int i = 0; i < 2; ++i)
#pragma unroll
    for (int j = 0; j < 2; ++j)
#pragma unroll
      for (int r = 0; r < 16; ++r) acc[i][j][r] = 0.f;
}

typedef __attribute__((ext_vector_type(4))) float f32x4g;
DI int g8_lds_byte(int r, int c) {
  int st = (r >> 4) * 2 + (c >> 5), rr = r & 15, cc = c & 31, ob = rr * 64 + cc * 2;
  return st * 1024 + (ob ^ (((ob >> 9) & 1) << 5));
}
DI void g8_stage_rc(int b, int& R, int& C) {
  int st = b / 1024, sb = b % 1024, swz = sb ^ (((sb >> 9) & 1) << 5);
  R = (st >> 1) * 16 + swz / 64; C = (st & 1) * 32 + (swz % 64) / 2;
}
DI void gemm8p(const unsigned short* __restrict__ A, const unsigned short* __restrict__ Bt, const int K, const int brow, const int bcol,
               f32x4g (&acc)[2][2][4][2], unsigned short* shm) {
  constexpr int BK = 64, HALF = 128, HT = HALF * BK;
  const int tidx = vtid();
  #define G8_SA(b,h) (shm+((b)*2+(h))*HT)
  #define G8_SB(b,h) (shm+(4+(b)*2+(h))*HT)
  int g8vo[2];
  { int r_, c_; g8_stage_rc(tidx * 16, r_, c_); g8vo[0] = (r_ * K + c_) * 2; g8_stage_rc(tidx * 16 + 8192, r_, c_); g8vo[1] = (r_ * K + c_) * 2; }
  const __amdgpu_buffer_rsrc_t g8rA = __builtin_amdgcn_make_buffer_rsrc((void*)A, 0, 16384 * 1024 * 2, 0x00020000);
  const __amdgpu_buffer_rsrc_t g8rBt = __builtin_amdgcn_make_buffer_rsrc((void*)Bt, 0, 6912 * 1024 * 2, 0x00020000);
  #define G8_STAGE(P,BASE,br,kt) do{ const int _so = ((br) * K + (kt) * BK) * 2; \
    for(int _i=0;_i<2;++_i){ \
      __builtin_amdgcn_raw_ptr_buffer_load_lds(g8r##BASE, (__attribute__((address_space(3))) void*)((char*)(P)+tidx*16+_i*8192), 16, g8vo[_i], _so, 0, 0);}}while(0)
  #define G8_LDA(dst,b,h) for(int m=0;m<4;++m)for(int k=0;k<2;++k) \
    dst[m][k]=*reinterpret_cast<const bf16x8*>((char*)G8_SA(b,h)+g8_lds_byte(wr*64+m*16+fr,k*32+fq*8))
  #define G8_LDB(dst,b,h) for(int n=0;n<2;++n)for(int k=0;k<2;++k) \
    dst[n][k]=*reinterpret_cast<const bf16x8*>((char*)G8_SB(b,h)+g8_lds_byte(wc*32+n*16+fr,k*32+fq*8))
  #define G8_MMA(ai,bj,At,Bt_) do{__builtin_amdgcn_s_setprio(1); \
    for(int m=0;m<4;++m)for(int n=0;n<2;++n)for(int k=0;k<2;++k) \
      acc[ai][bj][m][n]=__builtin_amdgcn_mfma_f32_16x16x32_bf16(Bt_[n][k],At[m][k],acc[ai][bj][m][n],0,0,0); \
    __builtin_amdgcn_s_setprio(0);}while(0)
  #define G8_WV(n) asm volatile("s_waitcnt vmcnt(" #n ")":::"memory")
  #define G8_WL(n) asm volatile("s_waitcnt lgkmcnt(" #n ")":::"memory")
  #define G8_BAR __builtin_amdgcn_s_barrier()
  #define G8_SCHED __builtin_amdgcn_sched_barrier(0)
  const int wid = tidx >> 6, lane = tidx & 63, wr = wid >> 2, wc = wid & 3, fr = lane & 15, fq = lane >> 4;
  bf16x8 At[4][2], B0[2][2], B1[2][2];
  const int nt = K / BK;
  G8_STAGE(G8_SB(0,0),Bt,bcol,0); G8_STAGE(G8_SA(0,0),A,brow,0);
  G8_STAGE(G8_SB(0,1),Bt,bcol+HALF,0); G8_STAGE(G8_SA(0,1),A,brow+HALF,0);
  if(wr==1)G8_BAR;
  G8_WV(4); G8_BAR;
  G8_STAGE(G8_SB(1,0),Bt,bcol,1); G8_STAGE(G8_SA(1,0),A,brow,1); G8_STAGE(G8_SB(1,1),Bt,bcol+HALF,1);
  G8_WV(6); G8_BAR;
  for(int t=0;t<nt-2;t+=2){
    G8_LDB(B0,0,0); G8_SCHED; G8_LDA(At,0,0); G8_STAGE(G8_SA(1,1),A,brow+HALF,t+1);
    G8_WL(8); G8_BAR; G8_WL(0); G8_MMA(0,0,At,B0); G8_BAR; G8_SCHED;
    G8_LDB(B1,0,1); G8_STAGE(G8_SB(0,0),Bt,bcol,t+2);
    G8_BAR; G8_WL(0); G8_MMA(0,1,At,B1); G8_BAR;
    G8_LDA(At,0,1); G8_STAGE(G8_SA(0,0),A,brow,t+2);
    G8_BAR; G8_WL(0); G8_MMA(1,0,At,B0); G8_BAR; G8_SCHED;
    G8_STAGE(G8_SB(0,1),Bt,bcol+HALF,t+2);
    G8_WV(6); G8_BAR; G8_MMA(1,1,At,B1); G8_BAR;
    G8_LDB(B0,1,0); G8_SCHED; G8_LDA(At,1,0); G8_STAGE(G8_SA(0,1),A,brow+HALF,t+2);
    G8_WL(8); G8_BAR; G8_WL(0); G8_MMA(0,0,At,B0); G8_BAR; G8_SCHED;
    G8_LDB(B1,1,1); G8_STAGE(G8_SB(1,0),Bt,bcol,t+3);
    G8_BAR; G8_WL(0); G8_MMA(0,1,At,B1); G8_BAR;
    G8_LDA(At,1,1); G8_STAGE(G8_SA(1,0),A,brow,t+3);
    G8_BAR; G8_WL(0); G8_MMA(1,0,At,B0); G8_BAR; G8_SCHED;
    G8_STAGE(G8_SB(1,1),Bt,bcol+HALF,t+3);
    G8_WV(6); G8_BAR; G8_MMA(1,1,At,B1); G8_BAR;
  }
  { G8_LDB(B0,0,0); G8_LDA(At,0,0); G8_STAGE(G8_SA(1,1),A,brow+HALF,nt-1);
    G8_BAR; G8_WL(0); G8_MMA(0,0,At,B0); G8_BAR;
    G8_LDB(B1,0,1); G8_BAR; G8_WL(0); G8_MMA(0,1,At,B1); G8_BAR;
    G8_LDA(At,0,1); G8_WV(4); G8_BAR; G8_WL(0); G8_MMA(1,0,At,B0); G8_MMA(1,1,At,B1); G8_BAR; }
  { G8_LDB(B0,1,0); G8_LDA(At,1,0); G8_WV(2); G8_BAR; G8_WL(0); G8_MMA(0,0,At,B0); G8_BAR;
    G8_LDB(B1,1,1); G8_WV(0); G8_BAR; G8_WL(0); G8_MMA(0,1,At,B1); G8_BAR;
    G8_LDA(At,1,1); G8_BAR; G8_WL(0); G8_MMA(1,0,At,B0); G8_MMA(1,1,At,B1); G8_BAR; }
  if(wr==0)G8_BAR;
  __syncthreads();
}

DI void p1_tile(const Params& p, int layer, int mb, int nt) {
  const int tid = vtid(), lane = tid & 63, w = tid >> 6, wm = w >> 1, wn = w & 1, hi = lane >> 5, c31 = lane & 31;
  f32x16 acc[2][2];
  zero_acc(acc);
  gemm_core((const uint4*)(p.ws + O_HB), mb * 8, (const uint4*)(p.ws + O_WTIN), nt * 4, 64, acc, (uint4*)smem);
  unsigned short* tile = (unsigned short*)smem;
  const int row0 = mb * 256;
  const float* bin = p.b_in + (size_t)layer * NIN;
  const float* lbs = (const float*)(p.ws + O_LBS) + layer * 512;
#pragma unroll
  for (int j = 0; j < 2; ++j) {
    const int col = 64 * wn + 32 * j + c31;
    const int np = nt * 128 + col;
    const int oc = colmap(np);
    const float bias = oc >= 0 ? bin[oc] : 0.f;
    float lb = 0.f;
    if (nt >= 4 && nt < 8) lb = lbs[(nt - 4) * 128 + col];
#pragma unroll
    for (int i = 0; i < 2; ++i) {
#pragma unroll
      for (int r = 0; r < 16; ++r) {
        const int row = 64 * wm + 32 * i + crow(r, hi);
        float v = acc[i][j][r] + bias;
        float o;
        if (nt < 4) o = v;
        else if (nt < 8) {
          float sg = sigm(v);
          float f = lb + (1.f - lb) * sg;
          ((float*)(p.ws + O_G))[(size_t)(row0 + row) * 512 + (nt - 4) * 128 + col] = __logf(f);
          o = (1.f - lb) * (1.f - sg);
        } else if (nt < 12) o = v;
        else if (nt < 16) o = silu(v);
        else if (nt < 20) o = v * 0.125f;
        else if (nt < 28) o = v;
        else if (nt < 32) o = silu(v);
        else if (nt < 36) o = v;
        else if (nt < 52) o = sigm(v);
        else {
          o = v;
          if (col >= 64 && col < 72)
            ((float*)(p.ws + O_WI))[(size_t)(row0 + row) * 8 + (col - 64)] = v * 0.044194173824159216f;
        }
        tile[row * 128 + col] = f2bf(o);
      }
    }
  }
  __syncthreads();
#pragma unroll
  for (int q = 0; q < 8; ++q) {
    const int u = tid + 512 * q, r = u >> 4, c8 = u & 15;
    const uint4 val = *(const uint4*)&tile[r * 128 + c8 * 8];
    const int t = row0 + r;
    if (nt >= 20 && nt < 28) {
      int w0 = __builtin_amdgcn_cvt_pk_fp8_f32(bflo(val.x), bfhi(val.x), 0, false);
      w0 = __builtin_amdgcn_cvt_pk_fp8_f32(bflo(val.y), bfhi(val.y), w0, true);
      int w1 = __builtin_amdgcn_cvt_pk_fp8_f32(bflo(val.z), bfhi(val.z), 0, false);
      w1 = __builtin_amdgcn_cvt_pk_fp8_f32(bflo(val.w), bfhi(val.w), w1, true);
      const size_t base8 = (nt < 24) ? O_KB : O_VB;
      *(uint2*)(p.ws + base8 + (size_t)t * 512 + (nt & 3) * 128 + c8 * 8) = make_uint2((unsigned)w0, (unsigned)w1);
    } else if (nt < 32) {
      size_t base;
      switch (nt >> 2) {
        case 0: base = O_QA; break; case 1: base = O_KK; break; case 2: base = O_IA; break; case 3: base = O_ZA; break;
        case 4: base = O_QB; break; case 5: base = O_KB; break; case 6: base = O_VB; break; default: base = O_ZB; break;
      }
      *(uint4*)(p.ws + base + ((size_t)t * 512 + (nt & 3) * 128 + c8 * 8) * 2) = val;
    } else if (nt < 36) {
      const int head = 2 * (nt - 32) + (c8 >> 3), d0 = (c8 & 7) * 8;
      const int item = t >> 5, tq = t & 31, mtile = tq >> 2, q4 = tq & 3;
      const int rr = (head & 3) + 4 * (q4 >> 1) + 8 * (head >> 2) + 16 * (q4 & 1);
      const int laneA = rr + 32 * ((d0 >> 3) & 1), ks = d0 >> 4;
      ((uint4*)(p.ws + O_QI))[((size_t)(item * 8 + mtile) * 4 + ks) * 64 + laneA] = val;
    } else if (nt < 44) {
      *(uint4*)(p.ws + O_SGA + ((size_t)t * 1024 + (nt - 36) * 128 + c8 * 8) * 2) = val;
    } else if (nt < 52) {
      *(uint4*)(p.ws + O_SGB + ((size_t)t * 1024 + (nt - 44) * 128 + c8 * 8) * 2) = val;
    } else {
      if (c8 < 8) {
        const int d0 = c8 * 8;
        ((uint4*)(p.ws + O_KI))[((size_t)(t >> 5) * 4 + (d0 >> 4)) * 64 + (t & 31) + 32 * ((d0 >> 3) & 1)] = val;
      }
    }
  }
  __syncthreads();
}

constexpr int T8S = 264;
enum { C_PLAIN = 0, C_FA = 1, C_SILU = 2, C_QB = 3, C_SIGM = 4, C_KIWI = 5 };
DI float sigm_fast(float x) { return __builtin_amdgcn_rcpf(1.f + __builtin_amdgcn_exp2f(-1.4426950408889634f * x)); }
template <int CLS>
DI void p1_epi_write(const Params& p, f32x4g (&acc)[2][2][4][2], int layer, int nt2, int row0) {
  const int tid = vtid(), wid = tid >> 6, lane = tid & 63, wr = wid >> 2, wc = wid & 3, fr = lane & 15, fq = lane >> 4;
  unsigned short* tile = (unsigned short*)smem;
  const float* bin = p.b_in + (size_t)layer * NIN;
  const float* lbs = (const float*)(p.ws + O_LBS) + layer * 512;
  const int rbase = wr * 64 + fr;
#pragma unroll
  for (int bj = 0; bj < 2; ++bj) {
    if (CLS == C_KIWI && bj == 1) break;
    const int nt = 2 * nt2 + bj;
#pragma unroll
    for (int n = 0; n < 2; ++n) {
      const int c4 = wc * 32 + n * 16 + 4 * fq;
      const int np = nt * 128 + c4;
      float4 b4;
      if (CLS == C_KIWI) b4 = (c4 < 72) ? *(const float4*)(bin + (np - 2048)) : make_float4(0.f, 0.f, 0.f, 0.f);
      else if (CLS == C_SIGM) b4 = *(const float4*)(bin + (np + 72));
      else b4 = *(const float4*)(bin + np);
      float4 l4 = make_float4(0.f, 0.f, 0.f, 0.f);
      if (CLS == C_FA) l4 = *(const float4*)(lbs + (nt - 4) * 128 + c4);
#pragma unroll
      for (int ai = 0; ai < 2; ++ai)
#pragma unroll
        for (int m = 0; m < 4; ++m) {
          const int row = ai * 128 + m * 16 + rbase;
          const f32x4g a = acc[ai][bj][m][n];
          const float v0 = a[0] + b4.x, v1 = a[1] + b4.y, v2 = a[2] + b4.z, v3 = a[3] + b4.w;
          float o0, o1, o2, o3;
          if (CLS == C_PLAIN) { o0 = v0; o1 = v1; o2 = v2; o3 = v3; }
          else if (CLS == C_QB) { o0 = v0 * 0.125f; o1 = v1 * 0.125f; o2 = v2 * 0.125f; o3 = v3 * 0.125f; }
          else if (CLS == C_SILU) { o0 = v0 * sigm_fast(v0); o1 = v1 * sigm_fast(v1); o2 = v2 * sigm_fast(v2); o3 = v3 * sigm_fast(v3); }
          else if (CLS == C_SIGM) { o0 = sigm_fast(v0); o1 = sigm_fast(v1); o2 = sigm_fast(v2); o3 = sigm_fast(v3); }
          else if (CLS == C_FA) {
            const float s0 = sigm_fast(v0), s1 = sigm_fast(v1), s2 = sigm_fast(v2), s3 = sigm_fast(v3);
            float4 g;
            g.x = __logf(l4.x + (1.f - l4.x) * s0); g.y = __logf(l4.y + (1.f - l4.y) * s1);
            g.z = __logf(l4.z + (1.f - l4.z) * s2); g.w = __logf(l4.w + (1.f - l4.w) * s3);
            *(float4*)((float*)(p.ws + O_G) + (size_t)(row0 + row) * 512 + (nt - 4) * 128 + c4) = g;
            o0 = (1.f - l4.x) * (1.f - s0); o1 = (1.f - l4.y) * (1.f - s1); o2 = (1.f - l4.z) * (1.f - s2); o3 = (1.f - l4.w) * (1.f - s3);
          } else {
            o0 = v0; o1 = v1; o2 = v2; o3 = v3;
            if (c4 >= 64 && c4 < 72) {
              const float sc = 0.044194173824159216f;
              *(float4*)((float*)(p.ws + O_WI) + (size_t)(row0 + row) * 8 + (c4 - 64)) = make_float4(v0 * sc, v1 * sc, v2 * sc, v3 * sc);
            }
          }
          *(uint2*)(tile + row * T8S + 128 * bj + c4) = make_uint2(cvtpk(o0, o1), cvtpk(o2, o3));
        }
    }
  }
}

DI void p1_tile8(const Params& p, int layer, int mb, int nt2) {
  f32x4g acc[2][2][4][2];
#pragma unroll
  for (int a = 0; a < 2; ++a)
#pragma unroll
    for (int b = 0; b < 2; ++b)
#pragma unroll
      for (int m = 0; m < 4; ++m)
#pragma unroll
        for (int n = 0; n < 2; ++n) acc[a][b][m][n] = f32x4g{0.f, 0.f, 0.f, 0.f};
  gemm8p((const unsigned short*)(p.ws + O_HB), (const unsigned short*)(p.ws + O_WTIN), 1024, mb * 256, nt2 * 256, acc, (unsigned short*)smem);
  __builtin_amdgcn_sched_barrier(0);
  asm volatile("" ::: "memory");
  const int row0 = mb * 256;
  if (nt2 < 2) p1_epi_write<C_PLAIN>(p, acc, layer, nt2, row0);
  else if (nt2 < 4) p1_epi_write<C_FA>(p, acc, layer, nt2, row0);
  else if (nt2 < 6) p1_epi_write<C_PLAIN>(p, acc, layer, nt2, row0);
  else if (nt2 < 8) p1_epi_write<C_SILU>(p, acc, layer, nt2, row0);
  else if (nt2 < 10) p1_epi_write<C_QB>(p, acc, layer, nt2, row0);
  else if (nt2 < 14) p1_epi_write<C_PLAIN>(p, acc, layer, nt2, row0);
  else if (nt2 < 16) p1_epi_write<C_SILU>(p, acc, layer, nt2, row0);
  else if (nt2 < 18) p1_epi_write<C_PLAIN>(p, acc, layer, nt2, row0);
  else if (nt2 < 26) p1_epi_write<C_SIGM>(p, acc, layer, nt2, row0);
  else p1_epi_write<C_KIWI>(p, acc, layer, nt2, row0);
  __syncthreads();
  const int tid = vtid();
  const unsigned short* tile = (const unsigned short*)smem;
  const int c32 = tid & 31, rq = tid >> 5;
  if (nt2 >= 10 && nt2 < 14) {
    char* dst = p.ws + (nt2 < 12 ? O_KB : O_VB) + (size_t)row0 * 512 + (nt2 & 1) * 256 + c32 * 8;
#pragma unroll 4
    for (int q = 0; q < 16; ++q) {
      const int r = rq + 16 * q;
      const uint4 val = *(const uint4*)(tile + r * T8S + c32 * 8);
      int w0 = __builtin_amdgcn_cvt_pk_fp8_f32(bflo(val.x), bfhi(val.x), 0, false);
      w0 = __builtin_amdgcn_cvt_pk_fp8_f32(bflo(val.y), bfhi(val.y), w0, true);
      int w1 = __builtin_amdgcn_cvt_pk_fp8_f32(bflo(val.z), bfhi(val.z), 0, false);
      w1 = __builtin_amdgcn_cvt_pk_fp8_f32(bflo(val.w), bfhi(val.w), w1, true);
      *(uint2*)(dst + (size_t)r * 512) = make_uint2((unsigned)w0, (unsigned)w1);
    }
  } else if (nt2 < 16) {
    size_t base;
    switch (nt2 >> 1) {
      case 0: base = O_QA; break; case 1: base = O_KK; break; case 2: base = O_IA; break; case 3: base = O_ZA; break;
      case 4: base = O_QB; break; default: base = O_ZB; break;
    }
    char* dst = p.ws + base + ((size_t)row0 * 512 + (nt2 & 1) * 256 + c32 * 8) * 2;
#pragma unroll 4
    for (int q = 0; q < 16; ++q) {
      const int r = rq + 16 * q;
      *(uint4*)(dst + (size_t)r * 1024) = *(const uint4*)(tile + r * T8S + c32 * 8);
    }
  } else if (nt2 < 18) {
    const int head = 4 * (nt2 - 16) + (c32 >> 3), d0 = (c32 & 7) * 8;
#pragma unroll 4
    for (int q = 0; q < 16; ++q) {
      const int r = rq + 16 * q, t = row0 + r;
      const int item = t >> 5, tq = t & 31, mtile = tq >> 2, q4 = tq & 3;
      const int rr = (head & 3) + 4 * (q4 >> 1) + 8 * (head >> 2) + 16 * (q4 & 1);
      const int laneA = rr + 32 * ((d0 >> 3) & 1), ks = d0 >> 4;
      ((uint4*)(p.ws + O_QI))[((size_t)(item * 8 + mtile) * 4 + ks) * 64 + laneA] = *(const uint4*)(tile + r * T8S + c32 * 8);
    }
  } else if (nt2 < 26) {
    char* dst = p.ws + (nt2 < 22 ? O_SGA : O_SGB) + ((size_t)row0 * 1024 + ((nt2 - 18) & 3) * 256 + c32 * 8) * 2;
#pragma unroll 4
    for (int q = 0; q < 16; ++q) {
      const int r = rq + 16 * q;
      *(uint4*)(dst + (size_t)r * 2048) = *(const uint4*)(tile + r * T8S + c32 * 8);
    }
  } else {
    if (c32 < 8) {
      const int d0 = c32 * 8;
#pragma unroll 4
      for (int q = 0; q < 16; ++q) {
        const int r = rq + 16 * q, t = row0 + r;
        ((uint4*)(p.ws + O_KI))[((size_t)(t >> 5) * 4 + (d0 >> 4)) * 64 + (t & 31) + 32 * ((d0 >> 3) & 1)] = *(const uint4*)(tile + r * T8S + c32 * 8);
      }
    }
  }
  asm volatile("s_waitcnt lgkmcnt(0)" ::: "memory");
  __builtin_amdgcn_s_barrier();
}

constexpr int CAP = 1000, SEGCAP = 250, SEGTRIG = 186;
constexpr int IX_SC = 0, IX_IX = 64000, IX_RING = 96000, IX_CNT = 161536, IX_TAU = 161792, IX_FLAG = 161856, IX_WL = 161872;

DI float key2float(unsigned k) {
  unsigned b = (k & 0x80000000u) ? (k ^ 0x80000000u) : ~k;
  return __uint_as_float(b);
}
DI unsigned float2key(float f) {
  unsigned b = __float_as_uint(f);
  return (b & 0x80000000u) ? ~b : (b ^ 0x80000000u);
}
DI int wave_prefix_incl(int x) {
  int v = x;
  v += __builtin_amdgcn_update_dpp(0, v, 0x111, 0xf, 0xf, false);
  v += __builtin_amdgcn_update_dpp(0, v, 0x112, 0xf, 0xf, false);
  v += __builtin_amdgcn_update_dpp(0, v, 0x114, 0xf, 0xf, false);
  v += __builtin_amdgcn_update_dpp(0, v, 0x118, 0xf, 0xf, false);
  v += __builtin_amdgcn_update_dpp(0, v, 0x142, 0xa, 0xf, false);
  v += __builtin_amdgcn_update_dpp(0, v, 0x143, 0xc, 0xf, false);
  return v;
}

#define SEG_ADDR(j_) (((j_) >> 2) * SEGCAP + lane + 64 * ((j_) & 3))
DI int seg_count(const int4 c4, int s_) { return s_ == 0 ? c4.x : (s_ == 1 ? c4.y : (s_ == 2 ? c4.z : c4.w)); }

DI void wave_select(float* scq, unsigned short* ixq, int* cnt4q, float* tauq, unsigned* hist, int lane, unsigned short* final_sel) {
  lds_fence();
  const int4 c4 = *(const int4*)cnt4q;
  const int n = c4.x + c4.y + c4.z + c4.w;
  unsigned u[16], v16[16];
  unsigned mm = 0, am = 0;
#pragma unroll
  for (int j = 0; j < 16; ++j) {
    const bool valid = (lane + 64 * (j & 3)) < seg_count(c4, j >> 2);
    const float sv = valid ? scq[SEG_ADDR(j)] : 0.f;
    const unsigned id = valid ? (unsigned)ixq[SEG_ADDR(j)] : 0u;
    u[j] = float2key(sv);
    v16[j] = 0xFFFFu - id;
    mm |= (((unsigned)(lane + 64 * (j & 3)) - (unsigned)seg_count(c4, j >> 2)) >> 31) << j;
  }
  unsigned prefix_u = 0;
  if (n > 256) {
    int need = 256;
    int r0 = 0;
    {
      unsigned ref = 0; bool have = false;
#pragma unroll
      for (int j = 15; j >= 0; --j) if ((mm >> j) & 1u) { ref = u[j] >> 24; have = true; }
      const unsigned long long hm = __ballot(have);
      const int fl = __ffsll((long long)hm) - 1;
      ref = (unsigned)__builtin_amdgcn_readlane((int)ref, fl);
      bool same = true;
#pragma unroll
      for (int j = 0; j < 16; ++j) same = same && (!((mm >> j) & 1u) || ((u[j] >> 24) == ref));
      if (__all(same)) { prefix_u = ref << 24; r0 = 1; }
    }
    for (int r = r0; r < 6; ++r) {
      const int sh = (r < 4) ? (24 - 8 * r) : (r == 4 ? 8 : 0);
      { const unsigned z_ = vzero(); ((uint4*)hist)[lane] = make_uint4(z_, z_, z_, z_); }
      lds_fence();
#pragma unroll
      for (int j = 0; j < 16; ++j) {
        const unsigned src = (r < 4) ? u[j] : v16[j];
        const unsigned dgt = ((mm >> j) & 1u) ? ((src >> sh) & 255u) : 256u + lane;
        atomicAdd(&hist[dgt], 1u);
      }
      lds_fence();
      const uint4 hv = ((const uint4*)hist)[lane];
      const int c0 = hv.x, c1 = hv.y, c2 = hv.z, c3 = hv.w;
      const int Lsum = c0 + c1 + c2 + c3;
      const int Pfx = wave_prefix_incl(Lsum);
      const int total = __builtin_amdgcn_readlane(Pfx, 63);
      const int S = total - Pfx + Lsum;
      const unsigned long long mask = __ballot(S >= need);
      const int lstar = 63 - __clzll((long long)mask);
      int d_, ca_, cd_;
      {
        const int accu = S - Lsum;
        if (accu + c3 >= need) { d_ = 3; ca_ = accu; cd_ = c3; }
        else if (accu + c3 + c2 >= need) { d_ = 2; ca_ = accu + c3; cd_ = c2; }
        else if (accu + c3 + c2 + c1 >= need) { d_ = 1; ca_ = accu + c3 + c2; cd_ = c1; }
        else { d_ = 0; ca_ = accu + c3 + c2 + c1; cd_ = c0; }
      }
      const int D = __builtin_amdgcn_readlane(4 * lane + d_, lstar);
      const int cntAbove = __builtin_amdgcn_readlane(ca_, lstar);
      const int cntD = __builtin_amdgcn_readlane(cd_, lstar);
#pragma unroll
      for (int j = 0; j < 16; ++j) {
        const unsigned src = (r < 4) ? u[j] : v16[j];
        const int dgt = (int)((src >> sh) & 255u);
        const unsigned bit = mm & (1u << j);
        const unsigned dd = (unsigned)D - (unsigned)dgt, de = (unsigned)dgt - (unsigned)D;
        const unsigned gtm = (unsigned)((int)dd >> 31);
        const unsigned nem = (unsigned)((int)(dd | de) >> 31);
        am |= bit & gtm;
        mm ^= bit & nem;
      }
      need -= cntAbove;
      if (r < 4) prefix_u |= ((unsigned)D) << sh;
      if (cntD == need) break;
    }
  }
  const unsigned km = am | mm;
  int base = 0;
#pragma unroll
  for (int j = 0; j < 16; ++j) {
    const bool keep = (km >> j) & 1u;
    const unsigned long long m = __ballot(keep);
    const int rk = base + __popcll(m & ((1ull << lane) - 1ull));
    if (keep) {
      if (final_sel) { if (rk < 256) final_sel[rk] = (unsigned short)(0xFFFFu - v16[j]); }
      else { const int ad = (rk & 3) * SEGCAP + (rk >> 2); scq[ad] = key2float(u[j]); ixq[ad] = (unsigned short)(0xFFFFu - v16[j]); }
    }
    base += __popcll(m);
  }
  if (!final_sel && lane == 0) {
    *(int4*)cnt4q = make_int4((base + 3) >> 2, (base + 2) >> 2, (base + 1) >> 2, base >> 2);
    if (n > 256) *tauq = key2float(prefix_u);
  }
  lds_fence();
}

typedef float f32x2v __attribute__((ext_vector_type(2)));
DI float relu_(float x) { int i = __float_as_int(x); i = i > 0 ? i : 0; return __int_as_float(i); }

DI unsigned wave_umin(unsigned v) {
#define UMIN_STEP(ctrl, rm) { const unsigned o_ = (unsigned)__builtin_amdgcn_update_dpp((int)0xFFFFFFFFu, (int)v, ctrl, rm, 0xf, false); v = o_ < v ? o_ : v; }
  UMIN_STEP(0x111, 0xf) UMIN_STEP(0x112, 0xf) UMIN_STEP(0x114, 0xf) UMIN_STEP(0x118, 0xf) UMIN_STEP(0x142, 0xa) UMIN_STEP(0x143, 0xc)
#undef UMIN_STEP
  return (unsigned)__builtin_amdgcn_readlane((int)v, 63);
}
DI unsigned wave_umax(unsigned v) {
#define UMAX_STEP(ctrl, rm) { const unsigned o_ = (unsigned)__builtin_amdgcn_update_dpp(0, (int)v, ctrl, rm, 0xf, false); v = o_ > v ? o_ : v; }
  UMAX_STEP(0x111, 0xf) UMAX_STEP(0x112, 0xf) UMAX_STEP(0x114, 0xf) UMAX_STEP(0x118, 0xf) UMAX_STEP(0x142, 0xa) UMAX_STEP(0x143, 0xc)
#undef UMAX_STEP
  return (unsigned)__builtin_amdgcn_readlane((int)v, 63);
}
DI void wave_compact(float* scq, unsigned short* ixq, int* cnt4q, float* tauq, unsigned* hist, int lane) {
  lds_fence();
  const int4 c4 = *(const int4*)cnt4q;
  const int n = c4.x + c4.y + c4.z + c4.w;
  if (n <= 320) return;
  unsigned u[16], idv[16];
  unsigned vm = 0;
  unsigned umin = 0xFFFFFFFFu, umax = 0u;
  { const unsigned z_ = vzero(); ((uint4*)hist)[lane] = make_uint4(z_, z_, z_, z_); }

#pragma unroll
  for (int j = 0; j < 16; ++j) {
    const bool valid = (lane + 64 * (j & 3)) < seg_count(c4, j >> 2);
    u[j] = valid ? float2key(scq[SEG_ADDR(j)]) : 0u;
    idv[j] = valid ? (unsigned)ixq[SEG_ADDR(j)] : 0u;
    vm |= (((unsigned)(lane + 64 * (j & 3)) - (unsigned)seg_count(c4, j >> 2)) >> 31) << j;
    umin = valid ? (u[j] < umin ? u[j] : umin) : umin;
    umax = valid ? (u[j] > umax ? u[j] : umax) : umax;
  }
  umin = wave_umin(umin);
  umax = wave_umax(umax);
  const unsigned range = umax - umin;
  const int sh = range < 256u ? 0 : (24 - __clz((int)range));
#pragma unroll
  for (int j = 0; j < 16; ++j) {
    const unsigned bin = ((vm >> j) & 1u) ? ((u[j] - umin) >> sh) : 256u + lane;
    atomicAdd(&hist[bin], 1u);
  }
  lds_fence();
  const uint4 hv = ((const uint4*)hist)[lane];
  const int c0 = hv.x, c1 = hv.y, c2 = hv.z, c3 = hv.w;
  const int Lsum = c0 + c1 + c2 + c3;
  const int Pfx = wave_prefix_incl(Lsum);
  const int total = __builtin_amdgcn_readlane(Pfx, 63);
  const int S = total - Pfx + Lsum;
  const unsigned long long mask = __ballot(S >= 256);
  const int lstar = 63 - __clzll((long long)mask);
  int d_, kept_;
  {
    const int accu = S - Lsum;
    if (accu + c3 >= 256) { d_ = 3; kept_ = accu + c3; }
    else if (accu + c3 + c2 >= 256) { d_ = 2; kept_ = accu + c3 + c2; }
    else if (accu + c3 + c2 + c1 >= 256) { d_ = 1; kept_ = accu + c3 + c2 + c1; }
    else { d_ = 0; kept_ = accu + Lsum; }
  }
  const int D = __builtin_amdgcn_readlane(4 * lane + d_, lstar);
  const int kept = __builtin_amdgcn_readlane(kept_, lstar);
  if (kept > 400) return;
  int base = 0;
#pragma unroll
  for (int j = 0; j < 16; ++j) {
    const bool keep = ((vm >> j) & 1u) && ((int)((u[j] - umin) >> sh) >= D);
    const unsigned long long m = __ballot(keep);
    const int rk = base + __popcll(m & ((1ull << lane) - 1ull));
    if (keep) { const int ad = (rk & 3) * SEGCAP + (rk >> 2); scq[ad] = key2float(u[j]); ixq[ad] = (unsigned short)idv[j]; }
    base += __popcll(m);
  }
  if (lane == 0) {
    *(int4*)cnt4q = make_int4((base + 3) >> 2, (base + 2) >> 2, (base + 1) >> 2, base >> 2);
    *tauq = key2float(umin + ((unsigned)D << sh));
  }
  lds_fence();
}

#define IDX_GLDS(step, bufi) do { _Pragma("unroll") for (int r_ = 0; r_ < 4; ++r_) \
    __builtin_amdgcn_global_load_lds((const unsigned*)(ki + (size_t)(step) * 2048 + tid + 512 * r_), \
                                     (unsigned*)(ring + (bufi) * 2048 + tid + 512 * r_), 16, 0, 0); } while (0)

DI void indexer_item(const Params& p, int item) {
  const int tid = vtid(), lane = tid & 63, w = tid >> 6, g = w & 1, kg = w >> 1, hi = lane >> 5, c31 = lane & 31;
  float* sc = (float*)(smem + IX_SC);
  unsigned short* ix = (unsigned short*)(smem + IX_IX);
  uint4* ring = (uint4*)(smem + IX_RING);
  int* cnt = (int*)(smem + IX_CNT);
  volatile int* flag = (volatile int*)(smem + IX_FLAG);
  float* tauv = (float*)(smem + IX_TAU);
  const uint4* qi = (const uint4*)(p.ws + O_QI);
  const uint4* ki = (const uint4*)(p.ws + O_KI);
  const float* wi = (const float*)(p.ws + O_WI);
  const int t0 = 16 * item;
  bf16x8 a[2][4];
#pragma unroll
  for (int mt = 0; mt < 2; ++mt)
#pragma unroll
    for (int ks = 0; ks < 4; ++ks)
      a[mt][ks] = __builtin_bit_cast(bf16x8, qi[((size_t)((item >> 1) * 8 + (item & 1) * 4 + 2 * g + mt) * 4 + ks) * 64 + lane]);
  float* wl = (float*)(smem + IX_WL);
  if (tid < 128) wl[tid] = wi[(size_t)t0 * 8 + tid];
  float tau[2][2];
#pragma unroll
  for (int mt = 0; mt < 2; ++mt) { tau[mt][0] = -INFINITY; tau[mt][1] = -INFINITY; }
  if (tid < 64) cnt[tid] = 0;
  if (tid < 16) tauv[tid] = -INFINITY;
  int cntv[2][2] = {{0, 0}, {0, 0}};
  if (tid < 2) flag[tid] = 0;
  const int nsteps = (t0 + 16 + 255) >> 8;
  asm volatile("s_waitcnt vmcnt(0)" ::: "memory");
  IDX_GLDS(0, 0);
  if (nsteps > 1) { IDX_GLDS(1, 1); asm volatile("s_waitcnt vmcnt(4)" ::: "memory"); }
  else asm volatile("s_waitcnt vmcnt(0)" ::: "memory");
  __syncthreads();
  const f32x16 z = {0.f, 0.f, 0.f, 0.f, 0.f, 0.f, 0.f, 0.f, 0.f, 0.f, 0.f, 0.f, 0.f, 0.f, 0.f, 0.f};
  f32x16 Ca0, Ca1, Cb0, Cb1;
  {
    const uint4* cur = ring;
    const uint4* bp = cur + ((2 * kg + 0) * 4) * 64 + lane;
    bf16x8 b0 = __builtin_bit_cast(bf16x8, bp[0]), b1 = __builtin_bit_cast(bf16x8, bp[64]);
    bf16x8 b2 = __builtin_bit_cast(bf16x8, bp[128]), b3 = __builtin_bit_cast(bf16x8, bp[192]);
    Ca0 = MFMA(a[0][0], b0, z); Ca1 = MFMA(a[1][0], b0, z);
    Ca0 = MFMA(a[0][1], b1, Ca0); Ca1 = MFMA(a[1][1], b1, Ca1);
    Ca0 = MFMA(a[0][2], b2, Ca0); Ca1 = MFMA(a[1][2], b2, Ca1);
    Ca0 = MFMA(a[0][3], b3, Ca0); Ca1 = MFMA(a[1][3], b3, Ca1);
  }
#define IDX_SCORE(Cx, mt_, aa_, sout) do { const float4 wa_ = *(const float4*)(wl + (8 * g + 4 * (mt_) + 2 * hi + (aa_)) * 8); \
    const float4 wb_ = *(const float4*)(wl + (8 * g + 4 * (mt_) + 2 * hi + (aa_)) * 8 + 4); \
    f32x2v r0_ = {relu_(Cx[8 * (aa_) + 0]), relu_(Cx[8 * (aa_) + 1])}, r1_ = {relu_(Cx[8 * (aa_) + 2]), relu_(Cx[8 * (aa_) + 3])}; \
    f32x2v r2_ = {relu_(Cx[8 * (aa_) + 4]), relu_(Cx[8 * (aa_) + 5])}, r3_ = {relu_(Cx[8 * (aa_) + 6]), relu_(Cx[8 * (aa_) + 7])}; \
    const f32x2v w0_ = {wa_.x, wa_.y}, w1_ = {wa_.z, wa_.w}, w2_ = {wb_.x, wb_.y}, w3_ = {wb_.z, wb_.w}; \
    f32x2v ac_ = r0_ * w0_; ac_ = r1_ * w1_ + ac_; ac_ = r2_ * w2_ + ac_; ac_ = r3_ * w3_ + ac_; \
    sout = ac_.x + ac_.y; } while (0)
  const unsigned ltm = (1u << c31) - 1u;
  const int tqb = t0 + 8 * g + 2 * hi;
  const int sb0 = ((8 * g + 2 * hi) * CAP + kg * SEGCAP) * 4;
#define IDX_APPEND(sval, mt_, aa_, keyv) do { \
    const bool pr_ = ((keyv) <= tqb + 4 * (mt_) + (aa_)) && ((sval) >= tau[mt_][aa_]); \
    const unsigned long long bm_ = __builtin_amdgcn_ballot_w64(pr_); \
    const unsigned half_ = hi ? (unsigned)(bm_ >> 32) : (unsigned)bm_; \
    const int pos_ = cntv[mt_][aa_] + __popc(half_ & ltm); \
    if (pr_) { const int bo_ = sb0 + (4 * (mt_) + (aa_)) * CAP * 4 + pos_ * 4; \
      *(float*)((char*)sc + bo_) = (sval); *(unsigned short*)((char*)ix + (bo_ >> 1)) = (unsigned short)(keyv); } \
    cntv[mt_][aa_] += __popc(half_); } while (0)
#define IDX_PUBLISH() do { if (c31 == 0) { _Pragma("unroll") for (int mt_ = 0; mt_ < 2; ++mt_) _Pragma("unroll") for (int aa_ = 0; aa_ < 2; ++aa_) \
    cnt[4 * (8 * g + 4 * mt_ + 2 * hi + aa_) + kg] = cntv[mt_][aa_]; } } while (0)
  for (int j = 0; j < nsteps; ++j) {
    const uint4* cur = ring + (j & 1) * 2048;
    {
      const uint4* bp = cur + ((2 * kg + 1) * 4) * 64 + lane;
      bf16x8 b0 = __builtin_bit_cast(bf16x8, bp[0]), b1 = __builtin_bit_cast(bf16x8, bp[64]);
      bf16x8 b2 = __builtin_bit_cast(bf16x8, bp[128]), b3 = __builtin_bit_cast(bf16x8, bp[192]);
      Cb0 = MFMA(a[0][0], b0, z); Cb1 = MFMA(a[1][0], b0, z);
      Cb0 = MFMA(a[0][1], b1, Cb0); Cb1 = MFMA(a[1][1], b1, Cb1);
      Cb0 = MFMA(a[0][2], b2, Cb0); Cb1 = MFMA(a[1][2], b2, Cb1);
      Cb0 = MFMA(a[0][3], b3, Cb0); Cb1 = MFMA(a[1][3], b3, Cb1);
    }
    {
      const int key = 256 * j + 64 * kg + c31;
      float s00, s01, s10, s11;
      IDX_SCORE(Ca0, 0, 0, s00); IDX_SCORE(Ca0, 0, 1, s01); IDX_SCORE(Ca1, 1, 0, s10); IDX_SCORE(Ca1, 1, 1, s11);
#pragma unroll
      for (int q_ = 0; q_ < 8; ++q_) { __builtin_amdgcn_sched_group_barrier(0x008, 1, 0); __builtin_amdgcn_sched_group_barrier(0x002, 9, 0); }
      IDX_APPEND(s00, 0, 0, key); IDX_APPEND(s01, 0, 1, key); IDX_APPEND(s10, 1, 0, key); IDX_APPEND(s11, 1, 1, key);
    }
    IDX_PUBLISH();
    {
      const int mxc = max(max(cntv[0][0], cntv[0][1]), max(cntv[1][0], cntv[1][1]));
      if (__ballot(mxc > SEGTRIG) != 0ull) { if (lane == 0) flag[j & 1] = j + 1; }
    }
    __syncthreads();
    if (flag[j & 1] == j + 1) {
      unsigned* hist = (unsigned*)(ring + (j & 1) * 2048) + w * 512;
#pragma unroll 1
      for (int k = 0; k < 2; ++k) {
        const int q = 2 * w + k;
        wave_compact(sc + q * CAP, ix + q * CAP, cnt + 4 * q, tauv + q, hist, lane);
        lds_fence();
        { const int4 cc = *(const int4*)(cnt + 4 * q); if (cc.x + cc.y + cc.z + cc.w > 400) wave_select(sc + q * CAP, ix + q * CAP, cnt + 4 * q, tauv + q, hist, lane, nullptr); }
      }
      __syncthreads();
#pragma unroll
      for (int mt = 0; mt < 2; ++mt)
#pragma unroll
        for (int aa = 0; aa < 2; ++aa) { const int ql = 8 * g + 4 * mt + 2 * hi + aa; tau[mt][aa] = tauv[ql]; cntv[mt][aa] = cnt[4 * ql + kg]; }
    }
    if (j + 2 < nsteps) IDX_GLDS(j + 2, j & 1);
    if (j + 1 < nsteps) {
      const uint4* nxt = ring + ((j + 1) & 1) * 2048;
      const uint4* bp = nxt + ((2 * kg + 0) * 4) * 64 + lane;
      bf16x8 b0 = __builtin_bit_cast(bf16x8, bp[0]), b1 = __builtin_bit_cast(bf16x8, bp[64]);
      bf16x8 b2 = __builtin_bit_cast(bf16x8, bp[128]), b3 = __builtin_bit_cast(bf16x8, bp[192]);
      Ca0 = MFMA(a[0][0], b0, z); Ca1 = MFMA(a[1][0], b0, z);
      Ca0 = MFMA(a[0][1], b1, Ca0); Ca1 = MFMA(a[1][1], b1, Ca1);
      Ca0 = MFMA(a[0][2], b2, Ca0); Ca1 = MFMA(a[1][2], b2, Ca1);
      Ca0 = MFMA(a[0][3], b3, Ca0); Ca1 = MFMA(a[1][3], b3, Ca1);
    }
    {
      const int key = 256 * j + 64 * kg + 32 + c31;
      float s00, s01, s10, s11;
      IDX_SCORE(Cb0, 0, 0, s00); IDX_SCORE(Cb0, 0, 1, s01); IDX_SCORE(Cb1, 1, 0, s10); IDX_SCORE(Cb1, 1, 1, s11);
#pragma unroll
      for (int q_ = 0; q_ < 8; ++q_) { __builtin_amdgcn_sched_group_barrier(0x008, 1, 0); __builtin_amdgcn_sched_group_barrier(0x002, 9, 0); }
      IDX_APPEND(s00, 0, 0, key); IDX_APPEND(s01, 0, 1, key); IDX_APPEND(s10, 1, 0, key); IDX_APPEND(s11, 1, 1, key);
    }
  }
  IDX_PUBLISH();
  __syncthreads();
  unsigned short* sel = (unsigned short*)(p.ws + O_SEL);
  unsigned* hist = (unsigned*)ring + w * 512;
#pragma unroll 1
  for (int k = 0; k < 2; ++k) {
    const int q = 2 * w + k;
    wave_select(sc + q * CAP, ix + q * CAP, cnt + 4 * q, tauv + q, hist, lane, sel + (size_t)(t0 + q) * 256);
  }
  __syncthreads();
}

DI void hgrn_a_item(const Params& p, int c, int h) {
  const int tid = vtid(), lane = tid & 63, w = tid >> 6, hi = lane >> 5, c31 = lane & 31;
  float* tot = (float*)smem;
  unsigned short* kT = (unsigned short*)(smem + 2048);
  unsigned short* vT = (unsigned short*)(smem + 2048 + 18432);
  const int seg = tid >> 7, k = tid & 127;
  const float* G = (const float*)(p.ws + O_G);
  const unsigned short* KK = (const unsigned short*)(p.ws + O_KK);
  const unsigned short* IA = (const unsigned short*)(p.ws + O_IA);
  const size_t rowbase = (size_t)(64 * c + 16 * seg);
  float b[16];
  {
    float run = 0.f;
#pragma unroll
    for (int i = 0; i < 16; ++i) { run += G[(rowbase + i) * 512 + 128 * h + k]; b[i] = run; }
    tot[seg * 128 + k] = run;
  }
  __syncthreads();
  float off = 0.f, blast = 0.f;
#pragma unroll
  for (int s2 = 0; s2 < 4; ++s2) { float tv = tot[s2 * 128 + k]; if (s2 < seg) off += tv; blast += tv; }
  {
    unsigned pk[8], pv[8];
#pragma unroll
    for (int i = 0; i < 16; i += 2) {
      float k0 = bf2f(KK[(rowbase + i) * 512 + 128 * h + k]) * __expf(blast - (b[i] + off));
      float k1 = bf2f(KK[(rowbase + i + 1) * 512 + 128 * h + k]) * __expf(blast - (b[i + 1] + off));
      pk[i >> 1] = cvtpk(k0, k1);
      unsigned v0 = IA[(rowbase + i) * 512 + 128 * h + k], v1 = IA[(rowbase + i + 1) * 512 + 128 * h + k];
      pv[i >> 1] = v0 | (v1 << 16);
    }
    uint4* dk = (uint4*)(kT + k * 72 + 16 * seg);
    dk[0] = make_uint4(pk[0], pk[1], pk[2], pk[3]); dk[1] = make_uint4(pk[4], pk[5], pk[6], pk[7]);
    uint4* dv = (uint4*)(vT + k * 72 + 16 * seg);
    dv[0] = make_uint4(pv[0], pv[1], pv[2], pv[3]); dv[1] = make_uint4(pv[4], pv[5], pv[6], pv[7]);
    if (seg == 0) ((float*)(p.ws + O_D))[(size_t)(c * 4 + h) * 128 + k] = __expf(blast);
  }
  __syncthreads();
  const int mt = w >> 1;
  f32x16 acc[2];
#pragma unroll
  for (int r = 0; r < 16; ++r) { acc[0][r] = 0.f; acc[1][r] = 0.f; }
#pragma unroll
  for (int ks = 0; ks < 4; ++ks) {
    bf16x8 af = __builtin_bit_cast(bf16x8, *(const uint4*)(kT + (32 * mt + c31) * 72 + 16 * ks + 8 * hi));
#pragma unroll
    for (int jn = 0; jn < 2; ++jn) {
      const int nt = 2 * (w & 1) + jn;
      bf16x8 bfv = __builtin_bit_cast(bf16x8, *(const uint4*)(vT + (32 * nt + c31) * 72 + 16 * ks + 8 * hi));
      acc[jn] = MFMA(af, bfv, acc[jn]);
    }
  }
  char* us = p.ws + O_US + (size_t)(c * 4 + h) * 32768;
#pragma unroll
  for (int jn = 0; jn < 2; ++jn) {
    const int nt = 2 * (w & 1) + jn;
    const int v = 32 * nt + c31;
#pragma unroll
    for (int gq = 0; gq < 4; ++gq) {
      const int k0 = 32 * mt + 8 * gq;
      const size_t unit = ((size_t)(v >> 5) * 8 + (k0 >> 4)) * 64 + (v & 31) + 32 * ((k0 >> 3) & 1);
      uint2 val;
      val.x = cvtpk(acc[jn][4 * gq + 0], acc[jn][4 * gq + 1]);
      val.y = cvtpk(acc[jn][4 * gq + 2], acc[jn][4 * gq + 3]);
      *(uint2*)(us + unit * 16 + 8 * hi) = val;
    }
  }
  __syncthreads();
}

DI void hgrn_scan(const Params& p) {
  const int tid = vtid();
  if (tid >= 128) return;
  for (int pid = blockIdx.x * 128 + tid; pid < 32768; pid += gridDim.x * 128) {
    const int q4 = pid & 3, unit = (pid >> 2) & 2047, h = pid >> 13;
    const int lanep = unit & 63, ks = (unit >> 6) & 7;
    const int k = ks * 16 + 8 * (lanep >> 5) + 2 * q4;
    unsigned* us = (unsigned*)(p.ws + O_US) + (size_t)h * 8192 + unit * 4 + q4;
    const float* dd = (const float*)(p.ws + O_D) + h * 128 + k;
    float s0 = 0.f, s1 = 0.f;
    unsigned uv[16], un[16];
    float2 dv[16], dn[16];
#pragma unroll
    for (int i = 0; i < 16; ++i) { uv[i] = us[(size_t)i * 32768]; dv[i] = *(const float2*)(dd + (size_t)i * 512); }
#pragma unroll 1
    for (int c0 = 0; c0 < 256; c0 += 16) {
      const int cn = (c0 + 16 < 256) ? c0 + 16 : c0;
#pragma unroll
      for (int i = 0; i < 16; ++i) { un[i] = us[(size_t)(cn + i) * 32768]; dn[i] = *(const float2*)(dd + (size_t)(cn + i) * 512); }
      asm volatile("" ::: "memory");
#pragma unroll
      for (int i = 0; i < 16; ++i) {
        us[(size_t)(c0 + i) * 32768] = cvtpk(s0, s1);
        s0 = fmaf(dv[i].x, s0, bflo(uv[i]));
        s1 = fmaf(dv[i].y, s1, bfhi(uv[i]));
      }
      asm volatile("" ::: "memory");
#pragma unroll
      for (int i = 0; i < 16; ++i) { uv[i] = un[i]; dv[i] = dn[i]; }
    }
  }
}

constexpr int AT_LUT = 0, AT_RB = 512, AT_WAVE = 2048, AT_WSZ = 8192 + 1024 + 16 * 528;
DI void attn_setup() {
  const int tid = vtid();
  int* lut = (int*)(smem + AT_LUT);
  if (tid < 128) {
    int d = tid;
    int bk;
    if (d < 16) bk = d;
    else {
      float df = (float)d;
      int lg = 16 + (int)(logf(df / 16.f) / 2.0794415416798357f * 16.f);
      bk = lg < 31 ? lg : 31;
    }
    lut[tid] = bk;
  }
}
DI float dppf(float v, int ctrl_sel) {
  const int iv = __builtin_bit_cast(int, v);
  int r;
  if (ctrl_sel == 0) r = __builtin_amdgcn_update_dpp(0, iv, 0xB1, 0xf, 0xf, false);
  else if (ctrl_sel == 1) r = __builtin_amdgcn_update_dpp(0, iv, 0x4E, 0xf, 0xf, false);
  else r = __builtin_amdgcn_update_dpp(0, iv, 0x141, 0xf, 0xf, false);
  return __builtin_bit_cast(float, r);
}
DI float sum8(float v) { v += dppf(v, 0); v += dppf(v, 1); v += dppf(v, 2); return v; }
DI float max8(float v) { v = fmaxf(v, dppf(v, 0)); v = fmaxf(v, dppf(v, 1)); v = fmaxf(v, dppf(v, 2)); return v; }

DI size_t prob_off(int t) {
  return t < 8192 ? O_MG + (size_t)t * 4096 : (t < 12288 ? O_AA + (size_t)(t - 8192) * 4096 : O_QI + (size_t)(t - 12288) * 4096);
}
#define MFMA8S(a, b, c) __builtin_amdgcn_mfma_f32_16x16x32_fp8_fp8((a), (b), (c), 0, 0, 0)
typedef __attribute__((ext_vector_type(4))) float f32x4v;
constexpr int AT_KROW = 528;
struct QKPF { int s0, s1, s2, s3; uint4 q0, q1; };
DI void qk_fetch(const Params& p, int t, int lane, QKPF& f) {
  const int nsel = t + 1 < 256 ? t + 1 : 256;
  const unsigned short* sel = (const unsigned short*)(p.ws + O_SEL) + (size_t)t * 256;
  f.s0 = lane < nsel ? (int)sel[lane] : 0; f.s1 = lane + 64 < nsel ? (int)sel[lane + 64] : 0;
  f.s2 = lane + 128 < nsel ? (int)sel[lane + 128] : 0; f.s3 = lane + 192 < nsel ? (int)sel[lane + 192] : 0;
  const unsigned short* qp = (const unsigned short*)(p.ws + O_QB) + (size_t)t * 512 + (lane & 7) * 64 + 8 * (lane >> 4);
  f.q0 = *(const uint4*)qp; f.q1 = *(const uint4*)(qp + 32);
}
DI void attn_query(const Params& p, int t, int tnext, int w, int lane, QKPF& pf) {
  const int h = lane >> 3, dg = lane & 7, n15 = lane & 15, quad = lane >> 4, hi = lane >> 5, c31 = lane & 31;
  const int* lut = (const int*)(smem + AT_LUT);
  const float* rb = (const float*)(smem + AT_RB);
  float* lgw = (float*)(smem + AT_WAVE + w * AT_WSZ);
  int* ixw = (int*)(smem + AT_WAVE + w * AT_WSZ + 8192);
  char* kst = smem + AT_WAVE + w * AT_WSZ + 9216;
  const int nsel = t + 1 < 256 ? t + 1 : 256;
  ixw[lane] = pf.s0; ixw[lane + 64] = pf.s1; ixw[lane + 128] = pf.s2; ixw[lane + 192] = pf.s3;
  const uint4 qcur0 = pf.q0, qcur1 = pf.q1;
  qk_fetch(p, tnext < L_ ? tnext : t, lane, pf);
  long qreg[2];
  {
#pragma unroll
    for (int c = 0; c < 2; ++c) {
      const uint4 qv = c == 0 ? qcur0 : qcur1;
      int w0 = __builtin_amdgcn_cvt_pk_fp8_f32(bflo(qv.x) * 8.f, bfhi(qv.x) * 8.f, 0, false);
      w0 = __builtin_amdgcn_cvt_pk_fp8_f32(bflo(qv.y) * 8.f, bfhi(qv.y) * 8.f, w0, true);
      int w1 = __builtin_amdgcn_cvt_pk_fp8_f32(bflo(qv.z) * 8.f, bfhi(qv.z) * 8.f, 0, false);
      w1 = __builtin_amdgcn_cvt_pk_fp8_f32(bflo(qv.w) * 8.f, bfhi(qv.w) * 8.f, w1, true);
      const long v = (long)(((unsigned long long)(unsigned)w1 << 32) | (unsigned long long)(unsigned)w0);
      qreg[c] = (n15 < 8) ? v : 0L;
    }
  }
  long bsel[16];
#pragma unroll
  for (int ks = 0; ks < 16; ++ks) bsel[ks] = (n15 == (ks >> 1)) ? qreg[ks & 1] : 0L;
  lds_fence();
  const uint4* KB16 = (const uint4*)(p.ws + O_KB);
  const uint2* VB = (const uint2*)(p.ws + O_VB);
  const int ntile = (nsel + 15) >> 4;
#define AT_KMMA(kt_) do { f32x4v acc0 = {0.f, 0.f, 0.f, 0.f}, acc1 = acc0, acc2 = acc0, acc3 = acc0; \
    const char* ar = kst + n15 * AT_KROW + 8 * quad; \
    _Pragma("unroll") for (int ks = 0; ks < 16; ks += 4) { \
      acc0 = MFMA8S(*(const long*)(ar + 32 * ks), bsel[ks], acc0); \
      acc1 = MFMA8S(*(const long*)(ar + 32 * ks + 32), bsel[ks + 1], acc1); \
      acc2 = MFMA8S(*(const long*)(ar + 32 * ks + 64), bsel[ks + 2], acc2); \
      acc3 = MFMA8S(*(const long*)(ar + 32 * ks + 96), bsel[ks + 3], acc3); } \
    const f32x4v acc = (acc0 + acc1) + (acc2 + acc3); \
    if (n15 < 8) { _Pragma("unroll") for (int i = 0; i < 4; ++i) lgw[(16 * (kt_) + 4 * quad + i) * 8 + n15] = acc[i] * 0.125f; } \
    cbar(); } while (0)
  uint4 kgA0, kgA1, kgA2, kgA3, kgA4, kgA5, kgA6, kgA7, kgB0, kgB1, kgB2, kgB3, kgB4, kgB5, kgB6, kgB7, kgC0, kgC1, kgC2, kgC3, kgC4, kgC5, kgC6, kgC7;
    { const int tl_ = (0) < ntile ? (0) : ntile - 1;
      const int4 ia_ = *(const int4*)(ixw + 16 * tl_ + 8 * hi), ib_ = *(const int4*)(ixw + 16 * tl_ + 8 * hi + 4);
      kgA0 = KB16[(size_t)ia_.x * 32 + c31]; kgA1 = KB16[(size_t)ia_.y * 32 + c31]; kgA2 = KB16[(size_t)ia_.z * 32 + c31]; kgA3 = KB16[(size_t)ia_.w * 32 + c31];
      kgA4 = KB16[(size_t)ib_.x * 32 + c31]; kgA5 = KB16[(size_t)ib_.y * 32 + c31]; kgA6 = KB16[(size_t)ib_.z * 32 + c31]; kgA7 = KB16[(size_t)ib_.w * 32 + c31]; }
    { const int tl_ = (1) < ntile ? (1) : ntile - 1;
      const int4 ia_ = *(const int4*)(ixw + 16 * tl_ + 8 * hi), ib_ = *(const int4*)(ixw + 16 * tl_ + 8 * hi + 4);
      kgB0 = KB16[(size_t)ia_.x * 32 + c31]; kgB1 = KB16[(size_t)ia_.y * 32 + c31]; kgB2 = KB16[(size_t)ia_.z * 32 + c31]; kgB3 = KB16[(size_t)ia_.w * 32 + c31];
      kgB4 = KB16[(size_t)ib_.x * 32 + c31]; kgB5 = KB16[(size_t)ib_.y * 32 + c31]; kgB6 = KB16[(size_t)ib_.z * 32 + c31]; kgB7 = KB16[(size_t)ib_.w * 32 + c31]; }
    { const int tl_ = (2) < ntile ? (2) : ntile - 1;
      const int4 ia_ = *(const int4*)(ixw + 16 * tl_ + 8 * hi), ib_ = *(const int4*)(ixw + 16 * tl_ + 8 * hi + 4);
      kgC0 = KB16[(size_t)ia_.x * 32 + c31]; kgC1 = KB16[(size_t)ia_.y * 32 + c31]; kgC2 = KB16[(size_t)ia_.z * 32 + c31]; kgC3 = KB16[(size_t)ia_.w * 32 + c31];
      kgC4 = KB16[(size_t)ib_.x * 32 + c31]; kgC5 = KB16[(size_t)ib_.y * 32 + c31]; kgC6 = KB16[(size_t)ib_.z * 32 + c31]; kgC7 = KB16[(size_t)ib_.w * 32 + c31]; }
  for (int kt = 0; kt < ntile; kt += 3) {
    { char* wr = kst + (8 * hi) * AT_KROW + c31 * 16; *(uint4*)(wr + 0 * AT_KROW) = kgA0; *(uint4*)(wr + 1 * AT_KROW) = kgA1; *(uint4*)(wr + 2 * AT_KROW) = kgA2; *(uint4*)(wr + 3 * AT_KROW) = kgA3; *(uint4*)(wr + 4 * AT_KROW) = kgA4; *(uint4*)(wr + 5 * AT_KROW) = kgA5; *(uint4*)(wr + 6 * AT_KROW) = kgA6; *(uint4*)(wr + 7 * AT_KROW) = kgA7; }
    { const int tl_ = ((kt) + 3) < ntile ? ((kt) + 3) : ntile - 1;
      const int4 ia_ = *(const int4*)(ixw + 16 * tl_ + 8 * hi), ib_ = *(const int4*)(ixw + 16 * tl_ + 8 * hi + 4);
      kgA0 = KB16[(size_t)ia_.x * 32 + c31]; kgA1 = KB16[(size_t)ia_.y * 32 + c31]; kgA2 = KB16[(size_t)ia_.z * 32 + c31]; kgA3 = KB16[(size_t)ia_.w * 32 + c31];
      kgA4 = KB16[(size_t)ib_.x * 32 + c31]; kgA5 = KB16[(size_t)ib_.y * 32 + c31]; kgA6 = KB16[(size_t)ib_.z * 32 + c31]; kgA7 = KB16[(size_t)ib_.w * 32 + c31]; }
    cbar();
    AT_KMMA(kt);
    if (kt + 1 < ntile) {
    { char* wr = kst + (8 * hi) * AT_KROW + c31 * 16; *(uint4*)(wr + 0 * AT_KROW) = kgB0; *(uint4*)(wr + 1 * AT_KROW) = kgB1; *(uint4*)(wr + 2 * AT_KROW) = kgB2; *(uint4*)(wr + 3 * AT_KROW) = kgB3; *(uint4*)(wr + 4 * AT_KROW) = kgB4; *(uint4*)(wr + 5 * AT_KROW) = kgB5; *(uint4*)(wr + 6 * AT_KROW) = kgB6; *(uint4*)(wr + 7 * AT_KROW) = kgB7; }
    { const int tl_ = ((kt + 1) + 3) < ntile ? ((kt + 1) + 3) : ntile - 1;
      const int4 ia_ = *(const int4*)(ixw + 16 * tl_ + 8 * hi), ib_ = *(const int4*)(ixw + 16 * tl_ + 8 * hi + 4);
      kgB0 = KB16[(size_t)ia_.x * 32 + c31]; kgB1 = KB16[(size_t)ia_.y * 32 + c31]; kgB2 = KB16[(size_t)ia_.z * 32 + c31]; kgB3 = KB16[(size_t)ia_.w * 32 + c31];
      kgB4 = KB16[(size_t)ib_.x * 32 + c31]; kgB5 = KB16[(size_t)ib_.y * 32 + c31]; kgB6 = KB16[(size_t)ib_.z * 32 + c31]; kgB7 = KB16[(size_t)ib_.w * 32 + c31]; }
    cbar();
    AT_KMMA(kt + 1);
    }
    if (kt + 2 < ntile) {
    { char* wr = kst + (8 * hi) * AT_KROW + c31 * 16; *(uint4*)(wr + 0 * AT_KROW) = kgC0; *(uint4*)(wr + 1 * AT_KROW) = kgC1; *(uint4*)(wr + 2 * AT_KROW) = kgC2; *(uint4*)(wr + 3 * AT_KROW) = kgC3; *(uint4*)(wr + 4 * AT_KROW) = kgC4; *(uint4*)(wr + 5 * AT_KROW) = kgC5; *(uint4*)(wr + 6 * AT_KROW) = kgC6; *(uint4*)(wr + 7 * AT_KROW) = kgC7; }
    { const int tl_ = ((kt + 2) + 3) < ntile ? ((kt + 2) + 3) : ntile - 1;
      const int4 ia_ = *(const int4*)(ixw + 16 * tl_ + 8 * hi), ib_ = *(const int4*)(ixw + 16 * tl_ + 8 * hi + 4);
      kgC0 = KB16[(size_t)ia_.x * 32 + c31]; kgC1 = KB16[(size_t)ia_.y * 32 + c31]; kgC2 = KB16[(size_t)ia_.z * 32 + c31]; kgC3 = KB16[(size_t)ia_.w * 32 + c31];
      kgC4 = KB16[(size_t)ib_.x * 32 + c31]; kgC5 = KB16[(size_t)ib_.y * 32 + c31]; kgC6 = KB16[(size_t)ib_.z * 32 + c31]; kgC7 = KB16[(size_t)ib_.w * 32 + c31]; }
    cbar();
    AT_KMMA(kt + 2);
    }
  }
  lds_fence();
  const int ngroups = (nsel + 7) >> 3;
  float mx = -INFINITY;
#pragma unroll 8
  for (int i = 0; i < 32; ++i) {
    const int kk = 8 * i + dg;
    const int myidx = ixw[kk];
    const int dist = t - myidx;
    const int bk = dist < 128 ? lut[dist < 0 ? 0 : dist] : 31;
    const float raw = lgw[kk * 8 + h];
    const float lgt = (kk < nsel) ? raw + rb[bk * 8 + h] : -INFINITY;
    lgw[kk * 8 + h] = lgt;
    mx = fmaxf(mx, lgt);
  }
  mx = max8(mx);
  float sum = 0.f;
#pragma unroll 8
  for (int i = 0; i < 32; ++i) {
    const float pv = __expf(lgw[(8 * i + dg) * 8 + h] - mx);
    sum += pv;
    lgw[(8 * i + dg) * 8 + h] = pv;
  }
  sum = sum8(sum);
  {
    const float inv = 1.f / sum;
#pragma unroll 8
    for (int i = 0; i < 32; ++i) lgw[(8 * i + dg) * 8 + h] *= inv;
  }
  lds_fence();
  {
    uint4 pk[4];
#pragma unroll
    for (int k = 0; k < 4; ++k) {
      const float4 a_ = *(const float4*)(lgw + (4 * lane + k) * 8), b_ = *(const float4*)(lgw + (4 * lane + k) * 8 + 4);
      pk[k] = make_uint4(cvtpk(a_.x, a_.y), cvtpk(a_.z, a_.w), cvtpk(b_.x, b_.y), cvtpk(b_.z, b_.w));
    }
    uint4* pdst = (uint4*)(p.ws + prob_off(t)) + lane * 4;
    pdst[0] = pk[0]; pdst[1] = pk[1]; pdst[2] = pk[2]; pdst[3] = pk[3];
  }
  lds_fence();
}

DI void attn_pv_query(const Params& p, int t, int w, int lane) {
  const int half = lane >> 5, l5 = lane & 31, h = l5 >> 2;
  unsigned short* pl = (unsigned short*)(smem + AT_WAVE + w * AT_WSZ);
  int* ixw = (int*)(smem + AT_WAVE + w * AT_WSZ + 8192);
  const int nsel = t + 1 < 256 ? t + 1 : 256;
  const unsigned short* sel = (const unsigned short*)(p.ws + O_SEL) + (size_t)t * 256;
#pragma unroll
  for (int j = 0; j < 4; ++j) {
    const int pos = lane + 64 * j;
    ixw[pos] = pos < nsel ? (int)sel[pos] : 0;
  }
  {
    const uint4* psrc = (const uint4*)(p.ws + prob_off(t)) + lane * 4;
    uint4* pd = (uint4*)pl + lane * 4;
    const uint4 a0 = psrc[0], a1 = psrc[1], a2 = psrc[2], a3 = psrc[3];
    pd[0] = a0; pd[1] = a1; pd[2] = a2; pd[3] = a3;
  }
  lds_fence();
  const uint4* VB4 = (const uint4*)(p.ws + O_VB) + l5;
  f32x2v o0 = {0.f, 0.f}, o1 = {0.f, 0.f}, o2 = {0.f, 0.f}, o3 = {0.f, 0.f}, o4 = {0.f, 0.f}, o5 = {0.f, 0.f}, o6 = {0.f, 0.f}, o7 = {0.f, 0.f};
  uint4 kc[8], kn[8];
#define AT_VLOAD16(dst, ib) do { _Pragma("unroll") for (int q_ = 0; q_ < 4; ++q_) { const int4 i_ = *(const int4*)(ixw + (ib) + 4 * q_); \
    dst[2 * q_ + 0] = VB4[(size_t)(half ? i_.y : i_.x) * 32]; dst[2 * q_ + 1] = VB4[(size_t)(half ? i_.w : i_.z) * 32]; } } while (0)
  const int ng16 = (nsel + 15) >> 4;
  AT_VLOAD16(kc, 0);
  const unsigned short* plh = pl + half * 8 + h;
  for (int i = 0; i < ng16; ++i) {
    { const int nx = (i + 1 < ng16) ? i + 1 : i; AT_VLOAD16(kn, 16 * nx); }
#pragma unroll
    for (int q = 0; q < 8; ++q) {
      const float pb = bf2f(plh[(16 * i + 2 * q) * 8]);
      const f32x2v pb2 = {pb, pb};
      o0 = __builtin_amdgcn_cvt_pk_f32_fp8(kc[q].x, false) * pb2 + o0;
      o1 = __builtin_amdgcn_cvt_pk_f32_fp8(kc[q].x, true) * pb2 + o1;
      o2 = __builtin_amdgcn_cvt_pk_f32_fp8(kc[q].y, false) * pb2 + o2;
      o3 = __builtin_amdgcn_cvt_pk_f32_fp8(kc[q].y, true) * pb2 + o3;
      o4 = __builtin_amdgcn_cvt_pk_f32_fp8(kc[q].z, false) * pb2 + o4;
      o5 = __builtin_amdgcn_cvt_pk_f32_fp8(kc[q].z, true) * pb2 + o5;
      o6 = __builtin_amdgcn_cvt_pk_f32_fp8(kc[q].w, false) * pb2 + o6;
      o7 = __builtin_amdgcn_cvt_pk_f32_fp8(kc[q].w, true) * pb2 + o7;
    }
#pragma unroll
    for (int q = 0; q < 8; ++q) kc[q] = kn[q];
  }
#define AT_HSUM(o) do { o.x += __shfl_xor(o.x, 32); o.y += __shfl_xor(o.y, 32); } while (0)
  AT_HSUM(o0); AT_HSUM(o1); AT_HSUM(o2); AT_HSUM(o3); AT_HSUM(o4); AT_HSUM(o5); AT_HSUM(o6); AT_HSUM(o7);
  if (half == 0) {
    const uint4 z0 = ((const uint4*)(p.ws + O_ZB))[(size_t)t * 64 + 2 * l5], z1 = ((const uint4*)(p.ws + O_ZB))[(size_t)t * 64 + 2 * l5 + 1];
    uint4 v0, v1;
    v0.x = cvtpk(o0.x * bflo(z0.x), o0.y * bfhi(z0.x)); v0.y = cvtpk(o1.x * bflo(z0.y), o1.y * bfhi(z0.y));
    v0.z = cvtpk(o2.x * bflo(z0.z), o2.y * bfhi(z0.z)); v0.w = cvtpk(o3.x * bflo(z0.w), o3.y * bfhi(z0.w));
    v1.x = cvtpk(o4.x * bflo(z1.x), o4.y * bfhi(z1.x)); v1.y = cvtpk(o5.x * bflo(z1.y), o5.y * bfhi(z1.y));
    v1.z = cvtpk(o6.x * bflo(z1.z), o6.y * bfhi(z1.z)); v1.w = cvtpk(o7.x * bflo(z1.w), o7.y * bfhi(z1.w));
    ((uint4*)(p.ws + O_AB))[tiled_unit(t, l5 * 16, 32)] = v0;
    ((uint4*)(p.ws + O_AB))[tiled_unit(t, l5 * 16 + 8, 32)] = v1;
  }
  lds_fence();
}

constexpr int HC_B = 0;
constexpr int HC_QT = 33792;
constexpr int HC_QH = HC_QT + 17408;
constexpr int HC_KH = HC_QH + 17408;
constexpr int HC_VT = HC_KH + 17408;
constexpr int HC_P = HC_VT + 18432;
constexpr int HC_TOT = HC_P + 9216;
DI void hgrn_c_item(const Params& p, int layer, int c, int h) {
  const int tid = vtid(), lane = tid & 63, w = tid >> 6, hi = lane >> 5, c31 = lane & 31;
  float* bL = (float*)(smem + HC_B);
  unsigned short* qT = (unsigned short*)(smem + HC_QT);
  unsigned short* qH = (unsigned short*)(smem + HC_QH);
  unsigned short* kH = (unsigned short*)(smem + HC_KH);
  unsigned short* vT = (unsigned short*)(smem + HC_VT);
  unsigned short* P = (unsigned short*)(smem + HC_P);
  float* tot = (float*)(smem + HC_TOT);
  const float* G = (const float*)(p.ws + O_G);
  const unsigned short* KK = (const unsigned short*)(p.ws + O_KK);
  const unsigned short* IA = (const unsigned short*)(p.ws + O_IA);
  const unsigned short* QA = (const unsigned short*)(p.ws + O_QA);
  const int mt = w >> 2, nv = w & 3;
  const uint4* us = (const uint4*)(p.ws + O_US + (size_t)(c * 4 + h) * 32768);
  uint4 sfr[8];
#pragma unroll
  for (int ks = 0; ks < 8; ++ks) sfr[ks] = us[(nv * 8 + ks) * 64 + lane];
  uint4 qv_pre[2], kv_pre[2];
#pragma unroll
  for (int rep = 0; rep < 2; ++rep) {
    const int pr = tid + 512 * rep, t = pr >> 4, oc = pr & 15;
    qv_pre[rep] = *(const uint4*)(QA + (size_t)(64 * c + t) * 512 + 128 * h + oc * 8);
    kv_pre[rep] = *(const uint4*)(KK + (size_t)(64 * c + t) * 512 + 128 * h + oc * 8);
  }
  const uint4 z0_pre = *(const uint4*)((const unsigned short*)(p.ws + O_ZA) + (size_t)(64 * c + (tid >> 3)) * 512 + 128 * h + 16 * (tid & 7));
  const uint4 z1_pre = *(const uint4*)((const unsigned short*)(p.ws + O_ZA) + (size_t)(64 * c + (tid >> 3)) * 512 + 128 * h + 16 * (tid & 7) + 8);
  {
    const int seg = tid >> 7, k = tid & 127;
    const size_t rowbase = (size_t)(64 * c + 16 * seg);
    float b[16];
    float run = 0.f;
#pragma unroll
    for (int i = 0; i < 16; ++i) { run += G[(rowbase + i) * 512 + 128 * h + k]; b[i] = run; }
    tot[seg * 128 + k] = run;
    unsigned pv[8];
#pragma unroll
    for (int i = 0; i < 16; i += 2) {
      unsigned v0 = IA[(rowbase + i) * 512 + 128 * h + k], v1 = IA[(rowbase + i + 1) * 512 + 128 * h + k];
      pv[i >> 1] = v0 | (v1 << 16);
    }
    uint4* dv = (uint4*)(vT + k * 72 + 16 * seg);
    dv[0] = make_uint4(pv[0], pv[1], pv[2], pv[3]); dv[1] = make_uint4(pv[4], pv[5], pv[6], pv[7]);
    __syncthreads();
    float off = 0.f;
#pragma unroll
    for (int s2 = 0; s2 < 4; ++s2) { float tv = tot[s2 * 128 + k]; if (s2 < seg) off += tv; }
#pragma unroll
    for (int i = 0; i < 16; ++i) bL[(16 * seg + i) * 132 + k] = b[i] + off;
  }
  __syncthreads();
#pragma unroll
  for (int rep = 0; rep < 2; ++rep) {
    const int pr = tid + 512 * rep, t = pr >> 4, oc = pr & 15;
    const float4 b0 = *(const float4*)(bL + t * 132 + oc * 8), b1 = *(const float4*)(bL + t * 132 + oc * 8 + 4);
    const float4 r0 = *(const float4*)(bL + 31 * 132 + oc * 8), r1 = *(const float4*)(bL + 31 * 132 + oc * 8 + 4);
    const uint4 qv = qv_pre[rep];
    const uint4 kv = kv_pre[rep];
    const float bb[8] = {b0.x, b0.y, b0.z, b0.w, b1.x, b1.y, b1.z, b1.w};
    const float rr[8] = {r0.x, r0.y, r0.z, r0.w, r1.x, r1.y, r1.z, r1.w};
    const float qq[8] = {bflo(qv.x), bfhi(qv.x), bflo(qv.y), bfhi(qv.y), bflo(qv.z), bfhi(qv.z), bflo(qv.w), bfhi(qv.w)};
    const float kq[8] = {bflo(kv.x), bfhi(kv.x), bflo(kv.y), bfhi(kv.y), bflo(kv.z), bfhi(kv.z), bflo(kv.w), bfhi(kv.w)};
    float a1[8], a2[8], a3[8];
#pragma unroll
    for (int e = 0; e < 8; ++e) {
      a1[e] = qq[e] * __expf(bb[e]);
      a2[e] = qq[e] * __expf(bb[e] - rr[e]);
      a3[e] = kq[e] * __expf(rr[e] - bb[e]);
    }
    *(uint4*)(qT + t * 136 + oc * 8) = make_uint4(cvtpk(a1[0], a1[1]), cvtpk(a1[2], a1[3]), cvtpk(a1[4], a1[5]), cvtpk(a1[6], a1[7]));
    *(uint4*)(qH + t * 136 + oc * 8) = make_uint4(cvtpk(a2[0], a2[1]), cvtpk(a2[2], a2[3]), cvtpk(a2[4], a2[5]), cvtpk(a2[6], a2[7]));
    *(uint4*)(kH + t * 136 + oc * 8) = make_uint4(cvtpk(a3[0], a3[1]), cvtpk(a3[2], a3[3]), cvtpk(a3[4], a3[5]), cvtpk(a3[6], a3[7]));
  }
  __syncthreads();
  if (w < 4) {
    const int ms = w >> 1, ntq = w & 1;
    f32x16 sacc;
#pragma unroll
    for (int r = 0; r < 16; ++r) sacc[r] = 0.f;
#pragma unroll
    for (int ks = 0; ks < 8; ++ks) {
      bf16x8 af = __builtin_bit_cast(bf16x8, *(const uint4*)(kH + (32 * ms + c31) * 136 + 16 * ks + 8 * hi));
      bf16x8 bfv = __builtin_bit_cast(bf16x8, *(const uint4*)(qH + (32 * ntq + c31) * 136 + 16 * ks + 8 * hi));
      sacc = MFMA(af, bfv, sacc);
    }
    const int t = 32 * ntq + c31;
#pragma unroll
    for (int gq = 0; gq < 4; ++gq) {
      const int s0 = 32 * ms + 8 * gq + 4 * hi;
      float v0 = (s0 + 0 <= t) ? sacc[4 * gq + 0] : 0.f;
      float v1 = (s0 + 1 <= t) ? sacc[4 * gq + 1] : 0.f;
      float v2 = (s0 + 2 <= t) ? sacc[4 * gq + 2] : 0.f;
      float v3 = (s0 + 3 <= t) ? sacc[4 * gq + 3] : 0.f;
      uint2 val; val.x = cvtpk(v0, v1); val.y = cvtpk(v2, v3);
      *(uint2*)(P + t * 72 + s0) = val;
    }
  }
  f32x16 oacc;
#pragma unroll
  for (int r = 0; r < 16; ++r) oacc[r] = 0.f;
#pragma unroll
  for (int ks = 0; ks < 8; ++ks) {
    bf16x8 af = __builtin_bit_cast(bf16x8, *(const uint4*)(qT + (32 * mt + c31) * 136 + 16 * ks + 8 * hi));
    oacc = MFMA(af, __builtin_bit_cast(bf16x8, sfr[ks]), oacc);
  }
  __syncthreads();
#pragma unroll
  for (int ks = 0; ks < 4; ++ks) {
    bf16x8 af = __builtin_bit_cast(bf16x8, *(const uint4*)(P + (32 * mt + c31) * 72 + 16 * ks + 8 * hi));
    bf16x8 bfv = __builtin_bit_cast(bf16x8, *(const uint4*)(vT + (32 * nv + c31) * 72 + 16 * ks + 8 * hi));
    oacc = MFMA(af, bfv, oacc);
  }
  float* oL = bL;
#pragma unroll
  for (int r = 0; r < 16; ++r) oL[(32 * mt + crow(r, hi)) * 132 + 32 * nv + c31] = oacc[r];
  __syncthreads();
  {
    const int t = tid >> 3, sg = tid & 7;
    float ov[16];
#pragma unroll
    for (int e = 0; e < 16; e += 4) {
      const float4 f = *(const float4*)(oL + t * 132 + 16 * sg + e);
      ov[e] = f.x; ov[e + 1] = f.y; ov[e + 2] = f.z; ov[e + 3] = f.w;
    }
    float ss = 0.f;
#pragma unroll
    for (int e = 0; e < 16; ++e) ss = fmaf(ov[e], ov[e], ss);
    ss += __shfl_xor(ss, 1);
    ss += __shfl_xor(ss, 2);
    ss += __shfl_xor(ss, 4);
    const float rs = rsqrtf(ss * (1.f / 128.f) + 1e-6f);
    const int tg = 64 * c + t, k0 = 128 * h + 16 * sg;
    const float* ng = p.norm_a_g + (size_t)layer * 512 + k0;
    const uint4 z0 = z0_pre, z1 = z1_pre;
    const float zz[16] = {bflo(z0.x), bfhi(z0.x), bflo(z0.y), bfhi(z0.y), bflo(z0.z), bfhi(z0.z), bflo(z0.w), bfhi(z0.w),
                          bflo(z1.x), bfhi(z1.x), bflo(z1.y), bfhi(z1.y), bflo(z1.z), bfhi(z1.z), bflo(z1.w), bfhi(z1.w)};
    float rr[16];
#pragma unroll
    for (int e = 0; e < 16; ++e) rr[e] = ov[e] * rs * ng[e] * zz[e];
    uint4* aa = (uint4*)(p.ws + O_AA);
    aa[tiled_unit(tg, k0, 32)] = make_uint4(cvtpk(rr[0], rr[1]), cvtpk(rr[2], rr[3]), cvtpk(rr[4], rr[5]), cvtpk(rr[6], rr[7]));
    aa[tiled_unit(tg, k0 + 8, 32)] = make_uint4(cvtpk(rr[8], rr[9]), cvtpk(rr[10], rr[11]), cvtpk(rr[12], rr[13]), cvtpk(rr[14], rr[15]));
  }
  __syncthreads();
}

DI void acc_to_lds_bf16(f32x16 (&acc)[2][2], unsigned short* tile) {
  const int tid = vtid(), lane = tid & 63, w = tid >> 6, wm = w >> 1, wn = w & 1, hi = lane >> 5, c31 = lane & 31;
#pragma unroll
  for (int i = 0; i < 2; ++i)
#pragma unroll
    for (int j = 0; j < 2; ++j)
#pragma unroll
      for (int r = 0; r < 16; ++r)
        tile[(64 * wm + 32 * i + crow(r, hi)) * 128 + 64 * wn + 32 * j + c31] = f2bf(acc[i][j][r]);
}
DI void p5_tile(const Params& p, int mb, int nt) {
  const int tid = vtid(), lane = tid & 63, w = tid >> 6, wm = w >> 1, wn = w & 1, hi = lane >> 5, c31 = lane & 31;
  f32x16 acc[2][2];
  zero_acc(acc);
  gemm_core((const uint4*)(p.ws + O_AA), mb * 8, (const uint4*)(p.ws + O_WUA), nt * 4, 32, acc, (uint4*)smem);
  unsigned uap[2][2][8];
#pragma unroll
  for (int i = 0; i < 2; ++i)
#pragma unroll
    for (int j = 0; j < 2; ++j)
#pragma unroll
      for (int r = 0; r < 16; r += 2) uap[i][j][r >> 1] = cvtpk(acc[i][j][r], acc[i][j][r + 1]);
  zero_acc(acc);
  gemm_core((const uint4*)(p.ws + O_AB), mb * 8, (const uint4*)(p.ws + O_WUB), nt * 4, 32, acc, (uint4*)smem);
  unsigned short* tA = (unsigned short*)smem;
  unsigned short* tB = (unsigned short*)(smem + 65536);
#pragma unroll
  for (int i = 0; i < 2; ++i)
#pragma unroll
    for (int j = 0; j < 2; ++j)
#pragma unroll
      for (int r = 0; r < 16; r += 2) {
        const int o0 = (64 * wm + 32 * i + crow(r, hi)) * 128 + 64 * wn + 32 * j + c31;
        tA[o0] = (unsigned short)(uap[i][j][r >> 1] & 0xffffu);
        tA[o0 + 128] = (unsigned short)(uap[i][j][r >> 1] >> 16);
        tB[o0] = f2bf(acc[i][j][r]);
        tB[o0 + 128] = f2bf(acc[i][j][r + 1]);
      }
  __syncthreads();
  const int row0 = mb * 256;
#pragma unroll 2
  for (int q = 0; q < 8; ++q) {
    const int u = tid + 512 * q, r = u >> 4, c8 = u & 15;
    const uint4 ua = *(const uint4*)&tA[r * 128 + c8 * 8];
    const uint4 ub = *(const uint4*)&tB[r * 128 + c8 * 8];
    const int t = row0 + r, n0 = nt * 128 + c8 * 8;
    const uint4 ga = *(const uint4*)(p.ws + O_SGA + ((size_t)t * 1024 + n0) * 2);
    const uint4 gb = *(const uint4*)(p.ws + O_SGB + ((size_t)t * 1024 + n0) * 2);
    uint4 o;
    o.x = cvtpk(bflo(ga.x) * bflo(ua.x) + bflo(gb.x) * bflo(ub.x), bfhi(ga.x) * bfhi(ua.x) + bfhi(gb.x) * bfhi(ub.x));
    o.y = cvtpk(bflo(ga.y) * bflo(ua.y) + bflo(gb.y) * bflo(ub.y), bfhi(ga.y) * bfhi(ua.y) + bfhi(gb.y) * bfhi(ub.y));
    o.z = cvtpk(bflo(ga.z) * bflo(ua.z) + bflo(gb.z) * bflo(ub.z), bfhi(ga.z) * bfhi(ua.z) + bfhi(gb.z) * bfhi(ub.z));
    o.w = cvtpk(bflo(ga.w) * bflo(ua.w) + bflo(gb.w) * bflo(ub.w), bfhi(ga.w) * bfhi(ua.w) + bfhi(gb.w) * bfhi(ub.w));
    ((uint4*)(p.ws + O_MG))[tiled_unit(t, n0, 64)] = o;
  }
  __syncthreads();
}

DI void p6_tile(const Params& p, int layer, int mb, int nt) {
  const int tid = vtid(), lane = tid & 63, w = tid >> 6, wm = w >> 1, wn = w & 1, hi = lane >> 5, c31 = lane & 31;
  f32x16 acc[2][2];
  zero_acc(acc);
  gemm_core((const uint4*)(p.ws + O_MG), mb * 8, (const uint4*)(p.ws + O_WOUT), nt * 4, 64, acc, (uint4*)smem);
  const float* hin = (layer == 0) ? p.x : p.out;
#pragma unroll
  for (int i = 0; i < 2; ++i)
#pragma unroll
    for (int j = 0; j < 2; ++j)
#pragma unroll
      for (int r = 0; r < 16; ++r) {
        const size_t idx = (size_t)(mb * 256 + 64 * wm + 32 * i + crow(r, hi)) * DM + nt * 128 + 64 * wn + 32 * j + c31;
        p.out[idx] = fmaf(ALPHA_, hin[idx], acc[i][j][r]);
      }
}

DI float dpp_add_f(float v, int which) {
  const int iv = __builtin_bit_cast(int, v);
  int r;
  switch (which) {
    case 0: r = __builtin_amdgcn_update_dpp(0, iv, 0x111, 0xf, 0xf, true); break;
    case 1: r = __builtin_amdgcn_update_dpp(0, iv, 0x112, 0xf, 0xf, true); break;
    case 2: r = __builtin_amdgcn_update_dpp(0, iv, 0x114, 0xf, 0xf, true); break;
    case 3: r = __builtin_amdgcn_update_dpp(0, iv, 0x118, 0xf, 0xf, true); break;
    default: r = __builtin_amdgcn_update_dpp(0, iv, 0x142, 0xa, 0xf, false); break;
  }
  return v + __builtin_bit_cast(float, r);
}
DI float half_sum_to_last(float v) {
  v = dpp_add_f(v, 0); v = dpp_add_f(v, 1); v = dpp_add_f(v, 2); v = dpp_add_f(v, 3); v = dpp_add_f(v, 4);
  return v;
}
DI void fused_out_ln(const Params& p, int layer, int mb64) {
  const int tid = vtid(), lane = tid & 63, w = tid >> 6, hi = lane >> 5, c31 = lane & 31;
  uint4* lds = (uint4*)smem;
  const uint4* A = (const uint4*)(p.ws + O_MG) + (size_t)(2 * mb64) * 64 * 64;
#pragma unroll
  for (int r = 0; r < 16; ++r)
    __builtin_amdgcn_global_load_lds((const unsigned*)(A + tid + 512 * r), (unsigned*)(lds + tid + 512 * r), 16, 0, 0);
  float* lnf = (float*)(smem + 131072);
  {
    const float* src_ = (tid < 256) ? (p.ln_g + (size_t)layer * DM) : (p.ln_b + (size_t)layer * DM);
    ((float4*)lnf)[tid] = ((const float4*)src_)[tid & 255];
  }
  const uint4* Bw = (const uint4*)(p.ws + O_WOUT) + (size_t)(4 * w) * 64 * 64 + lane;
  uint4 bq[4][4];
#pragma unroll
  for (int s_ = 0; s_ < 4; ++s_)
#pragma unroll
    for (int j = 0; j < 4; ++j) bq[s_][j] = Bw[(size_t)(j * 64 + s_) * 64];
  f32x16 acc[2][4];
#pragma unroll
  for (int i = 0; i < 2; ++i)
#pragma unroll
    for (int j = 0; j < 4; ++j)
#pragma unroll
      for (int r = 0; r < 16; ++r) acc[i][j][r] = 0.f;
  __syncthreads();
#pragma unroll 1
  for (int k4 = 0; k4 < 16; ++k4) {
#pragma unroll
    for (int s_ = 0; s_ < 4; ++s_) {
      const int ks = 4 * k4 + s_;
      const bf16x8 a0 = __builtin_bit_cast(bf16x8, lds[ks * 64 + lane]);
      const bf16x8 a1 = __builtin_bit_cast(bf16x8, lds[4096 + ks * 64 + lane]);
#pragma unroll
      for (int j = 0; j < 4; ++j) {
        const bf16x8 b = __builtin_bit_cast(bf16x8, bq[s_][j]);
        acc[0][j] = MFMA(a0, b, acc[0][j]);
        acc[1][j] = MFMA(a1, b, acc[1][j]);
      }
      if (k4 < 15) {
#pragma unroll
        for (int j = 0; j < 4; ++j) bq[s_][j] = Bw[(size_t)(j * 64 + ks + 4) * 64];
      }
    }
  }
  const float* hin = (layer == 0) ? p.x : p.out;
  float* ft = (float*)smem;
  uint2* hb2 = (uint2*)(p.ws + O_HB);
  const int rr = tid >> 4, seg = tid & 15;
#pragma unroll
  for (int i = 0; i < 2; ++i) {
    __syncthreads();
    float4 hvv[16];
    {
      const float* hrow_ = hin + (size_t)(64 * mb64 + 32 * i + rr) * DM + 4 * seg;
#pragma unroll
      for (int e = 0; e < 16; ++e) hvv[e] = *(const float4*)(hrow_ + 64 * e);
    }
    {
      float* b0 = ft + (4 * hi) * 1024 + 128 * w + c31;
      float* b1 = b0 + 16 * 1024;
#pragma unroll
      for (int j = 0; j < 4; ++j)
#pragma unroll
        for (int r = 0; r < 16; ++r) {
          float* bp = (r < 8) ? b0 : b1;
          bp[((r & 3) + 8 * ((r >> 2) & 1)) * 1024 + 32 * j] = acc[i][j][r];
        }
    }
    __syncthreads();
    const int trow = 64 * mb64 + 32 * i + rr;
    float s1 = 0.f, s2 = 0.f;
    float* frow = ft + rr * 1024 + 4 * seg;
#pragma unroll
    for (int e = 0; e < 16; ++e) {
      const float4 y = *(const float4*)(frow + 64 * e);
      const float4 hv = hvv[e];
      float4 pre;
      pre.x = fmaf(ALPHA_, hv.x, y.x); pre.y = fmaf(ALPHA_, hv.y, y.y); pre.z = fmaf(ALPHA_, hv.z, y.z); pre.w = fmaf(ALPHA_, hv.w, y.w);
      s1 += (pre.x + pre.y) + (pre.z + pre.w);
      s2 = fmaf(pre.x, pre.x, s2); s2 = fmaf(pre.y, pre.y, s2); s2 = fmaf(pre.z, pre.z, s2); s2 = fmaf(pre.w, pre.w, s2);
      *(float4*)(frow + 64 * e) = pre;
    }
    s1 += __shfl_xor(s1, 1); s1 += __shfl_xor(s1, 2); s1 += __shfl_xor(s1, 4); s1 += __shfl_xor(s1, 8);
    s2 += __shfl_xor(s2, 1); s2 += __shfl_xor(s2, 2); s2 += __shfl_xor(s2, 4); s2 += __shfl_xor(s2, 8);
    const float mu = s1 * (1.f / 1024.f);
    const float rs = rsqrtf(fmaxf(s2 * (1.f / 1024.f) - mu * mu, 0.f) + 1e-5f);
    float* orow = p.out + (size_t)trow * DM;
#pragma unroll 4
    for (int e = 0; e < 16; ++e) {
      const int c0 = 64 * e + 4 * seg;
      const float4 pre = *(const float4*)(frow + 64 * e);
      const float4 g4 = *(const float4*)(lnf + c0), b4 = *(const float4*)(lnf + 1024 + c0);
      float4 o;
      o.x = (pre.x - mu) * rs * g4.x + b4.x; o.y = (pre.y - mu) * rs * g4.y + b4.y;
      o.z = (pre.z - mu) * rs * g4.z + b4.z; o.w = (pre.w - mu) * rs * g4.w + b4.w;
      *(float4*)(orow + c0) = o;
      hb2[((size_t)trow * 1024 + c0) >> 2] = make_uint2(cvtpk(o.x, o.y), cvtpk(o.z, o.w));
    }
  }
  __syncthreads();
}

DI void p7_rows(const Params& p, int layer) {
  const int tid = vtid();
  const int lane = tid & 63, gw = blockIdx.x * 8 + (tid >> 6), nw = gridDim.x * 8;
  const float* g = p.ln_g + (size_t)layer * DM;
  const float* bb = p.ln_b + (size_t)layer * DM;
  uint4* hb = (uint4*)(p.ws + O_HB);
  for (int t = gw; t < L_; t += nw) {
    float* row = p.out + (size_t)t * DM;
    float v[16];
#pragma unroll
    for (int q = 0; q < 2; ++q) {
      const float4 a = *(const float4*)(row + q * 512 + lane * 8), b = *(const float4*)(row + q * 512 + lane * 8 + 4);
      v[8 * q + 0] = a.x; v[8 * q + 1] = a.y; v[8 * q + 2] = a.z; v[8 * q + 3] = a.w;
      v[8 * q + 4] = b.x; v[8 * q + 5] = b.y; v[8 * q + 6] = b.z; v[8 * q + 7] = b.w;
    }
    float s = 0.f;
#pragma unroll
    for (int e = 0; e < 16; ++e) s += v[e];
#pragma unroll
    for (int off = 1; off < 64; off <<= 1) s += __shfl_xor(s, off);
    const float mu = s * (1.f / 1024.f);
    float ss = 0.f;
#pragma unroll
    for (int e = 0; e < 16; ++e) { const float d = v[e] - mu; ss = fmaf(d, d, ss); }
#pragma unroll
    for (int off = 1; off < 64; off <<= 1) ss += __shfl_xor(ss, off);
    const float rs = rsqrtf(ss * (1.f / 1024.f) + 1e-5f);
#pragma unroll
    for (int q = 0; q < 2; ++q) {
      const int k0 = q * 512 + lane * 8;
      float o[8];
#pragma unroll
      for (int e = 0; e < 8; ++e) o[e] = (v[8 * q + e] - mu) * rs * g[k0 + e] + bb[k0 + e];
      *(float4*)(row + k0) = make_float4(o[0], o[1], o[2], o[3]);
      *(float4*)(row + k0 + 4) = make_float4(o[4], o[5], o[6], o[7]);
      hb[tiled_unit(t, k0, 64)] = make_uint4(cvtpk(o[0], o[1]), cvtpk(o[2], o[3]), cvtpk(o[4], o[5]), cvtpk(o[6], o[7]));
    }
  }
}


#define XB_TMO      128
#define XB_XCNT(j)  (256  + 64 * (j))
#define XB_XSUB(j)  (1280 + 64 * (j))
#define XB_XGEN(j)  (2304 + 64 * (j))
#define XB_TOP      3328
#define XB_TOPGEN   3392
#define XCD_BAR_WORDS 3456
#define XB_SPIN_CAP (1u << 22)
#define LAS __attribute__((address_space(3)))
DI unsigned xb_ld(unsigned* p)              { return __hip_atomic_load(p, __ATOMIC_RELAXED, __HIP_MEMORY_SCOPE_AGENT); }
DI unsigned xb_add(unsigned* p, unsigned v) { return __hip_atomic_fetch_add(p, v, __ATOMIC_RELAXED, __HIP_MEMORY_SCOPE_AGENT); }
DI unsigned xb_xcc_id() { return (unsigned)__builtin_amdgcn_s_getreg((3 << 11) | 20) & 0xFu; }
#define XB_SPIN(cond, bar) do { unsigned _sp = 0; while (cond) { __builtin_amdgcn_s_sleep(1); \
    if ((++_sp & 255u) == 0u) { if (xb_ld(&(bar)[XB_TMO])) break; if (_sp > XB_SPIN_CAP) { atomicAdd(&(bar)[XB_TMO], 1u); break; } } } } while (0)
struct XcdBarrier { unsigned* bar; unsigned x; volatile LAS unsigned* st; };
DI XcdBarrier xcd_barrier_post(unsigned* bar, volatile LAS unsigned* st) {
  XcdBarrier b; b.bar = bar; b.x = xb_xcc_id(); b.st = st;
  if (threadIdx.x == 0) (void)xb_add(&bar[XB_XCNT(b.x)], 1u);
  return b;
}
DI void xcd_barrier_complete(unsigned* bar, unsigned x, unsigned& nloc, unsigned& nx) {
  const unsigned G = gridDim.x * gridDim.y * gridDim.z;
  unsigned sum, cnt, mine, sp = 0u;
  for (;;) {
    sum = 0u; cnt = 0u; mine = 0u;
#pragma unroll
    for (unsigned j = 0; j < 16; ++j) { const unsigned c = xb_ld(&bar[XB_XCNT(j)]); sum += c; cnt += (c > 0u) ? 1u : 0u; mine = (j == x) ? c : mine; }
    if (sum == G) break;
    __builtin_amdgcn_s_sleep(1);
    if ((++sp & 255u) == 0u) { if (xb_ld(&bar[XB_TMO])) break; if (sp > XB_SPIN_CAP) { atomicAdd(&bar[XB_TMO], 1u); break; } }
  }
  nloc = mine > 0u ? mine : 1u; nx = cnt > 0u ? cnt : 1u;
}
DI void xcd_barrier(const XcdBarrier& b) {
  asm volatile("s_waitcnt vmcnt(0)" ::: "memory");
  __syncthreads();
  if (threadIdx.x == 0) {
    unsigned* bar = b.bar;
    __builtin_amdgcn_s_waitcnt(0);
    unsigned nloc = b.st[0], nx = b.st[1];
    if (nloc == 0u) { xcd_barrier_complete(bar, b.x, nloc, nx); b.st[0] = nloc; b.st[1] = nx; }
    const unsigned old = xb_add(&bar[XB_XSUB(b.x)], 1u);
    const unsigned gen = old / nloc;
    if (old + 1u == (gen + 1u) * nloc) {
      __builtin_amdgcn_fence(__ATOMIC_RELEASE, "agent");
      asm volatile("s_waitcnt vmcnt(0)" ::: "memory");
      const unsigned og = xb_add(&bar[XB_TOP], 1u);
      const unsigned tg = og / nx;
      if (og + 1u == (tg + 1u) * nx) xb_add(&bar[XB_TOPGEN], 1u);
      else XB_SPIN(xb_ld(&bar[XB_TOPGEN]) == tg, bar);
      __builtin_amdgcn_fence(__ATOMIC_ACQUIRE, "agent");
      xb_add(&bar[XB_XGEN(b.x)], 1u);
      asm volatile("s_waitcnt vmcnt(0)" ::: "memory");
    } else {
      XB_SPIN(xb_ld(&bar[XB_XGEN(b.x)]) == gen, bar);
      __builtin_amdgcn_fence(__ATOMIC_ACQUIRE, "agent");
      asm volatile("s_waitcnt vmcnt(0)" ::: "memory");
    }
  }
  __syncthreads();
}
constexpr int LDS_BARST = 163840 - 16;

__global__ void __launch_bounds__(512) mk(Params p) {
  cg::grid_group grid = cg::this_grid();
  const int nb = gridDim.x, bid = blockIdx.x;
  volatile LAS unsigned* bst_ = (volatile LAS unsigned*)(smem + LDS_BARST);
  if (threadIdx.x < 4) bst_[threadIdx.x] = 0u;
  __syncthreads();
  (void)xcd_barrier_post((unsigned*)(p.ws + O_BAR), bst_);
#define XB_NOW() XcdBarrier{(unsigned*)(p.ws + O_BAR), xb_xcc_id(), (volatile LAS unsigned*)(smem + LDS_BARST)}
  phase0(p);
  grid.sync();
  for (int layer = 0; layer < DEPTH_; ++layer) {
    {
      const int gtid = bid * 512 + vtid(), gthreads = nb * 512;
      conv_weight(p.w_up_a + (size_t)layer * 512 * 1024, 512, 1024, 1024, false, (uint4*)(p.ws + O_WUA), gtid, gthreads);
      conv_weight(p.w_up_b + (size_t)layer * 512 * 1024, 512, 1024, 1024, false, (uint4*)(p.ws + O_WUB), gtid, gthreads);
      conv_weight(p.w_out + (size_t)layer * 1024 * 1024, 1024, 1024, 1024, false, (uint4*)(p.ws + O_WOUT), gtid, gthreads);
#ifndef NO_P1
      for (int id = bid; id < 64 * 27; id += nb) p1_tile8(p, layer, id & 63, id >> 6);
#endif
    }
    xcd_barrier(XB_NOW());
    {
      if (layer + 1 < DEPTH_) {
        const int gtid = bid * 512 + vtid(), gthreads = nb * 512;
        conv_weight_rm(p.w_in + (size_t)(layer + 1) * 1024 * NIN, 1024, NIN, NPAD, true, (uint4*)(p.ws + O_WTIN), gtid, gthreads);
      }
#ifndef NO_HA
      for (int id = bid; id < 1024; id += nb) hgrn_a_item(p, id >> 2, id & 3);
#endif
      for (int s = bid; s < 1024; s += nb) {
        const int rnd = s / nb, pos = s - rnd * nb;
        const int rem = 1024 - rnd * nb, count = rem < nb ? rem : nb;
        const int sp = (rnd & 1) ? (rnd * nb + count - 1 - pos) : s;
        indexer_item(p, 1023 - sp);
      }
    }
    xcd_barrier(XB_NOW());
    {
      attn_setup();
      const int tid = vtid();
      if (tid < 256) ((float*)(smem + AT_RB))[tid] = p.rel_bias[tid];
      __syncthreads();
#ifndef NO_SCAN
      hgrn_scan(p);
#endif
      const int w = tid >> 6, lane = tid & 63;
#ifndef NO_ATT
      { QKPF pf; qk_fetch(p, bid * 8 + w, lane, pf);
        for (int t = bid * 8 + w; t < L_; t += nb * 8) attn_query(p, t, t + nb * 8, w, lane, pf); }
#endif
      __syncthreads();
    }
    {
      const int tid = vtid();
      const int w = tid >> 6, lane = tid & 63;
      for (int t = bid * 8 + w; t < L_; t += nb * 8) attn_pv_query(p, t, w, lane);
      __syncthreads();
    }
    xcd_barrier(XB_NOW());
#ifndef NO_HC
    for (int id = bid; id < 1024; id += nb) hgrn_c_item(p, layer, id >> 2, id & 3);
#endif
    xcd_barrier(XB_NOW());
#ifndef NO_P5
    for (int id = bid; id < 64 * 8; id += nb) p5_tile(p, id & 63, id >> 6);
#endif
    xcd_barrier(XB_NOW());
    for (int id = bid; id < 256; id += nb) fused_out_ln(p, layer, id);
    xcd_barrier(XB_NOW());
  }}

extern "C" void kernel_launch(void* const* d_in, const int* in_sizes, int n_in, void* d_out, int out_size, void* d_ws,
                              size_t ws_size, hipStream_t stream) {
  constexpr size_t kLds = 160 * 1024;
  static int grid_blocks = 0;
  if (!grid_blocks) {
    int dev = 0, cus = 0, per_cu = 0;
    (void)hipGetDevice(&dev);
    (void)hipDeviceGetAttribute(&cus, hipDeviceAttributeMultiprocessorCount, dev);
    (void)hipFuncSetAttribute((const void*)mk, hipFuncAttributeMaxDynamicSharedMemorySize, (int)kLds);
    (void)hipOccupancyMaxActiveBlocksPerMultiprocessor(&per_cu, mk, 512, kLds);
    if (per_cu > 1) per_cu = 1;
    grid_blocks = cus * per_cu;
  }
  if (ws_size < WS_NEED || grid_blocks <= 0) { fprintf(stderr, "ws too small or no occupancy\n"); return; }
  Params p{};
  p.x = (const float*)d_in[0]; p.w_in = (const float*)d_in[1]; p.b_in = (const float*)d_in[2];
  p.w_up_a = (const float*)d_in[3]; p.w_up_b = (const float*)d_in[4]; p.w_out = (const float*)d_in[5];
  p.lb_logits = (const float*)d_in[6]; p.norm_a_g = (const float*)d_in[7]; p.rel_bias = (const float*)d_in[8];
  p.ln_g = (const float*)d_in[9]; p.ln_b = (const float*)d_in[10];
  p.out = (float*)d_out; p.ws = (char*)d_ws;
  (void)hipMemsetAsync((char*)d_ws + O_BAR, 0, XCD_BAR_WORDS * 4, stream);
  void* args[] = {&p};
  hipError_t e = hipLaunchCooperativeKernel((void*)mk, dim3(grid_blocks), dim3(512), args, kLds, stream);
  if (e != hipSuccess) fprintf(stderr, "cooperative launch failed: %s (grid %d)\n", hipGetErrorString(e), grid_blocks);
}
```

```cpp
#include <hip/hip_runtime.h>
#include <hip/hip_cooperative_groups.h>
#include <cstdio>
#include <cstdint>
namespace cg = cooperative_groups;

#define DI __device__ __forceinline__
typedef __attribute__((ext_vector_type(8))) short bf16x8;
typedef __attribute__((ext_vector_type(16))) float f32x16;
typedef __attribute__((ext_vector_type(2))) float f32x2;
typedef __attribute__((ext_vector_type(2))) __bf16 bf16x2_t;
#define MFMA(a, b, c) __builtin_amdgcn_mfma_f32_32x32x16_bf16((a), (b), (c), 0, 0, 0)

constexpr int L_ = 16384, DM = 1024, NIN = 6728, NPAD = 6912, DEPTH_ = 4;
constexpr float ALPHA_ = 1.681792830507429f;
constexpr size_t MiB = 1048576;
constexpr size_t O_WTIN = 0 * MiB, O_WUA = 14 * MiB, O_WUB = 15 * MiB, O_WOUT = 16 * MiB, O_HB = 18 * MiB,
                 O_QA = 50 * MiB, O_G = 66 * MiB, O_KK = 98 * MiB, O_IA = 114 * MiB, O_ZA = 130 * MiB,
                 O_QB = 146 * MiB, O_KB = 162 * MiB, O_VB = 178 * MiB, O_ZB = 194 * MiB, O_QI = 210 * MiB,
                 O_KI = 226 * MiB, O_WI = 228 * MiB, O_D = 228 * MiB + 512 * 1024, O_SGA = 229 * MiB,
                 O_SGB = 261 * MiB, O_US = 293 * MiB, O_SEL = 325 * MiB, O_LBS = 333 * MiB,
                 O_BAR = 333 * MiB + 65536, O_AA = 334 * MiB, O_AB = 350 * MiB, O_MG = 366 * MiB, WS_NEED = 398 * MiB;

struct Params {
  const float *x, *w_in, *b_in, *w_up_a, *w_up_b, *w_out, *lb_logits, *norm_a_g, *rel_bias, *ln_g, *ln_b;
  float* out;
  char* ws;
};

extern __shared__ __attribute__((aligned(16))) char smem[];

DI unsigned cvtpk(float lo, float hi) {
  f32x2 v = {lo, hi};
  bf16x2_t b = __builtin_convertvector(v, bf16x2_t);
  return __builtin_bit_cast(unsigned, b);
}
DI unsigned short f2bf(float x) { return (unsigned short)(cvtpk(x, 0.f) & 0xffffu); }
DI float bflo(unsigned u) { return __uint_as_float(u << 16); }
DI float bfhi(unsigned u) { return __uint_as_float(u & 0xffff0000u); }
DI float bf2f(unsigned short s) { return __uint_as_float(((unsigned)s) << 16); }
DI float sigm(float x) { return 1.f / (1.f + __expf(-x)); }
DI float silu(float x) { return x / (1.f + __expf(-x)); }
DI int crow(int r, int hi) { return (r & 3) + 8 * (r >> 2) + 4 * hi; }
DI size_t tiled_unit(int r, int k, int KS) {
  return ((size_t)(r >> 5) * KS + (k >> 4)) * 64 + (r & 31) + 32 * ((k >> 3) & 1);
}
DI float dot2(unsigned a, unsigned b, float acc) {
  asm volatile("v_dot2c_f32_bf16 %0, %1, %2" : "+v"(acc) : "v"(a), "v"(b));
  return acc;
}
template <typename T> DI T* opq(T* x) { asm volatile("" : "+s"(x)); return x; }
#define LAUNDER(pin) Params p; p.x = opq((pin).x); p.w_in = (pin).w_in; p.b_in = (pin).b_in; p.w_up_a = (pin).w_up_a; p.w_up_b = (pin).w_up_b; \
  p.w_out = (pin).w_out; p.lb_logits = (pin).lb_logits; p.norm_a_g = (pin).norm_a_g; p.rel_bias = (pin).rel_bias; p.ln_g = (pin).ln_g; \
  p.ln_b = (pin).ln_b; p.out = opq((pin).out); p.ws = opq((pin).ws);
DI int vtid() { int t = threadIdx.x; asm volatile("" : "+v"(t)); return t; }
DI unsigned vzero() { unsigned z; asm volatile("v_mov_b32 %0, 0" : "=v"(z)); return z; }
DI void cbar() { asm volatile("" ::: "memory"); }
DI void lds_fence() { asm volatile("s_waitcnt lgkmcnt(0)" ::: "memory"); }

DI int colmap(int np) {
  if (np < 4608) return np;
  if (np < 5632) return 4680 + (np - 4608);
  if (np < 6656) return 5704 + (np - 5632);
  if (np < 6720) return 4608 + (np - 6656);
  if (np < 6728) return 4672 + (np - 6720);
  return -1;
}

DI void conv_weight(const float* __restrict__ src, int K, int ldn, int Npad, bool useMap, uint4* __restrict__ dst,
                    int gtid, int gthreads) {
  const int KS = K >> 4;
  const int total = Npad * (K >> 3);
  for (int u = gtid; u < total; u += gthreads) {
    int kg = u / Npad, n = u - kg * Npad;
    int col = useMap ? colmap(n) : n;
    float v[8];
#pragma unroll
    for (int j = 0; j < 8; ++j) v[j] = (col >= 0) ? src[(size_t)(kg * 8 + j) * ldn + col] : 0.f;
    uint4 o;
    o.x = cvtpk(v[0], v[1]); o.y = cvtpk(v[2], v[3]); o.z = cvtpk(v[4], v[5]); o.w = cvtpk(v[6], v[7]);
    dst[tiled_unit(n, kg * 8, KS)] = o;
  }
}

DI void conv_weight_rm(const float* __restrict__ src, int K, int ldn, int Npad, bool useMap, uint4* __restrict__ dst,
                       int gtid, int gthreads) {
  const int total = Npad * (K >> 3);
  for (int u = gtid; u < total; u += gthreads) {
    int kg = u / Npad, n = u - kg * Npad;
    int col = useMap ? colmap(n) : n;
    float v[8];
#pragma unroll
    for (int j = 0; j < 8; ++j) v[j] = (col >= 0) ? src[(size_t)(kg * 8 + j) * ldn + col] : 0.f;
    uint4 o;
    o.x = cvtpk(v[0], v[1]); o.y = cvtpk(v[2], v[3]); o.z = cvtpk(v[4], v[5]); o.w = cvtpk(v[6], v[7]);
    dst[(size_t)n * (K >> 3) + kg] = o;
  }
}

DI void phase0(const Params& p) {
  const int gtid = blockIdx.x * 512 + vtid(), gthreads = gridDim.x * 512;
  conv_weight_rm(p.w_in, 1024, NIN, NPAD, true, (uint4*)(p.ws + O_WTIN), gtid, gthreads);
  uint4* hb = (uint4*)(p.ws + O_HB);
  for (int u = gtid; u < L_ * 128; u += gthreads) {
    const float4* s_ = (const float4*)(p.x + (size_t)u * 8);
    const float4 a = s_[0], b = s_[1];
    uint4 o;
    o.x = cvtpk(a.x, a.y); o.y = cvtpk(a.z, a.w); o.z = cvtpk(b.x, b.y); o.w = cvtpk(b.z, b.w);
    hb[u] = o;
  }
  float* lbs = (float*)(p.ws + O_LBS);
  for (int c = gtid; c < 512; c += gthreads) {
    float l0 = p.lb_logits[c], l1 = p.lb_logits[512 + c], l2 = p.lb_logits[1024 + c], l3 = p.lb_logits[1536 + c];
    float m = fmaxf(fmaxf(l0, l1), fmaxf(l2, l3));
    float e0 = expf(l0 - m), e1 = expf(l1 - m), e2 = expf(l2 - m), e3 = expf(l3 - m);
    float inv = 1.f / (e0 + e1 + e2 + e3);
    lbs[c] = 0.f; lbs[512 + c] = e1 * inv; lbs[1024 + c] = (e1 + e2) * inv; lbs[1536 + c] = (e1 + e2 + e3) * inv;
  }
}

DI void gemm_core(const uint4* __restrict__ A, int mt0, const uint4* __restrict__ B, int nt0, int KS,
                  f32x16 (&acc)[2][2], uint4* lds) {
  const int tid = vtid(), lane = tid & 63, w = tid >> 6, wm = w >> 1, wn = w & 1;
  const int nk = KS >> 2;
  const uint4* sp[6];
#pragma unroll
  for (int r = 0; r < 6; ++r) {
    int u = tid + 512 * r;
    if (u < 2048) sp[r] = A + ((size_t)(mt0 + (u >> 8)) * KS) * 64 + (u & 255);
    else { int u2 = u - 2048; sp[r] = B + ((size_t)(nt0 + (u2 >> 8)) * KS) * 64 + (u2 & 255); }
  }
#pragma unroll
  for (int r = 0; r < 6; ++r)
    __builtin_amdgcn_global_load_lds((const unsigned*)sp[r], (unsigned*)(lds + tid + 512 * r), 16, 0, 0);
  if (nk > 1) {
#pragma unroll
    for (int r = 0; r < 6; ++r)
      __builtin_amdgcn_global_load_lds((const unsigned*)(sp[r] + 256), (unsigned*)(lds + 3072 + tid + 512 * r), 16, 0, 0);
  }
  int cb = 0;
  for (int kt = 0; kt < nk; ++kt) {
    if (kt + 1 < nk) asm volatile("s_waitcnt vmcnt(6)" ::: "memory");
    else asm volatile("s_waitcnt vmcnt(0)" ::: "memory");
    __builtin_amdgcn_s_barrier();
    asm volatile("" ::: "memory");
    if (kt + 2 < nk) {
      int nb2 = cb + 2; if (nb2 >= 3) nb2 -= 3;
      uint4* nxt = lds + nb2 * 3072;
#pragma unroll
      for (int r = 0; r < 6; ++r)
        __builtin_amdgcn_global_load_lds((const unsigned*)(sp[r] + (size_t)(kt + 2) * 256), (unsigned*)(nxt + tid + 512 * r), 16, 0, 0);
    }
    const uint4* cur = lds + cb * 3072;
#pragma unroll
    for (int ks = 0; ks < 4; ++ks) {
      bf16x8 a0 = __builtin_bit_cast(bf16x8, cur[(2 * wm + 0) * 256 + ks * 64 + lane]);
      bf16x8 a1 = __builtin_bit_cast(bf16x8, cur[(2 * wm + 1) * 256 + ks * 64 + lane]);
      bf16x8 b0 = __builtin_bit_cast(bf16x8, cur[2048 + (2 * wn + 0) * 256 + ks * 64 + lane]);
      bf16x8 b1 = __builtin_bit_cast(bf16x8, cur[2048 + (2 * wn + 1) * 256 + ks * 64 + lane]);
      acc[0][0] = MFMA(a0, b0, acc[0][0]);
      acc[0][1] = MFMA(a0, b1, acc[0][1]);
      acc[1][0] = MFMA(a1, b0, acc[1][0]);
      acc[1][1] = MFMA(a1, b1, acc[1][1]);
    }
    cb = (cb == 2) ? 0 : cb + 1;
  }
  __syncthreads();
}

DI void zero_acc(f32x16 (&acc)[2][2]) {
#pragma unroll
  for (int i = 0; i < 2; ++i)
#pragma unroll
    for (int j = 0; j < 2; ++j)
#pragma unroll
      for (int r = 0; r < 16; ++r) acc[i][j][r] = 0.f;
}

typedef __attribute__((ext_vector_type(4))) float f32x4g;
DI int g8_lds_byte(int r, int c) {
  int st = (r >> 4) * 2 + (c >> 5), rr = r & 15, cc = c & 31, ob = rr * 64 + cc * 2;
  return st * 1024 + (ob ^ (((ob >> 9) & 1) << 5));
}
DI void g8_stage_rc(int b, int& R, int& C) {
  int st = b / 1024, sb = b % 1024, swz = sb ^ (((sb >> 9) & 1) << 5);
  R = (st >> 1) * 16 + swz / 64; C = (st & 1) * 32 + (swz % 64) / 2;
}
DI void gemm8p(const unsigned short* __restrict__ A, const unsigned short* __restrict__ Bt, const int K, const int brow, const int bcol,
               f32x4g (&acc)[2][2][4][2], unsigned short* shm) {
  constexpr int BK = 64, HALF = 128, HT = HALF * BK;
  const int tidx = vtid();
  #define G8_SA(b,h) (shm+((b)*2+(h))*HT)
  #define G8_SB(b,h) (shm+(4+(b)*2+(h))*HT)
  int g8vo[2];
  { int r_, c_; g8_stage_rc(tidx * 16, r_, c_); g8vo[0] = (r_ * K + c_) * 2; g8_stage_rc(tidx * 16 + 8192, r_, c_); g8vo[1] = (r_ * K + c_) * 2; }
  const __amdgpu_buffer_rsrc_t g8rA = __builtin_amdgcn_make_buffer_rsrc((void*)A, 0, 16384 * 1024 * 2, 0x00020000);
  const __amdgpu_buffer_rsrc_t g8rBt = __builtin_amdgcn_make_buffer_rsrc((void*)Bt, 0, 6912 * 1024 * 2, 0x00020000);
  #define G8_STAGE(P,BASE,br,kt) do{ const int _so = ((br) * K + (kt) * BK) * 2; \
    for(int _i=0;_i<2;++_i){ \
      __builtin_amdgcn_raw_ptr_buffer_load_lds(g8r##BASE, (__attribute__((address_space(3))) void*)((char*)(P)+tidx*16+_i*8192), 16, g8vo[_i], _so, 0, 0);}}while(0)
  #define G8_LDA(dst,b,h) for(int m=0;m<4;++m)for(int k=0;k<2;++k) \
    dst[m][k]=*reinterpret_cast<const bf16x8*>((char*)G8_SA(b,h)+g8_lds_byte(wr*64+m*16+fr,k*32+fq*8))
  #define G8_LDB(dst,b,h) for(int n=0;n<2;++n)for(int k=0;k<2;++k) \
    dst[n][k]=*reinterpret_cast<const bf16x8*>((char*)G8_SB(b,h)+g8_lds_byte(wc*32+n*16+fr,k*32+fq*8))
  #define G8_MMA(ai,bj,At,Bt_) do{__builtin_amdgcn_s_setprio(1); \
    for(int m=0;m<4;++m)for(int n=0;n<2;++n)for(int k=0;k<2;++k) \
      acc[ai][bj][m][n]=__builtin_amdgcn_mfma_f32_16x16x32_bf16(Bt_[n][k],At[m][k],acc[ai][bj][m][n],0,0,0); \
    __builtin_amdgcn_s_setprio(0);}while(0)
  #define G8_WV(n) asm volatile("s_waitcnt vmcnt(" #n ")":::"memory")
  #define G8_WL(n) asm volatile("s_waitcnt lgkmcnt(" #n ")":::"memory")
  #define G8_BAR __builtin_amdgcn_s_barrier()
  #define G8_SCHED __builtin_amdgcn_sched_barrier(0)
  const int wid = tidx >> 6, lane = tidx & 63, wr = wid >> 2, wc = wid & 3, fr = lane & 15, fq = lane >> 4;
  bf16x8 At[4][2], B0[2][2], B1[2][2];
  const int nt = K / BK;
  G8_STAGE(G8_SB(0,0),Bt,bcol,0); G8_STAGE(G8_SA(0,0),A,brow,0);
  G8_STAGE(G8_SB(0,1),Bt,bcol+HALF,0); G8_STAGE(G8_SA(0,1),A,brow+HALF,0);
  if(wr==1)G8_BAR;
  G8_WV(4); G8_BAR;
  G8_STAGE(G8_SB(1,0),Bt,bcol,1); G8_STAGE(G8_SA(1,0),A,brow,1); G8_STAGE(G8_SB(1,1),Bt,bcol+HALF,1);
  G8_WV(6); G8_BAR;
  for(int t=0;t<nt-2;t+=2){
    G8_LDB(B0,0,0); G8_SCHED; G8_LDA(At,0,0); G8_STAGE(G8_SA(1,1),A,brow+HALF,t+1);
    G8_WL(8); G8_BAR; G8_WL(0); G8_MMA(0,0,At,B0); G8_BAR; G8_SCHED;
    G8_LDB(B1,0,1); G8_STAGE(G8_SB(0,0),Bt,bcol,t+2);
    G8_BAR; G8_WL(0); G8_MMA(0,1,At,B1); G8_BAR;
    G8_LDA(At,0,1); G8_STAGE(G8_SA(0,0),A,brow,t+2);
    G8_BAR; G8_WL(0); G8_MMA(1,0,At,B0); G8_BAR; G8_SCHED;
    G8_STAGE(G8_SB(0,1),Bt,bcol+HALF,t+2);
    G8_WV(6); G8_BAR; G8_MMA(1,1,At,B1); G8_BAR;
    G8_LDB(B0,1,0); G8_SCHED; G8_LDA(At,1,0); G8_STAGE(G8_SA(0,1),A,brow+HALF,t+2);
    G8_WL(8); G8_BAR; G8_WL(0); G8_MMA(0,0,At,B0); G8_BAR; G8_SCHED;
    G8_LDB(B1,1,1); G8_STAGE(G8_SB(1,0),Bt,bcol,t+3);
    G8_BAR; G8_WL(0); G8_MMA(0,1,At,B1); G8_BAR;
    G8_LDA(At,1,1); G8_STAGE(G8_SA(1,0),A,brow,t+3);
    G8_BAR; G8_WL(0); G8_MMA(1,0,At,B0); G8_BAR; G8_SCHED;
    G8_STAGE(G8_SB(1,1),Bt,bcol+HALF,t+3);
    G8_WV(6); G8_BAR; G8_MMA(1,1,At,B1); G8_BAR;
  }
  { G8_LDB(B0,0,0); G8_LDA(At,0,0); G8_STAGE(G8_SA(1,1),A,brow+HALF,nt-1);
    G8_BAR; G8_WL(0); G8_MMA(0,0,At,B0); G8_BAR;
    G8_LDB(B1,0,1); G8_BAR; G8_WL(0); G8_MMA(0,1,At,B1); G8_BAR;
    G8_LDA(At,0,1); G8_WV(4); G8_BAR; G8_WL(0); G8_MMA(1,0,At,B0); G8_MMA(1,1,At,B1); G8_BAR; }
  { G8_LDB(B0,1,0); G8_LDA(At,1,0); G8_WV(2); G8_BAR; G8_WL(0); G8_MMA(0,0,At,B0); G8_BAR;
    G8_LDB(B1,1,1); G8_WV(0); G8_BAR; G8_WL(0); G8_MMA(0,1,At,B1); G8_BAR;
    G8_LDA(At,1,1); G8_BAR; G8_WL(0); G8_MMA(1,0,At,B0); G8_MMA(1,1,At,B1); G8_BAR; }
  if(wr==0)G8_BAR;
  __syncthreads();
}

DI void p1_tile(const Params& p, int layer, int mb, int nt) {
  const int tid = vtid(), lane = tid & 63, w = tid >> 6, wm = w >> 1, wn = w & 1, hi = lane >> 5, c31 = lane & 31;
  f32x16 acc[2][2];
  zero_acc(acc);
  gemm_core((const uint4*)(p.ws + O_HB), mb * 8, (const uint4*)(p.ws + O_WTIN), nt * 4, 64, acc, (uint4*)smem);
  unsigned short* tile = (unsigned short*)smem;
  const int row0 = mb * 256;
  const float* bin = p.b_in + (size_t)layer * NIN;
  const float* lbs = (const float*)(p.ws + O_LBS) + layer * 512;
#pragma unroll
  for (int j = 0; j < 2; ++j) {
    const int col = 64 * wn + 32 * j + c31;
    const int np = nt * 128 + col;
    const int oc = colmap(np);
    const float bias = oc >= 0 ? bin[oc] : 0.f;
    float lb = 0.f;
    if (nt >= 4 && nt < 8) lb = lbs[(nt - 4) * 128 + col];
#pragma unroll
    for (int i = 0; i < 2; ++i) {
#pragma unroll
      for (int r = 0; r < 16; ++r) {
        const int row = 64 * wm + 32 * i + crow(r, hi);
        float v = acc[i][j][r] + bias;
        float o;
        if (nt < 4) o = v;
        else if (nt < 8) {
          float sg = sigm(v);
          float f = lb + (1.f - lb) * sg;
          ((float*)(p.ws + O_G))[(size_t)(row0 + row) * 512 + (nt - 4) * 128 + col] = __logf(f);
          o = (1.f - lb) * (1.f - sg);
        } else if (nt < 12) o = v;
        else if (nt < 16) o = silu(v);
        else if (nt < 20) o = v * 0.125f;
        else if (nt < 28) o = v;
        else if (nt < 32) o = silu(v);
        else if (nt < 36) o = v;
        else if (nt < 52) o = sigm(v);
        else {
          o = v;
          if (col >= 64 && col < 72)
            ((float*)(p.ws + O_WI))[(size_t)(row0 + row) * 8 + (col - 64)] = v * 0.044194173824159216f;
        }
        tile[row * 128 + col] = f2bf(o);
      }
    }
  }
  __syncthreads();
#pragma unroll
  for (int q = 0; q < 8; ++q) {
    const int u = tid + 512 * q, r = u >> 4, c8 = u & 15;
    const uint4 val = *(const uint4*)&tile[r * 128 + c8 * 8];
    const int t = row0 + r;
    if (nt >= 20 && nt < 28) {
      int w0 = __builtin_amdgcn_cvt_pk_fp8_f32(bflo(val.x), bfhi(val.x), 0, false);
      w0 = __builtin_amdgcn_cvt_pk_fp8_f32(bflo(val.y), bfhi(val.y), w0, true);
      int w1 = __builtin_amdgcn_cvt_pk_fp8_f32(bflo(val.z), bfhi(val.z), 0, false);
      w1 = __builtin_amdgcn_cvt_pk_fp8_f32(bflo(val.w), bfhi(val.w), w1, true);
      const size_t base8 = (nt < 24) ? O_KB : O_VB;
      *(uint2*)(p.ws + base8 + (size_t)t * 512 + (nt & 3) * 128 + c8 * 8) = make_uint2((unsigned)w0, (unsigned)w1);
    } else if (nt < 32) {
      size_t base;
      switch (nt >> 2) {
        case 0: base = O_QA; break; case 1: base = O_KK; break; case 2: base = O_IA; break; case 3: base = O_ZA; break;
        case 4: base = O_QB; break; case 5: base = O_KB; break; case 6: base = O_VB; break; default: base = O_ZB; break;
      }
      *(uint4*)(p.ws + base + ((size_t)t * 512 + (nt & 3) * 128 + c8 * 8) * 2) = val;
    } else if (nt < 36) {
      const int head = 2 * (nt - 32) + (c8 >> 3), d0 = (c8 & 7) * 8;
      const int item = t >> 5, tq = t & 31, mtile = tq >> 2, q4 = tq & 3;
      const int rr = (head & 3) + 4 * (q4 >> 1) + 8 * (head >> 2) + 16 * (q4 & 1);
      const int laneA = rr + 32 * ((d0 >> 3) & 1), ks = d0 >> 4;
      ((uint4*)(p.ws + O_QI))[((size_t)(item * 8 + mtile) * 4 + ks) * 64 + laneA] = val;
    } else if (nt < 44) {
      *(uint4*)(p.ws + O_SGA + ((size_t)t * 1024 + (nt - 36) * 128 + c8 * 8) * 2) = val;
    } else if (nt < 52) {
      *(uint4*)(p.ws + O_SGB + ((size_t)t * 1024 + (nt - 44) * 128 + c8 * 8) * 2) = val;
    } else {
      if (c8 < 8) {
        const int d0 = c8 * 8;
        ((uint4*)(p.ws + O_KI))[((size_t)(t >> 5) * 4 + (d0 >> 4)) * 64 + (t & 31) + 32 * ((d0 >> 3) & 1)] = val;
      }
    }
  }
  __syncthreads();
}

constexpr int T8S = 264;
enum { C_PLAIN = 0, C_FA = 1, C_SILU = 2, C_QB = 3, C_SIGM = 4, C_KIWI = 5 };
DI float sigm_fast(float x) { return __builtin_amdgcn_rcpf(1.f + __builtin_amdgcn_exp2f(-1.4426950408889634f * x)); }
template <int CLS>
DI void p1_epi_write(const Params& p, f32x4g (&acc)[2][2][4][2], int layer, int nt2, int row0) {
  const int tid = vtid(), wid = tid >> 6, lane = tid & 63, wr = wid >> 2, wc = wid & 3, fr = lane & 15, fq = lane >> 4;
  unsigned short* tile = (unsigned short*)smem;
  const float* bin = p.b_in + (size_t)layer * NIN;
  const float* lbs = (const float*)(p.ws + O_LBS) + layer * 512;
  const int rbase = wr * 64 + fr;
#pragma unroll
  for (int bj = 0; bj < 2; ++bj) {
    if (CLS == C_KIWI && bj == 1) break;
    const int nt = 2 * nt2 + bj;
#pragma unroll
    for (int n = 0; n < 2; ++n) {
      const int c4 = wc * 32 + n * 16 + 4 * fq;
      const int np = nt * 128 + c4;
      float4 b4;
      if (CLS == C_KIWI) b4 = (c4 < 72) ? *(const float4*)(bin + (np - 2048)) : make_float4(0.f, 0.f, 0.f, 0.f);
      else if (CLS == C_SIGM) b4 = *(const float4*)(bin + (np + 72));
      else b4 = *(const float4*)(bin + np);
      float4 l4 = make_float4(0.f, 0.f, 0.f, 0.f);
      if (CLS == C_FA) l4 = *(const float4*)(lbs + (nt - 4) * 128 + c4);
#pragma unroll
      for (int ai = 0; ai < 2; ++ai)
#pragma unroll
        for (int m = 0; m < 4; ++m) {
          const int row = ai * 128 + m * 16 + rbase;
          const f32x4g a = acc[ai][bj][m][n];
          const float v0 = a[0] + b4.x, v1 = a[1] + b4.y, v2 = a[2] + b4.z, v3 = a[3] + b4.w;
          float o0, o1, o2, o3;
          if (CLS == C_PLAIN) { o0 = v0; o1 = v1; o2 = v2; o3 = v3; }
          else if (CLS == C_QB) { o0 = v0 * 0.125f; o1 = v1 * 0.125f; o2 = v2 * 0.125f; o3 = v3 * 0.125f; }
          else if (CLS == C_SILU) { o0 = v0 * sigm_fast(v0); o1 = v1 * sigm_fast(v1); o2 = v2 * sigm_fast(v2); o3 = v3 * sigm_fast(v3); }
          else if (CLS == C_SIGM) { o0 = sigm_fast(v0); o1 = sigm_fast(v1); o2 = sigm_fast(v2); o3 = sigm_fast(v3); }
          else if (CLS == C_FA) {
            const float s0 = sigm_fast(v0), s1 = sigm_fast(v1), s2 = sigm_fast(v2), s3 = sigm_fast(v3);
            float4 g;
            g.x = __logf(l4.x + (1.f - l4.x) * s0); g.y = __logf(l4.y + (1.f - l4.y) * s1);
            g.z = __logf(l4.z + (1.f - l4.z) * s2); g.w = __logf(l4.w + (1.f - l4.w) * s3);
            *(float4*)((float*)(p.ws + O_G) + (size_t)(row0 + row) * 512 + (nt - 4) * 128 + c4) = g;
            o0 = (1.f - l4.x) * (1.f - s0); o1 = (1.f - l4.y) * (1.f - s1); o2 = (1.f - l4.z) * (1.f - s2); o3 = (1.f - l4.w) * (1.f - s3);
          } else {
            o0 = v0; o1 = v1; o2 = v2; o3 = v3;
            if (c4 >= 64 && c4 < 72) {
              const float sc = 0.044194173824159216f;
              *(float4*)((float*)(p.ws + O_WI) + (size_t)(row0 + row) * 8 + (c4 - 64)) = make_float4(v0 * sc, v1 * sc, v2 * sc, v3 * sc);
            }
          }
          *(uint2*)(tile + row * T8S + 128 * bj + c4) = make_uint2(cvtpk(o0, o1), cvtpk(o2, o3));
        }
    }
  }
}

DI void p1_tile8(const Params& p, int layer, int mb, int nt2) {
  f32x4g acc[2][2][4][2];
#pragma unroll
  for (int a = 0; a < 2; ++a)
#pragma unroll
    for (int b = 0; b < 2; ++b)
#pragma unroll
      for (int m = 0; m < 4; ++m)
#pragma unroll
        for (int n = 0; n < 2; ++n) acc[a][b][m][n] = f32x4g{0.f, 0.f, 0.f, 0.f};
  gemm8p((const unsigned short*)(p.ws + O_HB), (const unsigned short*)(p.ws + O_WTIN), 1024, mb * 256, nt2 * 256, acc, (unsigned short*)smem);
  __builtin_amdgcn_sched_barrier(0);
  asm volatile("" ::: "memory");
  const int row0 = mb * 256;
  if (nt2 < 2) p1_epi_write<C_PLAIN>(p, acc, layer, nt2, row0);
  else if (nt2 < 4) p1_epi_write<C_FA>(p, acc, layer, nt2, row0);
  else if (nt2 < 6) p1_epi_write<C_PLAIN>(p, acc, layer, nt2, row0);
  else if (nt2 < 8) p1_epi_write<C_SILU>(p, acc, layer, nt2, row0);
  else if (nt2 < 10) p1_epi_write<C_QB>(p, acc, layer, nt2, row0);
  else if (nt2 < 14) p1_epi_write<C_PLAIN>(p, acc, layer, nt2, row0);
  else if (nt2 < 16) p1_epi_write<C_SILU>(p, acc, layer, nt2, row0);
  else if (nt2 < 18) p1_epi_write<C_PLAIN>(p, acc, layer, nt2, row0);
  else if (nt2 < 26) p1_epi_write<C_SIGM>(p, acc, layer, nt2, row0);
  else p1_epi_write<C_KIWI>(p, acc, layer, nt2, row0);
  __syncthreads();
  const int tid = vtid();
  const unsigned short* tile = (const unsigned short*)smem;
  const int c32 = tid & 31, rq = tid >> 5;
  if (nt2 >= 10 && nt2 < 14) {
    char* dst = p.ws + (nt2 < 12 ? O_KB : O_VB) + (size_t)row0 * 512 + (nt2 & 1) * 256 + c32 * 8;
#pragma unroll 4
    for (int q = 0; q < 16; ++q) {
      const int r = rq + 16 * q;
      const uint4 val = *(const uint4*)(tile + r * T8S + c32 * 8);
      int w0 = __builtin_amdgcn_cvt_pk_fp8_f32(bflo(val.x), bfhi(val.x), 0, false);
      w0 = __builtin_amdgcn_cvt_pk_fp8_f32(bflo(val.y), bfhi(val.y), w0, true);
      int w1 = __builtin_amdgcn_cvt_pk_fp8_f32(bflo(val.z), bfhi(val.z), 0, false);
      w1 = __builtin_amdgcn_cvt_pk_fp8_f32(bflo(val.w), bfhi(val.w), w1, true);
      *(uint2*)(dst + (size_t)r * 512) = make_uint2((unsigned)w0, (unsigned)w1);
    }
  } else if (nt2 < 16) {
    size_t base;
    switch (nt2 >> 1) {
      case 0: base = O_QA; break; case 1: base = O_KK; break; case 2: base = O_IA; break; case 3: base = O_ZA; break;
      case 4: base = O_QB; break; default: base = O_ZB; break;
    }
    char* dst = p.ws + base + ((size_t)row0 * 512 + (nt2 & 1) * 256 + c32 * 8) * 2;
#pragma unroll 4
    for (int q = 0; q < 16; ++q) {
      const int r = rq + 16 * q;
      *(uint4*)(dst + (size_t)r * 1024) = *(const uint4*)(tile + r * T8S + c32 * 8);
    }
  } else if (nt2 < 18) {
    const int head = 4 * (nt2 - 16) + (c32 >> 3), d0 = (c32 & 7) * 8;
#pragma unroll 4
    for (int q = 0; q < 16; ++q) {
      const int r = rq + 16 * q, t = row0 + r;
      const int item = t >> 5, tq = t & 31, mtile = tq >> 2, q4 = tq & 3;
      const int rr = (head & 3) + 4 * (q4 >> 1) + 8 * (head >> 2) + 16 * (q4 & 1);
      const int laneA = rr + 32 * ((d0 >> 3) & 1), ks = d0 >> 4;
      ((uint4*)(p.ws + O_QI))[((size_t)(item * 8 + mtile) * 4 + ks) * 64 + laneA] = *(const uint4*)(tile + r * T8S + c32 * 8);
    }
  } else if (nt2 < 26) {
    char* dst = p.ws + (nt2 < 22 ? O_SGA : O_SGB) + ((size_t)row0 * 1024 + ((nt2 - 18) & 3) * 256 + c32 * 8) * 2;
#pragma unroll 4
    for (int q = 0; q < 16; ++q) {
      const int r = rq + 16 * q;
      *(uint4*)(dst + (size_t)r * 2048) = *(const uint4*)(tile + r * T8S + c32 * 8);
    }
  } else {
    if (c32 < 8) {
      const int d0 = c32 * 8;
#pragma unroll 4
      for (int q = 0; q < 16; ++q) {
        const int r = rq + 16 * q, t = row0 + r;
        ((uint4*)(p.ws + O_KI))[((size_t)(t >> 5) * 4 + (d0 >> 4)) * 64 + (t & 31) + 32 * ((d0 >> 3) & 1)] = *(const uint4*)(tile + r * T8S + c32 * 8);
      }
    }
  }
  asm volatile("s_waitcnt lgkmcnt(0)" ::: "memory");
  __builtin_amdgcn_s_barrier();
}

constexpr int CAP = 1000, SEGCAP = 250, SEGTRIG = 186;
constexpr int IX_SC = 0, IX_IX = 64000, IX_RING = 96000, IX_CNT = 161536, IX_TAU = 161792, IX_FLAG = 161856, IX_WL = 161872;

DI float key2float(unsigned k) {
  unsigned b = (k & 0x80000000u) ? (k ^ 0x80000000u) : ~k;
  return __uint_as_float(b);
}
DI unsigned float2key(float f) {
  unsigned b = __float_as_uint(f);
  return (b & 0x80000000u) ? ~b : (b ^ 0x80000000u);
}
DI int wave_prefix_incl(int x) {
  int v = x;
  v += __builtin_amdgcn_update_dpp(0, v, 0x111, 0xf, 0xf, false);
  v += __builtin_amdgcn_update_dpp(0, v, 0x112, 0xf, 0xf, false);
  v += __builtin_amdgcn_update_dpp(0, v, 0x114, 0xf, 0xf, false);
  v += __builtin_amdgcn_update_dpp(0, v, 0x118, 0xf, 0xf, false);
  v += __builtin_amdgcn_update_dpp(0, v, 0x142, 0xa, 0xf, false);
  v += __builtin_amdgcn_update_dpp(0, v, 0x143, 0xc, 0xf, false);
  return v;
}

#define SEG_ADDR(j_) (((j_) >> 2) * SEGCAP + lane + 64 * ((j_) & 3))
DI int seg_count(const int4 c4, int s_) { return s_ == 0 ? c4.x : (s_ == 1 ? c4.y : (s_ == 2 ? c4.z : c4.w)); }

DI void wave_select(float* scq, unsigned short* ixq, int* cnt4q, float* tauq, unsigned* hist, int lane, unsigned short* final_sel) {
  lds_fence();
  const int4 c4 = *(const int4*)cnt4q;
  const int n = c4.x + c4.y + c4.z + c4.w;
  unsigned u[16], v16[16];
  unsigned mm = 0, am = 0;
#pragma unroll
  for (int j = 0; j < 16; ++j) {
    const bool valid = (lane + 64 * (j & 3)) < seg_count(c4, j >> 2);
    const float sv = valid ? scq[SEG_ADDR(j)] : 0.f;
    const unsigned id = valid ? (unsigned)ixq[SEG_ADDR(j)] : 0u;
    u[j] = float2key(sv);
    v16[j] = 0xFFFFu - id;
    mm |= (((unsigned)(lane + 64 * (j & 3)) - (unsigned)seg_count(c4, j >> 2)) >> 31) << j;
  }
  unsigned prefix_u = 0;
  if (n > 256) {
    int need = 256;
    int r0 = 0;
    {
      unsigned ref = 0; bool have = false;
#pragma unroll
      for (int j = 15; j >= 0; --j) if ((mm >> j) & 1u) { ref = u[j] >> 24; have = true; }
      const unsigned long long hm = __ballot(have);
      const int fl = __ffsll((long long)hm) - 1;
      ref = (unsigned)__builtin_amdgcn_readlane((int)ref, fl);
      bool same = true;
#pragma unroll
      for (int j = 0; j < 16; ++j) same = same && (!((mm >> j) & 1u) || ((u[j] >> 24) == ref));
      if (__all(same)) { prefix_u = ref << 24; r0 = 1; }
    }
    for (int r = r0; r < 6; ++r) {
      const int sh = (r < 4) ? (24 - 8 * r) : (r == 4 ? 8 : 0);
      { const unsigned z_ = vzero(); ((uint4*)hist)[lane] = make_uint4(z_, z_, z_, z_); }
      lds_fence();
#pragma unroll
      for (int j = 0; j < 16; ++j) {
        const unsigned src = (r < 4) ? u[j] : v16[j];
        const unsigned dgt = ((mm >> j) & 1u) ? ((src >> sh) & 255u) : 256u + lane;
        atomicAdd(&hist[dgt], 1u);
      }
      lds_fence();
      const uint4 hv = ((const uint4*)hist)[lane];
      const int c0 = hv.x, c1 = hv.y, c2 = hv.z, c3 = hv.w;
      const int Lsum = c0 + c1 + c2 + c3;
      const int Pfx = wave_prefix_incl(Lsum);
      const int total = __builtin_amdgcn_readlane(Pfx, 63);
      const int S = total - Pfx + Lsum;
      const unsigned long long mask = __ballot(S >= need);
      const int lstar = 63 - __clzll((long long)mask);
      int d_, ca_, cd_;
      {
        const int accu = S - Lsum;
        if (accu + c3 >= need) { d_ = 3; ca_ = accu; cd_ = c3; }
        else if (accu + c3 + c2 >= need) { d_ = 2; ca_ = accu + c3; cd_ = c2; }
        else if (accu + c3 + c2 + c1 >= need) { d_ = 1; ca_ = accu + c3 + c2; cd_ = c1; }
        else { d_ = 0; ca_ = accu + c3 + c2 + c1; cd_ = c0; }
      }
      const int D = __builtin_amdgcn_readlane(4 * lane + d_, lstar);
      const int cntAbove = __builtin_amdgcn_readlane(ca_, lstar);
      const int cntD = __builtin_amdgcn_readlane(cd_, lstar);
#pragma unroll
      for (int j = 0; j < 16; ++j) {
        const unsigned src = (r < 4) ? u[j] : v16[j];
        const int dgt = (int)((src >> sh) & 255u);
        const unsigned bit = mm & (1u << j);
        const unsigned dd = (unsigned)D - (unsigned)dgt, de = (unsigned)dgt - (unsigned)D;
        const unsigned gtm = (unsigned)((int)dd >> 31);
        const unsigned nem = (unsigned)((int)(dd | de) >> 31);
        am |= bit & gtm;
        mm ^= bit & nem;
      }
      need -= cntAbove;
      if (r < 4) prefix_u |= ((unsigned)D) << sh;
      if (cntD == need) break;
    }
  }
  const unsigned km = am | mm;
  int base = 0;
#pragma unroll
  for (int j = 0; j < 16; ++j) {
    const bool keep = (km >> j) & 1u;
    const unsigned long long m = __ballot(keep);
    const int rk = base + __popcll(m & ((1ull << lane) - 1ull));
    if (keep) {
      if (final_sel) { if (rk < 256) final_sel[rk] = (unsigned short)(0xFFFFu - v16[j]); }
      else { const int ad = (rk & 3) * SEGCAP + (rk >> 2); scq[ad] = key2float(u[j]); ixq[ad] = (unsigned short)(0xFFFFu - v16[j]); }
    }
    base += __popcll(m);
  }
  if (!final_sel && lane == 0) {
    *(int4*)cnt4q = make_int4((base + 3) >> 2, (base + 2) >> 2, (base + 1) >> 2, base >> 2);
    if (n > 256) *tauq = key2float(prefix_u);
  }
  lds_fence();
}

typedef float f32x2v __attribute__((ext_vector_type(2)));
DI float relu_(float x) { int i = __float_as_int(x); i = i > 0 ? i : 0; return __int_as_float(i); }

DI unsigned wave_umin(unsigned v) {
#define UMIN_STEP(ctrl, rm) { const unsigned o_ = (unsigned)__builtin_amdgcn_update_dpp((int)0xFFFFFFFFu, (int)v, ctrl, rm, 0xf, false); v = o_ < v ? o_ : v; }
  UMIN_STEP(0x111, 0xf) UMIN_STEP(0x112, 0xf) UMIN_STEP(0x114, 0xf) UMIN_STEP(0x118, 0xf) UMIN_STEP(0x142, 0xa) UMIN_STEP(0x143, 0xc)
#undef UMIN_STEP
  return (unsigned)__builtin_amdgcn_readlane((int)v, 63);
}
DI unsigned wave_umax(unsigned v) {
#define UMAX_STEP(ctrl, rm) { const unsigned o_ = (unsigned)__builtin_amdgcn_update_dpp(0, (int)v, ctrl, rm, 0xf, false); v = o_ > v ? o_ : v; }
  UMAX_STEP(0x111, 0xf) UMAX_STEP(0x112, 0xf) UMAX_STEP(0x114, 0xf) UMAX_STEP(0x118, 0xf) UMAX_STEP(0x142, 0xa) UMAX_STEP(0x143, 0xc)
#undef UMAX_STEP
  return (unsigned)__builtin_amdgcn_readlane((int)v, 63);
}
DI void wave_compact(float* scq, unsigned short* ixq, int* cnt4q, float* tauq, unsigned* hist, int lane) {
  lds_fence();
  const int4 c4 = *(const int4*)cnt4q;
  const int n = c4.x + c4.y + c4.z + c4.w;
  if (n <= 320) return;
  unsigned u[16], idv[16];
  unsigned vm = 0;
  unsigned umin = 0xFFFFFFFFu, umax = 0u;
  { const unsigned z_ = vzero(); ((uint4*)hist)[lane] = make_uint4(z_, z_, z_, z_); }

#pragma unroll
  for (int j = 0; j < 16; ++j) {
    const bool valid = (lane + 64 * (j & 3)) < seg_count(c4, j >> 2);
    u[j] = valid ? float2key(scq[SEG_ADDR(j)]) : 0u;
    idv[j] = valid ? (unsigned)ixq[SEG_ADDR(j)] : 0u;
    vm |= (((unsigned)(lane + 64 * (j & 3)) - (unsigned)seg_count(c4, j >> 2)) >> 31) << j;
    umin = valid ? (u[j] < umin ? u[j] : umin) : umin;
    umax = valid ? (u[j] > umax ? u[j] : umax) : umax;
  }
  umin = wave_umin(umin);
  umax = wave_umax(umax);
  const unsigned range = umax - umin;
  const int sh = range < 256u ? 0 : (24 - __clz((int)range));
#pragma unroll
  for (int j = 0; j < 16; ++j) {
    const unsigned bin = ((vm >> j) & 1u) ? ((u[j] - umin) >> sh) : 256u + lane;
    atomicAdd(&hist[bin], 1u);
  }
  lds_fence();
  const uint4 hv = ((const uint4*)hist)[lane];
  const int c0 = hv.x, c1 = hv.y, c2 = hv.z, c3 = hv.w;
  const int Lsum = c0 + c1 + c2 + c3;
  const int Pfx = wave_prefix_incl(Lsum);
  const int total = __builtin_amdgcn_readlane(Pfx, 63);
  const int S = total - Pfx + Lsum;
  const unsigned long long mask = __ballot(S >= 256);
  const int lstar = 63 - __clzll((long long)mask);
  int d_, kept_;
  {
    const int accu = S - Lsum;
    if (accu + c3 >= 256) { d_ = 3; kept_ = accu + c3; }
    else if (accu + c3 + c2 >= 256) { d_ = 2; kept_ = accu + c3 + c2; }
    else if (accu + c3 + c2 + c1 >= 256) { d_ = 1; kept_ = accu + c3 + c2 + c1; }
    else { d_ = 0; kept_ = accu + Lsum; }
  }
  const int D = __builtin_amdgcn_readlane(4 * lane + d_, lstar);
  const int kept = __builtin_amdgcn_readlane(kept_, lstar);
  if (kept > 400) return;
  int base = 0;
#pragma unroll
  for (int j = 0; j < 16; ++j) {
    const bool keep = ((vm >> j) & 1u) && ((int)((u[j] - umin) >> sh) >= D);
    const unsigned long long m = __ballot(keep);
    const int rk = base + __popcll(m & ((1ull << lane) - 1ull));
    if (keep) { const int ad = (rk & 3) * SEGCAP + (rk >> 2); scq[ad] = key2float(u[j]); ixq[ad] = (unsigned short)idv[j]; }
    base += __popcll(m);
  }
  if (lane == 0) {
    *(int4*)cnt4q = make_int4((base + 3) >> 2, (base + 2) >> 2, (base + 1) >> 2, base >> 2);
    *tauq = key2float(umin + ((unsigned)D << sh));
  }
  lds_fence();
}

#define IDX_GLDS(step, bufi) do { _Pragma("unroll") for (int r_ = 0; r_ < 4; ++r_) \
    __builtin_amdgcn_global_load_lds((const unsigned*)(ki + (size_t)(step) * 2048 + tid + 512 * r_), \
                                     (unsigned*)(ring + (bufi) * 2048 + tid + 512 * r_), 16, 0, 0); } while (0)

DI void indexer_item(const Params& p, int item) {
  const int tid = vtid(), lane = tid & 63, w = tid >> 6, g = w & 1, kg = w >> 1, hi = lane >> 5, c31 = lane & 31;
  float* sc = (float*)(smem + IX_SC);
  unsigned short* ix = (unsigned short*)(smem + IX_IX);
  uint4* ring = (uint4*)(smem + IX_RING);
  int* cnt = (int*)(smem + IX_CNT);
  volatile int* flag = (volatile int*)(smem + IX_FLAG);
  float* tauv = (float*)(smem + IX_TAU);
  const uint4* qi = (const uint4*)(p.ws + O_QI);
  const uint4* ki = (const uint4*)(p.ws + O_KI);
  const float* wi = (const float*)(p.ws + O_WI);
  const int t0 = 16 * item;
  bf16x8 a[2][4];
#pragma unroll
  for (int mt = 0; mt < 2; ++mt)
#pragma unroll
    for (int ks = 0; ks < 4; ++ks)
      a[mt][ks] = __builtin_bit_cast(bf16x8, qi[((size_t)((item >> 1) * 8 + (item & 1) * 4 + 2 * g + mt) * 4 + ks) * 64 + lane]);
  float* wl = (float*)(smem + IX_WL);
  if (tid < 128) wl[tid] = wi[(size_t)t0 * 8 + tid];
  float tau[2][2];
#pragma unroll
  for (int mt = 0; mt < 2; ++mt) { tau[mt][0] = -INFINITY; tau[mt][1] = -INFINITY; }
  if (tid < 64) cnt[tid] = 0;
  if (tid < 16) tauv[tid] = -INFINITY;
  int cntv[2][2] = {{0, 0}, {0, 0}};
  if (tid < 2) flag[tid] = 0;
  const int nsteps = (t0 + 16 + 255) >> 8;
  asm volatile("s_waitcnt vmcnt(0)" ::: "memory");
  IDX_GLDS(0, 0);
  if (nsteps > 1) { IDX_GLDS(1, 1); asm volatile("s_waitcnt vmcnt(4)" ::: "memory"); }
  else asm volatile("s_waitcnt vmcnt(0)" ::: "memory");
  __syncthreads();
  const f32x16 z = {0.f, 0.f, 0.f, 0.f, 0.f, 0.f, 0.f, 0.f, 0.f, 0.f, 0.f, 0.f, 0.f, 0.f, 0.f, 0.f};
  f32x16 Ca0, Ca1, Cb0, Cb1;
  {
    const uint4* cur = ring;
    const uint4* bp = cur + ((2 * kg + 0) * 4) * 64 + lane;
    bf16x8 b0 = __builtin_bit_cast(bf16x8, bp[0]), b1 = __builtin_bit_cast(bf16x8, bp[64]);
    bf16x8 b2 = __builtin_bit_cast(bf16x8, bp[128]), b3 = __builtin_bit_cast(bf16x8, bp[192]);
    Ca0 = MFMA(a[0][0], b0, z); Ca1 = MFMA(a[1][0], b0, z);
    Ca0 = MFMA(a[0][1], b1, Ca0); Ca1 = MFMA(a[1][1], b1, Ca1);
    Ca0 = MFMA(a[0][2], b2, Ca0); Ca1 = MFMA(a[1][2], b2, Ca1);
    Ca0 = MFMA(a[0][3], b3, Ca0); Ca1 = MFMA(a[1][3], b3, Ca1);
  }
  float4 wqa[2][2], wqb[2][2];
#pragma unroll
  for (int mt_ = 0; mt_ < 2; ++mt_)
#pragma unroll
    for (int aa_ = 0; aa_ < 2; ++aa_) {
      wqa[mt_][aa_] = *(const float4*)(wl + (8 * g + 4 * mt_ + 2 * hi + aa_) * 8);
      wqb[mt_][aa_] = *(const float4*)(wl + (8 * g + 4 * mt_ + 2 * hi + aa_) * 8 + 4);
    }
#define IDX_SCORE(Cx, mt_, aa_, sout) do { const float4 wa_ = wqa[mt_][aa_], wb_ = wqb[mt_][aa_]; \
    f32x2v r0_ = {relu_(Cx[8 * (aa_) + 0]), relu_(Cx[8 * (aa_) + 1])}, r1_ = {relu_(Cx[8 * (aa_) + 2]), relu_(Cx[8 * (aa_) + 3])}; \
    f32x2v r2_ = {relu_(Cx[8 * (aa_) + 4]), relu_(Cx[8 * (aa_) + 5])}, r3_ = {relu_(Cx[8 * (aa_) + 6]), relu_(Cx[8 * (aa_) + 7])}; \
    const f32x2v w0_ = {wa_.x, wa_.y}, w1_ = {wa_.z, wa_.w}, w2_ = {wb_.x, wb_.y}, w3_ = {wb_.z, wb_.w}; \
    f32x2v ac_ = r0_ * w0_; ac_ = r1_ * w1_ + ac_; ac_ = r2_ * w2_ + ac_; ac_ = r3_ * w3_ + ac_; \
    sout = ac_.x + ac_.y; } while (0)
  const unsigned ltm = (1u << c31) - 1u;
  const int tqb = t0 + 8 * g + 2 * hi;
  const int sb0 = ((8 * g + 2 * hi) * CAP + kg * SEGCAP) * 4;
#define IDX_APPEND(sval, mt_, aa_, keyv) do { \
    const bool pr_ = ((keyv) <= tqb + 4 * (mt_) + (aa_)) && ((sval) >= tau[mt_][aa_]); \
    const unsigned long long bm_ = __builtin_amdgcn_ballot_w64(pr_); \
    const unsigned half_ = hi ? (unsigned)(bm_ >> 32) : (unsigned)bm_; \
    const int pos_ = cntv[mt_][aa_] + __popc(half_ & ltm); \
    if (pr_) { const int bo_ = sb0 + (4 * (mt_) + (aa_)) * CAP * 4 + pos_ * 4; \
      *(float*)((char*)sc + bo_) = (sval); *(unsigned short*)((char*)ix + (bo_ >> 1)) = (unsigned short)(keyv); } \
    cntv[mt_][aa_] += __popc(half_); } while (0)
#define IDX_PUBLISH() do { if (c31 == 0) { _Pragma("unroll") for (int mt_ = 0; mt_ < 2; ++mt_) _Pragma("unroll") for (int aa_ = 0; aa_ < 2; ++aa_) \
    cnt[4 * (8 * g + 4 * mt_ + 2 * hi + aa_) + kg] = cntv[mt_][aa_]; } } while (0)
  for (int j = 0; j < nsteps; ++j) {
    const uint4* cur = ring + (j & 1) * 2048;
    {
      const uint4* bp = cur + ((2 * kg + 1) * 4) * 64 + lane;
      bf16x8 b0 = __builtin_bit_cast(bf16x8, bp[0]), b1 = __builtin_bit_cast(bf16x8, bp[64]);
      bf16x8 b2 = __builtin_bit_cast(bf16x8, bp[128]), b3 = __builtin_bit_cast(bf16x8, bp[192]);
      Cb0 = MFMA(a[0][0], b0, z); Cb1 = MFMA(a[1][0], b0, z);
      Cb0 = MFMA(a[0][1], b1, Cb0); Cb1 = MFMA(a[1][1], b1, Cb1);
      Cb0 = MFMA(a[0][2], b2, Cb0); Cb1 = MFMA(a[1][2], b2, Cb1);
      Cb0 = MFMA(a[0][3], b3, Cb0); Cb1 = MFMA(a[1][3], b3, Cb1);
    }
    {
      const int key = 256 * j + 64 * kg + c31;
      float s00, s01, s10, s11;
      IDX_SCORE(Ca0, 0, 0, s00); IDX_SCORE(Ca0, 0, 1, s01); IDX_SCORE(Ca1, 1, 0, s10); IDX_SCORE(Ca1, 1, 1, s11);
#pragma unroll
      for (int q_ = 0; q_ < 8; ++q_) { __builtin_amdgcn_sched_group_barrier(0x008, 1, 0); __builtin_amdgcn_sched_group_barrier(0x002, 9, 0); }
      IDX_APPEND(s00, 0, 0, key); IDX_APPEND(s01, 0, 1, key); IDX_APPEND(s10, 1, 0, key); IDX_APPEND(s11, 1, 1, key);
    }
    IDX_PUBLISH();
    {
      const int mxc = max(max(cntv[0][0], cntv[0][1]), max(cntv[1][0], cntv[1][1]));
      if (__ballot(mxc > SEGTRIG) != 0ull) { if (lane == 0) flag[j & 1] = j + 1; }
    }
    __syncthreads();
    if (flag[j & 1] == j + 1) {
      unsigned* hist = (unsigned*)(ring + (j & 1) * 2048) + w * 512;
#pragma unroll 1
      for (int k = 0; k < 2; ++k) {
        const int q = 2 * w + k;
        wave_compact(sc + q * CAP, ix + q * CAP, cnt + 4 * q, tauv + q, hist, lane);
        lds_fence();
        { const int4 cc = *(const int4*)(cnt + 4 * q); if (cc.x + cc.y + cc.z + cc.w > 400) wave_select(sc + q * CAP, ix + q * CAP, cnt + 4 * q, tauv + q, hist, lane, nullptr); }
      }
      __syncthreads();
#pragma unroll
      for (int mt = 0; mt < 2; ++mt)
#pragma unroll
        for (int aa = 0; aa < 2; ++aa) { const int ql = 8 * g + 4 * mt + 2 * hi + aa; tau[mt][aa] = tauv[ql]; cntv[mt][aa] = cnt[4 * ql + kg]; }
    }
    if (j + 2 < nsteps) IDX_GLDS(j + 2, j & 1);
    if (j + 1 < nsteps) {
      const uint4* nxt = ring + ((j + 1) & 1) * 2048;
      const uint4* bp = nxt + ((2 * kg + 0) * 4) * 64 + lane;
      bf16x8 b0 = __builtin_bit_cast(bf16x8, bp[0]), b1 = __builtin_bit_cast(bf16x8, bp[64]);
      bf16x8 b2 = __builtin_bit_cast(bf16x8, bp[128]), b3 = __builtin_bit_cast(bf16x8, bp[192]);
      Ca0 = MFMA(a[0][0], b0, z); Ca1 = MFMA(a[1][0], b0, z);
      Ca0 = MFMA(a[0][1], b1, Ca0); Ca1 = MFMA(a[1][1], b1, Ca1);
      Ca0 = MFMA(a[0][2], b2, Ca0); Ca1 = MFMA(a[1][2], b2, Ca1);
      Ca0 = MFMA(a[0][3], b3, Ca0); Ca1 = MFMA(a[1][3], b3, Ca1);
    }
    {
      const int key = 256 * j + 64 * kg + 32 + c31;
      float s00, s01, s10, s11;
      IDX_SCORE(Cb0, 0, 0, s00); IDX_SCORE(Cb0, 0, 1, s01); IDX_SCORE(Cb1, 1, 0, s10); IDX_SCORE(Cb1, 1, 1, s11);
#pragma unroll
      for (int q_ = 0; q_ < 8; ++q_) { __builtin_amdgcn_sched_group_barrier(0x008, 1, 0); __builtin_amdgcn_sched_group_barrier(0x002, 9, 0); }
      IDX_APPEND(s00, 0, 0, key); IDX_APPEND(s01, 0, 1, key); IDX_APPEND(s10, 1, 0, key); IDX_APPEND(s11, 1, 1, key);
    }
  }
  IDX_PUBLISH();
  __syncthreads();
  unsigned short* sel = (unsigned short*)(p.ws + O_SEL);
  unsigned* hist = (unsigned*)ring + w * 512;
#pragma unroll 1
  for (int k = 0; k < 2; ++k) {
    const int q = 2 * w + k;
    wave_select(sc + q * CAP, ix + q * CAP, cnt + 4 * q, tauv + q, hist, lane, sel + (size_t)(t0 + q) * 256);
  }
  __syncthreads();
}

DI void hgrn_a_item(const Params& p, int c, int h) {
  const int tid = vtid(), lane = tid & 63, w = tid >> 6, hi = lane >> 5, c31 = lane & 31;
  float* tot = (float*)smem;
  unsigned short* kT = (unsigned short*)(smem + 2048);
  unsigned short* vT = (unsigned short*)(smem + 2048 + 18432);
  const int seg = tid >> 7, k = tid & 127;
  const float* G = (const float*)(p.ws + O_G);
  const unsigned short* KK = (const unsigned short*)(p.ws + O_KK);
  const unsigned short* IA = (const unsigned short*)(p.ws + O_IA);
  const size_t rowbase = (size_t)(64 * c + 16 * seg);
  float b[16];
  {
    float run = 0.f;
#pragma unroll
    for (int i = 0; i < 16; ++i) { run += G[(rowbase + i) * 512 + 128 * h + k]; b[i] = run; }
    tot[seg * 128 + k] = run;
  }
  __syncthreads();
  float off = 0.f, blast = 0.f;
#pragma unroll
  for (int s2 = 0; s2 < 4; ++s2) { float tv = tot[s2 * 128 + k]; if (s2 < seg) off += tv; blast += tv; }
  {
    unsigned pk[8], pv[8];
#pragma unroll
    for (int i = 0; i < 16; i += 2) {
      float k0 = bf2f(KK[(rowbase + i) * 512 + 128 * h + k]) * __expf(blast - (b[i] + off));
      float k1 = bf2f(KK[(rowbase + i + 1) * 512 + 128 * h + k]) * __expf(blast - (b[i + 1] + off));
      pk[i >> 1] = cvtpk(k0, k1);
      unsigned v0 = IA[(rowbase + i) * 512 + 128 * h + k], v1 = IA[(rowbase + i + 1) * 512 + 128 * h + k];
      pv[i >> 1] = v0 | (v1 << 16);
    }
    uint4* dk = (uint4*)(kT + k * 72 + 16 * seg);
    dk[0] = make_uint4(pk[0], pk[1], pk[2], pk[3]); dk[1] = make_uint4(pk[4], pk[5], pk[6], pk[7]);
    uint4* dv = (uint4*)(vT + k * 72 + 16 * seg);
    dv[0] = make_uint4(pv[0], pv[1], pv[2], pv[3]); dv[1] = make_uint4(pv[4], pv[5], pv[6], pv[7]);
    if (seg == 0) ((float*)(p.ws + O_D))[(size_t)(c * 4 + h) * 128 + k] = __expf(blast);
  }
  __syncthreads();
  const int mt = w >> 1;
  f32x16 acc[2];
#pragma unroll
  for (int r = 0; r < 16; ++r) { acc[0][r] = 0.f; acc[1][r] = 0.f; }
#pragma unroll
  for (int ks = 0; ks < 4; ++ks) {
    bf16x8 af = __builtin_bit_cast(bf16x8, *(const uint4*)(kT + (32 * mt + c31) * 72 + 16 * ks + 8 * hi));
#pragma unroll
    for (int jn = 0; jn < 2; ++jn) {
      const int nt = 2 * (w & 1) + jn;
      bf16x8 bfv = __builtin_bit_cast(bf16x8, *(const uint4*)(vT + (32 * nt + c31) * 72 + 16 * ks + 8 * hi));
      acc[jn] = MFMA(af, bfv, acc[jn]);
    }
  }
  char* us = p.ws + O_US + (size_t)(c * 4 + h) * 32768;
#pragma unroll
  for (int jn = 0; jn < 2; ++jn) {
    const int nt = 2 * (w & 1) + jn;
    const int v = 32 * nt + c31;
#pragma unroll
    for (int gq = 0; gq < 4; ++gq) {
      const int k0 = 32 * mt + 8 * gq;
      const size_t unit = ((size_t)(v >> 5) * 8 + (k0 >> 4)) * 64 + (v & 31) + 32 * ((k0 >> 3) & 1);
      uint2 val;
      val.x = cvtpk(acc[jn][4 * gq + 0], acc[jn][4 * gq + 1]);
      val.y = cvtpk(acc[jn][4 * gq + 2], acc[jn][4 * gq + 3]);
      *(uint2*)(us + unit * 16 + 8 * hi) = val;
    }
  }
  __syncthreads();
}

DI void hgrn_scan(const Params& p) {
  const int tid = vtid();
  if (tid >= 128) return;
  for (int pid = blockIdx.x * 128 + tid; pid < 32768; pid += gridDim.x * 128) {
    const int q4 = pid & 3, unit = (pid >> 2) & 2047, h = pid >> 13;
    const int lanep = unit & 63, ks = (unit >> 6) & 7;
    const int k = ks * 16 + 8 * (lanep >> 5) + 2 * q4;
    unsigned* us = (unsigned*)(p.ws + O_US) + (size_t)h * 8192 + unit * 4 + q4;
    const float* dd = (const float*)(p.ws + O_D) + h * 128 + k;
    float s0 = 0.f, s1 = 0.f;
    unsigned uv[16], un[16];
    float2 dv[16], dn[16];
#pragma unroll
    for (int i = 0; i < 16; ++i) { uv[i] = us[(size_t)i * 32768]; dv[i] = *(const float2*)(dd + (size_t)i * 512); }
#pragma unroll 1
    for (int c0 = 0; c0 < 256; c0 += 16) {
      const int cn = (c0 + 16 < 256) ? c0 + 16 : c0;
#pragma unroll
      for (int i = 0; i < 16; ++i) { un[i] = us[(size_t)(cn + i) * 32768]; dn[i] = *(const float2*)(dd + (size_t)(cn + i) * 512); }
      asm volatile("" ::: "memory");
#pragma unroll
      for (int i = 0; i < 16; ++i) {
        us[(size_t)(c0 + i) * 32768] = cvtpk(s0, s1);
        s0 = fmaf(dv[i].x, s0, bflo(uv[i]));
        s1 = fmaf(dv[i].y, s1, bfhi(uv[i]));
      }
      asm volatile("" ::: "memory");
#pragma unroll
      for (int i = 0; i < 16; ++i) { uv[i] = un[i]; dv[i] = dn[i]; }
    }
  }
}

constexpr int AT_LUT = 0, AT_RB = 512, AT_WAVE = 2048, AT_WSZ = 8192 + 1024 + 16 * 528;
DI void attn_setup() {
  const int tid = vtid();
  int* lut = (int*)(smem + AT_LUT);
  if (tid < 128) {
    int d = tid;
    int bk;
    if (d < 16) bk = d;
    else {
      float df = (float)d;
      int lg = 16 + (int)(logf(df / 16.f) / 2.0794415416798357f * 16.f);
      bk = lg < 31 ? lg : 31;
    }
    lut[tid] = bk;
  }
}
DI float dppf(float v, int ctrl_sel) {
  const int iv = __builtin_bit_cast(int, v);
  int r;
  if (ctrl_sel == 0) r = __builtin_amdgcn_update_dpp(0, iv, 0xB1, 0xf, 0xf, false);
  else if (ctrl_sel == 1) r = __builtin_amdgcn_update_dpp(0, iv, 0x4E, 0xf, 0xf, false);
  else r = __builtin_amdgcn_update_dpp(0, iv, 0x141, 0xf, 0xf, false);
  return __builtin_bit_cast(float, r);
}
DI float sum8(float v) { v += dppf(v, 0); v += dppf(v, 1); v += dppf(v, 2); return v; }
DI float max8(float v) { v = fmaxf(v, dppf(v, 0)); v = fmaxf(v, dppf(v, 1)); v = fmaxf(v, dppf(v, 2)); return v; }

DI size_t prob_off(int t) {
  return t < 8192 ? O_MG + (size_t)t * 4096 : (t < 12288 ? O_AA + (size_t)(t - 8192) * 4096 : O_QI + (size_t)(t - 12288) * 4096);
}
#define MFMA8S(a, b, c) __builtin_amdgcn_mfma_f32_16x16x32_fp8_fp8((a), (b), (c), 0, 0, 0)
typedef __attribute__((ext_vector_type(4))) float f32x4v;
constexpr int AT_KROW = 528;
struct QKPF { int s0, s1, s2, s3; uint4 q0, q1; };
DI void qk_fetch(const Params& p, int t, int lane, QKPF& f) {
  const int nsel = t + 1 < 256 ? t + 1 : 256;
  const unsigned short* sel = (const unsigned short*)(p.ws + O_SEL) + (size_t)t * 256;
  f.s0 = lane < nsel ? (int)sel[lane] : 0; f.s1 = lane + 64 < nsel ? (int)sel[lane + 64] : 0;
  f.s2 = lane + 128 < nsel ? (int)sel[lane + 128] : 0; f.s3 = lane + 192 < nsel ? (int)sel[lane + 192] : 0;
  const unsigned short* qp = (const unsigned short*)(p.ws + O_QB) + (size_t)t * 512 + (lane & 7) * 64 + 8 * (lane >> 4);
  f.q0 = *(const uint4*)qp; f.q1 = *(const uint4*)(qp + 32);
}
DI void attn_query(const Params& p, int t, int tnext, int w, int lane, QKPF& pf) {
  const int h = lane >> 3, dg = lane & 7, n15 = lane & 15, quad = lane >> 4, hi = lane >> 5, c31 = lane & 31;
  const int* lut = (const int*)(smem + AT_LUT);
  const float* rb = (const float*)(smem + AT_RB);
  float* lgw = (float*)(smem + AT_WAVE + w * AT_WSZ);
  int* ixw = (int*)(smem + AT_WAVE + w * AT_WSZ + 8192);
  char* kst = smem + AT_WAVE + w * AT_WSZ + 9216;
  const int nsel = t + 1 < 256 ? t + 1 : 256;
  ixw[lane] = pf.s0; ixw[lane + 64] = pf.s1; ixw[lane + 128] = pf.s2; ixw[lane + 192] = pf.s3;
  const uint4 qcur0 = pf.q0, qcur1 = pf.q1;
  qk_fetch(p, tnext < L_ ? tnext : t, lane, pf);
  long qreg[2];
  {
#pragma unroll
    for (int c = 0; c < 2; ++c) {
      const uint4 qv = c == 0 ? qcur0 : qcur1;
      int w0 = __builtin_amdgcn_cvt_pk_fp8_f32(bflo(qv.x) * 8.f, bfhi(qv.x) * 8.f, 0, false);
      w0 = __builtin_amdgcn_cvt_pk_fp8_f32(bflo(qv.y) * 8.f, bfhi(qv.y) * 8.f, w0, true);
      int w1 = __builtin_amdgcn_cvt_pk_fp8_f32(bflo(qv.z) * 8.f, bfhi(qv.z) * 8.f, 0, false);
      w1 = __builtin_amdgcn_cvt_pk_fp8_f32(bflo(qv.w) * 8.f, bfhi(qv.w) * 8.f, w1, true);
      const long v = (long)(((unsigned long long)(unsigned)w1 << 32) | (unsigned long long)(unsigned)w0);
      qreg[c] = (n15 < 8) ? v : 0L;
    }
  }
  long bsel[16];
#pragma unroll
  for (int ks = 0; ks < 16; ++ks) bsel[ks] = (n15 == (ks >> 1)) ? qreg[ks & 1] : 0L;
  lds_fence();
  const uint4* KB16 = (const uint4*)(p.ws + O_KB);
  const uint2* VB = (const uint2*)(p.ws + O_VB);
  const int ntile = (nsel + 15) >> 4;
#define AT_KMMA(kt_) do { f32x4v acc0 = {0.f, 0.f, 0.f, 0.f}, acc1 = acc0, acc2 = acc0, acc3 = acc0; \
    const char* ar = kst + n15 * AT_KROW + 8 * quad; \
    _Pragma("unroll") for (int ks = 0; ks < 16; ks += 4) { \
      acc0 = MFMA8S(*(const long*)(ar + 32 * ks), bsel[ks], acc0); \
      acc1 = MFMA8S(*(const long*)(ar + 32 * ks + 32), bsel[ks + 1], acc1); \
      acc2 = MFMA8S(*(const long*)(ar + 32 * ks + 64), bsel[ks + 2], acc2); \
      acc3 = MFMA8S(*(const long*)(ar + 32 * ks + 96), bsel[ks + 3], acc3); } \
    const f32x4v acc = (acc0 + acc1) + (acc2 + acc3); \
    if (n15 < 8) { _Pragma("unroll") for (int i = 0; i < 4; ++i) lgw[(16 * (kt_) + 4 * quad + i) * 8 + n15] = acc[i] * 0.125f; } \
    cbar(); } while (0)
  uint4 kgA0, kgA1, kgA2, kgA3, kgA4, kgA5, kgA6, kgA7, kgB0, kgB1, kgB2, kgB3, kgB4, kgB5, kgB6, kgB7, kgC0, kgC1, kgC2, kgC3, kgC4, kgC5, kgC6, kgC7;
    { const int tl_ = (0) < ntile ? (0) : ntile - 1;
      const int4 ia_ = *(const int4*)(ixw + 16 * tl_ + 8 * hi), ib_ = *(const int4*)(ixw + 16 * tl_ + 8 * hi + 4);
      kgA0 = KB16[(size_t)ia_.x * 32 + c31]; kgA1 = KB16[(size_t)ia_.y * 32 + c31]; kgA2 = KB16[(size_t)ia_.z * 32 + c31]; kgA3 = KB16[(size_t)ia_.w * 32 + c31];
      kgA4 = KB16[(size_t)ib_.x * 32 + c31]; kgA5 = KB16[(size_t)ib_.y * 32 + c31]; kgA6 = KB16[(size_t)ib_.z * 32 + c31]; kgA7 = KB16[(size_t)ib_.w * 32 + c31]; }
    { const int tl_ = (1) < ntile ? (1) : ntile - 1;
      const int4 ia_ = *(const int4*)(ixw + 16 * tl_ + 8 * hi), ib_ = *(const int4*)(ixw + 16 * tl_ + 8 * hi + 4);
      kgB0 = KB16[(size_t)ia_.x * 32 + c31]; kgB1 = KB16[(size_t)ia_.y * 32 + c31]; kgB2 = KB16[(size_t)ia_.z * 32 + c31]; kgB3 = KB16[(size_t)ia_.w * 32 + c31];
      kgB4 = KB16[(size_t)ib_.x * 32 + c31]; kgB5 = KB16[(size_t)ib_.y * 32 + c31]; kgB6 = KB16[(size_t)ib_.z * 32 + c31]; kgB7 = KB16[(size_t)ib_.w * 32 + c31]; }
    { const int tl_ = (2) < ntile ? (2) : ntile - 1;
      const int4 ia_ = *(const int4*)(ixw + 16 * tl_ + 8 * hi), ib_ = *(const int4*)(ixw + 16 * tl_ + 8 * hi + 4);
      kgC0 = KB16[(size_t)ia_.x * 32 + c31]; kgC1 = KB16[(size_t)ia_.y * 32 + c31]; kgC2 = KB16[(size_t)ia_.z * 32 + c31]; kgC3 = KB16[(size_t)ia_.w * 32 + c31];
      kgC4 = KB16[(size_t)ib_.x * 32 + c31]; kgC5 = KB16[(size_t)ib_.y * 32 + c31]; kgC6 = KB16[(size_t)ib_.z * 32 + c31]; kgC7 = KB16[(size_t)ib_.w * 32 + c31]; }
  for (int kt = 0; kt < ntile; kt += 3) {
    { char* wr = kst + (8 * hi) * AT_KROW + c31 * 16; *(uint4*)(wr + 0 * AT_KROW) = kgA0; *(uint4*)(wr + 1 * AT_KROW) = kgA1; *(uint4*)(wr + 2 * AT_KROW) = kgA2; *(uint4*)(wr + 3 * AT_KROW) = kgA3; *(uint4*)(wr + 4 * AT_KROW) = kgA4; *(uint4*)(wr + 5 * AT_KROW) = kgA5; *(uint4*)(wr + 6 * AT_KROW) = kgA6; *(uint4*)(wr + 7 * AT_KROW) = kgA7; }
    if (((kt) + 3) < ntile) { const int tl_ = ((kt) + 3);
      const int4 ia_ = *(const int4*)(ixw + 16 * tl_ + 8 * hi), ib_ = *(const int4*)(ixw + 16 * tl_ + 8 * hi + 4);
      kgA0 = KB16[(size_t)ia_.x * 32 + c31]; kgA1 = KB16[(size_t)ia_.y * 32 + c31]; kgA2 = KB16[(size_t)ia_.z * 32 + c31]; kgA3 = KB16[(size_t)ia_.w * 32 + c31];
      kgA4 = KB16[(size_t)ib_.x * 32 + c31]; kgA5 = KB16[(size_t)ib_.y * 32 + c31]; kgA6 = KB16[(size_t)ib_.z * 32 + c31]; kgA7 = KB16[(size_t)ib_.w * 32 + c31]; }
    cbar();
    AT_KMMA(kt);
    if (kt + 1 < ntile) {
    { char* wr = kst + (8 * hi) * AT_KROW + c31 * 16; *(uint4*)(wr + 0 * AT_KROW) = kgB0; *(uint4*)(wr + 1 * AT_KROW) = kgB1; *(uint4*)(wr + 2 * AT_KROW) = kgB2; *(uint4*)(wr + 3 * AT_KROW) = kgB3; *(uint4*)(wr + 4 * AT_KROW) = kgB4; *(uint4*)(wr + 5 * AT_KROW) = kgB5; *(uint4*)(wr + 6 * AT_KROW) = kgB6; *(uint4*)(wr + 7 * AT_KROW) = kgB7; }
    if (((kt + 1) + 3) < ntile) { const int tl_ = ((kt + 1) + 3);
      const int4 ia_ = *(const int4*)(ixw + 16 * tl_ + 8 * hi), ib_ = *(const int4*)(ixw + 16 * tl_ + 8 * hi + 4);
      kgB0 = KB16[(size_t)ia_.x * 32 + c31]; kgB1 = KB16[(size_t)ia_.y * 32 + c31]; kgB2 = KB16[(size_t)ia_.z * 32 + c31]; kgB3 = KB16[(size_t)ia_.w * 32 + c31];
      kgB4 = KB16[(size_t)ib_.x * 32 + c31]; kgB5 = KB16[(size_t)ib_.y * 32 + c31]; kgB6 = KB16[(size_t)ib_.z * 32 + c31]; kgB7 = KB16[(size_t)ib_.w * 32 + c31]; }
    cbar();
    AT_KMMA(kt + 1);
    }
    if (kt + 2 < ntile) {
    { char* wr = kst + (8 * hi) * AT_KROW + c31 * 16; *(uint4*)(wr + 0 * AT_KROW) = kgC0; *(uint4*)(wr + 1 * AT_KROW) = kgC1; *(uint4*)(wr + 2 * AT_KROW) = kgC2; *(uint4*)(wr + 3 * AT_KROW) = kgC3; *(uint4*)(wr + 4 * AT_KROW) = kgC4; *(uint4*)(wr + 5 * AT_KROW) = kgC5; *(uint4*)(wr + 6 * AT_KROW) = kgC6; *(uint4*)(wr + 7 * AT_KROW) = kgC7; }
    if (((kt + 2) + 3) < ntile) { const int tl_ = ((kt + 2) + 3);
      const int4 ia_ = *(const int4*)(ixw + 16 * tl_ + 8 * hi), ib_ = *(const int4*)(ixw + 16 * tl_ + 8 * hi + 4);
      kgC0 = KB16[(size_t)ia_.x * 32 + c31]; kgC1 = KB16[(size_t)ia_.y * 32 + c31]; kgC2 = KB16[(size_t)ia_.z * 32 + c31]; kgC3 = KB16[(size_t)ia_.w * 32 + c31];
      kgC4 = KB16[(size_t)ib_.x * 32 + c31]; kgC5 = KB16[(size_t)ib_.y * 32 + c31]; kgC6 = KB16[(size_t)ib_.z * 32 + c31]; kgC7 = KB16[(size_t)ib_.w * 32 + c31]; }
    cbar();
    AT_KMMA(kt + 2);
    }
  }
  lds_fence();
  const int ngroups = (nsel + 7) >> 3;
  float mx = -INFINITY;
#pragma unroll 8
  for (int i = 0; i < 32; ++i) {
    const int kk = 8 * i + dg;
    const int myidx = ixw[kk];
    const int dist = t - myidx;
    const int bk = dist < 128 ? lut[dist < 0 ? 0 : dist] : 31;
    const float raw = lgw[kk * 8 + h];
    const float lgt = (kk < nsel) ? raw + rb[bk * 8 + h] : -INFINITY;
    lgw[kk * 8 + h] = lgt;
    mx = fmaxf(mx, lgt);
  }
  mx = max8(mx);
  float sum = 0.f;
#pragma unroll 8
  for (int i = 0; i < 32; ++i) {
    const float pv = __expf(lgw[(8 * i + dg) * 8 + h] - mx);
    sum += pv;
    lgw[(8 * i + dg) * 8 + h] = pv;
  }
  sum = sum8(sum);
  {
    const float inv = 1.f / sum;
#pragma unroll 8
    for (int i = 0; i < 32; ++i) lgw[(8 * i + dg) * 8 + h] *= inv;
  }
  lds_fence();
  {
    uint4 pk[4];
#pragma unroll
    for (int k = 0; k < 4; ++k) {
      const float4 a_ = *(const float4*)(lgw + (4 * lane + k) * 8), b_ = *(const float4*)(lgw + (4 * lane + k) * 8 + 4);
      pk[k] = make_uint4(cvtpk(a_.x, a_.y), cvtpk(a_.z, a_.w), cvtpk(b_.x, b_.y), cvtpk(b_.z, b_.w));
    }
    uint4* pdst = (uint4*)(p.ws + prob_off(t)) + lane * 4;
    pdst[0] = pk[0]; pdst[1] = pk[1]; pdst[2] = pk[2]; pdst[3] = pk[3];
  }
  lds_fence();
}

DI void attn_pv_query(const Params& p, int t, int w, int lane) {
  const int half = lane >> 5, l5 = lane & 31, h = l5 >> 2;
  unsigned short* pl = (unsigned short*)(smem + AT_WAVE + w * AT_WSZ);
  int* ixw = (int*)(smem + AT_WAVE + w * AT_WSZ + 8192);
  const int nsel = t + 1 < 256 ? t + 1 : 256;
  const unsigned short* sel = (const unsigned short*)(p.ws + O_SEL) + (size_t)t * 256;
#pragma unroll
  for (int j = 0; j < 4; ++j) {
    const int pos = lane + 64 * j;
    ixw[pos] = pos < nsel ? (int)sel[pos] : 0;
  }
  {
    const uint4* psrc = (const uint4*)(p.ws + prob_off(t)) + lane * 4;
    uint4* pd = (uint4*)pl + lane * 4;
    const uint4 a0 = psrc[0], a1 = psrc[1], a2 = psrc[2], a3 = psrc[3];
    pd[0] = a0; pd[1] = a1; pd[2] = a2; pd[3] = a3;
  }
  lds_fence();
  const uint4* VB4 = (const uint4*)(p.ws + O_VB) + l5;
  f32x2v o0 = {0.f, 0.f}, o1 = {0.f, 0.f}, o2 = {0.f, 0.f}, o3 = {0.f, 0.f}, o4 = {0.f, 0.f}, o5 = {0.f, 0.f}, o6 = {0.f, 0.f}, o7 = {0.f, 0.f};
  uint4 kc[8], kn[8];
#define AT_VLOAD16(dst, ib) do { _Pragma("unroll") for (int q_ = 0; q_ < 4; ++q_) { const int4 i_ = *(const int4*)(ixw + (ib) + 4 * q_); \
    dst[2 * q_ + 0] = VB4[(size_t)(half ? i_.y : i_.x) * 32]; dst[2 * q_ + 1] = VB4[(size_t)(half ? i_.w : i_.z) * 32]; } } while (0)
  const int ng16 = (nsel + 15) >> 4;
  AT_VLOAD16(kc, 0);
  const unsigned short* plh = pl + half * 8 + h;
  for (int i = 0; i < ng16; ++i) {
    { const int nx = (i + 1 < ng16) ? i + 1 : i; AT_VLOAD16(kn, 16 * nx); }
#pragma unroll
    for (int q = 0; q < 8; ++q) {
      const float pb = bf2f(plh[(16 * i + 2 * q) * 8]);
      const f32x2v pb2 = {pb, pb};
      o0 = __builtin_amdgcn_cvt_pk_f32_fp8(kc[q].x, false) * pb2 + o0;
      o1 = __builtin_amdgcn_cvt_pk_f32_fp8(kc[q].x, true) * pb2 + o1;
      o2 = __builtin_amdgcn_cvt_pk_f32_fp8(kc[q].y, false) * pb2 + o2;
      o3 = __builtin_amdgcn_cvt_pk_f32_fp8(kc[q].y, true) * pb2 + o3;
      o4 = __builtin_amdgcn_cvt_pk_f32_fp8(kc[q].z, false) * pb2 + o4;
      o5 = __builtin_amdgcn_cvt_pk_f32_fp8(kc[q].z, true) * pb2 + o5;
      o6 = __builtin_amdgcn_cvt_pk_f32_fp8(kc[q].w, false) * pb2 + o6;
      o7 = __builtin_amdgcn_cvt_pk_f32_fp8(kc[q].w, true) * pb2 + o7;
    }
#pragma unroll
    for (int q = 0; q < 8; ++q) kc[q] = kn[q];
  }
#define AT_HSUM(o) do { o.x += __shfl_xor(o.x, 32); o.y += __shfl_xor(o.y, 32); } while (0)
  AT_HSUM(o0); AT_HSUM(o1); AT_HSUM(o2); AT_HSUM(o3); AT_HSUM(o4); AT_HSUM(o5); AT_HSUM(o6); AT_HSUM(o7);
  if (half == 0) {
    const uint4 z0 = ((const uint4*)(p.ws + O_ZB))[(size_t)t * 64 + 2 * l5], z1 = ((const uint4*)(p.ws + O_ZB))[(size_t)t * 64 + 2 * l5 + 1];
    uint4 v0, v1;
    v0.x = cvtpk(o0.x * bflo(z0.x), o0.y * bfhi(z0.x)); v0.y = cvtpk(o1.x * bflo(z0.y), o1.y * bfhi(z0.y));
    v0.z = cvtpk(o2.x * bflo(z0.z), o2.y * bfhi(z0.z)); v0.w = cvtpk(o3.x * bflo(z0.w), o3.y * bfhi(z0.w));
    v1.x = cvtpk(o4.x * bflo(z1.x), o4.y * bfhi(z1.x)); v1.y = cvtpk(o5.x * bflo(z1.y), o5.y * bfhi(z1.y));
    v1.z = cvtpk(o6.x * bflo(z1.z), o6.y * bfhi(z1.z)); v1.w = cvtpk(o7.x * bflo(z1.w), o7.y * bfhi(z1.w));
    ((uint4*)(p.ws + O_AB))[tiled_unit(t, l5 * 16, 32)] = v0;
    ((uint4*)(p.ws + O_AB))[tiled_unit(t, l5 * 16 + 8, 32)] = v1;
  }
  lds_fence();
}

constexpr int HC_B = 0;
constexpr int HC_QT = 33792;
constexpr int HC_QH = HC_QT + 17408;
constexpr int HC_KH = HC_QH + 17408;
constexpr int HC_VT = HC_KH + 17408;
constexpr int HC_P = HC_VT + 18432;
constexpr int HC_TOT = HC_P + 9216;
DI void hgrn_c_item(const Params& p, int layer, int c, int h) {
  const int tid = vtid(), lane = tid & 63, w = tid >> 6, hi = lane >> 5, c31 = lane & 31;
  float* bL = (float*)(smem + HC_B);
  unsigned short* qT = (unsigned short*)(smem + HC_QT);
  unsigned short* qH = (unsigned short*)(smem + HC_QH);
  unsigned short* kH = (unsigned short*)(smem + HC_KH);
  unsigned short* vT = (unsigned short*)(smem + HC_VT);
  unsigned short* P = (unsigned short*)(smem + HC_P);
  float* tot = (float*)(smem + HC_TOT);
  const float* G = (const float*)(p.ws + O_G);
  const unsigned short* KK = (const unsigned short*)(p.ws + O_KK);
  const unsigned short* IA = (const unsigned short*)(p.ws + O_IA);
  const unsigned short* QA = (const unsigned short*)(p.ws + O_QA);
  const int mt = w >> 2, nv = w & 3;
  const uint4* us = (const uint4*)(p.ws + O_US + (size_t)(c * 4 + h) * 32768);
  uint4 sfr[8];
#pragma unroll
  for (int ks = 0; ks < 8; ++ks) sfr[ks] = us[(nv * 8 + ks) * 64 + lane];
  uint4 qv_pre[2], kv_pre[2];
#pragma unroll
  for (int rep = 0; rep < 2; ++rep) {
    const int pr = tid + 512 * rep, t = pr >> 4, oc = pr & 15;
    qv_pre[rep] = *(const uint4*)(QA + (size_t)(64 * c + t) * 512 + 128 * h + oc * 8);
    kv_pre[rep] = *(const uint4*)(KK + (size_t)(64 * c + t) * 512 + 128 * h + oc * 8);
  }
  const uint4 z0_pre = *(const uint4*)((const unsigned short*)(p.ws + O_ZA) + (size_t)(64 * c + (tid >> 3)) * 512 + 128 * h + 16 * (tid & 7));
  const uint4 z1_pre = *(const uint4*)((const unsigned short*)(p.ws + O_ZA) + (size_t)(64 * c + (tid >> 3)) * 512 + 128 * h + 16 * (tid & 7) + 8);
  {
    const int seg = tid >> 7, k = tid & 127;
    const size_t rowbase = (size_t)(64 * c + 16 * seg);
    float b[16];
    float run = 0.f;
#pragma unroll
    for (int i = 0; i < 16; ++i) { run += G[(rowbase + i) * 512 + 128 * h + k]; b[i] = run; }
    tot[seg * 128 + k] = run;
    unsigned pv[8];
#pragma unroll
    for (int i = 0; i < 16; i += 2) {
      unsigned v0 = IA[(rowbase + i) * 512 + 128 * h + k], v1 = IA[(rowbase + i + 1) * 512 + 128 * h + k];
      pv[i >> 1] = v0 | (v1 << 16);
    }
    uint4* dv = (uint4*)(vT + k * 72 + 16 * seg);
    dv[0] = make_uint4(pv[0], pv[1], pv[2], pv[3]); dv[1] = make_uint4(pv[4], pv[5], pv[6], pv[7]);
    __syncthreads();
    float off = 0.f;
#pragma unroll
    for (int s2 = 0; s2 < 4; ++s2) { float tv = tot[s2 * 128 + k]; if (s2 < seg) off += tv; }
#pragma unroll
    for (int i = 0; i < 16; ++i) bL[(16 * seg + i) * 132 + k] = b[i] + off;
  }
  __syncthreads();
#pragma unroll
  for (int rep = 0; rep < 2; ++rep) {
    const int pr = tid + 512 * rep, t = pr >> 4, oc = pr & 15;
    const float4 b0 = *(const float4*)(bL + t * 132 + oc * 8), b1 = *(const float4*)(bL + t * 132 + oc * 8 + 4);
    const float4 r0 = *(const float4*)(bL + 31 * 132 + oc * 8), r1 = *(const float4*)(bL + 31 * 132 + oc * 8 + 4);
    const uint4 qv = qv_pre[rep];
    const uint4 kv = kv_pre[rep];
    const float bb[8] = {b0.x, b0.y, b0.z, b0.w, b1.x, b1.y, b1.z, b1.w};
    const float rr[8] = {r0.x, r0.y, r0.z, r0.w, r1.x, r1.y, r1.z, r1.w};
    const float qq[8] = {bflo(qv.x), bfhi(qv.x), bflo(qv.y), bfhi(qv.y), bflo(qv.z), bfhi(qv.z), bflo(qv.w), bfhi(qv.w)};
    const float kq[8] = {bflo(kv.x), bfhi(kv.x), bflo(kv.y), bfhi(kv.y), bflo(kv.z), bfhi(kv.z), bflo(kv.w), bfhi(kv.w)};
    float a1[8], a2[8], a3[8];
#pragma unroll
    for (int e = 0; e < 8; ++e) {
      a1[e] = qq[e] * __expf(bb[e]);
      a2[e] = qq[e] * __expf(bb[e] - rr[e]);
      a3[e] = kq[e] * __expf(rr[e] - bb[e]);
    }
    *(uint4*)(qT + t * 136 + oc * 8) = make_uint4(cvtpk(a1[0], a1[1]), cvtpk(a1[2], a1[3]), cvtpk(a1[4], a1[5]), cvtpk(a1[6], a1[7]));
    *(uint4*)(qH + t * 136 + oc * 8) = make_uint4(cvtpk(a2[0], a2[1]), cvtpk(a2[2], a2[3]), cvtpk(a2[4], a2[5]), cvtpk(a2[6], a2[7]));
    *(uint4*)(kH + t * 136 + oc * 8) = make_uint4(cvtpk(a3[0], a3[1]), cvtpk(a3[2], a3[3]), cvtpk(a3[4], a3[5]), cvtpk(a3[6], a3[7]));
  }
  __syncthreads();
  if (w < 4) {
    const int ms = w >> 1, ntq = w & 1;
    f32x16 sacc;
#pragma unroll
    for (int r = 0; r < 16; ++r) sacc[r] = 0.f;
#pragma unroll
    for (int ks = 0; ks < 8; ++ks) {
      bf16x8 af = __builtin_bit_cast(bf16x8, *(const uint4*)(kH + (32 * ms + c31) * 136 + 16 * ks + 8 * hi));
      bf16x8 bfv = __builtin_bit_cast(bf16x8, *(const uint4*)(qH + (32 * ntq + c31) * 136 + 16 * ks + 8 * hi));
      sacc = MFMA(af, bfv, sacc);
    }
    const int t = 32 * ntq + c31;
#pragma unroll
    for (int gq = 0; gq < 4; ++gq) {
      const int s0 = 32 * ms + 8 * gq + 4 * hi;
      float v0 = (s0 + 0 <= t) ? sacc[4 * gq + 0] : 0.f;
      float v1 = (s0 + 1 <= t) ? sacc[4 * gq + 1] : 0.f;
      float v2 = (s0 + 2 <= t) ? sacc[4 * gq + 2] : 0.f;
      float v3 = (s0 + 3 <= t) ? sacc[4 * gq + 3] : 0.f;
      uint2 val; val.x = cvtpk(v0, v1); val.y = cvtpk(v2, v3);
      *(uint2*)(P + t * 72 + s0) = val;
    }
  }
  f32x16 oacc;
#pragma unroll
  for (int r = 0; r < 16; ++r) oacc[r] = 0.f;
#pragma unroll
  for (int ks = 0; ks < 8; ++ks) {
    bf16x8 af = __builtin_bit_cast(bf16x8, *(const uint4*)(qT + (32 * mt + c31) * 136 + 16 * ks + 8 * hi));
    oacc = MFMA(af, __builtin_bit_cast(bf16x8, sfr[ks]), oacc);
  }
  __syncthreads();
#pragma unroll
  for (int ks = 0; ks < 4; ++ks) {
    bf16x8 af = __builtin_bit_cast(bf16x8, *(const uint4*)(P + (32 * mt + c31) * 72 + 16 * ks + 8 * hi));
    bf16x8 bfv = __builtin_bit_cast(bf16x8, *(const uint4*)(vT + (32 * nv + c31) * 72 + 16 * ks + 8 * hi));
    oacc = MFMA(af, bfv, oacc);
  }
  float* oL = bL;
#pragma unroll
  for (int r = 0; r < 16; ++r) oL[(32 * mt + crow(r, hi)) * 132 + 32 * nv + c31] = oacc[r];
  __syncthreads();
  {
    const int t = tid >> 3, sg = tid & 7;
    float ov[16];
#pragma unroll
    for (int e = 0; e < 16; e += 4) {
      const float4 f = *(const float4*)(oL + t * 132 + 16 * sg + e);
      ov[e] = f.x; ov[e + 1] = f.y; ov[e + 2] = f.z; ov[e + 3] = f.w;
    }
    float ss = 0.f;
#pragma unroll
    for (int e = 0; e < 16; ++e) ss = fmaf(ov[e], ov[e], ss);
    ss += __shfl_xor(ss, 1);
    ss += __shfl_xor(ss, 2);
    ss += __shfl_xor(ss, 4);
    const float rs = rsqrtf(ss * (1.f / 128.f) + 1e-6f);
    const int tg = 64 * c + t, k0 = 128 * h + 16 * sg;
    const float* ng = p.norm_a_g + (size_t)layer * 512 + k0;
    const uint4 z0 = z0_pre, z1 = z1_pre;
    const float zz[16] = {bflo(z0.x), bfhi(z0.x), bflo(z0.y), bfhi(z0.y), bflo(z0.z), bfhi(z0.z), bflo(z0.w), bfhi(z0.w),
                          bflo(z1.x), bfhi(z1.x), bflo(z1.y), bfhi(z1.y), bflo(z1.z), bfhi(z1.z), bflo(z1.w), bfhi(z1.w)};
    float rr[16];
#pragma unroll
    for (int e = 0; e < 16; ++e) rr[e] = ov[e] * rs * ng[e] * zz[e];
    uint4* aa = (uint4*)(p.ws + O_AA);
    aa[tiled_unit(tg, k0, 32)] = make_uint4(cvtpk(rr[0], rr[1]), cvtpk(rr[2], rr[3]), cvtpk(rr[4], rr[5]), cvtpk(rr[6], rr[7]));
    aa[tiled_unit(tg, k0 + 8, 32)] = make_uint4(cvtpk(rr[8], rr[9]), cvtpk(rr[10], rr[11]), cvtpk(rr[12], rr[13]), cvtpk(rr[14], rr[15]));
  }
  __syncthreads();
}

DI void acc_to_lds_bf16(f32x16 (&acc)[2][2], unsigned short* tile) {
  const int tid = vtid(), lane = tid & 63, w = tid >> 6, wm = w >> 1, wn = w & 1, hi = lane >> 5, c31 = lane & 31;
#pragma unroll
  for (int i = 0; i < 2; ++i)
#pragma unroll
    for (int j = 0; j < 2; ++j)
#pragma unroll
      for (int r = 0; r < 16; ++r)
        tile[(64 * wm + 32 * i + crow(r, hi)) * 128 + 64 * wn + 32 * j + c31] = f2bf(acc[i][j][r]);
}
DI void p5_tile(const Params& p, int mb, int nt) {
  const int tid = vtid(), lane = tid & 63, w = tid >> 6, wm = w >> 1, wn = w & 1, hi = lane >> 5, c31 = lane & 31;
  f32x16 acc[2][2];
  zero_acc(acc);
  gemm_core((const uint4*)(p.ws + O_AA), mb * 8, (const uint4*)(p.ws + O_WUA), nt * 4, 32, acc, (uint4*)smem);
  unsigned uap[2][2][8];
#pragma unroll
  for (int i = 0; i < 2; ++i)
#pragma unroll
    for (int j = 0; j < 2; ++j)
#pragma unroll
      for (int r = 0; r < 16; r += 2) uap[i][j][r >> 1] = cvtpk(acc[i][j][r], acc[i][j][r + 1]);
  zero_acc(acc);
  gemm_core((const uint4*)(p.ws + O_AB), mb * 8, (const uint4*)(p.ws + O_WUB), nt * 4, 32, acc, (uint4*)smem);
  unsigned short* tA = (unsigned short*)smem;
  unsigned short* tB = (unsigned short*)(smem + 65536);
#pragma unroll
  for (int i = 0; i < 2; ++i)
#pragma unroll
    for (int j = 0; j < 2; ++j)
#pragma unroll
      for (int r = 0; r < 16; r += 2) {
        const int o0 = (64 * wm + 32 * i + crow(r, hi)) * 128 + 64 * wn + 32 * j + c31;
        tA[o0] = (unsigned short)(uap[i][j][r >> 1] & 0xffffu);
        tA[o0 + 128] = (unsigned short)(uap[i][j][r >> 1] >> 16);
        tB[o0] = f2bf(acc[i][j][r]);
        tB[o0 + 128] = f2bf(acc[i][j][r + 1]);
      }
  __syncthreads();
  const int row0 = mb * 256;
#pragma unroll 2
  for (int q = 0; q < 8; ++q) {
    const int u = tid + 512 * q, r = u >> 4, c8 = u & 15;
    const uint4 ua = *(const uint4*)&tA[r * 128 + c8 * 8];
    const uint4 ub = *(const uint4*)&tB[r * 128 + c8 * 8];
    const int t = row0 + r, n0 = nt * 128 + c8 * 8;
    const uint4 ga = *(const uint4*)(p.ws + O_SGA + ((size_t)t * 1024 + n0) * 2);
    const uint4 gb = *(const uint4*)(p.ws + O_SGB + ((size_t)t * 1024 + n0) * 2);
    uint4 o;
    o.x = cvtpk(bflo(ga.x) * bflo(ua.x) + bflo(gb.x) * bflo(ub.x), bfhi(ga.x) * bfhi(ua.x) + bfhi(gb.x) * bfhi(ub.x));
    o.y = cvtpk(bflo(ga.y) * bflo(ua.y) + bflo(gb.y) * bflo(ub.y), bfhi(ga.y) * bfhi(ua.y) + bfhi(gb.y) * bfhi(ub.y));
    o.z = cvtpk(bflo(ga.z) * bflo(ua.z) + bflo(gb.z) * bflo(ub.z), bfhi(ga.z) * bfhi(ua.z) + bfhi(gb.z) * bfhi(ub.z));
    o.w = cvtpk(bflo(ga.w) * bflo(ua.w) + bflo(gb.w) * bflo(ub.w), bfhi(ga.w) * bfhi(ua.w) + bfhi(gb.w) * bfhi(ub.w));
    ((uint4*)(p.ws + O_MG))[tiled_unit(t, n0, 64)] = o;
  }
  __syncthreads();
}

DI void p6_tile(const Params& p, int layer, int mb, int nt) {
  const int tid = vtid(), lane = tid & 63, w = tid >> 6, wm = w >> 1, wn = w & 1, hi = lane >> 5, c31 = lane & 31;
  f32x16 acc[2][2];
  zero_acc(acc);
  gemm_core((const uint4*)(p.ws + O_MG), mb * 8, (const uint4*)(p.ws + O_WOUT), nt * 4, 64, acc, (uint4*)smem);
  const float* hin = (layer == 0) ? p.x : p.out;
#pragma unroll
  for (int i = 0; i < 2; ++i)
#pragma unroll
    for (int j = 0; j < 2; ++j)
#pragma unroll
      for (int r = 0; r < 16; ++r) {
        const size_t idx = (size_t)(mb * 256 + 64 * wm + 32 * i + crow(r, hi)) * DM + nt * 128 + 64 * wn + 32 * j + c31;
        p.out[idx] = fmaf(ALPHA_, hin[idx], acc[i][j][r]);
      }
}

DI float dpp_add_f(float v, int which) {
  const int iv = __builtin_bit_cast(int, v);
  int r;
  switch (which) {
    case 0: r = __builtin_amdgcn_update_dpp(0, iv, 0x111, 0xf, 0xf, true); break;
    case 1: r = __builtin_amdgcn_update_dpp(0, iv, 0x112, 0xf, 0xf, true); break;
    case 2: r = __builtin_amdgcn_update_dpp(0, iv, 0x114, 0xf, 0xf, true); break;
    case 3: r = __builtin_amdgcn_update_dpp(0, iv, 0x118, 0xf, 0xf, true); break;
    default: r = __builtin_amdgcn_update_dpp(0, iv, 0x142, 0xa, 0xf, false); break;
  }
  return v + __builtin_bit_cast(float, r);
}
DI float half_sum_to_last(float v) {
  v = dpp_add_f(v, 0); v = dpp_add_f(v, 1); v = dpp_add_f(v, 2); v = dpp_add_f(v, 3); v = dpp_add_f(v, 4);
  return v;
}
DI void fused_out_ln(const Params& p, int layer, int mb64) {
  const int tid = vtid(), lane = tid & 63, w = tid >> 6, hi = lane >> 5, c31 = lane & 31;
  uint4* lds = (uint4*)smem;
  const uint4* A = (const uint4*)(p.ws + O_MG) + (size_t)(2 * mb64) * 64 * 64;
#pragma unroll
  for (int r = 0; r < 16; ++r)
    __builtin_amdgcn_global_load_lds((const unsigned*)(A + tid + 512 * r), (unsigned*)(lds + tid + 512 * r), 16, 0, 0);
  float* lnf = (float*)(smem + 131072);
  {
    const float* src_ = (tid < 256) ? (p.ln_g + (size_t)layer * DM) : (p.ln_b + (size_t)layer * DM);
    ((float4*)lnf)[tid] = ((const float4*)src_)[tid & 255];
  }
  const uint4* Bw = (const uint4*)(p.ws + O_WOUT) + (size_t)(4 * w) * 64 * 64 + lane;
  uint4 bq[4][4];
#pragma unroll
  for (int s_ = 0; s_ < 4; ++s_)
#pragma unroll
    for (int j = 0; j < 4; ++j) bq[s_][j] = Bw[(size_t)(j * 64 + s_) * 64];
  f32x16 acc[2][4];
#pragma unroll
  for (int i = 0; i < 2; ++i)
#pragma unroll
    for (int j = 0; j < 4; ++j)
#pragma unroll
      for (int r = 0; r < 16; ++r) acc[i][j][r] = 0.f;
  __syncthreads();
#pragma unroll 1
  for (int k4 = 0; k4 < 16; ++k4) {
#pragma unroll
    for (int s_ = 0; s_ < 4; ++s_) {
      const int ks = 4 * k4 + s_;
      const bf16x8 a0 = __builtin_bit_cast(bf16x8, lds[ks * 64 + lane]);
      const bf16x8 a1 = __builtin_bit_cast(bf16x8, lds[4096 + ks * 64 + lane]);
#pragma unroll
      for (int j = 0; j < 4; ++j) {
        const bf16x8 b = __builtin_bit_cast(bf16x8, bq[s_][j]);
        acc[0][j] = MFMA(a0, b, acc[0][j]);
        acc[1][j] = MFMA(a1, b, acc[1][j]);
      }
      if (k4 < 15) {
#pragma unroll
        for (int j = 0; j < 4; ++j) bq[s_][j] = Bw[(size_t)(j * 64 + ks + 4) * 64];
      }
    }
  }
  const float* hin = (layer == 0) ? p.x : p.out;
  float* ft = (float*)smem;
  uint2* hb2 = (uint2*)(p.ws + O_HB);
  const int rr = tid >> 4, seg = tid & 15;
#pragma unroll
  for (int i = 0; i < 2; ++i) {
    __syncthreads();
    float4 hvv[16];
    {
      const float* hrow_ = hin + (size_t)(64 * mb64 + 32 * i + rr) * DM + 4 * seg;
#pragma unroll
      for (int e = 0; e < 16; ++e) hvv[e] = *(const float4*)(hrow_ + 64 * e);
    }
    {
      float* b0 = ft + (4 * hi) * 1024 + 128 * w + c31;
      float* b1 = b0 + 16 * 1024;
#pragma unroll
      for (int j = 0; j < 4; ++j)
#pragma unroll
        for (int r = 0; r < 16; ++r) {
          float* bp = (r < 8) ? b0 : b1;
          bp[((r & 3) + 8 * ((r >> 2) & 1)) * 1024 + 32 * j] = acc[i][j][r];
        }
    }
    __syncthreads();
    const int trow = 64 * mb64 + 32 * i + rr;
    float s1 = 0.f, s2 = 0.f;
    float* frow = ft + rr * 1024 + 4 * seg;
#pragma unroll
    for (int e = 0; e < 16; ++e) {
      const float4 y = *(const float4*)(frow + 64 * e);
      const float4 hv = hvv[e];
      float4 pre;
      pre.x = fmaf(ALPHA_, hv.x, y.x); pre.y = fmaf(ALPHA_, hv.y, y.y); pre.z = fmaf(ALPHA_, hv.z, y.z); pre.w = fmaf(ALPHA_, hv.w, y.w);
      s1 += (pre.x + pre.y) + (pre.z + pre.w);
      s2 = fmaf(pre.x, pre.x, s2); s2 = fmaf(pre.y, pre.y, s2); s2 = fmaf(pre.z, pre.z, s2); s2 = fmaf(pre.w, pre.w, s2);
      *(float4*)(frow + 64 * e) = pre;
    }
    s1 += __shfl_xor(s1, 1); s1 += __shfl_xor(s1, 2); s1 += __shfl_xor(s1, 4); s1 += __shfl_xor(s1, 8);
    s2 += __shfl_xor(s2, 1); s2 += __shfl_xor(s2, 2); s2 += __shfl_xor(s2, 4); s2 += __shfl_xor(s2, 8);
    const float mu = s1 * (1.f / 1024.f);
    const float rs = rsqrtf(fmaxf(s2 * (1.f / 1024.f) - mu * mu, 0.f) + 1e-5f);
    float* orow = p.out + (size_t)trow * DM;
#pragma unroll 4
    for (int e = 0; e < 16; ++e) {
      const int c0 = 64 * e + 4 * seg;
      const float4 pre = *(const float4*)(frow + 64 * e);
      const float4 g4 = *(const float4*)(lnf + c0), b4 = *(const float4*)(lnf + 1024 + c0);
      float4 o;
      o.x = (pre.x - mu) * rs * g4.x + b4.x; o.y = (pre.y - mu) * rs * g4.y + b4.y;
      o.z = (pre.z - mu) * rs * g4.z + b4.z; o.w = (pre.w - mu) * rs * g4.w + b4.w;
      *(float4*)(orow + c0) = o;
      hb2[((size_t)trow * 1024 + c0) >> 2] = make_uint2(cvtpk(o.x, o.y), cvtpk(o.z, o.w));
    }
  }
  __syncthreads();
}

DI void p7_rows(const Params& p, int layer) {
  const int tid = vtid();
  const int lane = tid & 63, gw = blockIdx.x * 8 + (tid >> 6), nw = gridDim.x * 8;
  const float* g = p.ln_g + (size_t)layer * DM;
  const float* bb = p.ln_b + (size_t)layer * DM;
  uint4* hb = (uint4*)(p.ws + O_HB);
  for (int t = gw; t < L_; t += nw) {
    float* row = p.out + (size_t)t * DM;
    float v[16];
#pragma unroll
    for (int q = 0; q < 2; ++q) {
      const float4 a = *(const float4*)(row + q * 512 + lane * 8), b = *(const float4*)(row + q * 512 + lane * 8 + 4);
      v[8 * q + 0] = a.x; v[8 * q + 1] = a.y; v[8 * q + 2] = a.z; v[8 * q + 3] = a.w;
      v[8 * q + 4] = b.x; v[8 * q + 5] = b.y; v[8 * q + 6] = b.z; v[8 * q + 7] = b.w;
    }
    float s = 0.f;
#pragma unroll
    for (int e = 0; e < 16; ++e) s += v[e];
#pragma unroll
    for (int off = 1; off < 64; off <<= 1) s += __shfl_xor(s, off);
    const float mu = s * (1.f / 1024.f);
    float ss = 0.f;
#pragma unroll
    for (int e = 0; e < 16; ++e) { const float d = v[e] - mu; ss = fmaf(d, d, ss); }
#pragma unroll
    for (int off = 1; off < 64; off <<= 1) ss += __shfl_xor(ss, off);
    const float rs = rsqrtf(ss * (1.f / 1024.f) + 1e-5f);
#pragma unroll
    for (int q = 0; q < 2; ++q) {
      const int k0 = q * 512 + lane * 8;
      float o[8];
#pragma unroll
      for (int e = 0; e < 8; ++e) o[e] = (v[8 * q + e] - mu) * rs * g[k0 + e] + bb[k0 + e];
      *(float4*)(row + k0) = make_float4(o[0], o[1], o[2], o[3]);
      *(float4*)(row + k0 + 4) = make_float4(o[4], o[5], o[6], o[7]);
      hb[tiled_unit(t, k0, 64)] = make_uint4(cvtpk(o[0], o[1]), cvtpk(o[2], o[3]), cvtpk(o[4], o[5]), cvtpk(o[6], o[7]));
    }
  }
}


#define XB_TMO      128
#define XB_XCNT(j)  (256  + 64 * (j))
#define XB_XSUB(j)  (1280 + 64 * (j))
#define XB_XGEN(j)  (2304 + 64 * (j))
#define XB_TOP      3328
#define XB_TOPGEN   3392
#define XCD_BAR_WORDS 3456
#define XB_SPIN_CAP (1u << 22)
#define LAS __attribute__((address_space(3)))
DI unsigned xb_ld(unsigned* p)              { return __hip_atomic_load(p, __ATOMIC_RELAXED, __HIP_MEMORY_SCOPE_AGENT); }
DI unsigned xb_add(unsigned* p, unsigned v) { return __hip_atomic_fetch_add(p, v, __ATOMIC_RELAXED, __HIP_MEMORY_SCOPE_AGENT); }
DI unsigned xb_xcc_id() { return (unsigned)__builtin_amdgcn_s_getreg((3 << 11) | 20) & 0xFu; }
#define XB_SPIN(cond, bar) do { unsigned _sp = 0; while (cond) { __builtin_amdgcn_s_sleep(1); \
    if ((++_sp & 255u) == 0u) { if (xb_ld(&(bar)[XB_TMO])) break; if (_sp > XB_SPIN_CAP) { atomicAdd(&(bar)[XB_TMO], 1u); break; } } } } while (0)
struct XcdBarrier { unsigned* bar; unsigned x; volatile LAS unsigned* st; };
DI XcdBarrier xcd_barrier_post(unsigned* bar, volatile LAS unsigned* st) {
  XcdBarrier b; b.bar = bar; b.x = xb_xcc_id(); b.st = st;
  if (threadIdx.x == 0) (void)xb_add(&bar[XB_XCNT(b.x)], 1u);
  return b;
}
DI void xcd_barrier_complete(unsigned* bar, unsigned x, unsigned& nloc, unsigned& nx) {
  const unsigned G = gridDim.x * gridDim.y * gridDim.z;
  unsigned sum, cnt, mine, sp = 0u;
  for (;;) {
    sum = 0u; cnt = 0u; mine = 0u;
#pragma unroll
    for (unsigned j = 0; j < 16; ++j) { const unsigned c = xb_ld(&bar[XB_XCNT(j)]); sum += c; cnt += (c > 0u) ? 1u : 0u; mine = (j == x) ? c : mine; }
    if (sum == G) break;
    __builtin_amdgcn_s_sleep(1);
    if ((++sp & 255u) == 0u) { if (xb_ld(&bar[XB_TMO])) break; if (sp > XB_SPIN_CAP) { atomicAdd(&bar[XB_TMO], 1u); break; } }
  }
  nloc = mine > 0u ? mine : 1u; nx = cnt > 0u ? cnt : 1u;
}
DI void xcd_barrier(const XcdBarrier& b) {
  asm volatile("s_waitcnt vmcnt(0)" ::: "memory");
  __syncthreads();
  if (threadIdx.x == 0) {
    unsigned* bar = b.bar;
    __builtin_amdgcn_s_waitcnt(0);
    unsigned nloc = b.st[0], nx = b.st[1];
    if (nloc == 0u) { xcd_barrier_complete(bar, b.x, nloc, nx); b.st[0] = nloc; b.st[1] = nx; }
    const unsigned old = xb_add(&bar[XB_XSUB(b.x)], 1u);
    const unsigned gen = old / nloc;
    if (old + 1u == (gen + 1u) * nloc) {
      __builtin_amdgcn_fence(__ATOMIC_RELEASE, "agent");
      asm volatile("s_waitcnt vmcnt(0)" ::: "memory");
      const unsigned og = xb_add(&bar[XB_TOP], 1u);
      const unsigned tg = og / nx;
      if (og + 1u == (tg + 1u) * nx) xb_add(&bar[XB_TOPGEN], 1u);
      else XB_SPIN(xb_ld(&bar[XB_TOPGEN]) == tg, bar);
      __builtin_amdgcn_fence(__ATOMIC_ACQUIRE, "agent");
      xb_add(&bar[XB_XGEN(b.x)], 1u);
      asm volatile("s_waitcnt vmcnt(0)" ::: "memory");
    } else {
      XB_SPIN(xb_ld(&bar[XB_XGEN(b.x)]) == gen, bar);
      __builtin_amdgcn_fence(__ATOMIC_ACQUIRE, "agent");
      asm volatile("s_waitcnt vmcnt(0)" ::: "memory");
    }
  }
  __syncthreads();
}
constexpr int LDS_BARST = 163840 - 16;

__global__ void __launch_bounds__(512) mk(Params p) {
  cg::grid_group grid = cg::this_grid();
  const int nb = gridDim.x, bid = blockIdx.x;
  volatile LAS unsigned* bst_ = (volatile LAS unsigned*)(smem + LDS_BARST);
  if (threadIdx.x < 4) bst_[threadIdx.x] = 0u;
  __syncthreads();
  (void)xcd_barrier_post((unsigned*)(p.ws + O_BAR), bst_);
#define XB_NOW() XcdBarrier{(unsigned*)(p.ws + O_BAR), xb_xcc_id(), (volatile LAS unsigned*)(smem + LDS_BARST)}
  phase0(p);
  grid.sync();
  for (int layer = 0; layer < DEPTH_; ++layer) {
    {
      const int gtid = bid * 512 + vtid(), gthreads = nb * 512;
      conv_weight(p.w_up_a + (size_t)layer * 512 * 1024, 512, 1024, 1024, false, (uint4*)(p.ws + O_WUA), gtid, gthreads);
      conv_weight(p.w_up_b + (size_t)layer * 512 * 1024, 512, 1024, 1024, false, (uint4*)(p.ws + O_WUB), gtid, gthreads);
      conv_weight(p.w_out + (size_t)layer * 1024 * 1024, 1024, 1024, 1024, false, (uint4*)(p.ws + O_WOUT), gtid, gthreads);
#ifndef NO_P1
      for (int id = bid; id < 64 * 27; id += nb) p1_tile8(p, layer, id & 63, id >> 6);
#endif
    }
    xcd_barrier(XB_NOW());
    {
      if (layer + 1 < DEPTH_) {
        const int gtid = bid * 512 + vtid(), gthreads = nb * 512;
        conv_weight_rm(p.w_in + (size_t)(layer + 1) * 1024 * NIN, 1024, NIN, NPAD, true, (uint4*)(p.ws + O_WTIN), gtid, gthreads);
      }
#ifndef NO_HA
      for (int id = bid; id < 1024; id += nb) hgrn_a_item(p, id >> 2, id & 3);
#endif
      for (int s = bid; s < 1024; s += nb) {
        const int rnd = s / nb, pos = s - rnd * nb;
        const int rem = 1024 - rnd * nb, count = rem < nb ? rem : nb;
        const int sp = (rnd & 1) ? (rnd * nb + count - 1 - pos) : s;
        indexer_item(p, 1023 - sp);
      }
    }
    xcd_barrier(XB_NOW());
    {
      attn_setup();
      const int tid = vtid();
      if (tid < 256) ((float*)(smem + AT_RB))[tid] = p.rel_bias[tid];
      __syncthreads();
#ifndef NO_SCAN
      hgrn_scan(p);
#endif
      const int w = tid >> 6, lane = tid & 63;
#ifndef NO_ATT
      { QKPF pf; qk_fetch(p, bid * 8 + w, lane, pf);
        for (int t = bid * 8 + w; t < L_; t += nb * 8) attn_query(p, t, t + nb * 8, w, lane, pf); }
#endif
      __syncthreads();
    }
    {
      const int tid = vtid();
      const int w = tid >> 6, lane = tid & 63;
      for (int t = bid * 8 + w; t < L_; t += nb * 8) attn_pv_query(p, t, w, lane);
      __syncthreads();
    }
    xcd_barrier(XB_NOW());
#ifndef NO_HC
    for (int id = bid; id < 1024; id += nb) hgrn_c_item(p, layer, id >> 2, id & 3);
#endif
    xcd_barrier(XB_NOW());
#ifndef NO_P5
    for (int id = bid; id < 64 * 8; id += nb) p5_tile(p, id & 63, id >> 6);
#endif
    xcd_barrier(XB_NOW());
    for (int id = bid; id < 256; id += nb) fused_out_ln(p, layer, id);
    xcd_barrier(XB_NOW());
  }}

extern "C" void kernel_launch(void* const* d_in, const int* in_sizes, int n_in, void* d_out, int out_size, void* d_ws,
                              size_t ws_size, hipStream_t stream) {
  constexpr size_t kLds = 160 * 1024;
  static int grid_blocks = 0;
  if (!grid_blocks) {
    int dev = 0, cus = 0, per_cu = 0;
    (void)hipGetDevice(&dev);
    (void)hipDeviceGetAttribute(&cus, hipDeviceAttributeMultiprocessorCount, dev);
    (void)hipFuncSetAttribute((const void*)mk, hipFuncAttributeMaxDynamicSharedMemorySize, (int)kLds);
    (void)hipOccupancyMaxActiveBlocksPerMultiprocessor(&per_cu, mk, 512, kLds);
    if (per_cu > 1) per_cu = 1;
    grid_blocks = cus * per_cu;
  }
  if (ws_size < WS_NEED || grid_blocks <= 0) { fprintf(stderr, "ws too small or no occupancy\n"); return; }
  Params p{};
  p.x = (const float*)d_in[0]; p.w_in = (const float*)d_in[1]; p.b_in = (const float*)d_in[2];
  p.w_up_a = (const float*)d_in[3]; p.w_up_b = (const float*)d_in[4]; p.w_out = (const float*)d_in[5];
  p.lb_logits = (const float*)d_in[6]; p.norm_a_g = (const float*)d_in[7]; p.rel_bias = (const float*)d_in[8];
  p.ln_g = (const float*)d_in[9]; p.ln_b = (const float*)d_in[10];
  p.out = (float*)d_out; p.ws = (char*)d_ws;
  (void)hipMemsetAsync((char*)d_ws + O_BAR, 0, XCD_BAR_WORDS * 4, stream);
  void* args[] = {&p};
  hipError_t e = hipLaunchCooperativeKernel((void*)mk, dim3(grid_blocks), dim3(512), args, kLds, stream);
  if (e != hipSuccess) fprintf(stderr, "cooperative launch failed: %s (grid %d)\n", hipGetErrorString(e), grid_blocks);
}
```

```cpp
#include <hip/hip_runtime.h>
#include <hip/hip_cooperative_groups.h>
#include <cstdio>
#include <cstdint>
namespace cg = cooperative_groups;

#define DI __device__ __forceinline__
typedef __attribute__((ext_vector_type(8))) short bf16x8;
typedef __attribute__((ext_vector_type(16))) float f32x16;
typedef __attribute__((ext_vector_type(2))) float f32x2;
typedef __attribute__((ext_vector_type(2))) __bf16 bf16x2_t;
#define MFMA(a, b, c) __builtin_amdgcn_mfma_f32_32x32x16_bf16((a), (b), (c), 0, 0, 0)

constexpr int L_ = 16384, DM = 1024, NIN = 6728, NPAD = 6912, DEPTH_ = 4;
constexpr float ALPHA_ = 1.681792830507429f;
constexpr size_t MiB = 1048576;
constexpr size_t O_WTIN = 0 * MiB, O_WUA = 14 * MiB, O_WUB = 15 * MiB, O_WOUT = 16 * MiB, O_HB = 18 * MiB,
                 O_QA = 50 * MiB, O_G = 66 * MiB, O_KK = 98 * MiB, O_IA = 114 * MiB, O_ZA = 130 * MiB,
                 O_QB = 146 * MiB, O_KB = 162 * MiB, O_VB = 178 * MiB, O_ZB = 194 * MiB, O_QI = 210 * MiB,
                 O_KI = 226 * MiB, O_WI = 228 * MiB, O_D = 228 * MiB + 512 * 1024, O_SGA = 229 * MiB,
                 O_SGB = 261 * MiB, O_US = 293 * MiB, O_SEL = 325 * MiB, O_LBS = 333 * MiB,
                 O_BAR = 333 * MiB + 65536, O_AA = 334 * MiB, O_AB = 350 * MiB, O_MG = 366 * MiB, WS_NEED = 398 * MiB;

struct Params {
  const float *x, *w_in, *b_in, *w_up_a, *w_up_b, *w_out, *lb_logits, *norm_a_g, *rel_bias, *ln_g, *ln_b;
  float* out;
  char* ws;
};

extern __shared__ __attribute__((aligned(16))) char smem[];

DI unsigned cvtpk(float lo, float hi) {
  f32x2 v = {lo, hi};
  bf16x2_t b = __builtin_convertvector(v, bf16x2_t);
  return __builtin_bit_cast(unsigned, b);
}
DI unsigned short f2bf(float x) { return (unsigned short)(cvtpk(x, 0.f) & 0xffffu); }
DI float bflo(unsigned u) { return __uint_as_float(u << 16); }
DI float bfhi(unsigned u) { return __uint_as_float(u & 0xffff0000u); }
DI float bf2f(unsigned short s) { return __uint_as_float(((unsigned)s) << 16); }
DI float sigm(float x) { return 1.f / (1.f + __expf(-x)); }
DI float silu(float x) { return x / (1.f + __expf(-x)); }
DI int crow(int r, int hi) { return (r & 3) + 8 * (r >> 2) + 4 * hi; }
DI size_t tiled_unit(int r, int k, int KS) {
  return ((size_t)(r >> 5) * KS + (k >> 4)) * 64 + (r & 31) + 32 * ((k >> 3) & 1);
}
DI float dot2(unsigned a, unsigned b, float acc) {
  asm volatile("v_dot2c_f32_bf16 %0, %1, %2" : "+v"(acc) : "v"(a), "v"(b));
  return acc;
}
template <typename T> DI T* opq(T* x) { asm volatile("" : "+s"(x)); return x; }
#define LAUNDER(pin) Params p; p.x = opq((pin).x); p.w_in = (pin).w_in; p.b_in = (pin).b_in; p.w_up_a = (pin).w_up_a; p.w_up_b = (pin).w_up_b; \
  p.w_out = (pin).w_out; p.lb_logits = (pin).lb_logits; p.norm_a_g = (pin).norm_a_g; p.rel_bias = (pin).rel_bias; p.ln_g = (pin).ln_g; \
  p.ln_b = (pin).ln_b; p.out = opq((pin).out); p.ws = opq((pin).ws);
DI int vtid() { int t = threadIdx.x; asm volatile("" : "+v"(t)); return t; }
DI unsigned vzero() { unsigned z; asm volatile("v_mov_b32 %0, 0" : "=v"(z)); return z; }
DI void cbar() { asm volatile("" ::: "memory"); }
DI void lds_fence() { asm volatile("s_waitcnt lgkmcnt(0)" ::: "memory"); }

DI int colmap(int np) {
  if (np < 4608) return np;
  if (np < 5632) return 4680 + (np - 4608);
  if (np < 6656) return 5704 + (np - 5632);
  if (np < 6720) return 4608 + (np - 6656);
  if (np < 6728) return 4672 + (np - 6720);
  return -1;
}

DI void conv_weight(const float* __restrict__ src, int K, int ldn, int Npad, bool useMap, uint4* __restrict__ dst,
                    int gtid, int gthreads) {
  const int KS = K >> 4;
  const int total = Npad * (K >> 3);
  for (int u = gtid; u < total; u += gthreads) {
    int kg = u / Npad, n = u - kg * Npad;
    int col = useMap ? colmap(n) : n;
    float v[8];
#pragma unroll
    for (int j = 0; j < 8; ++j) v[j] = (col >= 0) ? src[(size_t)(kg * 8 + j) * ldn + col] : 0.f;
    uint4 o;
    o.x = cvtpk(v[0], v[1]); o.y = cvtpk(v[2], v[3]); o.z = cvtpk(v[4], v[5]); o.w = cvtpk(v[6], v[7]);
    dst[tiled_unit(n, kg * 8, KS)] = o;
  }
}

DI void conv_weight_rm(const float* __restrict__ src, int K, int ldn, int Npad, bool useMap, uint4* __restrict__ dst,
                       int gtid, int gthreads) {
  const int total = Npad * (K >> 3);
  for (int u = gtid; u < total; u += gthreads) {
    int kg = u / Npad, n = u - kg * Npad;
    int col = useMap ? colmap(n) : n;
    float v[8];
#pragma unroll
    for (int j = 0; j < 8; ++j) v[j] = (col >= 0) ? src[(size_t)(kg * 8 + j) * ldn + col] : 0.f;
    uint4 o;
    o.x = cvtpk(v[0], v[1]); o.y = cvtpk(v[2], v[3]); o.z = cvtpk(v[4], v[5]); o.w = cvtpk(v[6], v[7]);
    dst[(size_t)n * (K >> 3) + kg] = o;
  }
}

DI void phase0(const Params& p) {
  const int gtid = blockIdx.x * 512 + vtid(), gthreads = gridDim.x * 512;
  conv_weight_rm(p.w_in, 1024, NIN, NPAD, true, (uint4*)(p.ws + O_WTIN), gtid, gthreads);
  uint4* hb = (uint4*)(p.ws + O_HB);
  for (int u = gtid; u < L_ * 128; u += gthreads) {
    const float4* s_ = (const float4*)(p.x + (size_t)u * 8);
    const float4 a = s_[0], b = s_[1];
    uint4 o;
    o.x = cvtpk(a.x, a.y); o.y = cvtpk(a.z, a.w); o.z = cvtpk(b.x, b.y); o.w = cvtpk(b.z, b.w);
    hb[u] = o;
  }
  float* lbs = (float*)(p.ws + O_LBS);
  for (int c = gtid; c < 512; c += gthreads) {
    float l0 = p.lb_logits[c], l1 = p.lb_logits[512 + c], l2 = p.lb_logits[1024 + c], l3 = p.lb_logits[1536 + c];
    float m = fmaxf(fmaxf(l0, l1), fmaxf(l2, l3));
    float e0 = expf(l0 - m), e1 = expf(l1 - m), e2 = expf(l2 - m), e3 = expf(l3 - m);
    float inv = 1.f / (e0 + e1 + e2 + e3);
    lbs[c] = 0.f; lbs[512 + c] = e1 * inv; lbs[1024 + c] = (e1 + e2) * inv; lbs[1536 + c] = (e1 + e2 + e3) * inv;
  }
}

DI void gemm_core(const uint4* __restrict__ A, int mt0, const uint4* __restrict__ B, int nt0, int KS,
                  f32x16 (&acc)[2][2], uint4* lds) {
  const int tid = vtid(), lane = tid & 63, w = tid >> 6, wm = w >> 1, wn = w & 1;
  const int nk = KS >> 2;
  const uint4* sp[6];
#pragma unroll
  for (int r = 0; r < 6; ++r) {
    int u = tid + 512 * r;
    if (u < 2048) sp[r] = A + ((size_t)(mt0 + (u >> 8)) * KS) * 64 + (u & 255);
    else { int u2 = u - 2048; sp[r] = B + ((size_t)(nt0 + (u2 >> 8)) * KS) * 64 + (u2 & 255); }
  }
#pragma unroll
  for (int r = 0; r < 6; ++r)
    __builtin_amdgcn_global_load_lds((const unsigned*)sp[r], (unsigned*)(lds + tid + 512 * r), 16, 0, 0);
  if (nk > 1) {
#pragma unroll
    for (int r = 0; r < 6; ++r)
      __builtin_amdgcn_global_load_lds((const unsigned*)(sp[r] + 256), (unsigned*)(lds + 3072 + tid + 512 * r), 16, 0, 0);
  }
  int cb = 0;
  for (int kt = 0; kt < nk; ++kt) {
    if (kt + 1 < nk) asm volatile("s_waitcnt vmcnt(6)" ::: "memory");
    else asm volatile("s_waitcnt vmcnt(0)" ::: "memory");
    __builtin_amdgcn_s_barrier();
    asm volatile("" ::: "memory");
    if (kt + 2 < nk) {
      int nb2 = cb + 2; if (nb2 >= 3) nb2 -= 3;
      uint4* nxt = lds + nb2 * 3072;
#pragma unroll
      for (int r = 0; r < 6; ++r)
        __builtin_amdgcn_global_load_lds((const unsigned*)(sp[r] + (size_t)(kt + 2) * 256), (unsigned*)(nxt + tid + 512 * r), 16, 0, 0);
    }
    const uint4* cur = lds + cb * 3072;
#pragma unroll
    for (int ks = 0; ks < 4; ++ks) {
      bf16x8 a0 = __builtin_bit_cast(bf16x8, cur[(2 * wm + 0) * 256 + ks * 64 + lane]);
      bf16x8 a1 = __builtin_bit_cast(bf16x8, cur[(2 * wm + 1) * 256 + ks * 64 + lane]);
      bf16x8 b0 = __builtin_bit_cast(bf16x8, cur[2048 + (2 * wn + 0) * 256 + ks * 64 + lane]);
      bf16x8 b1 = __builtin_bit_cast(bf16x8, cur[2048 + (2 * wn + 1) * 256 + ks * 64 + lane]);
      acc[0][0] = MFMA(a0, b0, acc[0][0]);
      acc[0][1] = MFMA(a0, b1, acc[0][1]);
      acc[1][0] = MFMA(a1, b0, acc[1][0]);
      acc[1][1] = MFMA(a1, b1, acc[1][1]);
    }
    cb = (cb == 2) ? 0 : cb + 1;
  }
  __syncthreads();
}

DI void zero_acc(f32x16 (&acc)[2][2]) {
#pragma unroll
  for (int i = 0; i < 2; ++i)
#pragma unroll
    for (int j = 0; j < 2; ++j)
#pragma unroll
      for (int r = 0; r < 16; ++r) acc[i][j][r] = 0.f;
}

typedef __attribute__((ext_vector_type(4))) float f32x4g;
DI int g8_lds_byte(int r, int c) {
  int st = (r >> 4) * 2 + (c >> 5), rr = r & 15, cc = c & 31, ob = rr * 64 + cc * 2;
  return st * 1024 + (ob ^ (((ob >> 9) & 1) << 5));
}
DI void g8_stage_rc(int b, int& R, int& C) {
  int st = b / 1024, sb = b % 1024, swz = sb ^ (((sb >> 9) & 1) << 5);
  R = (st >> 1) * 16 + swz / 64; C = (st & 1) * 32 + (swz % 64) / 2;
}
DI void gemm8p(const unsigned short* __restrict__ A, const unsigned short* __restrict__ Bt, const int K, const int brow, const int bcol,
               f32x4g (&acc)[2][2][4][2], unsigned short* shm) {
  constexpr int BK = 64, HALF = 128, HT = HALF * BK;
  const int tidx = vtid();
  #define G8_SA(b,h) (shm+((b)*2+(h))*HT)
  #define G8_SB(b,h) (shm+(4+(b)*2+(h))*HT)
  int g8vo[2];
  { int r_, c_; g8_stage_rc(tidx * 16, r_, c_); g8vo[0] = (r_ * K + c_) * 2; g8_stage_rc(tidx * 16 + 8192, r_, c_); g8vo[1] = (r_ * K + c_) * 2; }
  const __amdgpu_buffer_rsrc_t g8rA = __builtin_amdgcn_make_buffer_rsrc((void*)A, 0, 16384 * 1024 * 2, 0x00020000);
  const __amdgpu_buffer_rsrc_t g8rBt = __builtin_amdgcn_make_buffer_rsrc((void*)Bt, 0, 6912 * 1024 * 2, 0x00020000);
  #define G8_STAGE(P,BASE,br,kt) do{ const int _so = ((br) * K + (kt) * BK) * 2; \
    for(int _i=0;_i<2;++_i){ \
      __builtin_amdgcn_raw_ptr_buffer_load_lds(g8r##BASE, (__attribute__((address_space(3))) void*)((char*)(P)+tidx*16+_i*8192), 16, g8vo[_i], _so, 0, 0);}}while(0)
  #define G8_LDA(dst,b,h) for(int m=0;m<4;++m)for(int k=0;k<2;++k) \
    dst[m][k]=*reinterpret_cast<const bf16x8*>((char*)G8_SA(b,h)+g8_lds_byte(wr*64+m*16+fr,k*32+fq*8))
  #define G8_LDB(dst,b,h) for(int n=0;n<2;++n)for(int k=0;k<2;++k) \
    dst[n][k]=*reinterpret_cast<const bf16x8*>((char*)G8_SB(b,h)+g8_lds_byte(wc*32+n*16+fr,k*32+fq*8))
  #define G8_MMA(ai,bj,At,Bt_) do{__builtin_amdgcn_s_setprio(1); \
    for(int m=0;m<4;++m)for(int n=0;n<2;++n)for(int k=0;k<2;++k) \
      acc[ai][bj][m][n]=__builtin_amdgcn_mfma_f32_16x16x32_bf16(Bt_[n][k],At[m][k],acc[ai][bj][m][n],0,0,0); \
    __builtin_amdgcn_s_setprio(0);}while(0)
  #define G8_WV(n) asm volatile("s_waitcnt vmcnt(" #n ")":::"memory")
  #define G8_WL(n) asm volatile("s_waitcnt lgkmcnt(" #n ")":::"memory")
  #define G8_BAR __builtin_amdgcn_s_barrier()
  #define G8_SCHED __builtin_amdgcn_sched_barrier(0)
  const int wid = tidx >> 6, lane = tidx & 63, wr = wid >> 2, wc = wid & 3, fr = lane & 15, fq = lane >> 4;
  bf16x8 At[4][2], B0[2][2], B1[2][2];
  const int nt = K / BK;
  G8_STAGE(G8_SB(0,0),Bt,bcol,0); G8_STAGE(G8_SA(0,0),A,brow,0);
  G8_STAGE(G8_SB(0,1),Bt,bcol+HALF,0); G8_STAGE(G8_SA(0,1),A,brow+HALF,0);
  if(wr==1)G8_BAR;
  G8_WV(4); G8_BAR;
  G8_STAGE(G8_SB(1,0),Bt,bcol,1); G8_STAGE(G8_SA(1,0),A,brow,1); G8_STAGE(G8_SB(1,1),Bt,bcol+HALF,1);
  G8_WV(6); G8_BAR;
  for(int t=0;t<nt-2;t+=2){
    G8_LDB(B0,0,0); G8_SCHED; G8_LDA(At,0,0); G8_STAGE(G8_SA(1,1),A,brow+HALF,t+1);
    G8_WL(8); G8_BAR; G8_WL(0); G8_MMA(0,0,At,B0); G8_BAR; G8_SCHED;
    G8_LDB(B1,0,1); G8_STAGE(G8_SB(0,0),Bt,bcol,t+2);
    G8_BAR; G8_WL(0); G8_MMA(0,1,At,B1); G8_BAR;
    G8_LDA(At,0,1); G8_STAGE(G8_SA(0,0),A,brow,t+2);
    G8_BAR; G8_WL(0); G8_MMA(1,0,At,B0); G8_BAR; G8_SCHED;
    G8_STAGE(G8_SB(0,1),Bt,bcol+HALF,t+2);
    G8_WV(6); G8_BAR; G8_MMA(1,1,At,B1); G8_BAR;
    G8_LDB(B0,1,0); G8_SCHED; G8_LDA(At,1,0); G8_STAGE(G8_SA(0,1),A,brow+HALF,t+2);
    G8_WL(8); G8_BAR; G8_WL(0); G8_MMA(0,0,At,B0); G8_BAR; G8_SCHED;
    G8_LDB(B1,1,1); G8_STAGE(G8_SB(1,0),Bt,bcol,t+3);
    G8_BAR; G8_WL(0); G8_MMA(0,1,At,B1); G8_BAR;
    G8_LDA(At,1,1); G8_STAGE(G8_SA(1,0),A,brow,t+3);
    G8_BAR; G8_WL(0); G8_MMA(1,0,At,B0); G8_BAR; G8_SCHED;
    G8_STAGE(G8_SB(1,1),Bt,bcol+HALF,t+3);
    G8_WV(6); G8_BAR; G8_MMA(1,1,At,B1); G8_BAR;
  }
  { G8_LDB(B0,0,0); G8_LDA(At,0,0); G8_STAGE(G8_SA(1,1),A,brow+HALF,nt-1);
    G8_BAR; G8_WL(0); G8_MMA(0,0,At,B0); G8_BAR;
    G8_LDB(B1,0,1); G8_BAR; G8_WL(0); G8_MMA(0,1,At,B1); G8_BAR;
    G8_LDA(At,0,1); G8_WV(4); G8_BAR; G8_WL(0); G8_MMA(1,0,At,B0); G8_MMA(1,1,At,B1); G8_BAR; }
  { G8_LDB(B0,1,0); G8_LDA(At,1,0); G8_WV(2); G8_BAR; G8_WL(0); G8_MMA(0,0,At,B0); G8_BAR;
    G8_LDB(B1,1,1); G8_WV(0); G8_BAR; G8_WL(0); G8_MMA(0,1,At,B1); G8_BAR;
    G8_LDA(At,1,1); G8_BAR; G8_WL(0); G8_MMA(1,0,At,B0); G8_MMA(1,1,At,B1); G8_BAR; }
  if(wr==0)G8_BAR;
  __syncthreads();
}

DI void p1_tile(const Params& p, int layer, int mb, int nt) {
  const int tid = vtid(), lane = tid & 63, w = tid >> 6, wm = w >> 1, wn = w & 1, hi = lane >> 5, c31 = lane & 31;
  f32x16 acc[2][2];
  zero_acc(acc);
  gemm_core((const uint4*)(p.ws + O_HB), mb * 8, (const uint4*)(p.ws + O_WTIN), nt * 4, 64, acc, (uint4*)smem);
  unsigned short* tile = (unsigned short*)smem;
  const int row0 = mb * 256;
  const float* bin = p.b_in + (size_t)layer * NIN;
  const float* lbs = (const float*)(p.ws + O_LBS) + layer * 512;
#pragma unroll
  for (int j = 0; j < 2; ++j) {
    const int col = 64 * wn + 32 * j + c31;
    const int np = nt * 128 + col;
    const int oc = colmap(np);
    const float bias = oc >= 0 ? bin[oc] : 0.f;
    float lb = 0.f;
    if (nt >= 4 && nt < 8) lb = lbs[(nt - 4) * 128 + col];
#pragma unroll
    for (int i = 0; i < 2; ++i) {
#pragma unroll
      for (int r = 0; r < 16; ++r) {
        const int row = 64 * wm + 32 * i + crow(r, hi);
        float v = acc[i][j][r] + bias;
        float o;
        if (nt < 4) o = v;
        else if (nt < 8) {
          float sg = sigm(v);
          float f = lb + (1.f - lb) * sg;
          ((float*)(p.ws + O_G))[(size_t)(row0 + row) * 512 + (nt - 4) * 128 + col] = __logf(f);
          o = (1.f - lb) * (1.f - sg);
        } else if (nt < 12) o = v;
        else if (nt < 16) o = silu(v);
        else if (nt < 20) o = v * 0.125f;
        else if (nt < 28) o = v;
        else if (nt < 32) o = silu(v);
        else if (nt < 36) o = v;
        else if (nt < 52) o = sigm(v);
        else {
          o = v;
          if (col >= 64 && col < 72)
            ((float*)(p.ws + O_WI))[(size_t)(row0 + row) * 8 + (col - 64)] = v * 0.044194173824159216f;
        }
        tile[row * 128 + col] = f2bf(o);
      }
    }
  }
  __syncthreads();
#pragma unroll
  for (int q = 0; q < 8; ++q) {
    const int u = tid + 512 * q, r = u >> 4, c8 = u & 15;
    const uint4 val = *(const uint4*)&tile[r * 128 + c8 * 8];
    const int t = row0 + r;
    if (nt >= 20 && nt < 28) {
      int w0 = __builtin_amdgcn_cvt_pk_fp8_f32(bflo(val.x), bfhi(val.x), 0, false);
      w0 = __builtin_amdgcn_cvt_pk_fp8_f32(bflo(val.y), bfhi(val.y), w0, true);
      int w1 = __builtin_amdgcn_cvt_pk_fp8_f32(bflo(val.z), bfhi(val.z), 0, false);
      w1 = __builtin_amdgcn_cvt_pk_fp8_f32(bflo(val.w), bfhi(val.w), w1, true);
      const size_t base8 = (nt < 24) ? O_KB : O_VB;
      *(uint2*)(p.ws + base8 + (size_t)t * 512 + (nt & 3) * 128 + c8 * 8) = make_uint2((unsigned)w0, (unsigned)w1);
    } else if (nt < 32) {
      size_t base;
      switch (nt >> 2) {
        case 0: base = O_QA; break; case 1: base = O_KK; break; case 2: base = O_IA; break; case 3: base = O_ZA; break;
        case 4: base = O_QB; break; case 5: base = O_KB; break; case 6: base = O_VB; break; default: base = O_ZB; break;
      }
      *(uint4*)(p.ws + base + ((size_t)t * 512 + (nt & 3) * 128 + c8 * 8) * 2) = val;
    } else if (nt < 36) {
      const int head = 2 * (nt - 32) + (c8 >> 3), d0 = (c8 & 7) * 8;
      const int item = t >> 5, tq = t & 31, mtile = tq >> 2, q4 = tq & 3;
      const int rr = (head & 3) + 4 * (q4 >> 1) + 8 * (head >> 2) + 16 * (q4 & 1);
      const int laneA = rr + 32 * ((d0 >> 3) & 1), ks = d0 >> 4;
      ((uint4*)(p.ws + O_QI))[((size_t)(item * 8 + mtile) * 4 + ks) * 64 + laneA] = val;
    } else if (nt < 44) {
      *(uint4*)(p.ws + O_SGA + ((size_t)t * 1024 + (nt - 36) * 128 + c8 * 8) * 2) = val;
    } else if (nt < 52) {
      *(uint4*)(p.ws + O_SGB + ((size_t)t * 1024 + (nt - 44) * 128 + c8 * 8) * 2) = val;
    } else {
      if (c8 < 8) {
        const int d0 = c8 * 8;
        ((uint4*)(p.ws + O_KI))[((size_t)(t >> 5) * 4 + (d0 >> 4)) * 64 + (t & 31) + 32 * ((d0 >> 3) & 1)] = val;
      }
    }
  }
  __syncthreads();
}

constexpr int T8S = 264;
enum { C_PLAIN = 0, C_FA = 1, C_SILU = 2, C_QB = 3, C_SIGM = 4, C_KIWI = 5 };
DI float sigm_fast(float x) { return __builtin_amdgcn_rcpf(1.f + __builtin_amdgcn_exp2f(-1.4426950408889634f * x)); }
template <int CLS>
DI void p1_epi_write(const Params& p, f32x4g (&acc)[2][2][4][2], int layer, int nt2, int row0) {
  const int tid = vtid(), wid = tid >> 6, lane = tid & 63, wr = wid >> 2, wc = wid & 3, fr = lane & 15, fq = lane >> 4;
  unsigned short* tile = (unsigned short*)smem;
  const float* bin = p.b_in + (size_t)layer * NIN;
  const float* lbs = (const float*)(p.ws + O_LBS) + layer * 512;
  const int rbase = wr * 64 + fr;
#pragma unroll
  for (int bj = 0; bj < 2; ++bj) {
    if (CLS == C_KIWI && bj == 1) break;
    const int nt = 2 * nt2 + bj;
#pragma unroll
    for (int n = 0; n < 2; ++n) {
      const int c4 = wc * 32 + n * 16 + 4 * fq;
      const int np = nt * 128 + c4;
      float4 b4;
      if (CLS == C_KIWI) b4 = (c4 < 72) ? *(const float4*)(bin + (np - 2048)) : make_float4(0.f, 0.f, 0.f, 0.f);
      else if (CLS == C_SIGM) b4 = *(const float4*)(bin + (np + 72));
      else b4 = *(const float4*)(bin + np);
      float4 l4 = make_float4(0.f, 0.f, 0.f, 0.f);
      if (CLS == C_FA) l4 = *(const float4*)(lbs + (nt - 4) * 128 + c4);
#pragma unroll
      for (int ai = 0; ai < 2; ++ai)
#pragma unroll
        for (int m = 0; m < 4; ++m) {
          const int row = ai * 128 + m * 16 + rbase;
          const f32x4g a = acc[ai][bj][m][n];
          const float v0 = a[0] + b4.x, v1 = a[1] + b4.y, v2 = a[2] + b4.z, v3 = a[3] + b4.w;
          float o0, o1, o2, o3;
          if (CLS == C_PLAIN) { o0 = v0; o1 = v1; o2 = v2; o3 = v3; }
          else if (CLS == C_QB) { o0 = v0 * 0.125f; o1 = v1 * 0.125f; o2 = v2 * 0.125f; o3 = v3 * 0.125f; }
          else if (CLS == C_SILU) { o0 = v0 * sigm_fast(v0); o1 = v1 * sigm_fast(v1); o2 = v2 * sigm_fast(v2); o3 = v3 * sigm_fast(v3); }
          else if (CLS == C_SIGM) { o0 = sigm_fast(v0); o1 = sigm_fast(v1); o2 = sigm_fast(v2); o3 = sigm_fast(v3); }
          else if (CLS == C_FA) {
            const float s0 = sigm_fast(v0), s1 = sigm_fast(v1), s2 = sigm_fast(v2), s3 = sigm_fast(v3);
            float4 g;
            g.x = __logf(l4.x + (1.f - l4.x) * s0); g.y = __logf(l4.y + (1.f - l4.y) * s1);
            g.z = __logf(l4.z + (1.f - l4.z) * s2); g.w = __logf(l4.w + (1.f - l4.w) * s3);
            *(float4*)((float*)(p.ws + O_G) + (size_t)(row0 + row) * 512 + (nt - 4) * 128 + c4) = g;
            o0 = (1.f - l4.x) * (1.f - s0); o1 = (1.f - l4.y) * (1.f - s1); o2 = (1.f - l4.z) * (1.f - s2); o3 = (1.f - l4.w) * (1.f - s3);
          } else {
            o0 = v0; o1 = v1; o2 = v2; o3 = v3;
            if (c4 >= 64 && c4 < 72) {
              const float sc = 0.044194173824159216f;
              *(float4*)((float*)(p.ws + O_WI) + (size_t)(row0 + row) * 8 + (c4 - 64)) = make_float4(v0 * sc, v1 * sc, v2 * sc, v3 * sc);
            }
          }
          *(uint2*)(tile + row * T8S + 128 * bj + c4) = make_uint2(cvtpk(o0, o1), cvtpk(o2, o3));
        }
    }
  }
}

DI void p1_tile8(const Params& p, int layer, int mb, int nt2) {
  f32x4g acc[2][2][4][2];
#pragma unroll
  for (int a = 0; a < 2; ++a)
#pragma unroll
    for (int b = 0; b < 2; ++b)
#pragma unroll
      for (int m = 0; m < 4; ++m)
#pragma unroll
        for (int n = 0; n < 2; ++n) acc[a][b][m][n] = f32x4g{0.f, 0.f, 0.f, 0.f};
  gemm8p((const unsigned short*)(p.ws + O_HB), (const unsigned short*)(p.ws + O_WTIN), 1024, mb * 256, nt2 * 256, acc, (unsigned short*)smem);
  __builtin_amdgcn_sched_barrier(0);
  asm volatile("" ::: "memory");
  const int row0 = mb * 256;
  if (nt2 < 2) p1_epi_write<C_PLAIN>(p, acc, layer, nt2, row0);
  else if (nt2 < 4) p1_epi_write<C_FA>(p, acc, layer, nt2, row0);
  else if (nt2 < 6) p1_epi_write<C_PLAIN>(p, acc, layer, nt2, row0);
  else if (nt2 < 8) p1_epi_write<C_SILU>(p, acc, layer, nt2, row0);
  else if (nt2 < 10) p1_epi_write<C_QB>(p, acc, layer, nt2, row0);
  else if (nt2 < 14) p1_epi_write<C_PLAIN>(p, acc, layer, nt2, row0);
  else if (nt2 < 16) p1_epi_write<C_SILU>(p, acc, layer, nt2, row0);
  else if (nt2 < 18) p1_epi_write<C_PLAIN>(p, acc, layer, nt2, row0);
  else if (nt2 < 26) p1_epi_write<C_SIGM>(p, acc, layer, nt2, row0);
  else p1_epi_write<C_KIWI>(p, acc, layer, nt2, row0);
  __syncthreads();
  const int tid = vtid();
  const unsigned short* tile = (const unsigned short*)smem;
  const int c32 = tid & 31, rq = tid >> 5;
  if (nt2 >= 10 && nt2 < 14) {
    char* dst = p.ws + (nt2 < 12 ? O_KB : O_VB) + (size_t)row0 * 512 + (nt2 & 1) * 256 + c32 * 8;
#pragma unroll 4
    for (int q = 0; q < 16; ++q) {
      const int r = rq + 16 * q;
      const uint4 val = *(const uint4*)(tile + r * T8S + c32 * 8);
      int w0 = __builtin_amdgcn_cvt_pk_fp8_f32(bflo(val.x), bfhi(val.x), 0, false);
      w0 = __builtin_amdgcn_cvt_pk_fp8_f32(bflo(val.y), bfhi(val.y), w0, true);
      int w1 = __builtin_amdgcn_cvt_pk_fp8_f32(bflo(val.z), bfhi(val.z), 0, false);
      w1 = __builtin_amdgcn_cvt_pk_fp8_f32(bflo(val.w), bfhi(val.w), w1, true);
      *(uint2*)(dst + (size_t)r * 512) = make_uint2((unsigned)w0, (unsigned)w1);
    }
  } else if (nt2 < 16) {
    size_t base;
    switch (nt2 >> 1) {
      case 0: base = O_QA; break; case 1: base = O_KK; break; case 2: base = O_IA; break; case 3: base = O_ZA; break;
      case 4: base = O_QB; break; default: base = O_ZB; break;
    }
    char* dst = p.ws + base + ((size_t)row0 * 512 + (nt2 & 1) * 256 + c32 * 8) * 2;
#pragma unroll 4
    for (int q = 0; q < 16; ++q) {
      const int r = rq + 16 * q;
      *(uint4*)(dst + (size_t)r * 1024) = *(const uint4*)(tile + r * T8S + c32 * 8);
    }
  } else if (nt2 < 18) {
    const int head = 4 * (nt2 - 16) + (c32 >> 3), d0 = (c32 & 7) * 8;
#pragma unroll 4
    for (int q = 0; q < 16; ++q) {
      const int r = rq + 16 * q, t = row0 + r;
      const int item = t >> 5, tq = t & 31, mtile = tq >> 2, q4 = tq & 3;
      const int rr = (head & 3) + 4 * (q4 >> 1) + 8 * (head >> 2) + 16 * (q4 & 1);
      const int laneA = rr + 32 * ((d0 >> 3) & 1), ks = d0 >> 4;
      ((uint4*)(p.ws + O_QI))[((size_t)(item * 8 + mtile) * 4 + ks) * 64 + laneA] = *(const uint4*)(tile + r * T8S + c32 * 8);
    }
  } else if (nt2 < 26) {
    char* dst = p.ws + (nt2 < 22 ? O_SGA : O_SGB) + ((size_t)row0 * 1024 + ((nt2 - 18) & 3) * 256 + c32 * 8) * 2;
#pragma unroll 4
    for (int q = 0; q < 16; ++q) {
      const int r = rq + 16 * q;
      *(uint4*)(dst + (size_t)r * 2048) = *(const uint4*)(tile + r * T8S + c32 * 8);
    }
  } else {
    if (c32 < 8) {
      const int d0 = c32 * 8;
#pragma unroll 4
      for (int q = 0; q < 16; ++q) {
        const int r = rq + 16 * q, t = row0 + r;
        ((uint4*)(p.ws + O_KI))[((size_t)(t >> 5) * 4 + (d0 >> 4)) * 64 + (t & 31) + 32 * ((d0 >> 3) & 1)] = *(const uint4*)(tile + r * T8S + c32 * 8);
      }
    }
  }
  asm volatile("s_waitcnt lgkmcnt(0)" ::: "memory");
  __builtin_amdgcn_s_barrier();
}

constexpr int CAP = 1000, SEGCAP = 250, SEGTRIG = 186;
constexpr int IX_SC = 0, IX_IX = 64000, IX_RING = 96000, IX_CNT = 161536, IX_TAU = 161792, IX_FLAG = 161856, IX_WL = 161872;

DI float key2float(unsigned k) {
  unsigned b = (k & 0x80000000u) ? (k ^ 0x80000000u) : ~k;
  return __uint_as_float(b);
}
DI unsigned float2key(float f) {
  unsigned b = __float_as_uint(f);
  return (b & 0x80000000u) ? ~b : (b ^ 0x80000000u);
}
DI int wave_prefix_incl(int x) {
  int v = x;
  v += __builtin_amdgcn_update_dpp(0, v, 0x111, 0xf, 0xf, false);
  v += __builtin_amdgcn_update_dpp(0, v, 0x112, 0xf, 0xf, false);
  v += __builtin_amdgcn_update_dpp(0, v, 0x114, 0xf, 0xf, false);
  v += __builtin_amdgcn_update_dpp(0, v, 0x118, 0xf, 0xf, false);
  v += __builtin_amdgcn_update_dpp(0, v, 0x142, 0xa, 0xf, false);
  v += __builtin_amdgcn_update_dpp(0, v, 0x143, 0xc, 0xf, false);
  return v;
}

#define SEG_ADDR(j_) (((j_) >> 2) * SEGCAP + lane + 64 * ((j_) & 3))
DI int seg_count(const int4 c4, int s_) { return s_ == 0 ? c4.x : (s_ == 1 ? c4.y : (s_ == 2 ? c4.z : c4.w)); }

DI void wave_select(float* scq, unsigned short* ixq, int* cnt4q, float* tauq, unsigned* hist, int lane, unsigned short* final_sel) {
  lds_fence();
  const int4 c4 = *(const int4*)cnt4q;
  const int n = c4.x + c4.y + c4.z + c4.w;
  unsigned u[16], v16[16];
  unsigned mm = 0, am = 0;
#pragma unroll
  for (int j = 0; j < 16; ++j) {
    const bool valid = (lane + 64 * (j & 3)) < seg_count(c4, j >> 2);
    const float sv = valid ? scq[SEG_ADDR(j)] : 0.f;
    const unsigned id = valid ? (unsigned)ixq[SEG_ADDR(j)] : 0u;
    u[j] = float2key(sv);
    v16[j] = 0xFFFFu - id;
    mm |= (((unsigned)(lane + 64 * (j & 3)) - (unsigned)seg_count(c4, j >> 2)) >> 31) << j;
  }
  unsigned prefix_u = 0;
  if (n > 256) {
    int need = 256;
    int r0 = 0;
    {
      unsigned ref = 0; bool have = false;
#pragma unroll
      for (int j = 15; j >= 0; --j) if ((mm >> j) & 1u) { ref = u[j] >> 24; have = true; }
      const unsigned long long hm = __ballot(have);
      const int fl = __ffsll((long long)hm) - 1;
      ref = (unsigned)__builtin_amdgcn_readlane((int)ref, fl);
      bool same = true;
#pragma unroll
      for (int j = 0; j < 16; ++j) same = same && (!((mm >> j) & 1u) || ((u[j] >> 24) == ref));
      if (__all(same)) { prefix_u = ref << 24; r0 = 1; }
    }
    for (int r = r0; r < 6; ++r) {
      const int sh = (r < 4) ? (24 - 8 * r) : (r == 4 ? 8 : 0);
      { const unsigned z_ = vzero(); ((uint4*)hist)[lane] = make_uint4(z_, z_, z_, z_); }
      lds_fence();
#pragma unroll
      for (int j = 0; j < 16; ++j) {
        const unsigned src = (r < 4) ? u[j] : v16[j];
        const unsigned dgt = ((mm >> j) & 1u) ? ((src >> sh) & 255u) : 256u + lane;
        atomicAdd(&hist[dgt], 1u);
      }
      lds_fence();
      const uint4 hv = ((const uint4*)hist)[lane];
      const int c0 = hv.x, c1 = hv.y, c2 = hv.z, c3 = hv.w;
      const int Lsum = c0 + c1 + c2 + c3;
      const int Pfx = wave_prefix_incl(Lsum);
      const int total = __builtin_amdgcn_readlane(Pfx, 63);
      const int S = total - Pfx + Lsum;
      const unsigned long long mask = __ballot(S >= need);
      const int lstar = 63 - __clzll((long long)mask);
      int d_, ca_, cd_;
      {
        const int accu = S - Lsum;
        if (accu + c3 >= need) { d_ = 3; ca_ = accu; cd_ = c3; }
        else if (accu + c3 + c2 >= need) { d_ = 2; ca_ = accu + c3; cd_ = c2; }
        else if (accu + c3 + c2 + c1 >= need) { d_ = 1; ca_ = accu + c3 + c2; cd_ = c1; }
        else { d_ = 0; ca_ = accu + c3 + c2 + c1; cd_ = c0; }
      }
      const int D = __builtin_amdgcn_readlane(4 * lane + d_, lstar);
      const int cntAbove = __builtin_amdgcn_readlane(ca_, lstar);
      const int cntD = __builtin_amdgcn_readlane(cd_, lstar);
#pragma unroll
      for (int j = 0; j < 16; ++j) {
        const unsigned src = (r < 4) ? u[j] : v16[j];
        const int dgt = (int)((src >> sh) & 255u);
        const unsigned bit = mm & (1u << j);
        const unsigned dd = (unsigned)D - (unsigned)dgt, de = (unsigned)dgt - (unsigned)D;
        const unsigned gtm = (unsigned)((int)dd >> 31);
        const unsigned nem = (unsigned)((int)(dd | de) >> 31);
        am |= bit & gtm;
        mm ^= bit & nem;
      }
      need -= cntAbove;
      if (r < 4) prefix_u |= ((unsigned)D) << sh;
      if (cntD == need) break;
    }
  }
  const unsigned km = am | mm;
  int base = 0;
#pragma unroll
  for (int j = 0; j < 16; ++j) {
    const bool keep = (km >> j) & 1u;
    const unsigned long long m = __ballot(keep);
    const int rk = base + __popcll(m & ((1ull << lane) - 1ull));
    if (keep) {
      if (final_sel) { if (rk < 256) final_sel[rk] = (unsigned short)(0xFFFFu - v16[j]); }
      else { const int ad = (rk & 3) * SEGCAP + (rk >> 2); scq[ad] = key2float(u[j]); ixq[ad] = (unsigned short)(0xFFFFu - v16[j]); }
    }
    base += __popcll(m);
  }
  if (!final_sel && lane == 0) {
    *(int4*)cnt4q = make_int4((base + 3) >> 2, (base + 2) >> 2, (base + 1) >> 2, base >> 2);
    if (n > 256) *tauq = key2float(prefix_u);
  }
  lds_fence();
}

typedef float f32x2v __attribute__((ext_vector_type(2)));
DI float relu_(float x) { int i = __float_as_int(x); i = i > 0 ? i : 0; return __int_as_float(i); }

DI unsigned wave_umin(unsigned v) {
#define UMIN_STEP(ctrl, rm) { const unsigned o_ = (unsigned)__builtin_amdgcn_update_dpp((int)0xFFFFFFFFu, (int)v, ctrl, rm, 0xf, false); v = o_ < v ? o_ : v; }
  UMIN_STEP(0x111, 0xf) UMIN_STEP(0x112, 0xf) UMIN_STEP(0x114, 0xf) UMIN_STEP(0x118, 0xf) UMIN_STEP(0x142, 0xa) UMIN_STEP(0x143, 0xc)
#undef UMIN_STEP
  return (unsigned)__builtin_amdgcn_readlane((int)v, 63);
}
DI unsigned wave_umax(unsigned v) {
#define UMAX_STEP(ctrl, rm) { const unsigned o_ = (unsigned)__builtin_amdgcn_update_dpp(0, (int)v, ctrl, rm, 0xf, false); v = o_ > v ? o_ : v; }
  UMAX_STEP(0x111, 0xf) UMAX_STEP(0x112, 0xf) UMAX_STEP(0x114, 0xf) UMAX_STEP(0x118, 0xf) UMAX_STEP(0x142, 0xa) UMAX_STEP(0x143, 0xc)
#undef UMAX_STEP
  return (unsigned)__builtin_amdgcn_readlane((int)v, 63);
}
DI void wave_compact(float* scq, unsigned short* ixq, int* cnt4q, float* tauq, unsigned* hist, int lane) {
  lds_fence();
  const int4 c4 = *(const int4*)cnt4q;
  const int n = c4.x + c4.y + c4.z + c4.w;
  if (n <= 320) return;
  unsigned u[16], idv[16];
  unsigned vm = 0;
  unsigned umin = 0xFFFFFFFFu, umax = 0u;
  { const unsigned z_ = vzero(); ((uint4*)hist)[lane] = make_uint4(z_, z_, z_, z_); }

#pragma unroll
  for (int j = 0; j < 16; ++j) {
    const bool valid = (lane + 64 * (j & 3)) < seg_count(c4, j >> 2);
    u[j] = valid ? float2key(scq[SEG_ADDR(j)]) : 0u;
    idv[j] = valid ? (unsigned)ixq[SEG_ADDR(j)] : 0u;
    vm |= (((unsigned)(lane + 64 * (j & 3)) - (unsigned)seg_count(c4, j >> 2)) >> 31) << j;
    umin = valid ? (u[j] < umin ? u[j] : umin) : umin;
    umax = valid ? (u[j] > umax ? u[j] : umax) : umax;
  }
  umin = wave_umin(umin);
  umax = wave_umax(umax);
  const unsigned range = umax - umin;
  const int sh = range < 256u ? 0 : (24 - __clz((int)range));
#pragma unroll
  for (int j = 0; j < 16; ++j) {
    const unsigned bin = ((vm >> j) & 1u) ? ((u[j] - umin) >> sh) : 256u + lane;
    atomicAdd(&hist[bin], 1u);
  }
  lds_fence();
  const uint4 hv = ((const uint4*)hist)[lane];
  const int c0 = hv.x, c1 = hv.y, c2 = hv.z, c3 = hv.w;
  const int Lsum = c0 + c1 + c2 + c3;
  const int Pfx = wave_prefix_incl(Lsum);
  const int total = __builtin_amdgcn_readlane(Pfx, 63);
  const int S = total - Pfx + Lsum;
  const unsigned long long mask = __ballot(S >= 256);
  const int lstar = 63 - __clzll((long long)mask);
  int d_, kept_;
  {
    const int accu = S - Lsum;
    if (accu + c3 >= 256) { d_ = 3; kept_ = accu + c3; }
    else if (accu + c3 + c2 >= 256) { d_ = 2; kept_ = accu + c3 + c2; }
    else if (accu + c3 + c2 + c1 >= 256) { d_ = 1; kept_ = accu + c3 + c2 + c1; }
    else { d_ = 0; kept_ = accu + Lsum; }
  }
  const int D = __builtin_amdgcn_readlane(4 * lane + d_, lstar);
  const int kept = __builtin_amdgcn_readlane(kept_, lstar);
  if (kept > 400) return;
  int base = 0;
#pragma unroll
  for (int j = 0; j < 16; ++j) {
    const bool keep = ((vm >> j) & 1u) && ((int)((u[j] - umin) >> sh) >= D);
    const unsigned long long m = __ballot(keep);
    const int rk = base + __popcll(m & ((1ull << lane) - 1ull));
    if (keep) { const int ad = (rk & 3) * SEGCAP + (rk >> 2); scq[ad] = key2float(u[j]); ixq[ad] = (unsigned short)idv[j]; }
    base += __popcll(m);
  }
  if (lane == 0) {
    *(int4*)cnt4q = make_int4((base + 3) >> 2, (base + 2) >> 2, (base + 1) >> 2, base >> 2);
    *tauq = key2float(umin + ((unsigned)D << sh));
  }
  lds_fence();
}

#define IDX_GLDS(step, bufi) do { _Pragma("unroll") for (int r_ = 0; r_ < 4; ++r_) \
    __builtin_amdgcn_global_load_lds((const unsigned*)(ki + (size_t)(step) * 2048 + tid + 512 * r_), \
                                     (unsigned*)(ring + (bufi) * 2048 + tid + 512 * r_), 16, 0, 0); } while (0)

DI void indexer_item(const Params& p, int item) {
  const int tid = vtid(), lane = tid & 63, w = tid >> 6, g = w & 1, kg = w >> 1, hi = lane >> 5, c31 = lane & 31;
  float* sc = (float*)(smem + IX_SC);
  unsigned short* ix = (unsigned short*)(smem + IX_IX);
  uint4* ring = (uint4*)(smem + IX_RING);
  int* cnt = (int*)(smem + IX_CNT);
  volatile int* flag = (volatile int*)(smem + IX_FLAG);
  float* tauv = (float*)(smem + IX_TAU);
  const uint4* qi = (const uint4*)(p.ws + O_QI);
  const uint4* ki = (const uint4*)(p.ws + O_KI);
  const float* wi = (const float*)(p.ws + O_WI);
  const int t0 = 16 * item;
  bf16x8 a[2][4];
#pragma unroll
  for (int mt = 0; mt < 2; ++mt)
#pragma unroll
    for (int ks = 0; ks < 4; ++ks)
      a[mt][ks] = __builtin_bit_cast(bf16x8, qi[((size_t)((item >> 1) * 8 + (item & 1) * 4 + 2 * g + mt) * 4 + ks) * 64 + lane]);
  float* wl = (float*)(smem + IX_WL);
  if (tid < 128) wl[tid] = wi[(size_t)t0 * 8 + tid];
  float tau[2][2];
#pragma unroll
  for (int mt = 0; mt < 2; ++mt) { tau[mt][0] = -INFINITY; tau[mt][1] = -INFINITY; }
  if (tid < 64) cnt[tid] = 0;
  if (tid < 16) tauv[tid] = -INFINITY;
  int cntv[2][2] = {{0, 0}, {0, 0}};
  if (tid < 2) flag[tid] = 0;
  const int nsteps = (t0 + 16 + 255) >> 8;
  asm volatile("s_waitcnt vmcnt(0)" ::: "memory");
  IDX_GLDS(0, 0);
  if (nsteps > 1) { IDX_GLDS(1, 1); asm volatile("s_waitcnt vmcnt(4)" ::: "memory"); }
  else asm volatile("s_waitcnt vmcnt(0)" ::: "memory");
  __syncthreads();
  const f32x16 z = {0.f, 0.f, 0.f, 0.f, 0.f, 0.f, 0.f, 0.f, 0.f, 0.f, 0.f, 0.f, 0.f, 0.f, 0.f, 0.f};
  f32x16 Ca0, Ca1, Cb0, Cb1;
  {
    const uint4* cur = ring;
    const uint4* bp = cur + ((2 * kg + 0) * 4) * 64 + lane;
    bf16x8 b0 = __builtin_bit_cast(bf16x8, bp[0]), b1 = __builtin_bit_cast(bf16x8, bp[64]);
    bf16x8 b2 = __builtin_bit_cast(bf16x8, bp[128]), b3 = __builtin_bit_cast(bf16x8, bp[192]);
    Ca0 = MFMA(a[0][0], b0, z); Ca1 = MFMA(a[1][0], b0, z);
    Ca0 = MFMA(a[0][1], b1, Ca0); Ca1 = MFMA(a[1][1], b1, Ca1);
    Ca0 = MFMA(a[0][2], b2, Ca0); Ca1 = MFMA(a[1][2], b2, Ca1);
    Ca0 = MFMA(a[0][3], b3, Ca0); Ca1 = MFMA(a[1][3], b3, Ca1);
  }
  float4 wqa[2][2], wqb[2][2];
#pragma unroll
  for (int mt_ = 0; mt_ < 2; ++mt_)
#pragma unroll
    for (int aa_ = 0; aa_ < 2; ++aa_) {
      wqa[mt_][aa_] = *(const float4*)(wl + (8 * g + 4 * mt_ + 2 * hi + aa_) * 8);
      wqb[mt_][aa_] = *(const float4*)(wl + (8 * g + 4 * mt_ + 2 * hi + aa_) * 8 + 4);
    }
#define IDX_SCORE(Cx, mt_, aa_, sout) do { const float4 wa_ = wqa[mt_][aa_], wb_ = wqb[mt_][aa_]; \
    f32x2v r0_ = {relu_(Cx[8 * (aa_) + 0]), relu_(Cx[8 * (aa_) + 1])}, r1_ = {relu_(Cx[8 * (aa_) + 2]), relu_(Cx[8 * (aa_) + 3])}; \
    f32x2v r2_ = {relu_(Cx[8 * (aa_) + 4]), relu_(Cx[8 * (aa_) + 5])}, r3_ = {relu_(Cx[8 * (aa_) + 6]), relu_(Cx[8 * (aa_) + 7])}; \
    const f32x2v w0_ = {wa_.x, wa_.y}, w1_ = {wa_.z, wa_.w}, w2_ = {wb_.x, wb_.y}, w3_ = {wb_.z, wb_.w}; \
    f32x2v ac_ = r0_ * w0_; ac_ = r1_ * w1_ + ac_; ac_ = r2_ * w2_ + ac_; ac_ = r3_ * w3_ + ac_; \
    sout = ac_.x + ac_.y; } while (0)
  const unsigned ltm = (1u << c31) - 1u;
  const int tqb = t0 + 8 * g + 2 * hi;
  const int sb0 = ((8 * g + 2 * hi) * CAP + kg * SEGCAP) * 4;
#define IDX_APPEND(sval, mt_, aa_, keyv) do { \
    const bool pr_ = ((keyv) <= tqb + 4 * (mt_) + (aa_)) && ((sval) >= tau[mt_][aa_]); \
    const unsigned long long bm_ = __builtin_amdgcn_ballot_w64(pr_); \
    const unsigned half_ = hi ? (unsigned)(bm_ >> 32) : (unsigned)bm_; \
    const int pos_ = cntv[mt_][aa_] + __popc(half_ & ltm); \
    if (pr_) { const int bo_ = sb0 + (4 * (mt_) + (aa_)) * CAP * 4 + pos_ * 4; \
      *(float*)((char*)sc + bo_) = (sval); *(unsigned short*)((char*)ix + (bo_ >> 1)) = (unsigned short)(keyv); } \
    cntv[mt_][aa_] += __popc(half_); } while (0)
#define IDX_PUBLISH() do { if (c31 == 0) { _Pragma("unroll") for (int mt_ = 0; mt_ < 2; ++mt_) _Pragma("unroll") for (int aa_ = 0; aa_ < 2; ++aa_) \
    cnt[4 * (8 * g + 4 * mt_ + 2 * hi + aa_) + kg] = cntv[mt_][aa_]; } } while (0)
  for (int j = 0; j < nsteps; ++j) {
    const uint4* cur = ring + (j & 1) * 2048;
    {
      const uint4* bp = cur + ((2 * kg + 1) * 4) * 64 + lane;
      bf16x8 b0 = __builtin_bit_cast(bf16x8, bp[0]), b1 = __builtin_bit_cast(bf16x8, bp[64]);
      bf16x8 b2 = __builtin_bit_cast(bf16x8, bp[128]), b3 = __builtin_bit_cast(bf16x8, bp[192]);
      Cb0 = MFMA(a[0][0], b0, z); Cb1 = MFMA(a[1][0], b0, z);
      Cb0 = MFMA(a[0][1], b1, Cb0); Cb1 = MFMA(a[1][1], b1, Cb1);
      Cb0 = MFMA(a[0][2], b2, Cb0); Cb1 = MFMA(a[1][2], b2, Cb1);
      Cb0 = MFMA(a[0][3], b3, Cb0); Cb1 = MFMA(a[1][3], b3, Cb1);
    }
    {
      const int key = 256 * j + 64 * kg + c31;
      float s00, s01, s10, s11;
      IDX_SCORE(Ca0, 0, 0, s00); IDX_SCORE(Ca0, 0, 1, s01); IDX_SCORE(Ca1, 1, 0, s10); IDX_SCORE(Ca1, 1, 1, s11);
#pragma unroll
      for (int q_ = 0; q_ < 8; ++q_) { __builtin_amdgcn_sched_group_barrier(0x008, 1, 0); __builtin_amdgcn_sched_group_barrier(0x002, 9, 0); }
      IDX_APPEND(s00, 0, 0, key); IDX_APPEND(s01, 0, 1, key); IDX_APPEND(s10, 1, 0, key); IDX_APPEND(s11, 1, 1, key);
    }
    IDX_PUBLISH();
    {
      const int mxc = max(max(cntv[0][0], cntv[0][1]), max(cntv[1][0], cntv[1][1]));
      if (__ballot(mxc > SEGTRIG) != 0ull) { if (lane == 0) flag[j & 1] = j + 1; }
    }
    __syncthreads();
    if (flag[j & 1] == j + 1) {
      unsigned* hist = (unsigned*)(ring + (j & 1) * 2048) + w * 512;
#pragma unroll 1
      for (int k = 0; k < 2; ++k) {
        const int q = 2 * w + k;
        wave_compact(sc + q * CAP, ix + q * CAP, cnt + 4 * q, tauv + q, hist, lane);
        lds_fence();
        { const int4 cc = *(const int4*)(cnt + 4 * q); if (cc.x + cc.y + cc.z + cc.w > 400) wave_select(sc + q * CAP, ix + q * CAP, cnt + 4 * q, tauv + q, hist, lane, nullptr); }
      }
      __syncthreads();
#pragma unroll
      for (int mt = 0; mt < 2; ++mt)
#pragma unroll
        for (int aa = 0; aa < 2; ++aa) { const int ql = 8 * g + 4 * mt + 2 * hi + aa; tau[mt][aa] = tauv[ql]; cntv[mt][aa] = cnt[4 * ql + kg]; }
    }
    if (j + 2 < nsteps) IDX_GLDS(j + 2, j & 1);
    if (j + 1 < nsteps) {
      const uint4* nxt = ring + ((j + 1) & 1) * 2048;
      const uint4* bp = nxt + ((2 * kg + 0) * 4) * 64 + lane;
      bf16x8 b0 = __builtin_bit_cast(bf16x8, bp[0]), b1 = __builtin_bit_cast(bf16x8, bp[64]);
      bf16x8 b2 = __builtin_bit_cast(bf16x8, bp[128]), b3 = __builtin_bit_cast(bf16x8, bp[192]);
      Ca0 = MFMA(a[0][0], b0, z); Ca1 = MFMA(a[1][0], b0, z);
      Ca0 = MFMA(a[0][1], b1, Ca0); Ca1 = MFMA(a[1][1], b1, Ca1);
      Ca0 = MFMA(a[0][2], b2, Ca0); Ca1 = MFMA(a[1][2], b2, Ca1);
      Ca0 = MFMA(a[0][3], b3, Ca0); Ca1 = MFMA(a[1][3], b3, Ca1);
    }
    {
      const int key = 256 * j + 64 * kg + 32 + c31;
      float s00, s01, s10, s11;
      IDX_SCORE(Cb0, 0, 0, s00); IDX_SCORE(Cb0, 0, 1, s01); IDX_SCORE(Cb1, 1, 0, s10); IDX_SCORE(Cb1, 1, 1, s11);
#pragma unroll
      for (int q_ = 0; q_ < 8; ++q_) { __builtin_amdgcn_sched_group_barrier(0x008, 1, 0); __builtin_amdgcn_sched_group_barrier(0x002, 9, 0); }
      IDX_APPEND(s00, 0, 0, key); IDX_APPEND(s01, 0, 1, key); IDX_APPEND(s10, 1, 0, key); IDX_APPEND(s11, 1, 1, key);
    }
  }
  IDX_PUBLISH();
  __syncthreads();
  unsigned short* sel = (unsigned short*)(p.ws + O_SEL);
  unsigned* hist = (unsigned*)ring + w * 512;
#pragma unroll 1
  for (int k = 0; k < 2; ++k) {
    const int q = 2 * w + k;
    wave_select(sc + q * CAP, ix + q * CAP, cnt + 4 * q, tauv + q, hist, lane, sel + (size_t)(t0 + q) * 256);
  }
  __syncthreads();
}

DI void hgrn_a_item(const Params& p, int c, int h) {
  const int tid = vtid(), lane = tid & 63, w = tid >> 6, hi = lane >> 5, c31 = lane & 31;
  float* tot = (float*)smem;
  unsigned short* kT = (unsigned short*)(smem + 2048);
  unsigned short* vT = (unsigned short*)(smem + 2048 + 18432);
  const int seg = tid >> 7, k = tid & 127;
  const float* G = (const float*)(p.ws + O_G);
  const unsigned short* KK = (const unsigned short*)(p.ws + O_KK);
  const unsigned short* IA = (const unsigned short*)(p.ws + O_IA);
  const size_t rowbase = (size_t)(64 * c + 16 * seg);
  float b[16];
  {
    float run = 0.f;
#pragma unroll
    for (int i = 0; i < 16; ++i) { run += G[(rowbase + i) * 512 + 128 * h + k]; b[i] = run; }
    tot[seg * 128 + k] = run;
  }
  __syncthreads();
  float off = 0.f, blast = 0.f;
#pragma unroll
  for (int s2 = 0; s2 < 4; ++s2) { float tv = tot[s2 * 128 + k]; if (s2 < seg) off += tv; blast += tv; }
  {
    unsigned pk[8], pv[8];
#pragma unroll
    for (int i = 0; i < 16; i += 2) {
      float k0 = bf2f(KK[(rowbase + i) * 512 + 128 * h + k]) * __expf(blast - (b[i] + off));
      float k1 = bf2f(KK[(rowbase + i + 1) * 512 + 128 * h + k]) * __expf(blast - (b[i + 1] + off));
      pk[i >> 1] = cvtpk(k0, k1);
      unsigned v0 = IA[(rowbase + i) * 512 + 128 * h + k], v1 = IA[(rowbase + i + 1) * 512 + 128 * h + k];
      pv[i >> 1] = v0 | (v1 << 16);
    }
    uint4* dk = (uint4*)(kT + k * 72 + 16 * seg);
    dk[0] = make_uint4(pk[0], pk[1], pk[2], pk[3]); dk[1] = make_uint4(pk[4], pk[5], pk[6], pk[7]);
    uint4* dv = (uint4*)(vT + k * 72 + 16 * seg);
    dv[0] = make_uint4(pv[0], pv[1], pv[2], pv[3]); dv[1] = make_uint4(pv[4], pv[5], pv[6], pv[7]);
    if (seg == 0) ((float*)(p.ws + O_D))[(size_t)(c * 4 + h) * 128 + k] = __expf(blast);
  }
  __syncthreads();
  const int mt = w >> 1;
  f32x16 acc[2];
#pragma unroll
  for (int r = 0; r < 16; ++r) { acc[0][r] = 0.f; acc[1][r] = 0.f; }
#pragma unroll
  for (int ks = 0; ks < 4; ++ks) {
    bf16x8 af = __builtin_bit_cast(bf16x8, *(const uint4*)(kT + (32 * mt + c31) * 72 + 16 * ks + 8 * hi));
#pragma unroll
    for (int jn = 0; jn < 2; ++jn) {
      const int nt = 2 * (w & 1) + jn;
      bf16x8 bfv = __builtin_bit_cast(bf16x8, *(const uint4*)(vT + (32 * nt + c31) * 72 + 16 * ks + 8 * hi));
      acc[jn] = MFMA(af, bfv, acc[jn]);
    }
  }
  char* us = p.ws + O_US + (size_t)(c * 4 + h) * 32768;
#pragma unroll
  for (int jn = 0; jn < 2; ++jn) {
    const int nt = 2 * (w & 1) + jn;
    const int v = 32 * nt + c31;
#pragma unroll
    for (int gq = 0; gq < 4; ++gq) {
      const int k0 = 32 * mt + 8 * gq;
      const size_t unit = ((size_t)(v >> 5) * 8 + (k0 >> 4)) * 64 + (v & 31) + 32 * ((k0 >> 3) & 1);
      uint2 val;
      val.x = cvtpk(acc[jn][4 * gq + 0], acc[jn][4 * gq + 1]);
      val.y = cvtpk(acc[jn][4 * gq + 2], acc[jn][4 * gq + 3]);
      *(uint2*)(us + unit * 16 + 8 * hi) = val;
    }
  }
  __syncthreads();
}

DI void hgrn_scan(const Params& p) {
  const int tid = vtid();
  if (tid >= 128) return;
  for (int pid = blockIdx.x * 128 + tid; pid < 32768; pid += gridDim.x * 128) {
    const int q4 = pid & 3, unit = (pid >> 2) & 2047, h = pid >> 13;
    const int lanep = unit & 63, ks = (unit >> 6) & 7;
    const int k = ks * 16 + 8 * (lanep >> 5) + 2 * q4;
    unsigned* us = (unsigned*)(p.ws + O_US) + (size_t)h * 8192 + unit * 4 + q4;
    const float* dd = (const float*)(p.ws + O_D) + h * 128 + k;
    float s0 = 0.f, s1 = 0.f;
    unsigned uv[16], un[16];
    float2 dv[16], dn[16];
#pragma unroll
    for (int i = 0; i < 16; ++i) { uv[i] = us[(size_t)i * 32768]; dv[i] = *(const float2*)(dd + (size_t)i * 512); }
#pragma unroll 1
    for (int c0 = 0; c0 < 256; c0 += 16) {
      const int cn = (c0 + 16 < 256) ? c0 + 16 : c0;
#pragma unroll
      for (int i = 0; i < 16; ++i) { un[i] = us[(size_t)(cn + i) * 32768]; dn[i] = *(const float2*)(dd + (size_t)(cn + i) * 512); }
      asm volatile("" ::: "memory");
#pragma unroll
      for (int i = 0; i < 16; ++i) {
        us[(size_t)(c0 + i) * 32768] = cvtpk(s0, s1);
        s0 = fmaf(dv[i].x, s0, bflo(uv[i]));
        s1 = fmaf(dv[i].y, s1, bfhi(uv[i]));
      }
      asm volatile("" ::: "memory");
#pragma unroll
      for (int i = 0; i < 16; ++i) { uv[i] = un[i]; dv[i] = dn[i]; }
    }
  }
}

constexpr int AT_LUT = 0, AT_RB = 512, AT_WAVE = 2048, AT_WSZ = 8192 + 1024 + 16 * 528;
DI void attn_setup() {
  const int tid = vtid();
  int* lut = (int*)(smem + AT_LUT);
  if (tid < 128) {
    int d = tid;
    int bk;
    if (d < 16) bk = d;
    else {
      float df = (float)d;
      int lg = 16 + (int)(logf(df / 16.f) / 2.0794415416798357f * 16.f);
      bk = lg < 31 ? lg : 31;
    }
    lut[tid] = bk;
  }
}
DI float dppf(float v, int ctrl_sel) {
  const int iv = __builtin_bit_cast(int, v);
  int r;
  if (ctrl_sel == 0) r = __builtin_amdgcn_update_dpp(0, iv, 0xB1, 0xf, 0xf, false);
  else if (ctrl_sel == 1) r = __builtin_amdgcn_update_dpp(0, iv, 0x4E, 0xf, 0xf, false);
  else r = __builtin_amdgcn_update_dpp(0, iv, 0x141, 0xf, 0xf, false);
  return __builtin_bit_cast(float, r);
}
DI float sum8(float v) { v += dppf(v, 0); v += dppf(v, 1); v += dppf(v, 2); return v; }
DI float max8(float v) { v = fmaxf(v, dppf(v, 0)); v = fmaxf(v, dppf(v, 1)); v = fmaxf(v, dppf(v, 2)); return v; }

DI size_t prob_off(int t) {
  return t < 8192 ? O_MG + (size_t)t * 4096 : (t < 12288 ? O_AA + (size_t)(t - 8192) * 4096 : O_QI + (size_t)(t - 12288) * 4096);
}
#define MFMA8S(a, b, c) __builtin_amdgcn_mfma_f32_16x16x32_fp8_fp8((a), (b), (c), 0, 0, 0)
typedef __attribute__((ext_vector_type(4))) float f32x4v;
constexpr int AT_KROW = 528;
struct QKPF { int s0, s1, s2, s3; uint4 q0, q1; };
DI void qk_fetch(const Params& p, int t, int lane, QKPF& f) {
  const int nsel = t + 1 < 256 ? t + 1 : 256;
  const unsigned short* sel = (const unsigned short*)(p.ws + O_SEL) + (size_t)t * 256;
  f.s0 = lane < nsel ? (int)sel[lane] : 0; f.s1 = lane + 64 < nsel ? (int)sel[lane + 64] : 0;
  f.s2 = lane + 128 < nsel ? (int)sel[lane + 128] : 0; f.s3 = lane + 192 < nsel ? (int)sel[lane + 192] : 0;
  const unsigned short* qp = (const unsigned short*)(p.ws + O_QB) + (size_t)t * 512 + (lane & 7) * 64 + 8 * (lane >> 4);
  f.q0 = *(const uint4*)qp; f.q1 = *(const uint4*)(qp + 32);
}
DI void attn_query(const Params& p, int t, int tnext, int w, int lane, QKPF& pf) {
  const int h = lane >> 3, dg = lane & 7, n15 = lane & 15, quad = lane >> 4, hi = lane >> 5, c31 = lane & 31;
  const int* lut = (const int*)(smem + AT_LUT);
  const float* rb = (const float*)(smem + AT_RB);
  float* lgw = (float*)(smem + AT_WAVE + w * AT_WSZ);
  int* ixw = (int*)(smem + AT_WAVE + w * AT_WSZ + 8192);
  char* kst = smem + AT_WAVE + w * AT_WSZ + 9216;
  const int nsel = t + 1 < 256 ? t + 1 : 256;
  ixw[lane] = pf.s0; ixw[lane + 64] = pf.s1; ixw[lane + 128] = pf.s2; ixw[lane + 192] = pf.s3;
  const uint4 qcur0 = pf.q0, qcur1 = pf.q1;
  qk_fetch(p, tnext < L_ ? tnext : t, lane, pf);
  long qreg[2];
  {
#pragma unroll
    for (int c = 0; c < 2; ++c) {
      const uint4 qv = c == 0 ? qcur0 : qcur1;
      int w0 = __builtin_amdgcn_cvt_pk_fp8_f32(bflo(qv.x) * 8.f, bfhi(qv.x) * 8.f, 0, false);
      w0 = __builtin_amdgcn_cvt_pk_fp8_f32(bflo(qv.y) * 8.f, bfhi(qv.y) * 8.f, w0, true);
      int w1 = __builtin_amdgcn_cvt_pk_fp8_f32(bflo(qv.z) * 8.f, bfhi(qv.z) * 8.f, 0, false);
      w1 = __builtin_amdgcn_cvt_pk_fp8_f32(bflo(qv.w) * 8.f, bfhi(qv.w) * 8.f, w1, true);
      const long v = (long)(((unsigned long long)(unsigned)w1 << 32) | (unsigned long long)(unsigned)w0);
      qreg[c] = (n15 < 8) ? v : 0L;
    }
  }
  long bsel[16];
#pragma unroll
  for (int ks = 0; ks < 16; ++ks) bsel[ks] = (n15 == (ks >> 1)) ? qreg[ks & 1] : 0L;
  lds_fence();
  const uint4* KB16 = (const uint4*)(p.ws + O_KB);
  const uint2* VB = (const uint2*)(p.ws + O_VB);
  const int ntile = (nsel + 15) >> 4;
#define AT_KMMA(kt_) do { f32x4v acc0 = {0.f, 0.f, 0.f, 0.f}, acc1 = acc0, acc2 = acc0, acc3 = acc0; \
    const char* ar = kst + n15 * AT_KROW + 8 * quad; \
    _Pragma("unroll") for (int ks = 0; ks < 16; ks += 4) { \
      acc0 = MFMA8S(*(const long*)(ar + 32 * ks), bsel[ks], acc0); \
      acc1 = MFMA8S(*(const long*)(ar + 32 * ks + 32), bsel[ks + 1], acc1); \
      acc2 = MFMA8S(*(const long*)(ar + 32 * ks + 64), bsel[ks + 2], acc2); \
      acc3 = MFMA8S(*(const long*)(ar + 32 * ks + 96), bsel[ks + 3], acc3); } \
    const f32x4v acc = (acc0 + acc1) + (acc2 + acc3); \
    if (n15 < 8) { _Pragma("unroll") for (int i = 0; i < 4; ++i) lgw[(16 * (kt_) + 4 * quad + i) * 8 + n15] = acc[i] * 0.125f; } \
    cbar(); } while (0)
  uint4 kgA0, kgA1, kgA2, kgA3, kgA4, kgA5, kgA6, kgA7, kgB0, kgB1, kgB2, kgB3, kgB4, kgB5, kgB6, kgB7, kgC0, kgC1, kgC2, kgC3, kgC4, kgC5, kgC6, kgC7;
    { const int tl_ = (0) < ntile ? (0) : ntile - 1;
      const int4 ia_ = *(const int4*)(ixw + 16 * tl_ + 8 * hi), ib_ = *(const int4*)(ixw + 16 * tl_ + 8 * hi + 4);
      kgA0 = KB16[(size_t)ia_.x * 32 + c31]; kgA1 = KB16[(size_t)ia_.y * 32 + c31]; kgA2 = KB16[(size_t)ia_.z * 32 + c31]; kgA3 = KB16[(size_t)ia_.w * 32 + c31];
      kgA4 = KB16[(size_t)ib_.x * 32 + c31]; kgA5 = KB16[(size_t)ib_.y * 32 + c31]; kgA6 = KB16[(size_t)ib_.z * 32 + c31]; kgA7 = KB16[(size_t)ib_.w * 32 + c31]; }
    { const int tl_ = (1) < ntile ? (1) : ntile - 1;
      const int4 ia_ = *(const int4*)(ixw + 16 * tl_ + 8 * hi), ib_ = *(const int4*)(ixw + 16 * tl_ + 8 * hi + 4);
      kgB0 = KB16[(size_t)ia_.x * 32 + c31]; kgB1 = KB16[(size_t)ia_.y * 32 + c31]; kgB2 = KB16[(size_t)ia_.z * 32 + c31]; kgB3 = KB16[(size_t)ia_.w * 32 + c31];
      kgB4 = KB16[(size_t)ib_.x * 32 + c31]; kgB5 = KB16[(size_t)ib_.y * 32 + c31]; kgB6 = KB16[(size_t)ib_.z * 32 + c31]; kgB7 = KB16[(size_t)ib_.w * 32 + c31]; }
    { const int tl_ = (2) < ntile ? (2) : ntile - 1;
      const int4 ia_ = *(const int4*)(ixw + 16 * tl_ + 8 * hi), ib_ = *(const int4*)(ixw + 16 * tl_ + 8 * hi + 4);
      kgC0 = KB16[(size_t)ia_.x * 32 + c31]; kgC1 = KB16[(size_t)ia_.y * 32 + c31]; kgC2 = KB16[(size_t)ia_.z * 32 + c31]; kgC3 = KB16[(size_t)ia_.w * 32 + c31];
      kgC4 = KB16[(size_t)ib_.x * 32 + c31]; kgC5 = KB16[(size_t)ib_.y * 32 + c31]; kgC6 = KB16[(size_t)ib_.z * 32 + c31]; kgC7 = KB16[(size_t)ib_.w * 32 + c31]; }
  for (int kt = 0; kt < ntile; kt += 3) {
    { char* wr = kst + (8 * hi) * AT_KROW + c31 * 16; *(uint4*)(wr + 0 * AT_KROW) = kgA0; *(uint4*)(wr + 1 * AT_KROW) = kgA1; *(uint4*)(wr + 2 * AT_KROW) = kgA2; *(uint4*)(wr + 3 * AT_KROW) = kgA3; *(uint4*)(wr + 4 * AT_KROW) = kgA4; *(uint4*)(wr + 5 * AT_KROW) = kgA5; *(uint4*)(wr + 6 * AT_KROW) = kgA6; *(uint4*)(wr + 7 * AT_KROW) = kgA7; }
    if (((kt) + 3) < ntile) { const int tl_ = ((kt) + 3);
      const int4 ia_ = *(const int4*)(ixw + 16 * tl_ + 8 * hi), ib_ = *(const int4*)(ixw + 16 * tl_ + 8 * hi + 4);
      kgA0 = KB16[(size_t)ia_.x * 32 + c31]; kgA1 = KB16[(size_t)ia_.y * 32 + c31]; kgA2 = KB16[(size_t)ia_.z * 32 + c31]; kgA3 = KB16[(size_t)ia_.w * 32 + c31];
      kgA4 = KB16[(size_t)ib_.x * 32 + c31]; kgA5 = KB16[(size_t)ib_.y * 32 + c31]; kgA6 = KB16[(size_t)ib_.z * 32 + c31]; kgA7 = KB16[(size_t)ib_.w * 32 + c31]; }
    cbar();
    AT_KMMA(kt);
    if (kt + 1 < ntile) {
    { char* wr = kst + (8 * hi) * AT_KROW + c31 * 16; *(uint4*)(wr + 0 * AT_KROW) = kgB0; *(uint4*)(wr + 1 * AT_KROW) = kgB1; *(uint4*)(wr + 2 * AT_KROW) = kgB2; *(uint4*)(wr + 3 * AT_KROW) = kgB3; *(uint4*)(wr + 4 * AT_KROW) = kgB4; *(uint4*)(wr + 5 * AT_KROW) = kgB5; *(uint4*)(wr + 6 * AT_KROW) = kgB6; *(uint4*)(wr + 7 * AT_KROW) = kgB7; }
    if (((kt + 1) + 3) < ntile) { const int tl_ = ((kt + 1) + 3);
      const int4 ia_ = *(const int4*)(ixw + 16 * tl_ + 8 * hi), ib_ = *(const int4*)(ixw + 16 * tl_ + 8 * hi + 4);
      kgB0 = KB16[(size_t)ia_.x * 32 + c31]; kgB1 = KB16[(size_t)ia_.y * 32 + c31]; kgB2 = KB16[(size_t)ia_.z * 32 + c31]; kgB3 = KB16[(size_t)ia_.w * 32 + c31];
      kgB4 = KB16[(size_t)ib_.x * 32 + c31]; kgB5 = KB16[(size_t)ib_.y * 32 + c31]; kgB6 = KB16[(size_t)ib_.z * 32 + c31]; kgB7 = KB16[(size_t)ib_.w * 32 + c31]; }
    cbar();
    AT_KMMA(kt + 1);
    }
    if (kt + 2 < ntile) {
    { char* wr = kst + (8 * hi) * AT_KROW + c31 * 16; *(uint4*)(wr + 0 * AT_KROW) = kgC0; *(uint4*)(wr + 1 * AT_KROW) = kgC1; *(uint4*)(wr + 2 * AT_KROW) = kgC2; *(uint4*)(wr + 3 * AT_KROW) = kgC3; *(uint4*)(wr + 4 * AT_KROW) = kgC4; *(uint4*)(wr + 5 * AT_KROW) = kgC5; *(uint4*)(wr + 6 * AT_KROW) = kgC6; *(uint4*)(wr + 7 * AT_KROW) = kgC7; }
    if (((kt + 2) + 3) < ntile) { const int tl_ = ((kt + 2) + 3);
      const int4 ia_ = *(const int4*)(ixw + 16 * tl_ + 8 * hi), ib_ = *(const int4*)(ixw + 16 * tl_ + 8 * hi + 4);
      kgC0 = KB16[(size_t)ia_.x * 32 + c31]; kgC1 = KB16[(size_t)ia_.y * 32 + c31]; kgC2 = KB16[(size_t)ia_.z * 32 + c31]; kgC3 = KB16[(size_t)ia_.w * 32 + c31];
      kgC4 = KB16[(size_t)ib_.x * 32 + c31]; kgC5 = KB16[(size_t)ib_.y * 32 + c31]; kgC6 = KB16[(size_t)ib_.z * 32 + c31]; kgC7 = KB16[(size_t)ib_.w * 32 + c31]; }
    cbar();
    AT_KMMA(kt + 2);
    }
  }
  lds_fence();
  const int ngroups = (nsel + 7) >> 3;
  float mx = -INFINITY;
#pragma unroll 8
  for (int i = 0; i < 32; ++i) {
    const int kk = 8 * i + dg;
    const int myidx = ixw[kk];
    const int dist = t - myidx;
    const int bk = dist < 128 ? lut[dist < 0 ? 0 : dist] : 31;
    const float raw = lgw[kk * 8 + h];
    const float lgt = (kk < nsel) ? raw + rb[bk * 8 + h] : -INFINITY;
    lgw[kk * 8 + h] = lgt;
    mx = fmaxf(mx, lgt);
  }
  mx = max8(mx);
  float sum = 0.f;
#pragma unroll 8
  for (int i = 0; i < 32; ++i) {
    const float pv = __expf(lgw[(8 * i + dg) * 8 + h] - mx);
    sum += pv;
    lgw[(8 * i + dg) * 8 + h] = pv;
  }
  sum = sum8(sum);
  {
    const float inv = 1.f / sum;
#pragma unroll 8
    for (int i = 0; i < 32; ++i) lgw[(8 * i + dg) * 8 + h] *= inv;
  }
  lds_fence();
  {
    uint4 pk[4];
#pragma unroll
    for (int k = 0; k < 4; ++k) {
      const float4 a_ = *(const float4*)(lgw + (4 * lane + k) * 8), b_ = *(const float4*)(lgw + (4 * lane + k) * 8 + 4);
      pk[k] = make_uint4(cvtpk(a_.x, a_.y), cvtpk(a_.z, a_.w), cvtpk(b_.x, b_.y), cvtpk(b_.z, b_.w));
    }
    uint4* pdst = (uint4*)(p.ws + prob_off(t)) + lane * 4;
    pdst[0] = pk[0]; pdst[1] = pk[1]; pdst[2] = pk[2]; pdst[3] = pk[3];
  }
  lds_fence();
}

DI void attn_pv_query(const Params& p, int t, int w, int lane) {
  const int half = lane >> 5, l5 = lane & 31, h = l5 >> 2;
  unsigned short* pl = (unsigned short*)(smem + AT_WAVE + w * AT_WSZ);
  int* ixw = (int*)(smem + AT_WAVE + w * AT_WSZ + 8192);
  const int nsel = t + 1 < 256 ? t + 1 : 256;
  const unsigned short* sel = (const unsigned short*)(p.ws + O_SEL) + (size_t)t * 256;
#pragma unroll
  for (int j = 0; j < 4; ++j) {
    const int pos = lane + 64 * j;
    ixw[pos] = pos < nsel ? (int)sel[pos] : 0;
  }
  {
    const uint4* psrc = (const uint4*)(p.ws + prob_off(t)) + lane * 4;
    uint4* pd = (uint4*)pl + lane * 4;
    const uint4 a0 = psrc[0], a1 = psrc[1], a2 = psrc[2], a3 = psrc[3];
    pd[0] = a0; pd[1] = a1; pd[2] = a2; pd[3] = a3;
  }
  lds_fence();
  const uint4* VB4 = (const uint4*)(p.ws + O_VB) + l5;
  f32x2v o0 = {0.f, 0.f}, o1 = {0.f, 0.f}, o2 = {0.f, 0.f}, o3 = {0.f, 0.f}, o4 = {0.f, 0.f}, o5 = {0.f, 0.f}, o6 = {0.f, 0.f}, o7 = {0.f, 0.f};
  uint4 kc[8], kn[8];
#define AT_VLOAD16(dst, ib) do { _Pragma("unroll") for (int q_ = 0; q_ < 4; ++q_) { const int4 i_ = *(const int4*)(ixw + (ib) + 4 * q_); \
    dst[2 * q_ + 0] = VB4[(size_t)(half ? i_.y : i_.x) * 32]; dst[2 * q_ + 1] = VB4[(size_t)(half ? i_.w : i_.z) * 32]; } } while (0)
  const int ng16 = (nsel + 15) >> 4;
  AT_VLOAD16(kc, 0);
  const unsigned short* plh = pl + half * 8 + h;
  for (int i = 0; i < ng16; ++i) {
    { const int nx = (i + 1 < ng16) ? i + 1 : i; AT_VLOAD16(kn, 16 * nx); }
#pragma unroll
    for (int q = 0; q < 8; ++q) {
      const float pb = bf2f(plh[(16 * i + 2 * q) * 8]);
      const f32x2v pb2 = {pb, pb};
      o0 = __builtin_amdgcn_cvt_pk_f32_fp8(kc[q].x, false) * pb2 + o0;
      o1 = __builtin_amdgcn_cvt_pk_f32_fp8(kc[q].x, true) * pb2 + o1;
      o2 = __builtin_amdgcn_cvt_pk_f32_fp8(kc[q].y, false) * pb2 + o2;
      o3 = __builtin_amdgcn_cvt_pk_f32_fp8(kc[q].y, true) * pb2 + o3;
      o4 = __builtin_amdgcn_cvt_pk_f32_fp8(kc[q].z, false) * pb2 + o4;
      o5 = __builtin_amdgcn_cvt_pk_f32_fp8(kc[q].z, true) * pb2 + o5;
      o6 = __builtin_amdgcn_cvt_pk_f32_fp8(kc[q].w, false) * pb2 + o6;
      o7 = __builtin_amdgcn_cvt_pk_f32_fp8(kc[q].w, true) * pb2 + o7;
    }
#pragma unroll
    for (int q = 0; q < 8; ++q) kc[q] = kn[q];
  }
#define AT_HSUM(o) do { o.x += __shfl_xor(o.x, 32); o.y += __shfl_xor(o.y, 32); } while (0)
  AT_HSUM(o0); AT_HSUM(o1); AT_HSUM(o2); AT_HSUM(o3); AT_HSUM(o4); AT_HSUM(o5); AT_HSUM(o6); AT_HSUM(o7);
  if (half == 0) {
    const uint4 z0 = ((const uint4*)(p.ws + O_ZB))[(size_t)t * 64 + 2 * l5], z1 = ((const uint4*)(p.ws + O_ZB))[(size_t)t * 64 + 2 * l5 + 1];
    uint4 v0, v1;
    v0.x = cvtpk(o0.x * bflo(z0.x), o0.y * bfhi(z0.x)); v0.y = cvtpk(o1.x * bflo(z0.y), o1.y * bfhi(z0.y));
    v0.z = cvtpk(o2.x * bflo(z0.z), o2.y * bfhi(z0.z)); v0.w = cvtpk(o3.x * bflo(z0.w), o3.y * bfhi(z0.w));
    v1.x = cvtpk(o4.x * bflo(z1.x), o4.y * bfhi(z1.x)); v1.y = cvtpk(o5.x * bflo(z1.y), o5.y * bfhi(z1.y));
    v1.z = cvtpk(o6.x * bflo(z1.z), o6.y * bfhi(z1.z)); v1.w = cvtpk(o7.x * bflo(z1.w), o7.y * bfhi(z1.w));
    ((uint4*)(p.ws + O_AB))[tiled_unit(t, l5 * 16, 32)] = v0;
    ((uint4*)(p.ws + O_AB))[tiled_unit(t, l5 * 16 + 8, 32)] = v1;
  }
  lds_fence();
}

constexpr int HC_B = 0;
constexpr int HC_QT = 33792;
constexpr int HC_QH = HC_QT + 17408;
constexpr int HC_KH = HC_QH + 17408;
constexpr int HC_VT = HC_KH + 17408;
constexpr int HC_P = HC_VT + 18432;
constexpr int HC_TOT = HC_P + 9216;
DI void hgrn_c_item(const Params& p, int layer, int c, int h) {
  const int tid = vtid(), lane = tid & 63, w = tid >> 6, hi = lane >> 5, c31 = lane & 31;
  float* bL = (float*)(smem + HC_B);
  unsigned short* qT = (unsigned short*)(smem + HC_QT);
  unsigned short* qH = (unsigned short*)(smem + HC_QH);
  unsigned short* kH = (unsigned short*)(smem + HC_KH);
  unsigned short* vT = (unsigned short*)(smem + HC_VT);
  unsigned short* P = (unsigned short*)(smem + HC_P);
  float* tot = (float*)(smem + HC_TOT);
  const float* G = (const float*)(p.ws + O_G);
  const unsigned short* KK = (const unsigned short*)(p.ws + O_KK);
  const unsigned short* IA = (const unsigned short*)(p.ws + O_IA);
  const unsigned short* QA = (const unsigned short*)(p.ws + O_QA);
  const int mt = w >> 2, nv = w & 3;
  const uint4* us = (const uint4*)(p.ws + O_US + (size_t)(c * 4 + h) * 32768);
  uint4 sfr[8];
#pragma unroll
  for (int ks = 0; ks < 8; ++ks) sfr[ks] = us[(nv * 8 + ks) * 64 + lane];
  uint4 qv_pre[2], kv_pre[2];
#pragma unroll
  for (int rep = 0; rep < 2; ++rep) {
    const int pr = tid + 512 * rep, t = pr >> 4, oc = pr & 15;
    qv_pre[rep] = *(const uint4*)(QA + (size_t)(64 * c + t) * 512 + 128 * h + oc * 8);
    kv_pre[rep] = *(const uint4*)(KK + (size_t)(64 * c + t) * 512 + 128 * h + oc * 8);
  }
  const uint4 z0_pre = *(const uint4*)((const unsigned short*)(p.ws + O_ZA) + (size_t)(64 * c + (tid >> 3)) * 512 + 128 * h + 16 * (tid & 7));
  const uint4 z1_pre = *(const uint4*)((const unsigned short*)(p.ws + O_ZA) + (size_t)(64 * c + (tid >> 3)) * 512 + 128 * h + 16 * (tid & 7) + 8);
  {
    const int seg = tid >> 7, k = tid & 127;
    const size_t rowbase = (size_t)(64 * c + 16 * seg);
    float b[16];
    float run = 0.f;
#pragma unroll
    for (int i = 0; i < 16; ++i) { run += G[(rowbase + i) * 512 + 128 * h + k]; b[i] = run; }
    tot[seg * 128 + k] = run;
    unsigned pv[8];
#pragma unroll
    for (int i = 0; i < 16; i += 2) {
      unsigned v0 = IA[(rowbase + i) * 512 + 128 * h + k], v1 = IA[(rowbase + i + 1) * 512 + 128 * h + k];
      pv[i >> 1] = v0 | (v1 << 16);
    }
    uint4* dv = (uint4*)(vT + k * 72 + 16 * seg);
    dv[0] = make_uint4(pv[0], pv[1], pv[2], pv[3]); dv[1] = make_uint4(pv[4], pv[5], pv[6], pv[7]);
    __syncthreads();
    float off = 0.f;
#pragma unroll
    for (int s2 = 0; s2 < 4; ++s2) { float tv = tot[s2 * 128 + k]; if (s2 < seg) off += tv; }
#pragma unroll
    for (int i = 0; i < 16; ++i) bL[(16 * seg + i) * 132 + k] = b[i] + off;
  }
  __syncthreads();
#pragma unroll
  for (int rep = 0; rep < 2; ++rep) {
    const int pr = tid + 512 * rep, t = pr >> 4, oc = pr & 15;
    const float4 b0 = *(const float4*)(bL + t * 132 + oc * 8), b1 = *(const float4*)(bL + t * 132 + oc * 8 + 4);
    const float4 r0 = *(const float4*)(bL + 31 * 132 + oc * 8), r1 = *(const float4*)(bL + 31 * 132 + oc * 8 + 4);
    const uint4 qv = qv_pre[rep];
    const uint4 kv = kv_pre[rep];
    const float bb[8] = {b0.x, b0.y, b0.z, b0.w, b1.x, b1.y, b1.z, b1.w};
    const float rr[8] = {r0.x, r0.y, r0.z, r0.w, r1.x, r1.y, r1.z, r1.w};
    const float qq[8] = {bflo(qv.x), bfhi(qv.x), bflo(qv.y), bfhi(qv.y), bflo(qv.z), bfhi(qv.z), bflo(qv.w), bfhi(qv.w)};
    const float kq[8] = {bflo(kv.x), bfhi(kv.x), bflo(kv.y), bfhi(kv.y), bflo(kv.z), bfhi(kv.z), bflo(kv.w), bfhi(kv.w)};
    float a1[8], a2[8], a3[8];
#pragma unroll
    for (int e = 0; e < 8; ++e) {
      a1[e] = qq[e] * __expf(bb[e]);
      a2[e] = qq[e] * __expf(bb[e] - rr[e]);
      a3[e] = kq[e] * __expf(rr[e] - bb[e]);
    }
    *(uint4*)(qT + t * 136 + oc * 8) = make_uint4(cvtpk(a1[0], a1[1]), cvtpk(a1[2], a1[3]), cvtpk(a1[4], a1[5]), cvtpk(a1[6], a1[7]));
    *(uint4*)(qH + t * 136 + oc * 8) = make_uint4(cvtpk(a2[0], a2[1]), cvtpk(a2[2], a2[3]), cvtpk(a2[4], a2[5]), cvtpk(a2[6], a2[7]));
    *(uint4*)(kH + t * 136 + oc * 8) = make_uint4(cvtpk(a3[0], a3[1]), cvtpk(a3[2], a3[3]), cvtpk(a3[4], a3[5]), cvtpk(a3[6], a3[7]));
  }
  __syncthreads();
  if (w < 4) {
    const int ms = w >> 1, ntq = w & 1;
    f32x16 sacc;
#pragma unroll
    for (int r = 0; r < 16; ++r) sacc[r] = 0.f;
#pragma unroll
    for (int ks = 0; ks < 8; ++ks) {
      bf16x8 af = __builtin_bit_cast(bf16x8, *(const uint4*)(kH + (32 * ms + c31) * 136 + 16 * ks + 8 * hi));
      bf16x8 bfv = __builtin_bit_cast(bf16x8, *(const uint4*)(qH + (32 * ntq + c31) * 136 + 16 * ks + 8 * hi));
      sacc = MFMA(af, bfv, sacc);
    }
    const int t = 32 * ntq + c31;
#pragma unroll
    for (int gq = 0; gq < 4; ++gq) {
      const int s0 = 32 * ms + 8 * gq + 4 * hi;
      float v0 = (s0 + 0 <= t) ? sacc[4 * gq + 0] : 0.f;
      float v1 = (s0 + 1 <= t) ? sacc[4 * gq + 1] : 0.f;
      float v2 = (s0 + 2 <= t) ? sacc[4 * gq + 2] : 0.f;
      float v3 = (s0 + 3 <= t) ? sacc[4 * gq + 3] : 0.f;
      uint2 val; val.x = cvtpk(v0, v1); val.y = cvtpk(v2, v3);
      *(uint2*)(P + t * 72 + s0) = val;
    }
  }
  f32x16 oacc;
#pragma unroll
  for (int r = 0; r < 16; ++r) oacc[r] = 0.f;
#pragma unroll
  for (int ks = 0; ks < 8; ++ks) {
    bf16x8 af = __builtin_bit_cast(bf16x8, *(const uint4*)(qT + (32 * mt + c31) * 136 + 16 * ks + 8 * hi));
    oacc = MFMA(af, __builtin_bit_cast(bf16x8, sfr[ks]), oacc);
  }
  __syncthreads();
#pragma unroll
  for (int ks = 0; ks < 4; ++ks) {
    bf16x8 af = __builtin_bit_cast(bf16x8, *(const uint4*)(P + (32 * mt + c31) * 72 + 16 * ks + 8 * hi));
    bf16x8 bfv = __builtin_bit_cast(bf16x8, *(const uint4*)(vT + (32 * nv + c31) * 72 + 16 * ks + 8 * hi));
    oacc = MFMA(af, bfv, oacc);
  }
  float* oL = bL;
#pragma unroll
  for (int r = 0; r < 16; ++r) oL[(32 * mt + crow(r, hi)) * 132 + 32 * nv + c31] = oacc[r];
  __syncthreads();
  {
    const int t = tid >> 3, sg = tid & 7;
    float ov[16];
#pragma unroll
    for (int e = 0; e < 16; e += 4) {
      const float4 f = *(const float4*)(oL + t * 132 + 16 * sg + e);
      ov[e] = f.x; ov[e + 1] = f.y; ov[e + 2] = f.z; ov[e + 3] = f.w;
    }
    float ss = 0.f;
#pragma unroll
    for (int e = 0; e < 16; ++e) ss = fmaf(ov[e], ov[e], ss);
    ss += __shfl_xor(ss, 1);
    ss += __shfl_xor(ss, 2);
    ss += __shfl_xor(ss, 4);
    const float rs = rsqrtf(ss * (1.f / 128.f) + 1e-6f);
    const int tg = 64 * c + t, k0 = 128 * h + 16 * sg;
    const float* ng = p.norm_a_g + (size_t)layer * 512 + k0;
    const uint4 z0 = z0_pre, z1 = z1_pre;
    const float zz[16] = {bflo(z0.x), bfhi(z0.x), bflo(z0.y), bfhi(z0.y), bflo(z0.z), bfhi(z0.z), bflo(z0.w), bfhi(z0.w),
                          bflo(z1.x), bfhi(z1.x), bflo(z1.y), bfhi(z1.y), bflo(z1.z), bfhi(z1.z), bflo(z1.w), bfhi(z1.w)};
    float rr[16];
#pragma unroll
    for (int e = 0; e < 16; ++e) rr[e] = ov[e] * rs * ng[e] * zz[e];
    uint4* aa = (uint4*)(p.ws + O_AA);
    aa[tiled_unit(tg, k0, 32)] = make_uint4(cvtpk(rr[0], rr[1]), cvtpk(rr[2], rr[3]), cvtpk(rr[4], rr[5]), cvtpk(rr[6], rr[7]));
    aa[tiled_unit(tg, k0 + 8, 32)] = make_uint4(cvtpk(rr[8], rr[9]), cvtpk(rr[10], rr[11]), cvtpk(rr[12], rr[13]), cvtpk(rr[14], rr[15]));
  }
  __syncthreads();
}

DI void acc_to_lds_bf16(f32x16 (&acc)[2][2], unsigned short* tile) {
  const int tid = vtid(), lane = tid & 63, w = tid >> 6, wm = w >> 1, wn = w & 1, hi = lane >> 5, c31 = lane & 31;
#pragma unroll
  for (int i = 0; i < 2; ++i)
#pragma unroll
    for (int j = 0; j < 2; ++j)
#pragma unroll
      for (int r = 0; r < 16; ++r)
        tile[(64 * wm + 32 * i + crow(r, hi)) * 128 + 64 * wn + 32 * j + c31] = f2bf(acc[i][j][r]);
}
DI void p5_tile(const Params& p, int mb, int nt) {
  const int tid = vtid(), lane = tid & 63, w = tid >> 6, wm = w >> 1, wn = w & 1, hi = lane >> 5, c31 = lane & 31;
  f32x16 acc[2][2];
  zero_acc(acc);
  gemm_core((const uint4*)(p.ws + O_AA), mb * 8, (const uint4*)(p.ws + O_WUA), nt * 4, 32, acc, (uint4*)smem);
  unsigned uap[2][2][8];
#pragma unroll
  for (int i = 0; i < 2; ++i)
#pragma unroll
    for (int j = 0; j < 2; ++j)
#pragma unroll
      for (int r = 0; r < 16; r += 2) uap[i][j][r >> 1] = cvtpk(acc[i][j][r], acc[i][j][r + 1]);
  zero_acc(acc);
  gemm_core((const uint4*)(p.ws + O_AB), mb * 8, (const uint4*)(p.ws + O_WUB), nt * 4, 32, acc, (uint4*)smem);
  unsigned short* tA = (unsigned short*)smem;
  unsigned short* tB = (unsigned short*)(smem + 65536);
#pragma unroll
  for (int i = 0; i < 2; ++i)
#pragma unroll
    for (int j = 0; j < 2; ++j)
#pragma unroll
      for (int r = 0; r < 16; r += 2) {
        const int o0 = (64 * wm + 32 * i + crow(r, hi)) * 128 + 64 * wn + 32 * j + c31;
        tA[o0] = (unsigned short)(uap[i][j][r >> 1] & 0xffffu);
        tA[o0 + 128] = (unsigned short)(uap[i][j][r >> 1] >> 16);
        tB[o0] = f2bf(acc[i][j][r]);
        tB[o0 + 128] = f2bf(acc[i][j][r + 1]);
      }
  __syncthreads();
  const int row0 = mb * 256;
#pragma unroll 2
  for (int q = 0; q < 8; ++q) {
    const int u = tid + 512 * q, r = u >> 4, c8 = u & 15;
    const uint4 ua = *(const uint4*)&tA[r * 128 + c8 * 8];
    const uint4 ub = *(const uint4*)&tB[r * 128 + c8 * 8];
    const int t = row0 + r, n0 = nt * 128 + c8 * 8;
    const uint4 ga = *(const uint4*)(p.ws + O_SGA + ((size_t)t * 1024 + n0) * 2);
    const uint4 gb = *(const uint4*)(p.ws + O_SGB + ((size_t)t * 1024 + n0) * 2);
    uint4 o;
    o.x = cvtpk(bflo(ga.x) * bflo(ua.x) + bflo(gb.x) * bflo(ub.x), bfhi(ga.x) * bfhi(ua.x) + bfhi(gb.x) * bfhi(ub.x));
    o.y = cvtpk(bflo(ga.y) * bflo(ua.y) + bflo(gb.y) * bflo(ub.y), bfhi(ga.y) * bfhi(ua.y) + bfhi(gb.y) * bfhi(ub.y));
    o.z = cvtpk(bflo(ga.z) * bflo(ua.z) + bflo(gb.z) * bflo(ub.z), bfhi(ga.z) * bfhi(ua.z) + bfhi(gb.z) * bfhi(ub.z));
    o.w = cvtpk(bflo(ga.w) * bflo(ua.w) + bflo(gb.w) * bflo(ub.w), bfhi(ga.w) * bfhi(ua.w) + bfhi(gb.w) * bfhi(ub.w));
    ((uint4*)(p.ws + O_MG))[tiled_unit(t, n0, 64)] = o;
  }
  __syncthreads();
}

DI void p6_tile(const Params& p, int layer, int mb, int nt) {
  const int tid = vtid(), lane = tid & 63, w = tid >> 6, wm = w >> 1, wn = w & 1, hi = lane >> 5, c31 = lane & 31;
  f32x16 acc[2][2];
  zero_acc(acc);
  gemm_core((const uint4*)(p.ws + O_MG), mb * 8, (const uint4*)(p.ws + O_WOUT), nt * 4, 64, acc, (uint4*)smem);
  const float* hin = (layer == 0) ? p.x : p.out;
#pragma unroll
  for (int i = 0; i < 2; ++i)
#pragma unroll
    for (int j = 0; j < 2; ++j)
#pragma unroll
      for (int r = 0; r < 16; ++r) {
        const size_t idx = (size_t)(mb * 256 + 64 * wm + 32 * i + crow(r, hi)) * DM + nt * 128 + 64 * wn + 32 * j + c31;
        p.out[idx] = fmaf(ALPHA_, hin[idx], acc[i][j][r]);
      }
}

DI float dpp_add_f(float v, int which) {
  const int iv = __builtin_bit_cast(int, v);
  int r;
  switch (which) {
    case 0: r = __builtin_amdgcn_update_dpp(0, iv, 0x111, 0xf, 0xf, true); break;
    case 1: r = __builtin_amdgcn_update_dpp(0, iv, 0x112, 0xf, 0xf, true); break;
    case 2: r = __builtin_amdgcn_update_dpp(0, iv, 0x114, 0xf, 0xf, true); break;
    case 3: r = __builtin_amdgcn_update_dpp(0, iv, 0x118, 0xf, 0xf, true); break;
    default: r = __builtin_amdgcn_update_dpp(0, iv, 0x142, 0xa, 0xf, false); break;
  }
  return v + __builtin_bit_cast(float, r);
}
DI float half_sum_to_last(float v) {
  v = dpp_add_f(v, 0); v = dpp_add_f(v, 1); v = dpp_add_f(v, 2); v = dpp_add_f(v, 3); v = dpp_add_f(v, 4);
  return v;
}
DI void fused_out_ln(const Params& p, int layer, int mb64) {
  const int tid = vtid(), lane = tid & 63, w = tid >> 6, hi = lane >> 5, c31 = lane & 31;
  uint4* lds = (uint4*)smem;
  const uint4* A = (const uint4*)(p.ws + O_MG) + (size_t)(2 * mb64) * 64 * 64;
#pragma unroll
  for (int r = 0; r < 16; ++r)
    __builtin_amdgcn_global_load_lds((const unsigned*)(A + tid + 512 * r), (unsigned*)(lds + tid + 512 * r), 16, 0, 0);
  float* lnf = (float*)(smem + 131072);
  {
    const float* src_ = (tid < 256) ? (p.ln_g + (size_t)layer * DM) : (p.ln_b + (size_t)layer * DM);
    ((float4*)lnf)[tid] = ((const float4*)src_)[tid & 255];
  }
  const uint4* Bw = (const uint4*)(p.ws + O_WOUT) + (size_t)(4 * w) * 64 * 64 + lane;
  uint4 bq[4][4];
#pragma unroll
  for (int s_ = 0; s_ < 4; ++s_)
#pragma unroll
    for (int j = 0; j < 4; ++j) bq[s_][j] = Bw[(size_t)(j * 64 + s_) * 64];
  f32x16 acc[2][4];
#pragma unroll
  for (int i = 0; i < 2; ++i)
#pragma unroll
    for (int j = 0; j < 4; ++j)
#pragma unroll
      for (int r = 0; r < 16; ++r) acc[i][j][r] = 0.f;
  __syncthreads();
#pragma unroll 1
  for (int k4 = 0; k4 < 16; ++k4) {
#pragma unroll
    for (int s_ = 0; s_ < 4; ++s_) {
      const int ks = 4 * k4 + s_;
      const bf16x8 a0 = __builtin_bit_cast(bf16x8, lds[ks * 64 + lane]);
      const bf16x8 a1 = __builtin_bit_cast(bf16x8, lds[4096 + ks * 64 + lane]);
#pragma unroll
      for (int j = 0; j < 4; ++j) {
        const bf16x8 b = __builtin_bit_cast(bf16x8, bq[s_][j]);
        acc[0][j] = MFMA(a0, b, acc[0][j]);
        acc[1][j] = MFMA(a1, b, acc[1][j]);
      }
      if (k4 < 15) {
#pragma unroll
        for (int j = 0; j < 4; ++j) bq[s_][j] = Bw[(size_t)(j * 64 + ks + 4) * 64];
      }
    }
  }
  const float* hin = (layer == 0) ? p.x : p.out;
  float* ft = (float*)smem;
  uint2* hb2 = (uint2*)(p.ws + O_HB);
  const int rr = tid >> 4, seg = tid & 15;
#pragma unroll
  for (int i = 0; i < 2; ++i) {
    __syncthreads();
    float4 hvv[16];
    {
      const float* hrow_ = hin + (size_t)(64 * mb64 + 32 * i + rr) * DM + 4 * seg;
#pragma unroll
      for (int e = 0; e < 16; ++e) hvv[e] = *(const float4*)(hrow_ + 64 * e);
    }
    {
      float* b0 = ft + (4 * hi) * 1024 + 128 * w + c31;
      float* b1 = b0 + 16 * 1024;
#pragma unroll
      for (int j = 0; j < 4; ++j)
#pragma unroll
        for (int r = 0; r < 16; ++r) {
          float* bp = (r < 8) ? b0 : b1;
          bp[((r & 3) + 8 * ((r >> 2) & 1)) * 1024 + 32 * j] = acc[i][j][r];
        }
    }
    __syncthreads();
    const int trow = 64 * mb64 + 32 * i + rr;
    float s1 = 0.f, s2 = 0.f;
    float* frow = ft + rr * 1024 + 4 * seg;
#pragma unroll
    for (int e = 0; e < 16; ++e) {
      const float4 y = *(const float4*)(frow + 64 * e);
      const float4 hv = hvv[e];
      float4 pre;
      pre.x = fmaf(ALPHA_, hv.x, y.x); pre.y = fmaf(ALPHA_, hv.y, y.y); pre.z = fmaf(ALPHA_, hv.z, y.z); pre.w = fmaf(ALPHA_, hv.w, y.w);
      s1 += (pre.x + pre.y) + (pre.z + pre.w);
      s2 = fmaf(pre.x, pre.x, s2); s2 = fmaf(pre.y, pre.y, s2); s2 = fmaf(pre.z, pre.z, s2); s2 = fmaf(pre.w, pre.w, s2);
      *(float4*)(frow + 64 * e) = pre;
    }
    s1 += __shfl_xor(s1, 1); s1 += __shfl_xor(s1, 2); s1 += __shfl_xor(s1, 4); s1 += __shfl_xor(s1, 8);
    s2 += __shfl_xor(s2, 1); s2 += __shfl_xor(s2, 2); s2 += __shfl_xor(s2, 4); s2 += __shfl_xor(s2, 8);
    const float mu = s1 * (1.f / 1024.f);
    const float rs = rsqrtf(fmaxf(s2 * (1.f / 1024.f) - mu * mu, 0.f) + 1e-5f);
    float* orow = p.out + (size_t)trow * DM;
#pragma unroll 4
    for (int e = 0; e < 16; ++e) {
      const int c0 = 64 * e + 4 * seg;
      const float4 pre = *(const float4*)(frow + 64 * e);
      const float4 g4 = *(const float4*)(lnf + c0), b4 = *(const float4*)(lnf + 1024 + c0);
      float4 o;
      o.x = (pre.x - mu) * rs * g4.x + b4.x; o.y = (pre.y - mu) * rs * g4.y + b4.y;
      o.z = (pre.z - mu) * rs * g4.z + b4.z; o.w = (pre.w - mu) * rs * g4.w + b4.w;
      *(float4*)(orow + c0) = o;
      hb2[((size_t)trow * 1024 + c0) >> 2] = make_uint2(cvtpk(o.x, o.y), cvtpk(o.z, o.w));
    }
  }
  __syncthreads();
}

DI void p7_rows(const Params& p, int layer) {
  const int tid = vtid();
  const int lane = tid & 63, gw = blockIdx.x * 8 + (tid >> 6), nw = gridDim.x * 8;
  const float* g = p.ln_g + (size_t)layer * DM;
  const float* bb = p.ln_b + (size_t)layer * DM;
  uint4* hb = (uint4*)(p.ws + O_HB);
  for (int t = gw; t < L_; t += nw) {
    float* row = p.out + (size_t)t * DM;
    float v[16];
#pragma unroll
    for (int q = 0; q < 2; ++q) {
      const float4 a = *(const float4*)(row + q * 512 + lane * 8), b = *(const float4*)(row + q * 512 + lane * 8 + 4);
      v[8 * q + 0] = a.x; v[8 * q + 1] = a.y; v[8 * q + 2] = a.z; v[8 * q + 3] = a.w;
      v[8 * q + 4] = b.x; v[8 * q + 5] = b.y; v[8 * q + 6] = b.z; v[8 * q + 7] = b.w;
    }
    float s = 0.f;
#pragma unroll
    for (int e = 0; e < 16; ++e) s += v[e];
#pragma unroll
    for (int off = 1; off < 64; off <<= 1) s += __shfl_xor(s, off);
    const float mu = s * (1.f / 1024.f);
    float ss = 0.f;
#pragma unroll
    for (int e = 0; e < 16; ++e) { const float d = v[e] - mu; ss = fmaf(d, d, ss); }
#pragma unroll
    for (int off = 1; off < 64; off <<= 1) ss += __shfl_xor(ss, off);
    const float rs = rsqrtf(ss * (1.f / 1024.f) + 1e-5f);
#pragma unroll
    for (int q = 0; q < 2; ++q) {
      const int k0 = q * 512 + lane * 8;
      float o[8];
#pragma unroll
      for (int e = 0; e < 8; ++e) o[e] = (v[8 * q + e] - mu) * rs * g[k0 + e] + bb[k0 + e];
      *(float4*)(row + k0) = make_float4(o[0], o[1], o[2], o[3]);
      *(float4*)(row + k0 + 4) = make_float4(o[4], o[5], o[6], o[7]);
      hb[tiled_unit(t, k0, 64)] = make_uint4(cvtpk(o[0], o[1]), cvtpk(o[2], o[3]), cvtpk(o[4], o[5]), cvtpk(o[6], o[7]));
    }
  }
}


#define XB_TMO      128
#define XB_XCNT(j)  (256  + 64 * (j))
#define XB_XSUB(j)  (1280 + 64 * (j))
#define XB_XGEN(j)  (2304 + 64 * (j))
#define XB_TOP      3328
#define XB_TOPGEN   3392
#define XCD_BAR_WORDS 3456
#define XB_SPIN_CAP (1u << 22)
#define LAS __attribute__((address_space(3)))
DI unsigned xb_ld(unsigned* p)              { return __hip_atomic_load(p, __ATOMIC_RELAXED, __HIP_MEMORY_SCOPE_AGENT); }
DI unsigned xb_add(unsigned* p, unsigned v) { return __hip_atomic_fetch_add(p, v, __ATOMIC_RELAXED, __HIP_MEMORY_SCOPE_AGENT); }
DI unsigned xb_xcc_id() { return (unsigned)__builtin_amdgcn_s_getreg((3 << 11) | 20) & 0xFu; }
#define XB_SPIN(cond, bar) do { unsigned _sp = 0; while (cond) { __builtin_amdgcn_s_sleep(1); \
    if ((++_sp & 255u) == 0u) { if (xb_ld(&(bar)[XB_TMO])) break; if (_sp > XB_SPIN_CAP) { atomicAdd(&(bar)[XB_TMO], 1u); break; } } } } while (0)
struct XcdBarrier { unsigned* bar; unsigned x; volatile LAS unsigned* st; };
DI XcdBarrier xcd_barrier_post(unsigned* bar, volatile LAS unsigned* st) {
  XcdBarrier b; b.bar = bar; b.x = xb_xcc_id(); b.st = st;
  if (threadIdx.x == 0) (void)xb_add(&bar[XB_XCNT(b.x)], 1u);
  return b;
}
DI void xcd_barrier_complete(unsigned* bar, unsigned x, unsigned& nloc, unsigned& nx) {
  const unsigned G = gridDim.x * gridDim.y * gridDim.z;
  unsigned sum, cnt, mine, sp = 0u;
  for (;;) {
    sum = 0u; cnt = 0u; mine = 0u;
#pragma unroll
    for (unsigned j = 0; j < 16; ++j) { const unsigned c = xb_ld(&bar[XB_XCNT(j)]); sum += c; cnt += (c > 0u) ? 1u : 0u; mine = (j == x) ? c : mine; }
    if (sum == G) break;
    __builtin_amdgcn_s_sleep(1);
    if ((++sp & 255u) == 0u) { if (xb_ld(&bar[XB_TMO])) break; if (sp > XB_SPIN_CAP) { atomicAdd(&bar[XB_TMO], 1u); break; } }
  }
  nloc = mine > 0u ? mine : 1u; nx = cnt > 0u ? cnt : 1u;
}
DI void xcd_barrier(const XcdBarrier& b) {
  asm volatile("s_waitcnt vmcnt(0)" ::: "memory");
  __syncthreads();
  if (threadIdx.x == 0) {
    unsigned* bar = b.bar;
    __builtin_amdgcn_s_waitcnt(0);
    unsigned nloc = b.st[0], nx = b.st[1];
    if (nloc == 0u) { xcd_barrier_complete(bar, b.x, nloc, nx); b.st[0] = nloc; b.st[1] = nx; }
    const unsigned old = xb_add(&bar[XB_XSUB(b.x)], 1u);
    const unsigned gen = old / nloc;
    if (old + 1u == (gen + 1u) * nloc) {
      __builtin_amdgcn_fence(__ATOMIC_RELEASE, "agent");
      asm volatile("s_waitcnt vmcnt(0)" ::: "memory");
      const unsigned og = xb_add(&bar[XB_TOP], 1u);
      const unsigned tg = og / nx;
      if (og + 1u == (tg + 1u) * nx) xb_add(&bar[XB_TOPGEN], 1u);
      else XB_SPIN(xb_ld(&bar[XB_TOPGEN]) == tg, bar);
      __builtin_amdgcn_fence(__ATOMIC_ACQUIRE, "agent");
      xb_add(&bar[XB_XGEN(b.x)], 1u);
      asm volatile("s_waitcnt vmcnt(0)" ::: "memory");
    } else {
      XB_SPIN(xb_ld(&bar[XB_XGEN(b.x)]) == gen, bar);
      __builtin_amdgcn_fence(__ATOMIC_ACQUIRE, "agent");
      asm volatile("s_waitcnt vmcnt(0)" ::: "memory");
    }
  }
  __syncthreads();
}
constexpr int LDS_BARST = 163840 - 16;

__global__ void __launch_bounds__(512) mk(Params p) {
  cg::grid_group grid = cg::this_grid();
  const int nb = gridDim.x, bid = blockIdx.x;
  volatile LAS unsigned* bst_ = (volatile LAS unsigned*)(smem + LDS_BARST);
  if (threadIdx.x < 4) bst_[threadIdx.x] = 0u;
  __syncthreads();
  (void)xcd_barrier_post((unsigned*)(p.ws + O_BAR), bst_);
#define XB_NOW() XcdBarrier{(unsigned*)(p.ws + O_BAR), xb_xcc_id(), (volatile LAS unsigned*)(smem + LDS_BARST)}
  phase0(p);
  grid.sync();
  for (int layer = 0; layer < DEPTH_; ++layer) {
    {
      const int gtid = bid * 512 + vtid(), gthreads = nb * 512;
      conv_weight(p.w_up_a + (size_t)layer * 512 * 1024, 512, 1024, 1024, false, (uint4*)(p.ws + O_WUA), gtid, gthreads);
      conv_weight(p.w_up_b + (size_t)layer * 512 * 1024, 512, 1024, 1024, false, (uint4*)(p.ws + O_WUB), gtid, gthreads);
      conv_weight(p.w_out + (size_t)layer * 1024 * 1024, 1024, 1024, 1024, false, (uint4*)(p.ws + O_WOUT), gtid, gthreads);
#ifndef NO_P1
      if ((64 * 27) % nb != 0 && bid >= (64 * 27) % nb) { for (int i_ = 0; i_ < 4; ++i_) __builtin_amdgcn_s_sleep(127); }
      for (int id = bid; id < 64 * 27; id += nb) p1_tile8(p, layer, id & 63, id >> 6);
#endif
    }
    xcd_barrier(XB_NOW());
    {
      if (layer + 1 < DEPTH_) {
        const int gtid = bid * 512 + vtid(), gthreads = nb * 512;
        conv_weight_rm(p.w_in + (size_t)(layer + 1) * 1024 * NIN, 1024, NIN, NPAD, true, (uint4*)(p.ws + O_WTIN), gtid, gthreads);
      }
#ifndef NO_HA
      for (int id = bid; id < 1024; id += nb) hgrn_a_item(p, id >> 2, id & 3);
#endif
      for (int s = bid; s < 1024; s += nb) {
        const int rnd = s / nb, pos = s - rnd * nb;
        const int rem = 1024 - rnd * nb, count = rem < nb ? rem : nb;
        const int sp = (rnd & 1) ? (rnd * nb + count - 1 - pos) : s;
        indexer_item(p, 1023 - sp);
      }
    }
    xcd_barrier(XB_NOW());
    {
      attn_setup();
      const int tid = vtid();
      if (tid < 256) ((float*)(smem + AT_RB))[tid] = p.rel_bias[tid];
      __syncthreads();
#ifndef NO_SCAN
      hgrn_scan(p);
#endif
      const int w = tid >> 6, lane = tid & 63;
#ifndef NO_ATT
      { QKPF pf; qk_fetch(p, bid * 8 + w, lane, pf);
        for (int t = bid * 8 + w; t < L_; t += nb * 8) attn_query(p, t, t + nb * 8, w, lane, pf); }
#endif
      __syncthreads();
    }
    {
      const int tid = vtid();
      const int w = tid >> 6, lane = tid & 63;
      for (int t = bid * 8 + w; t < L_; t += nb * 8) attn_pv_query(p, t, w, lane);
      __syncthreads();
    }
    xcd_barrier(XB_NOW());
#ifndef NO_HC
    for (int id = bid; id < 1024; id += nb) hgrn_c_item(p, layer, id >> 2, id & 3);
#endif
    xcd_barrier(XB_NOW());
#ifndef NO_P5
    for (int id = bid; id < 64 * 8; id += nb) p5_tile(p, id & 63, id >> 6);
#endif
    xcd_barrier(XB_NOW());
    for (int id = bid; id < 256; id += nb) fused_out_ln(p, layer, id);
    xcd_barrier(XB_NOW());
  }}

extern "C" void kernel_launch(void* const* d_in, const int* in_sizes, int n_in, void* d_out, int out_size, void* d_ws,
                              size_t ws_size, hipStream_t stream) {
  constexpr size_t kLds = 160 * 1024;
  static int grid_blocks = 0;
  if (!grid_blocks) {
    int dev = 0, cus = 0, per_cu = 0;
    (void)hipGetDevice(&dev);
    (void)hipDeviceGetAttribute(&cus, hipDeviceAttributeMultiprocessorCount, dev);
    (void)hipFuncSetAttribute((const void*)mk, hipFuncAttributeMaxDynamicSharedMemorySize, (int)kLds);
    (void)hipOccupancyMaxActiveBlocksPerMultiprocessor(&per_cu, mk, 512, kLds);
    if (per_cu > 1) per_cu = 1;
    grid_blocks = cus * per_cu;
  }
  if (ws_size < WS_NEED || grid_blocks <= 0) { fprintf(stderr, "ws too small or no occupancy\n"); return; }
  Params p{};
  p.x = (const float*)d_in[0]; p.w_in = (const float*)d_in[1]; p.b_in = (const float*)d_in[2];
  p.w_up_a = (const float*)d_in[3]; p.w_up_b = (const float*)d_in[4]; p.w_out = (const float*)d_in[5];
  p.lb_logits = (const float*)d_in[6]; p.norm_a_g = (const float*)d_in[7]; p.rel_bias = (const float*)d_in[8];
  p.ln_g = (const float*)d_in[9]; p.ln_b = (const float*)d_in[10];
  p.out = (float*)d_out; p.ws = (char*)d_ws;
  (void)hipMemsetAsync((char*)d_ws + O_BAR, 0, XCD_BAR_WORDS * 4, stream);
  void* args[] = {&p};
  hipError_t e = hipLaunchCooperativeKernel((void*)mk, dim3(grid_blocks), dim3(512), args, kLds, stream);
  if (e != hipSuccess) fprintf(stderr, "cooperative launch failed: %s (grid %d)\n", hipGetErrorString(e), grid_blocks);
}
```
